# Optimizing an MI355X kernel written in HIP

```python
import jax
import jax.numpy as jnp
from jax import lax
import numpy as np

D_MODEL = 1024
BATCH = 2
SEQ = 8192
DEPTH = 2

HEAD_DIM = 64
Q_BLOCK = 128
MIX_W = 256
N_BRANCH = 4
SB_HEADS = 4
NSA_HEADS = 4
NSA_GATES = 3
CMP_LEN = 32
CMP_STRIDE = 16
SEL_LEN = 64
SEL_TOPK = 16
WINDOW = 512
RET_HEADS = 4
RET_CHUNK = 128
GLA_HEADS = 4
GLA_DK = 32
GLA_DV = 64
GLA_LOWRANK = 16
GLA_TAU = 16.0
GLA_CHUNK = 64
PEER_HEADS = 8
N_KEYS = 128
N_EXPERTS = N_KEYS * N_KEYS
PEER_TOPK = 16
PEER_QDIM = 256
PEER_BLOCK = 128
DN_ALPHA = (2 * DEPTH) ** 0.25
DN_BETA = (8 * DEPTH) ** -0.25
LN_EPS = 1e-5
NEG = -1e30

IN_WIDTHS = (
    MIX_W, MIX_W, MIX_W,
    NSA_HEADS * HEAD_DIM,
    HEAD_DIM, HEAD_DIM, HEAD_DIM, HEAD_DIM, HEAD_DIM, HEAD_DIM,
    NSA_HEADS * NSA_GATES,
    MIX_W, MIX_W, MIX_W, MIX_W,
    GLA_HEADS * GLA_DK, GLA_HEADS * GLA_DK,
    GLA_HEADS * GLA_DV, GLA_HEADS * GLA_DV,
    GLA_LOWRANK,
    N_BRANCH * D_MODEL,
)
IN_TOTAL = sum(IN_WIDTHS)

kernel_name = 'hybrid_sb_nsa_ret_gla_peer_deepnorm'


def _layer_norm(x, g, b):
    xf = x.astype(jnp.float32)
    mu = jnp.mean(xf, axis=-1, keepdims=True)
    var = jnp.mean(jnp.square(xf - mu), axis=-1, keepdims=True)
    return ((xf - mu) * lax.rsqrt(var + LN_EPS) * g + b).astype(x.dtype)


def _split(h, widths):
    cuts = [int(c) for c in np.cumsum(widths)[:-1]]
    return jnp.split(h, cuts, axis=-1)


def _heads(t, n):
    B, S, _ = t.shape
    return t.reshape(B, S, n, -1).transpose(0, 2, 1, 3)


def _merge_heads(t):
    B, H, S, d = t.shape
    return t.transpose(0, 2, 1, 3).reshape(B, S, H * d)


def _alibi_slopes(n):
    return 2.0 ** (-8.0 * jnp.arange(1, n + 1, dtype=jnp.float32) / n)


def _masked_softmax(s, mask):
    return jax.nn.softmax(jnp.where(mask, s, NEG), axis=-1)


def _band(t, n_prev):
    B, S, D = t.shape
    nb = S // Q_BLOCK
    tp = jnp.pad(t, ((0, 0), (n_prev * Q_BLOCK, 0), (0, 0))).reshape(B, nb + n_prev, Q_BLOCK, D)
    return jnp.concatenate([tp[:, j:j + nb] for j in range(n_prev + 1)], axis=2)


def stick_breaking_attention(q, k, v):
    B, H, S, Dh = q.shape
    nb = S // Q_BLOCK
    scale = Dh ** -0.5
    s_pos = jnp.arange(S)
    qb = q.reshape(B, H, nb, Q_BLOCK, Dh).transpose(2, 0, 1, 3, 4)

    def one_block(args):
        qi, i = args
        z = jnp.einsum('bhqd,bhsd->bhqs', qi, k).astype(jnp.float32) * scale
        t_pos = i * Q_BLOCK + jnp.arange(Q_BLOCK)
        causal = s_pos[None, :] < t_pos[:, None]
        log_1mb = jnp.where(causal, jax.nn.log_sigmoid(-z), 0.0)
        between = lax.cumsum(log_1mb, axis=3, reverse=True) - log_1mb
        w = jnp.where(causal, jnp.exp(jax.nn.log_sigmoid(z) + between), 0.0)
        return jnp.einsum('bhqs,bhsd->bhqd', w.astype(v.dtype), v)

    o = lax.map(one_block, (qb, jnp.arange(nb)))
    return o.transpose(1, 2, 0, 3, 4).reshape(B, H, S, Dh)


def nsa_attention(q, k_cmp, v_cmp, k_slc, v_slc, k_win, v_win, gate_logits, cmp_pos, cmp_wk, cmp_wv):
    B, H, S, Dh = q.shape
    f32 = jnp.float32
    scale = Dh ** -0.5
    slopes = _alibi_slopes(H)[None, :, None, None]
    t_pos = jnp.arange(S)
    nb = S // Q_BLOCK
    t_blk = t_pos.reshape(nb, Q_BLOCK)

    n_cmp = (S - CMP_LEN) // CMP_STRIDE + 1
    tok = jnp.arange(n_cmp)[:, None] * CMP_STRIDE + jnp.arange(CMP_LEN)[None, :]

    def compress(kv, w):
        blk = kv[:, tok] + cmp_pos
        return blk.reshape(B, n_cmp, CMP_LEN * Dh) @ w

    kc = compress(k_cmp, cmp_wk)
    vc = compress(v_cmp, cmp_wv)
    cmp_end = jnp.arange(n_cmp) * CMP_STRIDE + CMP_LEN - 1
    d_c = (t_pos[:, None] - cmp_end[None, :]).astype(f32)
    s_c = jnp.einsum('bhtd,bcd->bhtc', q, kc).astype(f32) * scale - slopes * d_c
    any_c = (t_pos >= CMP_LEN - 1).astype(f32)[:, None]
    p_c = _masked_softmax(s_c, d_c >= 0) * any_c
    o_cmp = jnp.einsum('bhtc,bcd->bhtd', p_c.astype(vc.dtype), vc)

    n_sel = S // SEL_LEN
    c_start = jnp.arange(n_cmp) * CMP_STRIDE
    sel_start = jnp.arange(n_sel) * SEL_LEN
    overlap = ((c_start[:, None] < sel_start[None, :] + SEL_LEN)
               & (c_start[:, None] + CMP_LEN > sel_start[None, :])).astype(f32)
    imp = jnp.einsum('bhtc,cn->btn', p_c, overlap)
    imp = jnp.where(sel_start[None, :] > t_pos[:, None], NEG, imp)
    imp = jnp.where(jnp.arange(n_sel)[None, :] == (t_pos // SEL_LEN)[:, None], -NEG, imp)
    n_top = min(SEL_TOPK, n_sel)
    _, sel_idx = lax.top_k(imp, n_top)

    qb = q.reshape(B, H, nb, Q_BLOCK, Dh).transpose(2, 0, 1, 3, 4)
    ib = sel_idx.reshape(B, nb, Q_BLOCK, n_top).transpose(1, 0, 2, 3)
    b_ix = jnp.arange(B)[:, None, None]

    def sel_block(args):
        qi, ii, ti = args
        pos = (ii[..., None] * SEL_LEN + jnp.arange(SEL_LEN)).reshape(B, Q_BLOCK, n_top * SEL_LEN)
        kk = k_slc[b_ix, pos]
        vv = v_slc[b_ix, pos]
        dist = (ti[None, :, None] - pos).astype(f32)
        s = jnp.einsum('bhqd,bqld->bhql', qi, kk).astype(f32) * scale - slopes * dist[:, None]
        p = _masked_softmax(s, (dist >= 0)[:, None])
        return jnp.einsum('bhql,bqld->bhqd', p.astype(vv.dtype), vv)

    o_slc = lax.map(sel_block, (qb, ib, t_blk)).transpose(1, 2, 0, 3, 4).reshape(B, H, S, Dh)

    n_prev = WINDOW // Q_BLOCK
    Lw = (n_prev + 1) * Q_BLOCK
    kw = _band(k_win, n_prev)
    vw = _band(v_win, n_prev)
    key_pos = (jnp.arange(nb)[:, None] - n_prev) * Q_BLOCK + jnp.arange(Lw)[None, :]
    dist_w = t_blk[:, :, None] - key_pos[:, None, :]
    mask_w = (dist_w >= 0) & (dist_w < WINDOW) & (key_pos[:, None, :] >= 0)
    s_w = (jnp.einsum('bhnqd,bnld->bhnql', q.reshape(B, H, nb, Q_BLOCK, Dh), kw).astype(f32) * scale
           - slopes[..., None] * dist_w.astype(f32))
    p_w = _masked_softmax(s_w, mask_w)
    o_win = jnp.einsum('bhnql,bnld->bhnqd', p_w.astype(vw.dtype), vw).reshape(B, H, S, Dh)

    g = jax.nn.sigmoid(gate_logits.astype(f32)).reshape(B, S, H, NSA_GATES).transpose(0, 2, 1, 3).astype(q.dtype)
    return g[..., 0:1] * o_cmp + g[..., 1:2] * o_slc + g[..., 2:3] * o_win


def retention_block(q, k, v, gate, gn_g, gn_b):
    B, S, _ = q.shape
    H = RET_HEADS
    Dh = MIX_W // H
    C = RET_CHUNK
    n = S // C
    f32 = jnp.float32
    log_g = jnp.log1p(-(2.0 ** (-5.0 - jnp.arange(H, dtype=f32))))
    idx = jnp.arange(C, dtype=f32)
    diff = idx[:, None] - idx[None, :]
    decay_in = jnp.where(diff >= 0, jnp.exp(log_g[:, None, None] * jnp.maximum(diff, 0.0)), 0.0)
    q_decay = jnp.exp(log_g[:, None] * (idx + 1.0))[None, :, :, None]
    k_decay = jnp.exp(log_g[:, None] * (C - 1.0 - idx))[None, :, :, None]
    chunk_decay = jnp.exp(log_g * C)[None, :, None, None]

    def chunks(t):
        return t.reshape(B, H, n, C, Dh).transpose(2, 0, 1, 3, 4).astype(f32)

    qc = chunks(_heads(q, H))
    kc = chunks(_heads(k, H) * Dh ** -0.5)
    vc = chunks(_heads(v, H))

    def step(R, inp):
        qi, ki, vi = inp
        att = jnp.einsum('bhid,bhjd->bhij', qi, ki) * decay_in
        o = jnp.einsum('bhij,bhjd->bhid', att, vi) + jnp.einsum('bhid,bhde->bhie', qi, R) * q_decay
        R = chunk_decay * R + jnp.einsum('bhjd,bhje->bhde', ki * k_decay, vi)
        return R, o

    _, o = lax.scan(step, jnp.zeros((B, H, Dh, Dh), f32), (qc, kc, vc))
    o = o.transpose(1, 2, 0, 3, 4).reshape(B, H, S, Dh)
    mu = jnp.mean(o, axis=-1, keepdims=True)
    var = jnp.mean(jnp.square(o - mu), axis=-1, keepdims=True)
    o = _merge_heads((o - mu) * lax.rsqrt(var + LN_EPS)) * gn_g + gn_b
    return (jax.nn.silu(gate.astype(f32)) * o).astype(q.dtype)


def gla_block(q, k, v, r, lr, w_alpha, b_alpha, norm_g):
    B, S, _ = q.shape
    H = GLA_HEADS
    C = GLA_CHUNK
    n = S // C
    f32 = jnp.float32
    log_a = jax.nn.log_sigmoid((lr @ w_alpha + b_alpha).astype(f32)) / GLA_TAU

    def chunks(t, d):
        return t.reshape(B, n, C, H, d).transpose(1, 0, 3, 2, 4).astype(f32)

    qc = chunks(q * GLA_DK ** -0.5, GLA_DK)
    kc = chunks(k, GLA_DK)
    vc = chunks(v, GLA_DV)
    ac = chunks(log_a, GLA_DK)
    causal = jnp.tril(jnp.ones((C, C), dtype=bool))[:, :, None]

    def step(St, inp):
        qi, ki, vi, ai = inp
        b = jnp.cumsum(ai, axis=2)
        inter = jnp.einsum('bhtk,bhkv->bhtv', qi * jnp.exp(b), St)
        diff = b[:, :, :, None, :] - b[:, :, None, :, :]
        decay = jnp.where(causal, jnp.exp(jnp.where(causal, diff, 0.0)), 0.0)
        att = jnp.einsum('bhtk,bhsk,bhtsk->bhts', qi, ki, decay)
        intra = jnp.einsum('bhts,bhsv->bhtv', att, vi)
        b_last = b[:, :, -1, :]
        St = jnp.exp(b_last)[..., None] * St + jnp.einsum('bhsk,bhsv->bhkv', ki * jnp.exp(b_last[:, :, None, :] - b), vi)
        return St, inter + intra

    _, o = lax.scan(step, jnp.zeros((B, H, GLA_DK, GLA_DV), f32), (qc, kc, vc, ac))
    o = o.transpose(1, 0, 3, 2, 4).reshape(B, S, H, GLA_DV)
    o = (o * lax.rsqrt(jnp.mean(jnp.square(o), axis=-1, keepdims=True) + LN_EPS)).reshape(B, S, H * GLA_DV) * norm_g
    return (jax.nn.silu(r.astype(f32)) * o).astype(q.dtype)


def peer_ffn(x, wq, sub_keys, u_tab, v_tab):
    B, S, D = x.shape
    nb = S // PEER_BLOCK
    half = PEER_QDIM // 2
    K = PEER_TOPK
    xb = x.reshape(B, nb, PEER_BLOCK, D).transpose(1, 0, 2, 3)

    def block(xi):
        qv = (xi @ wq).reshape(B, PEER_BLOCK, PEER_HEADS, 2, half)
        s = jnp.einsum('bthpc,hpnc->bthpn', qv, sub_keys).astype(jnp.float32)
        top_s, top_i = lax.top_k(s, K)
        cand_s = (top_s[..., 0, :, None] + top_s[..., 1, None, :]).reshape(B, PEER_BLOCK, PEER_HEADS, K * K)
        cand_i = (top_i[..., 0, :, None] * N_KEYS + top_i[..., 1, None, :]).reshape(B, PEER_BLOCK, PEER_HEADS, K * K)
        best_s, best_j = lax.top_k(cand_s, K)
        expert = jnp.take_along_axis(cand_i, best_j, axis=-1)
        gate = jax.nn.softmax(best_s, axis=-1)
        act = jax.nn.gelu(jnp.einsum('btd,bthkd->bthk', xi, u_tab[expert]).astype(jnp.float32), approximate=False)
        return jnp.einsum('bthk,bthkd->btd', (gate * act).astype(xi.dtype), v_tab[expert])

    return lax.map(block, xb).transpose(1, 0, 2, 3).reshape(B, S, D)


def hybrid_layer(x, w_in, cmp_pos, cmp_wk, cmp_wv, ret_gn_g, ret_gn_b, gla_w_alpha, gla_b_alpha,
                 gla_norm_g, w_branch, w_out, ln1_g, ln1_b, peer_wq, peer_keys, peer_u, peer_v, ln2_g, ln2_b):
    B, S, D = x.shape
    f32 = jnp.float32
    (sb_q, sb_k, sb_v, n_q, n_kc, n_vc, n_ks, n_vs, n_kw, n_vw, n_g,
     r_q, r_k, r_v, r_g, g_q, g_k, g_v, g_r, g_lr, m_g) = _split(x @ w_in, IN_WIDTHS)

    o_a = _merge_heads(stick_breaking_attention(_heads(sb_q, SB_HEADS), _heads(sb_k, SB_HEADS), _heads(sb_v, SB_HEADS)))
    o_b = _merge_heads(nsa_attention(_heads(n_q, NSA_HEADS), n_kc, n_vc, n_ks, n_vs, n_kw, n_vw, n_g,
                                     cmp_pos, cmp_wk, cmp_wv))
    o_c = retention_block(r_q, r_k, r_v, r_g, ret_gn_g, ret_gn_b)
    o_d = gla_block(g_q, g_k, g_v, g_r, g_lr, gla_w_alpha, gla_b_alpha, gla_norm_g)

    branches = jnp.stack([o_a, o_b, o_c, o_d], axis=2)
    proj = jnp.einsum('bsnc,ncd->bsnd', branches, w_branch)
    gates = jax.nn.sigmoid(m_g.astype(f32)).reshape(B, S, N_BRANCH, D).astype(x.dtype)
    mix = jnp.sum(gates * proj, axis=2) @ w_out
    x = _layer_norm(DN_ALPHA * x + mix, ln1_g, ln1_b)
    x = _layer_norm(DN_ALPHA * x + peer_ffn(x, peer_wq, peer_keys, peer_u, peer_v), ln2_g, ln2_b)
    return x


def setup_inputs(seed: int = 0) -> dict:
    key = jax.random.key(seed)
    ks = jax.random.split(key, 24)
    f32 = jnp.float32
    L = DEPTH

    def nrm(k, shape, scale):
        return jax.random.normal(k, shape, f32) * scale

    return {
        'x': nrm(ks[0], (BATCH, SEQ, D_MODEL), 1.0),
        'ln_in_g': 1.0 + nrm(ks[1], (D_MODEL,), 0.02),
        'ln_in_b': nrm(ks[2], (D_MODEL,), 0.02),
        'w_in': nrm(ks[3], (L, D_MODEL, IN_TOTAL), D_MODEL ** -0.5),
        'nsa_cmp_pos': nrm(ks[4], (L, CMP_LEN, HEAD_DIM), 0.1),
        'nsa_cmp_wk': nrm(ks[5], (L, CMP_LEN * HEAD_DIM, HEAD_DIM), (CMP_LEN * HEAD_DIM) ** -0.5),
        'nsa_cmp_wv': nrm(ks[6], (L, CMP_LEN * HEAD_DIM, HEAD_DIM), (CMP_LEN * HEAD_DIM) ** -0.5),
        'ret_gn_g': 1.0 + nrm(ks[7], (L, MIX_W), 0.02),
        'ret_gn_b': nrm(ks[8], (L, MIX_W), 0.02),
        'gla_w_alpha': nrm(ks[9], (L, GLA_LOWRANK, GLA_HEADS * GLA_DK), GLA_LOWRANK ** -0.5),
        'gla_b_alpha': nrm(ks[10], (L, GLA_HEADS * GLA_DK), 0.1),
        'gla_norm_g': 1.0 + nrm(ks[11], (L, GLA_HEADS * GLA_DV), 0.02),
        'w_branch': nrm(ks[12], (L, N_BRANCH, MIX_W, D_MODEL), DN_BETA * MIX_W ** -0.5),
        'w_out': nrm(ks[13], (L, D_MODEL, D_MODEL), DN_BETA * D_MODEL ** -0.5),
        'ln1_g': 1.0 + nrm(ks[14], (L, D_MODEL), 0.02),
        'ln1_b': nrm(ks[15], (L, D_MODEL), 0.02),
        'peer_wq': nrm(ks[16], (L, D_MODEL, PEER_HEADS * PEER_QDIM), D_MODEL ** -0.5),
        'peer_keys': nrm(ks[17], (L, PEER_HEADS, 2, N_KEYS, PEER_QDIM // 2), (PEER_QDIM // 2) ** -0.5),
        'peer_u': nrm(ks[18], (L, N_EXPERTS, D_MODEL), D_MODEL ** -0.5),
        'peer_v': nrm(ks[19], (L, N_EXPERTS, D_MODEL), DN_BETA * PEER_HEADS ** -0.5),
        'ln2_g': 1.0 + nrm(ks[20], (L, D_MODEL), 0.02),
        'ln2_b': nrm(ks[21], (L, D_MODEL), 0.02),
    }


def reference(x, ln_in_g, ln_in_b, w_in, nsa_cmp_pos, nsa_cmp_wk, nsa_cmp_wv, ret_gn_g, ret_gn_b,
              gla_w_alpha, gla_b_alpha, gla_norm_g, w_branch, w_out, ln1_g, ln1_b,
              peer_wq, peer_keys, peer_u, peer_v, ln2_g, ln2_b):
    h = _layer_norm(x, ln_in_g, ln_in_b)
    for l in range(DEPTH):
        h = hybrid_layer(h, w_in[l], nsa_cmp_pos[l], nsa_cmp_wk[l], nsa_cmp_wv[l], ret_gn_g[l], ret_gn_b[l],
                         gla_w_alpha[l], gla_b_alpha[l], gla_norm_g[l], w_branch[l], w_out[l],
                         ln1_g[l], ln1_b[l], peer_wq[l], peer_keys[l], peer_u[l], peer_v[l],
                         ln2_g[l], ln2_b[l])
    return h
```

```cpp
#include <hip/hip_runtime.h>
#include <stdint.h>
#include <stdio.h>

#ifndef ONE_LAUNCH
#define ONE_LAUNCH 1
#endif

#define LAS __attribute__((address_space(3)))
typedef unsigned short bf16_t;
typedef short bf16x8 __attribute__((ext_vector_type(8)));
typedef float f32x4 __attribute__((ext_vector_type(4)));
typedef float f32x16 __attribute__((ext_vector_type(16)));
typedef unsigned u32x4 __attribute__((ext_vector_type(4)));
typedef unsigned u32x2 __attribute__((ext_vector_type(2)));
typedef __bf16 bf2_t __attribute__((ext_vector_type(2)));
typedef LAS unsigned char* lptr;

constexpr int NTOK = 16384, SEQ = 8192, DM = 1024, NB = 2;
constexpr int NY = 3328;
constexpr int W_IN_LD = 7324;
constexpr int C_SBQ = 0, C_SBK = 256, C_SBV = 512, C_NQ = 768, C_NKC = 1024, C_NVC = 1088, C_NKS = 1152, C_NVS = 1216, C_NKW = 1280, C_NVW = 1344;
constexpr int C_RQ = 1408, C_RK = 1664, C_RV = 1920, C_RG = 2176, C_GQ = 2432, C_GK = 2560, C_GV = 2688, C_GR = 2944, C_NG = 3200, C_GLR = 3216;
constexpr int W_MG = 3228;
constexpr float NEGF = -1e30f;
constexpr float LN_EPS = 1e-5f;
constexpr float DN_ALPHA = 1.41421356237f;

constexpr int NTHREADS = 512;
constexpr int LDS_BYTES = 147456;

constexpr size_t MB = 1024 * 1024;
constexpr size_t WS_CTL   = 0;
constexpr size_t WS_HF    = 1 * MB;
constexpr size_t WS_HB    = WS_HF + 64 * MB;
constexpr size_t WS_Y     = WS_HB + 32 * MB;
constexpr size_t WS_Z     = WS_Y;
constexpr size_t WS_TOPS  = WS_Y + 64 * MB;
constexpr size_t WS_TOPI  = WS_TOPS + 16 * MB;
constexpr size_t WS_O     = WS_Y + 104 * MB;
constexpr size_t WS_MIX   = WS_O + 32 * MB;
constexpr size_t WS_QV    = WS_O;
constexpr size_t WS_UST   = WS_MIX + 32 * MB;
constexpr size_t WS_RST   = WS_UST + 8 * MB;
constexpr size_t WS_UGLA  = WS_RST + 8 * MB;
constexpr size_t WS_SGLA  = WS_UGLA + 8 * MB;
constexpr size_t WS_BL    = WS_SGLA + 8 * MB;
constexpr size_t WS_KC    = WS_BL + 1 * MB;
constexpr size_t WS_VC    = WS_KC + 1 * MB;
constexpr size_t WS_WIN   = WS_VC + 1 * MB;
constexpr size_t WS_WG    = WS_WIN + 14 * MB;
constexpr size_t WS_WB    = WS_WG + 16 * MB;
constexpr size_t WS_WO    = WS_WB + 4 * MB;
constexpr size_t WS_WQ    = WS_WO + 4 * MB;
constexpr size_t WS_KEYS  = WS_WQ + 8 * MB;
constexpr size_t WS_UB    = WS_KEYS + 1 * MB;
constexpr size_t WS_VB    = WS_UB + 64 * MB;
constexpr size_t WS_SU    = WS_UB + 32 * MB;
constexpr size_t WS_SV    = WS_VB + 32 * MB;
constexpr size_t WS_END   = WS_VB + 64 * MB;

typedef float f32x2_t __attribute__((ext_vector_type(2)));
__device__ __forceinline__ unsigned pk_bf16(float lo, float hi) { f32x2_t v = {lo, hi}; bf2_t b = __builtin_convertvector(v, bf2_t); return __builtin_bit_cast(unsigned, b); }
__device__ __forceinline__ float bf_lo(unsigned u) { return __uint_as_float(u << 16); }
__device__ __forceinline__ float bf_hi(unsigned u) { return __uint_as_float(u & 0xffff0000u); }
__device__ __forceinline__ bf16_t f2bf(float f) { return (bf16_t)(pk_bf16(f, f) & 0xffffu); }
__device__ __forceinline__ float bf2f(bf16_t b) { return __uint_as_float(((unsigned)b) << 16); }
__device__ __forceinline__ float wave_sum(float v) {
#pragma unroll
    for (int o = 32; o; o >>= 1) v += __shfl_xor(v, o);
    return v;
}
__device__ __forceinline__ float wave_max(float v) {
#pragma unroll
    for (int o = 32; o; o >>= 1) v = fmaxf(v, __shfl_xor(v, o));
    return v;
}
__device__ __forceinline__ float sigmoidf_(float x) { return 1.0f / (1.0f + __expf(-x)); }
__device__ __forceinline__ float softplusf_(float x) { return fmaxf(x, 0.f) + __logf(1.0f + __expf(-fabsf(x))); }
__device__ __forceinline__ float siluf_(float x) { return x * sigmoidf_(x); }
__device__ __forceinline__ float dot2bf(unsigned a, unsigned b, float c) {
    return __builtin_amdgcn_fdot2_f32_bf16(__builtin_bit_cast(bf2_t, a), __builtin_bit_cast(bf2_t, b), c, false);
}

#define XB_TMO      128
#define XB_XCNT(j)  (256  + 64 * (j))
#define XB_XSUB(j)  (1280 + 64 * (j))
#define XB_XGEN(j)  (2304 + 64 * (j))
#define XB_TOP      3328
#define XB_TOPGEN   3392
#define XCD_BAR_WORDS 3456
#define XB_SPIN_CAP (1u << 22)

__device__ __forceinline__ unsigned xb_ld(unsigned* p)              { return __hip_atomic_load(p, __ATOMIC_RELAXED, __HIP_MEMORY_SCOPE_AGENT); }
__device__ __forceinline__ unsigned xb_add(unsigned* p, unsigned v) { return __hip_atomic_fetch_add(p, v, __ATOMIC_RELAXED, __HIP_MEMORY_SCOPE_AGENT); }
__device__ __forceinline__ unsigned xb_xcc_id() { return (unsigned)__builtin_amdgcn_s_getreg((3 << 11) | 20) & 0xFu; }
#define XB_SPIN(cond, bar) do { unsigned _sp = 0; while (cond) { __builtin_amdgcn_s_sleep(1); \
    if ((++_sp & 255u) == 0u) { if (xb_ld(&(bar)[XB_TMO])) break; if (_sp > XB_SPIN_CAP) { atomicAdd(&(bar)[XB_TMO], 1u); break; } } } } while (0)

struct XcdBarrier { unsigned* bar; unsigned x; volatile LAS unsigned* st; };

__device__ __forceinline__ XcdBarrier xcd_barrier_post(unsigned* bar, volatile LAS unsigned* st) {
    XcdBarrier b; b.bar = bar; b.x = xb_xcc_id(); b.st = st;
    if (threadIdx.x == 0) (void)xb_add(&bar[XB_XCNT(b.x)], 1u);
    return b;
}
__device__ __forceinline__ void xcd_barrier_complete(unsigned* bar, unsigned x, unsigned& nloc, unsigned& nx) {
    const unsigned G = gridDim.x * gridDim.y * gridDim.z;
    unsigned sum, cnt, mine, sp = 0u;
    for (;;) {
        sum = 0u; cnt = 0u; mine = 0u;
#pragma unroll
        for (unsigned j = 0; j < 16; ++j) { const unsigned c = xb_ld(&bar[XB_XCNT(j)]); sum += c; cnt += (c > 0u) ? 1u : 0u; mine = (j == x) ? c : mine; }
        if (sum == G) break;
        __builtin_amdgcn_s_sleep(1);
        if ((++sp & 255u) == 0u) { if (xb_ld(&bar[XB_TMO])) break; if (sp > XB_SPIN_CAP) { atomicAdd(&bar[XB_TMO], 1u); break; } }
    }
    nloc = mine > 0u ? mine : 1u; nx = cnt > 0u ? cnt : 1u;
}
__device__ __forceinline__ void xcd_barrier(const XcdBarrier& b) {
    asm volatile("s_waitcnt vmcnt(0)" ::: "memory");
    __syncthreads();
    if (threadIdx.x == 0) {
        unsigned* bar = b.bar;
        __builtin_amdgcn_s_waitcnt(0);
        unsigned nloc = b.st[0], nx = b.st[1];
        if (nloc == 0u) { xcd_barrier_complete(bar, b.x, nloc, nx); b.st[0] = nloc; b.st[1] = nx; }
        const unsigned old = xb_add(&bar[XB_XSUB(b.x)], 1u);
        const unsigned gen = old / nloc;
        if (old + 1u == (gen + 1u) * nloc) {
            __builtin_amdgcn_fence(__ATOMIC_RELEASE, "agent");
            asm volatile("s_waitcnt vmcnt(0)" ::: "memory");
            const unsigned og = xb_add(&bar[XB_TOP], 1u);
            const unsigned tg = og / nx;
            if (og + 1u == (tg + 1u) * nx) xb_add(&bar[XB_TOPGEN], 1u);
            else XB_SPIN(xb_ld(&bar[XB_TOPGEN]) == tg, bar);
            __builtin_amdgcn_fence(__ATOMIC_ACQUIRE, "agent");
            xb_add(&bar[XB_XGEN(b.x)], 1u);
            asm volatile("s_waitcnt vmcnt(0)" ::: "memory");
        } else {
            XB_SPIN(xb_ld(&bar[XB_XGEN(b.x)]) == gen, bar);
            __builtin_amdgcn_fence(__ATOMIC_ACQUIRE, "agent");
            asm volatile("s_waitcnt vmcnt(0)" ::: "memory");
        }
    }
    __syncthreads();
}

struct Args { const float* in[22]; float* out; unsigned char* ws; int ph_lo, ph_hi; };
struct Ctx {
    lptr lds; int tid, lane, wave, nblk, blk;
    unsigned char* ws;
};

__device__ __forceinline__ void ln_rows(const Ctx& c, const float* src, const float* g, const float* b, float* outf, bf16_t* outb) {
    const int gw = c.blk * 8 + c.wave, nw = c.nblk * 8;
    for (int row = gw; row < NTOK; row += nw) {
        const f32x4* p = (const f32x4*)(src + (size_t)row * DM);
        f32x4 v[4]; float s = 0.f;
#pragma unroll
        for (int i = 0; i < 4; ++i) { v[i] = p[i * 64 + c.lane]; s += (v[i][0] + v[i][1]) + (v[i][2] + v[i][3]); }
        const float mean = wave_sum(s) * (1.0f / 1024.0f);
        float q = 0.f;
#pragma unroll
        for (int i = 0; i < 4; ++i) { const f32x4 d = v[i] - mean; q += (d[0] * d[0] + d[1] * d[1]) + (d[2] * d[2] + d[3] * d[3]); }
        const float rstd = rsqrtf(wave_sum(q) * (1.0f / 1024.0f) + LN_EPS);
#pragma unroll
        for (int i = 0; i < 4; ++i) {
            const int idx = i * 64 + c.lane;
            const f32x4 gg = ((const f32x4*)g)[idx], bb = ((const f32x4*)b)[idx];
            const f32x4 y = (v[i] - mean) * rstd * gg + bb;
            if (outf) ((f32x4*)(outf + (size_t)row * DM))[idx] = y;
            if (outb) { u32x2 w; w.x = pk_bf16(y[0], y[1]); w.y = pk_bf16(y[2], y[3]); ((u32x2*)(outb + (size_t)row * DM))[idx] = w; }
        }
    }
}

__device__ __forceinline__ int ycol_to_wcol(int j) {
    if (j < 1408) return j;
    if (j < 3200) return j + 12;
    if (j < 3212) return 1408 + (j - 3200);
    if (j < 3216) return -1;
    if (j < 3232) return 3212 + (j - 3216);
    return -1;
}
__device__ __forceinline__ void transpose_cvt(const Ctx& c, const float* src, int ld_src, int R, int c_off, int C, int Cpad, int mode, bf16_t* dst, int ld_dst) {
    LAS float* buf = (LAS float*)c.lds;
    const int nRt = R / 64, nCt = Cpad / 64;
    for (int tile = c.blk; tile < nRt * nCt; tile += c.nblk) {
        const int rt = tile % nRt, ct = tile / nRt;
        const int r0 = rt * 64, c0 = ct * 64;
        {
            const int row = c.tid >> 3, cc = (c.tid & 7) * 8;
            const float* sp = src + (size_t)(r0 + row) * ld_src;
            float v[8];
            bool fast = false; int sc0 = 0;
            if (mode == 0) { fast = (c0 + 64 <= C); sc0 = c_off + c0 + cc; }
            else { if (c0 + 64 <= 1408) { fast = true; sc0 = c0 + cc; } else if (c0 >= 1408 && c0 + 64 <= 3200) { fast = true; sc0 = c0 + cc + 12; } }
            if (fast) {
                const f32x4 a = *(const f32x4*)(sp + sc0), b = *(const f32x4*)(sp + sc0 + 4);
                v[0] = a[0]; v[1] = a[1]; v[2] = a[2]; v[3] = a[3]; v[4] = b[0]; v[5] = b[1]; v[6] = b[2]; v[7] = b[3];
            } else {
#pragma unroll
                for (int i = 0; i < 8; ++i) {
                    const int n = c0 + cc + i; int sc;
                    if (mode == 0) sc = (n < C) ? c_off + n : -1; else sc = ycol_to_wcol(n);
                    v[i] = (sc >= 0) ? sp[sc] : 0.f;
                }
            }
#pragma unroll
            for (int i = 0; i < 8; ++i) buf[row * 65 + cc + i] = v[i];
        }
        __syncthreads();
        {
            const int n = c.tid >> 3, kc = (c.tid & 7) * 8;
            float v[8];
#pragma unroll
            for (int i = 0; i < 8; ++i) v[i] = buf[(kc + i) * 65 + n];
            u32x4 w; w.x = pk_bf16(v[0], v[1]); w.y = pk_bf16(v[2], v[3]); w.z = pk_bf16(v[4], v[5]); w.w = pk_bf16(v[6], v[7]);
            *(u32x4*)(dst + (size_t)(c0 + n) * ld_dst + r0 + kc) = w;
        }
        __syncthreads();
    }
}
__device__ __forceinline__ void convert_flat(const Ctx& c, const float* src, bf16_t* dst, size_t n) {
    const size_t stride = (size_t)c.nblk * NTHREADS;
    for (size_t i = (size_t)c.blk * NTHREADS + c.tid; i < n / 8; i += stride) {
        const f32x4 a = ((const f32x4*)src)[2 * i], b = ((const f32x4*)src)[2 * i + 1];
        u32x4 w; w.x = pk_bf16(a[0], a[1]); w.y = pk_bf16(a[2], a[3]); w.z = pk_bf16(b[0], b[1]); w.w = pk_bf16(b[2], b[3]);
        ((u32x4*)dst)[i] = w;
    }
}

template <int WM, int WN>
__device__ __forceinline__ void gemm_kloop(const Ctx& c, f32x16 (&acc)[WM][WN], const bf16_t* A, int lda, const bf16_t* Bt, int ldb, int K) {
    constexpr int BMt = 128 * WM, BNt = 64 * WN, STAGE = (BMt + BNt) * 144;
    constexpr int NA = BMt * 8 / NTHREADS, NBc = BNt * 8 / NTHREADS;
    static_assert(NBc >= 1, "tile too small");
    const lptr lds = c.lds;
    const int wm = c.wave >> 1, wn = c.wave & 1, r = c.lane & 31, h = c.lane >> 5;
    u32x4 ra[NA], rb[NBc];
    const int nk = K / 64;
#pragma unroll
    for (int i = 0; i < NA; ++i) { const int id = c.tid + i * NTHREADS; ra[i] = *(const u32x4*)(A + (size_t)(id >> 3) * lda + (id & 7) * 8); }
#pragma unroll
    for (int i = 0; i < NBc; ++i) { const int id = c.tid + i * NTHREADS; rb[i] = *(const u32x4*)(Bt + (size_t)(id >> 3) * ldb + (id & 7) * 8); }
#pragma unroll
    for (int i = 0; i < NA; ++i) { const int id = c.tid + i * NTHREADS; *(LAS u32x4*)(lds + (id >> 3) * 144 + (id & 7) * 16) = ra[i]; }
#pragma unroll
    for (int i = 0; i < NBc; ++i) { const int id = c.tid + i * NTHREADS; *(LAS u32x4*)(lds + BMt * 144 + (id >> 3) * 144 + (id & 7) * 16) = rb[i]; }
    __syncthreads();
    for (int kt = 0; kt < nk; ++kt) {
        const lptr cur = lds + (kt & 1) * STAGE, nxt = lds + ((kt + 1) & 1) * STAGE;
        const bool more = (kt + 1 < nk);
        if (more) {
            const int k0 = (kt + 1) * 64;
#pragma unroll
            for (int i = 0; i < NA; ++i) { const int id = c.tid + i * NTHREADS; ra[i] = *(const u32x4*)(A + (size_t)(id >> 3) * lda + k0 + (id & 7) * 8); }
#pragma unroll
            for (int i = 0; i < NBc; ++i) { const int id = c.tid + i * NTHREADS; rb[i] = *(const u32x4*)(Bt + (size_t)(id >> 3) * ldb + k0 + (id & 7) * 8); }
        }
        const lptr pa = cur + (wm * WM * 32 + r) * 144 + h * 16;
        const lptr pb = cur + BMt * 144 + (wn * WN * 32 + r) * 144 + h * 16;
#pragma unroll
        for (int s = 0; s < 4; ++s) {
            bf16x8 fa[WM], fb[WN];
#pragma unroll
            for (int i = 0; i < WM; ++i) fa[i] = *(LAS const bf16x8*)(pa + i * 32 * 144 + s * 32);
#pragma unroll
            for (int j = 0; j < WN; ++j) fb[j] = *(LAS const bf16x8*)(pb + j * 32 * 144 + s * 32);
#pragma unroll
            for (int i = 0; i < WM; ++i)
#pragma unroll
                for (int j = 0; j < WN; ++j) acc[i][j] = __builtin_amdgcn_mfma_f32_32x32x16_bf16(fb[j], fa[i], acc[i][j], 0, 0, 0);
        }
        if (more) {
#pragma unroll
            for (int i = 0; i < NA; ++i) { const int id = c.tid + i * NTHREADS; *(LAS u32x4*)(nxt + (id >> 3) * 144 + (id & 7) * 16) = ra[i]; }
#pragma unroll
            for (int i = 0; i < NBc; ++i) { const int id = c.tid + i * NTHREADS; *(LAS u32x4*)(nxt + BMt * 144 + (id >> 3) * 144 + (id & 7) * 16) = rb[i]; }
        }
        __syncthreads();
    }
}
template <int WM, int WN>
__device__ __forceinline__ void acc_zero(f32x16 (&acc)[WM][WN]) {
#pragma unroll
    for (int i = 0; i < WM; ++i)
#pragma unroll
        for (int j = 0; j < WN; ++j)
#pragma unroll
            for (int e = 0; e < 16; ++e) acc[i][j][e] = 0.f;
}

#define EPI_LOOP(WM_, WN_)                                                                  \
    _Pragma("unroll") for (int i = 0; i < WM_; ++i)                                         \
    _Pragma("unroll") for (int j = 0; j < WN_; ++j)                                         \
    _Pragma("unroll") for (int g = 0; g < 4; ++g)

__device__ __forceinline__ void phase_inproj(const Ctx& c, const bf16_t* hb, const bf16_t* Wt, bf16_t* Y) {
    constexpr int NTN = NY / 128;
    const int wm = c.wave >> 1, wn = c.wave & 1, r = c.lane & 31, h = c.lane >> 5;
    for (int u = c.blk; u < 64 * NTN; u += c.nblk) {
        const int pm = u / NTN, pn = u % NTN;
        f32x16 acc[2][2]; acc_zero<2, 2>(acc);
        gemm_kloop<2, 2>(c, acc, hb + (size_t)pm * 256 * DM, DM, Wt + (size_t)pn * 128 * DM, DM, DM);
        EPI_LOOP(2, 2) {
            const int m = pm * 256 + (wm * 2 + i) * 32 + r, n = pn * 128 + (wn * 2 + j) * 32 + 8 * g + 4 * h;
            u32x2 w; w.x = pk_bf16(acc[i][j][4 * g], acc[i][j][4 * g + 1]); w.y = pk_bf16(acc[i][j][4 * g + 2], acc[i][j][4 * g + 3]);
            *(u32x2*)(Y + (size_t)m * NY + n) = w;
        }
    }
}
__device__ __forceinline__ void phase_merge(const Ctx& c, const bf16_t* hb, const bf16_t* Wg, const bf16_t* O, const bf16_t* Wb, bf16_t* MIX) {
    const int wm = c.wave >> 1, wn = c.wave & 1, r = c.lane & 31, h = c.lane >> 5;
    for (int u = c.blk; u < 128 * 8; u += c.nblk) {
        const int pm = u >> 3, pn = u & 7;
        f32x16 mix[1][2]; acc_zero<1, 2>(mix);
#pragma unroll 1
        for (int nb = 0; nb < 4; ++nb) {
            f32x16 ag[1][2]; acc_zero<1, 2>(ag);
            gemm_kloop<1, 2>(c, ag, hb + (size_t)pm * 128 * DM, DM, Wg + ((size_t)nb * 1024 + pn * 128) * DM, DM, DM);
            f32x16 ap[1][2]; acc_zero<1, 2>(ap);
            gemm_kloop<1, 2>(c, ap, O + (size_t)pm * 128 * DM + nb * 256, DM, Wb + ((size_t)nb * 1024 + pn * 128) * 256, 256, 256);
#pragma unroll
            for (int j = 0; j < 2; ++j)
#pragma unroll
                for (int e = 0; e < 16; ++e) mix[0][j][e] += sigmoidf_(ag[0][j][e]) * ap[0][j][e];
        }
        EPI_LOOP(1, 2) {
            const int m = pm * 128 + (wm + i) * 32 + r, n = pn * 128 + (wn * 2 + j) * 32 + 8 * g + 4 * h;
            u32x2 w; w.x = pk_bf16(mix[i][j][4 * g], mix[i][j][4 * g + 1]); w.y = pk_bf16(mix[i][j][4 * g + 2], mix[i][j][4 * g + 3]);
            *(u32x2*)(MIX + (size_t)m * DM + n) = w;
        }
    }
}
__device__ __forceinline__ void phase_outproj(const Ctx& c, const bf16_t* MIX, const bf16_t* Wo, const float* hf, float* Z) {
    const int wm = c.wave >> 1, wn = c.wave & 1, r = c.lane & 31, h = c.lane >> 5;
    for (int u = c.blk; u < 64 * 8; u += c.nblk) {
        const int pm = u >> 3, pn = u & 7;
        f32x16 acc[2][2]; acc_zero<2, 2>(acc);
        gemm_kloop<2, 2>(c, acc, MIX + (size_t)pm * 256 * DM, DM, Wo + (size_t)pn * 128 * DM, DM, DM);
        EPI_LOOP(2, 2) {
            const int m = pm * 256 + (wm * 2 + i) * 32 + r, n = pn * 128 + (wn * 2 + j) * 32 + 8 * g + 4 * h;
            const f32x4 x = *(const f32x4*)(hf + (size_t)m * DM + n);
            f32x4 y; y[0] = DN_ALPHA * x[0] + acc[i][j][4 * g]; y[1] = DN_ALPHA * x[1] + acc[i][j][4 * g + 1]; y[2] = DN_ALPHA * x[2] + acc[i][j][4 * g + 2]; y[3] = DN_ALPHA * x[3] + acc[i][j][4 * g + 3];
            *(f32x4*)(Z + (size_t)m * DM + n) = y;
        }
    }
}
__device__ __forceinline__ void phase_wq(const Ctx& c, const bf16_t* hb, const bf16_t* Wq, bf16_t* QV) {
    const int wm = c.wave >> 1, wn = c.wave & 1, r = c.lane & 31, h = c.lane >> 5;
    for (int u = c.blk; u < 64 * 16; u += c.nblk) {
        const int pm = u >> 4, pn = u & 15;
        f32x16 acc[2][2]; acc_zero<2, 2>(acc);
        gemm_kloop<2, 2>(c, acc, hb + (size_t)pm * 256 * DM, DM, Wq + (size_t)pn * 128 * DM, DM, DM);
        EPI_LOOP(2, 2) {
            const int m = pm * 256 + (wm * 2 + i) * 32 + r, n = pn * 128 + (wn * 2 + j) * 32 + 8 * g + 4 * h;
            u32x2 w; w.x = pk_bf16(acc[i][j][4 * g], acc[i][j][4 * g + 1]); w.y = pk_bf16(acc[i][j][4 * g + 2], acc[i][j][4 * g + 3]);
            *(u32x2*)(QV + (size_t)m * 2048 + n) = w;
        }
    }
}

__device__ __forceinline__ f32x16 mma_lds(f32x16 acc, lptr A, int sa, lptr B, int sb, int K, int lane) {
    const int r = lane & 31, h = lane >> 5;
    const lptr pa = A + r * sa + h * 16, pb = B + r * sb + h * 16;
    for (int k = 0; k < K; k += 16) {
        const bf16x8 a = *(LAS const bf16x8*)(pa + k * 2), b = *(LAS const bf16x8*)(pb + k * 2);
        acc = __builtin_amdgcn_mfma_f32_32x32x16_bf16(b, a, acc, 0, 0, 0);
    }
    return acc;
}
__device__ __forceinline__ f32x16 zero16() { f32x16 z;
#pragma unroll
    for (int e = 0; e < 16; ++e) z[e] = 0.f; return z; }

__device__ __forceinline__ void sb_wave_unit(const bf16_t* Y, bf16_t* O, int b, int hh, int qt, lptr wl, int lane) {
    const int t = qt * 64 + lane;
    const size_t row = (size_t)b * SEQ + t;
    unsigned q[32];
    {
        const u32x4* qp = (const u32x4*)(Y + row * NY + C_SBQ + hh * 64);
#pragma unroll
        for (int i = 0; i < 8; ++i) { const u32x4 v = qp[i]; q[4 * i] = v.x; q[4 * i + 1] = v.y; q[4 * i + 2] = v.z; q[4 * i + 3] = v.w; }
    }
    float acc[64];
#pragma unroll
    for (int e = 0; e < 64; ++e) acc[e] = 0.f;
    float C = 0.f;
    for (int kt = qt; kt >= 0; --kt) {
        {
            const size_t krow = (size_t)b * SEQ + kt * 64 + lane;
            const u32x4* kp = (const u32x4*)(Y + krow * NY + C_SBK + hh * 64);
            const u32x4* vp = (const u32x4*)(Y + krow * NY + C_SBV + hh * 64);
            u32x4 kr[8], vr[8];
#pragma unroll
            for (int i = 0; i < 8; ++i) { kr[i] = kp[i]; vr[i] = vp[i]; }
#pragma unroll
            for (int i = 0; i < 8; ++i) { *(LAS u32x4*)(wl + lane * 144 + i * 16) = kr[i]; *(LAS u32x4*)(wl + 9216 + lane * 144 + i * 16) = vr[i]; }
        }
        asm volatile("s_waitcnt lgkmcnt(0)" ::: "memory");
        const int s_hi = (kt == qt) ? 62 : 63;
#pragma unroll 1
        for (int s = s_hi; s >= 0; --s) {
            const int pos = kt * 64 + s;
            float z0 = 0.f, z1 = 0.f;
#pragma unroll
            for (int i = 0; i < 8; ++i) {
                const u32x4 kv = *(LAS const u32x4*)(wl + s * 144 + i * 16);
                z0 = dot2bf(q[4 * i], kv.x, z0); z1 = dot2bf(q[4 * i + 1], kv.y, z1); z0 = dot2bf(q[4 * i + 2], kv.z, z0); z1 = dot2bf(q[4 * i + 3], kv.w, z1);
            }
            const float z = (z0 + z1) * 0.125f;
            const bool valid = pos < t;
            const float Cn = C - softplusf_(z);
            const float w = valid ? __expf(z + Cn) : 0.f;
            C = valid ? Cn : C;
#pragma unroll
            for (int i = 0; i < 8; ++i) {
                const u32x4 vv = *(LAS const u32x4*)(wl + 9216 + s * 144 + i * 16);
                acc[8 * i + 0] += w * bf_lo(vv.x); acc[8 * i + 1] += w * bf_hi(vv.x); acc[8 * i + 2] += w * bf_lo(vv.y); acc[8 * i + 3] += w * bf_hi(vv.y);
                acc[8 * i + 4] += w * bf_lo(vv.z); acc[8 * i + 5] += w * bf_hi(vv.z); acc[8 * i + 6] += w * bf_lo(vv.w); acc[8 * i + 7] += w * bf_hi(vv.w);
            }
        }
        asm volatile("" ::: "memory");
        if (__all(C < -104.0f)) break;
    }
    u32x4* op = (u32x4*)(O + row * DM + 0 * 256 + hh * 64);
#pragma unroll
    for (int i = 0; i < 8; ++i) {
        u32x4 w; w.x = pk_bf16(acc[8 * i], acc[8 * i + 1]); w.y = pk_bf16(acc[8 * i + 2], acc[8 * i + 3]); w.z = pk_bf16(acc[8 * i + 4], acc[8 * i + 5]); w.w = pk_bf16(acc[8 * i + 6], acc[8 * i + 7]);
        op[i] = w;
    }
}
__device__ __forceinline__ void phase_sb(const Ctx& c, const bf16_t* Y, bf16_t* O) {
    const lptr wl = c.lds + c.wave * 18432;
    for (int u = c.blk * 8 + c.wave; u < 1024; u += c.nblk * 8) {
        const int qt = u & 127, hh = (u >> 7) & 3, b = u >> 9;
        sb_wave_unit(Y, O, b, hh, qt, wl, c.lane);
    }
    __syncthreads();
}

__device__ __forceinline__ void phase_compress(const Ctx& c, const bf16_t* Y, const float* pos, const float* wk, const float* wv, bf16_t* KC, bf16_t* VC) {
    LAS float* kl = (LAS float*)c.lds;
    LAS float* pl = (LAS float*)(c.lds + 144 * 64 * 4);
    for (int u = c.blk; u < 256; u += c.nblk) {
        const int cg = u & 63, kv = (u >> 6) & 1, b = u >> 7;
        const int c0 = cg * 8;
        const int col = kv ? C_NVC : C_NKC;
        for (int i = c.tid; i < 144 * 64; i += NTHREADS) {
            const int tr = i >> 6, d = i & 63, tok = c0 * 16 + tr;
            kl[i] = (tok < SEQ) ? bf2f(Y[((size_t)b * SEQ + tok) * NY + col + d]) : 0.f;
        }
        for (int i = c.tid; i < 32 * 64; i += NTHREADS) pl[i] = pos[i];
        __syncthreads();
        const int cl = c.tid >> 6, d = c.tid & 63, cc = c0 + cl;
        const float* w = kv ? wv : wk;
        float a0 = 0.f, a1 = 0.f;
#pragma unroll 4
        for (int l = 0; l < 32; ++l) {
            const LAS float* kr = kl + (cl * 16 + l) * 64;
            const LAS float* pr = pl + l * 64;
            const float* wr = w + (size_t)l * 64 * 64 + d;
#pragma unroll 8
            for (int dp = 0; dp < 64; dp += 2) {
                a0 += (kr[dp] + pr[dp]) * wr[(size_t)dp * 64];
                a1 += (kr[dp + 1] + pr[dp + 1]) * wr[(size_t)(dp + 1) * 64];
            }
        }
        bf16_t* dst = kv ? VC : KC;
        dst[((size_t)b * 512 + cc) * 64 + d] = (cc < 511) ? f2bf(a0 + a1) : (bf16_t)0;
        __syncthreads();
    }
}

__device__ __forceinline__ float ret_logg(int h) { return log1pf(-exp2f(-5.0f - (float)h)); }
__device__ __forceinline__ void phase_ret_local(const Ctx& c, const bf16_t* Y, float* UST) {
    const lptr Kt = c.lds, Vt = c.lds + 64 * 272;
    for (int u = c.blk; u < 512; u += c.nblk) {
        const int i = u & 63, hh = (u >> 6) & 3, b = u >> 8;
        const float lg = ret_logg(hh);
        {
            const int j = c.tid >> 2, dc = (c.tid & 3) * 16;
            const size_t row = (size_t)b * SEQ + i * 128 + j;
            const float kd = __expf(lg * (float)(127 - j)) * 0.125f;
            const u32x4* kp = (const u32x4*)(Y + row * NY + C_RK + hh * 64 + dc);
            const u32x4* vp = (const u32x4*)(Y + row * NY + C_RV + hh * 64 + dc);
            const u32x4 k0 = kp[0], k1 = kp[1], v0 = vp[0], v1 = vp[1];
            const unsigned kk[8] = {k0.x, k0.y, k0.z, k0.w, k1.x, k1.y, k1.z, k1.w};
            const unsigned vv[8] = {v0.x, v0.y, v0.z, v0.w, v1.x, v1.y, v1.z, v1.w};
#pragma unroll
            for (int e = 0; e < 8; ++e) {
                *(LAS bf16_t*)(Kt + (dc + 2 * e) * 272 + j * 2) = f2bf(bf_lo(kk[e]) * kd);
                *(LAS bf16_t*)(Kt + (dc + 2 * e + 1) * 272 + j * 2) = f2bf(bf_hi(kk[e]) * kd);
                *(LAS bf16_t*)(Vt + (dc + 2 * e) * 272 + j * 2) = (bf16_t)(vv[e] & 0xffffu);
                *(LAS bf16_t*)(Vt + (dc + 2 * e + 1) * 272 + j * 2) = (bf16_t)(vv[e] >> 16);
            }
        }
        __syncthreads();
        if (c.wave < 4) {
            const int wm = c.wave >> 1, wn = c.wave & 1, r = c.lane & 31, h = c.lane >> 5;
            f32x16 acc = mma_lds(zero16(), Kt + wm * 32 * 272, 272, Vt + wn * 32 * 272, 272, 128, c.lane);
            float* dst = UST + (((size_t)(b * 4 + hh) * 64 + i) * 64 + wm * 32 + r) * 64 + wn * 32 + 4 * h;
#pragma unroll
            for (int g = 0; g < 4; ++g) { f32x4 o; o[0] = acc[4 * g]; o[1] = acc[4 * g + 1]; o[2] = acc[4 * g + 2]; o[3] = acc[4 * g + 3]; *(f32x4*)(dst + 8 * g) = o; }
        }
        __syncthreads();
    }
}
__device__ __forceinline__ void phase_scans(const Ctx& c, const float* UST, float* RST, const float* UGLA, float* SGLA, const float* BL) {
    for (int u = c.blk; u < 96; u += c.nblk) {
        if (u < 64) {
            const int ch = u * NTHREADS + c.tid;
            const int bh = ch >> 12, de = ch & 4095;
            const float cd = __expf(ret_logg(bh & 3) * 128.0f);
            const float* up = UST + (size_t)bh * 64 * 4096 + de; float* rp = RST + (size_t)bh * 64 * 4096 + de;
            float R = 0.f;
            for (int i0 = 0; i0 < 64; i0 += 16) {
                float uv[16];
#pragma unroll
                for (int j = 0; j < 16; ++j) uv[j] = up[(size_t)(i0 + j) * 4096];
#pragma unroll
                for (int j = 0; j < 16; ++j) { rp[(size_t)(i0 + j) * 4096] = R; R = cd * R + uv[j]; }
            }
        } else {
            const int ch = (u - 64) * NTHREADS + c.tid;
            const int bh = ch >> 11, ke = ch & 2047, k = ke >> 6;
            const float* up = UGLA + (size_t)bh * 128 * 2048 + ke; float* sp = SGLA + (size_t)bh * 128 * 2048 + ke;
            const float* bl = BL + (size_t)bh * 128 * 32 + k;
            float S = 0.f;
            for (int i0 = 0; i0 < 128; i0 += 16) {
                float uv[16], dv[16];
#pragma unroll
                for (int j = 0; j < 16; ++j) { uv[j] = up[(size_t)(i0 + j) * 2048]; dv[j] = bl[(i0 + j) * 32]; }
#pragma unroll
                for (int j = 0; j < 16; ++j) { sp[(size_t)(i0 + j) * 2048] = S; S = __expf(dv[j]) * S + uv[j]; }
            }
        }
    }
}
__device__ __forceinline__ void phase_ret_out(const Ctx& c, const bf16_t* Y, const float* RST, const float* gn_g, const float* gn_b, bf16_t* O) {
    const lptr Qs = c.lds, Ks = c.lds + 18432, Vt = c.lds + 36864, Rt = c.lds + 54272, Att = c.lds + 63488;
    LAS float* Of = (LAS float*)(c.lds + 98304);
    for (int u = c.blk; u < 512; u += c.nblk) {
        const int i = u & 63, hh = (u >> 6) & 3, b = u >> 8;
        const float lg = ret_logg(hh);
        const size_t row0 = (size_t)b * SEQ + i * 128;
        {
            const int j = c.tid >> 2, dc = (c.tid & 3) * 16;
            const size_t row = row0 + j;
            const u32x4* qp = (const u32x4*)(Y + row * NY + C_RQ + hh * 64 + dc);
            const u32x4* kp = (const u32x4*)(Y + row * NY + C_RK + hh * 64 + dc);
            const u32x4* vp = (const u32x4*)(Y + row * NY + C_RV + hh * 64 + dc);
            const u32x4 q0 = qp[0], q1 = qp[1], k0 = kp[0], k1 = kp[1], v0 = vp[0], v1 = vp[1];
            *(LAS u32x4*)(Qs + j * 144 + dc * 2) = q0; *(LAS u32x4*)(Qs + j * 144 + dc * 2 + 16) = q1;
            *(LAS u32x4*)(Ks + j * 144 + dc * 2) = k0; *(LAS u32x4*)(Ks + j * 144 + dc * 2 + 16) = k1;
            const unsigned vv[8] = {v0.x, v0.y, v0.z, v0.w, v1.x, v1.y, v1.z, v1.w};
#pragma unroll
            for (int e = 0; e < 8; ++e) {
                *(LAS bf16_t*)(Vt + (dc + 2 * e) * 272 + j * 2) = (bf16_t)(vv[e] & 0xffffu);
                *(LAS bf16_t*)(Vt + (dc + 2 * e + 1) * 272 + j * 2) = (bf16_t)(vv[e] >> 16);
            }
            const int d = c.tid >> 3, ec = (c.tid & 7) * 8;
            const float* rp = RST + (((size_t)(b * 4 + hh) * 64 + i) * 64 + d) * 64 + ec;
            const f32x4 r0 = *(const f32x4*)rp, r1 = *(const f32x4*)(rp + 4);
            const float rv[8] = {r0[0], r0[1], r0[2], r0[3], r1[0], r1[1], r1[2], r1[3]};
#pragma unroll
            for (int e = 0; e < 8; ++e) *(LAS bf16_t*)(Rt + (ec + e) * 144 + d * 2) = f2bf(rv[e]);
        }
        __syncthreads();
        const int r = c.lane & 31, h = c.lane >> 5;
        {
            const int mi = c.wave >> 1;
#pragma unroll
            for (int jj = 0; jj < 2; ++jj) {
                const int nj = (c.wave & 1) * 2 + jj;
                if (nj <= mi) {
                    f32x16 s = mma_lds(zero16(), Qs + mi * 32 * 144, 144, Ks + nj * 32 * 144, 144, 64, c.lane);
                    const int ii = mi * 32 + r;
#pragma unroll
                    for (int g = 0; g < 4; ++g) {
                        float p[4];
#pragma unroll
                        for (int e = 0; e < 4; ++e) { const int jx = nj * 32 + 8 * g + 4 * h + e; const int df = ii - jx; p[e] = (df >= 0) ? s[4 * g + e] * 0.125f * __expf(lg * (float)df) : 0.f; }
                        u32x2 w; w.x = pk_bf16(p[0], p[1]); w.y = pk_bf16(p[2], p[3]);
                        *(LAS u32x2*)(Att + ii * 272 + (nj * 32 + 8 * g + 4 * h) * 2) = w;
                    }
                }
            }
        }
        __syncthreads();
        {
            const int wm = c.wave >> 1, wn = c.wave & 1;
            f32x16 acc = mma_lds(zero16(), Qs + wm * 32 * 144, 144, Rt + wn * 32 * 144, 144, 64, c.lane);
            const int ii = wm * 32 + r;
            const float qd = __expf(lg * (float)(ii + 1));
#pragma unroll
            for (int e = 0; e < 16; ++e) acc[e] *= qd;
            acc = mma_lds(acc, Att + wm * 32 * 272, 272, Vt + wn * 32 * 272, 272, (wm + 1) * 32, c.lane);
#pragma unroll
            for (int g = 0; g < 4; ++g) { f32x4 o; o[0] = acc[4 * g]; o[1] = acc[4 * g + 1]; o[2] = acc[4 * g + 2]; o[3] = acc[4 * g + 3]; *(LAS f32x4*)(Of + ii * 68 + wn * 32 + 8 * g + 4 * h) = o; }
        }
        __syncthreads();
        {
            const int rw = c.tid >> 2, part = c.tid & 3;
            float v[16]; float s = 0.f;
#pragma unroll
            for (int e = 0; e < 16; ++e) { v[e] = Of[rw * 68 + part * 16 + e]; s += v[e]; }
            s += __shfl_xor(s, 1); s += __shfl_xor(s, 2);
            const float mu = s * (1.0f / 64.0f);
            float q = 0.f;
#pragma unroll
            for (int e = 0; e < 16; ++e) { const float d = v[e] - mu; q += d * d; }
            q += __shfl_xor(q, 1); q += __shfl_xor(q, 2);
            const float rstd = rsqrtf(q * (1.0f / 64.0f) + LN_EPS);
            const size_t row = row0 + rw;
            const int ch = hh * 64 + part * 16;
            const u32x4* gp = (const u32x4*)(Y + row * NY + C_RG + ch);
            const u32x4 g0 = gp[0], g1 = gp[1];
            const unsigned gg[8] = {g0.x, g0.y, g0.z, g0.w, g1.x, g1.y, g1.z, g1.w};
            unsigned ow[8];
#pragma unroll
            for (int e = 0; e < 8; ++e) {
                const float y0 = ((v[2 * e] - mu) * rstd * gn_g[ch + 2 * e] + gn_b[ch + 2 * e]) * siluf_(bf_lo(gg[e]));
                const float y1 = ((v[2 * e + 1] - mu) * rstd * gn_g[ch + 2 * e + 1] + gn_b[ch + 2 * e + 1]) * siluf_(bf_hi(gg[e]));
                ow[e] = pk_bf16(y0, y1);
            }
            u32x4* op = (u32x4*)(O + row * DM + 2 * 256 + ch);
            u32x4 w0, w1; w0.x = ow[0]; w0.y = ow[1]; w0.z = ow[2]; w0.w = ow[3]; w1.x = ow[4]; w1.y = ow[5]; w1.z = ow[6]; w1.w = ow[7];
            op[0] = w0; op[1] = w1;
        }
        __syncthreads();
    }
}

template <int NH>
__device__ __forceinline__ void gla_decays(const Ctx& c, const bf16_t* Y, size_t row0, int h0, const float* w_alpha, const float* b_alpha, LAS float* Ab, LAS float* lrs) {
    for (int i = c.tid; i < 64 * 16; i += NTHREADS) lrs[i] = bf2f(Y[(row0 + (i >> 4)) * NY + C_GLR + (i & 15)]);
    __syncthreads();
    for (int i = c.tid; i < NH * 64 * 32; i += NTHREADS) {
        const int k = i & 31, t = (i >> 5) & 63, hl = i >> 11;
        const int col = (h0 + hl) * 32 + k;
        float x = b_alpha[col];
#pragma unroll
        for (int rr = 0; rr < 16; ++rr) x += lrs[t * 16 + rr] * w_alpha[rr * 128 + col];
        Ab[i] = -softplusf_(-x) * (1.0f / 16.0f);
    }
    __syncthreads();
    if (c.tid < NH * 32) {
        const int k = c.tid & 31, hl = c.tid >> 5;
        float s = 0.f;
        for (int t = 0; t < 64; ++t) { s += Ab[(hl * 64 + t) * 32 + k]; Ab[(hl * 64 + t) * 32 + k] = s; }
    }
    __syncthreads();
}
__device__ __forceinline__ void phase_gla_local(const Ctx& c, const bf16_t* Y, const float* w_alpha, const float* b_alpha, float* UGLA, float* BL) {
    LAS float* Ab = (LAS float*)c.lds;
    LAS float* lrs = (LAS float*)(c.lds + 32768);
    const lptr Kt = c.lds + 36864;
    const lptr Vt = c.lds + 36864 + 18432;
    for (int u = c.blk; u < 256; u += c.nblk) {
        const int i = u & 127, b = u >> 7;
        const size_t row0 = (size_t)b * SEQ + i * 64;
        gla_decays<4>(c, Y, row0, 0, w_alpha, b_alpha, Ab, lrs);
        {
            const int s = c.tid >> 3, cc = (c.tid & 7) * 16;
            const u32x4* kp = (const u32x4*)(Y + (row0 + s) * NY + C_GK + cc);
            const u32x4 k0 = kp[0], k1 = kp[1];
            const unsigned kk[8] = {k0.x, k0.y, k0.z, k0.w, k1.x, k1.y, k1.z, k1.w};
#pragma unroll
            for (int e = 0; e < 16; ++e) {
                const int col = cc + e, hl = col >> 5, k = col & 31;
                const float kvf = (e & 1) ? bf_hi(kk[e >> 1]) : bf_lo(kk[e >> 1]);
                const float dec = __expf(Ab[(hl * 64 + 63) * 32 + k] - Ab[(hl * 64 + s) * 32 + k]);
                *(LAS bf16_t*)(Kt + hl * 4608 + k * 144 + s * 2) = f2bf(kvf * dec);
            }
            const int vc = (c.tid & 7) * 32;
            const u32x4* vp = (const u32x4*)(Y + (row0 + s) * NY + C_GV + vc);
#pragma unroll
            for (int q4 = 0; q4 < 4; ++q4) {
                const u32x4 v = vp[q4];
                const unsigned vv[4] = {v.x, v.y, v.z, v.w};
#pragma unroll
                for (int e = 0; e < 4; ++e) {
                    const int col = vc + q4 * 8 + 2 * e, hl = col >> 6, ee = col & 63;
                    *(LAS bf16_t*)(Vt + hl * 9216 + ee * 144 + s * 2) = (bf16_t)(vv[e] & 0xffffu);
                    *(LAS bf16_t*)(Vt + hl * 9216 + (ee + 1) * 144 + s * 2) = (bf16_t)(vv[e] >> 16);
                }
            }
        }
        __syncthreads();
        {
            const int hl = c.wave >> 1, wn = c.wave & 1, r = c.lane & 31, h = c.lane >> 5;
            f32x16 acc = mma_lds(zero16(), Kt + hl * 4608, 144, Vt + hl * 9216 + wn * 32 * 144, 144, 64, c.lane);
            float* dst = UGLA + (((size_t)(b * 4 + hl) * 128 + i) * 32 + r) * 64 + wn * 32 + 4 * h;
#pragma unroll
            for (int g = 0; g < 4; ++g) { f32x4 o; o[0] = acc[4 * g]; o[1] = acc[4 * g + 1]; o[2] = acc[4 * g + 2]; o[3] = acc[4 * g + 3]; *(f32x4*)(dst + 8 * g) = o; }
            if (c.tid < 128) { const int hl2 = c.tid >> 5, k = c.tid & 31; BL[((size_t)(b * 4 + hl2) * 128 + i) * 32 + k] = Ab[(hl2 * 64 + 63) * 32 + k]; }
        }
        __syncthreads();
    }
}
__device__ __forceinline__ void phase_gla_out(const Ctx& c, const bf16_t* Y, const float* w_alpha, const float* b_alpha, const float* SGLA, const float* norm_g, bf16_t* O) {
    LAS float* Ab = (LAS float*)c.lds;
    LAS float* lrs = (LAS float*)(c.lds + 16384);
    const lptr Qp = c.lds + 20480;
    const lptr Kp = Qp + 10240;
    const lptr Vt = Kp + 10240;
    const lptr St = Vt + 18432;
    const lptr Att = St + 10240;
    LAS float* Of = (LAS float*)(Att + 18432);
    for (int u = c.blk; u < 512; u += c.nblk) {
        const int hp = u & 1, i = (u >> 1) & 127, b = u >> 8;
        const size_t row0 = (size_t)b * SEQ + i * 64;
        gla_decays<2>(c, Y, row0, hp * 2, w_alpha, b_alpha, Ab, lrs);
        {
            const int s = c.tid >> 3, cc = (c.tid & 7) * 8;
            const int hl = cc >> 5, k0 = cc & 31;
            const u32x4 qv = *(const u32x4*)(Y + (row0 + s) * NY + C_GQ + hp * 64 + cc);
            const u32x4 kv = *(const u32x4*)(Y + (row0 + s) * NY + C_GK + hp * 64 + cc);
            const unsigned qq[4] = {qv.x, qv.y, qv.z, qv.w}, kk[4] = {kv.x, kv.y, kv.z, kv.w};
            unsigned qo[4], ko[4];
#pragma unroll
            for (int e = 0; e < 4; ++e) {
                const float b0 = Ab[(hl * 64 + s) * 32 + k0 + 2 * e], b1 = Ab[(hl * 64 + s) * 32 + k0 + 2 * e + 1];
                const float e0 = __expf(b0), e1 = __expf(b1);
                qo[e] = pk_bf16(bf_lo(qq[e]) * 0.17677669529663687f * e0, bf_hi(qq[e]) * 0.17677669529663687f * e1);
                ko[e] = pk_bf16(bf_lo(kk[e]) / e0, bf_hi(kk[e]) / e1);
            }
            u32x4 w; w.x = qo[0]; w.y = qo[1]; w.z = qo[2]; w.w = qo[3];
            *(LAS u32x4*)(Qp + hl * 5120 + s * 80 + k0 * 2) = w;
            w.x = ko[0]; w.y = ko[1]; w.z = ko[2]; w.w = ko[3];
            *(LAS u32x4*)(Kp + hl * 5120 + s * 80 + k0 * 2) = w;
            const int vc = (c.tid & 7) * 16;
            const u32x4* vp = (const u32x4*)(Y + (row0 + s) * NY + C_GV + hp * 128 + vc);
#pragma unroll
            for (int q4 = 0; q4 < 2; ++q4) {
                const u32x4 v = vp[q4];
                const unsigned vv[4] = {v.x, v.y, v.z, v.w};
#pragma unroll
                for (int e = 0; e < 4; ++e) {
                    const int col = vc + q4 * 8 + 2 * e, hl2 = col >> 6, ee = col & 63;
                    *(LAS bf16_t*)(Vt + hl2 * 9216 + ee * 144 + s * 2) = (bf16_t)(vv[e] & 0xffffu);
                    *(LAS bf16_t*)(Vt + hl2 * 9216 + (ee + 1) * 144 + s * 2) = (bf16_t)(vv[e] >> 16);
                }
            }
            const int sh = c.tid >> 8, sk = (c.tid >> 3) & 31, se = (c.tid & 7) * 8;
            const float* spp = SGLA + (((size_t)(b * 4 + hp * 2 + sh) * 128 + i) * 32 + sk) * 64 + se;
            const f32x4 s0 = *(const f32x4*)spp, s1 = *(const f32x4*)(spp + 4);
            const float sv[8] = {s0[0], s0[1], s0[2], s0[3], s1[0], s1[1], s1[2], s1[3]};
#pragma unroll
            for (int e = 0; e < 8; ++e) *(LAS bf16_t*)(St + sh * 5120 + (se + e) * 80 + sk * 2) = f2bf(sv[e]);
        }
        __syncthreads();
        const int hl = c.wave >> 2, mi = (c.wave >> 1) & 1, nj = c.wave & 1, r = c.lane & 31, h = c.lane >> 5;
        if (nj <= mi) {
            f32x16 s = mma_lds(zero16(), Qp + hl * 5120 + mi * 32 * 80, 80, Kp + hl * 5120 + nj * 32 * 80, 80, 32, c.lane);
            const int tt = mi * 32 + r;
#pragma unroll
            for (int g = 0; g < 4; ++g) {
                float p[4];
#pragma unroll
                for (int e = 0; e < 4; ++e) { const int sx = nj * 32 + 8 * g + 4 * h + e; p[e] = (sx <= tt) ? s[4 * g + e] : 0.f; }
                u32x2 w; w.x = pk_bf16(p[0], p[1]); w.y = pk_bf16(p[2], p[3]);
                *(LAS u32x2*)(Att + hl * 9216 + tt * 144 + (nj * 32 + 8 * g + 4 * h) * 2) = w;
            }
        }
        __syncthreads();
        {
            f32x16 acc = mma_lds(zero16(), Qp + hl * 5120 + mi * 32 * 80, 80, St + hl * 5120 + nj * 32 * 80, 80, 32, c.lane);
            acc = mma_lds(acc, Att + hl * 9216 + mi * 32 * 144, 144, Vt + hl * 9216 + nj * 32 * 144, 144, (mi + 1) * 32, c.lane);
            const int tt = mi * 32 + r;
#pragma unroll
            for (int g = 0; g < 4; ++g) { f32x4 o; o[0] = acc[4 * g]; o[1] = acc[4 * g + 1]; o[2] = acc[4 * g + 2]; o[3] = acc[4 * g + 3]; *(LAS f32x4*)(Of + (hl * 64 + tt) * 68 + nj * 32 + 8 * g + 4 * h) = o; }
        }
        __syncthreads();
        {
            const int rw = c.tid >> 2, part = c.tid & 3;
            const int hl2 = rw >> 6, tt = rw & 63, hh = hp * 2 + hl2;
            float v[16]; float q = 0.f;
#pragma unroll
            for (int e = 0; e < 16; ++e) { v[e] = Of[rw * 68 + part * 16 + e]; q += v[e] * v[e]; }
            q += __shfl_xor(q, 1); q += __shfl_xor(q, 2);
            const float rstd = rsqrtf(q * (1.0f / 64.0f) + LN_EPS);
            const size_t row = row0 + tt;
            const int ch = hh * 64 + part * 16;
            const u32x4* gp = (const u32x4*)(Y + row * NY + C_GR + ch);
            const u32x4 g0 = gp[0], g1 = gp[1];
            const unsigned gg[8] = {g0.x, g0.y, g0.z, g0.w, g1.x, g1.y, g1.z, g1.w};
            unsigned ow[8];
#pragma unroll
            for (int e = 0; e < 8; ++e) {
                const float y0 = v[2 * e] * rstd * norm_g[ch + 2 * e] * siluf_(bf_lo(gg[e]));
                const float y1 = v[2 * e + 1] * rstd * norm_g[ch + 2 * e + 1] * siluf_(bf_hi(gg[e]));
                ow[e] = pk_bf16(y0, y1);
            }
            u32x4* op = (u32x4*)(O + row * DM + 3 * 256 + ch);
            u32x4 w0, w1; w0.x = ow[0]; w0.y = ow[1]; w0.z = ow[2]; w0.w = ow[3]; w1.x = ow[4]; w1.y = ow[5]; w1.z = ow[6]; w1.w = ow[7];
            op[0] = w0; op[1] = w1;
        }
        __syncthreads();
    }
}

constexpr int NS_Q = 0;
constexpr int NS_K = 18432;
constexpr int NS_VT = 27648;
constexpr int NS_S = 36864;
constexpr int NS_P = 71680;
constexpr int NS_M = 90112;
constexpr int NS_L = NS_M + 512;
constexpr int NS_A = NS_L + 512;
constexpr int NS_G = NS_A + 512;
constexpr int NS_IMP = NS_G + 2048;
constexpr int NS_SEL = NS_IMP + 16384;
constexpr int NS_UM = NS_SEL + 512;
constexpr int NS_CARRY = NS_UM + 64;
constexpr int NS_END = NS_CARRY + 128;

__device__ __forceinline__ void ns_stage_rows(const Ctx& c, lptr dst, const bf16_t* src, size_t ld) {
    const int rr = c.tid >> 3, cc = (c.tid & 7) * 8;
    *(LAS u32x4*)(dst + rr * 144 + cc * 2) = *(const u32x4*)(src + (size_t)rr * ld + cc);
}
__device__ __forceinline__ void ns_stage_T(const Ctx& c, lptr dst, const bf16_t* src, size_t ld) {
    const int rr = c.tid >> 3, cc = (c.tid & 7) * 8;
    const u32x4 v = *(const u32x4*)(src + (size_t)rr * ld + cc);
    const unsigned vv[4] = {v.x, v.y, v.z, v.w};
#pragma unroll
    for (int e = 0; e < 4; ++e) {
        *(LAS bf16_t*)(dst + (cc + 2 * e) * 144 + rr * 2) = (bf16_t)(vv[e] & 0xffffu);
        *(LAS bf16_t*)(dst + (cc + 2 * e + 1) * 144 + rr * 2) = (bf16_t)(vv[e] >> 16);
    }
}
__device__ __forceinline__ void ns_scores(const Ctx& c) {
    const int wm = c.wave >> 1, wn = c.wave & 1, r = c.lane & 31, h = c.lane >> 5;
    const f32x16 s = mma_lds(zero16(), c.lds + NS_Q + wm * 32 * 144, 144, c.lds + NS_K + wn * 32 * 144, 144, 64, c.lane);
    LAS float* Sf = (LAS float*)(c.lds + NS_S);
#pragma unroll
    for (int g = 0; g < 4; ++g) { f32x4 o; o[0] = s[4 * g]; o[1] = s[4 * g + 1]; o[2] = s[4 * g + 2]; o[3] = s[4 * g + 3]; *(LAS f32x4*)(Sf + (wm * 32 + r) * 68 + wn * 32 + 8 * g + 4 * h) = o; }
}
template <int MODE>
__device__ __forceinline__ bool ns_valid(int t, int kidx, int tok, const Ctx& c, float& dist) {
    if (MODE == 0) { const int d = t - 16 * kidx - 31; dist = (float)d; return d >= 0 && kidx < 511; }
    if (MODE == 1) { const int nb = kidx >> 6; const unsigned m = ((LAS const unsigned*)(c.lds + NS_SEL))[tok * 4 + (nb >> 5)]; const int d = t - kidx; dist = (float)d; return ((m >> (nb & 31)) & 1u) && d >= 0; }
    const int d = t - kidx; dist = (float)d; return d >= 0 && d < 512;
}
template <int MODE, int PASS>
__device__ __forceinline__ void ns_softmax(const Ctx& c, int t0, int k0) {
    LAS float* Sf = (LAS float*)(c.lds + NS_S);
    LAS float* Mr = (LAS float*)(c.lds + NS_M); LAS float* Lr = (LAS float*)(c.lds + NS_L); LAS float* Ar = (LAS float*)(c.lds + NS_A);
    const int row = c.tid >> 2, part = c.tid & 3, tok = row & 31, hh = row >> 5, t = t0 + tok;
    const float slope = exp2f(-2.0f * (float)(hh + 1));
    float s[16]; bool ok[16]; float mloc = NEGF;
#pragma unroll
    for (int e = 0; e < 16; ++e) {
        const int j = part * 16 + e; float dist;
        ok[e] = ns_valid<MODE>(t, k0 + j, tok, c, dist);
        s[e] = Sf[row * 68 + j] * 0.125f - slope * dist;
        if (ok[e]) mloc = fmaxf(mloc, s[e]);
    }
    mloc = fmaxf(mloc, __shfl_xor(mloc, 1)); mloc = fmaxf(mloc, __shfl_xor(mloc, 2));
    const float mold = Mr[row], lold = Lr[row];
    if (PASS == 2) {
        const float inv = lold > 0.f ? 1.0f / lold : 0.f;
        unsigned pw[8];
#pragma unroll
        for (int e = 0; e < 16; e += 2) {
            const float p0 = ok[e] ? __expf(s[e] - mold) * inv : 0.f, p1 = ok[e + 1] ? __expf(s[e + 1] - mold) * inv : 0.f;
            Sf[row * 68 + part * 16 + e] = p0; Sf[row * 68 + part * 16 + e + 1] = p1;
            pw[e >> 1] = pk_bf16(p0, p1);
        }
        u32x4 w0, w1; w0.x = pw[0]; w0.y = pw[1]; w0.z = pw[2]; w0.w = pw[3]; w1.x = pw[4]; w1.y = pw[5]; w1.z = pw[6]; w1.w = pw[7];
        *(LAS u32x4*)(c.lds + NS_P + row * 144 + part * 32) = w0; *(LAS u32x4*)(c.lds + NS_P + row * 144 + part * 32 + 16) = w1;
        return;
    }
    const float mnew = fmaxf(mold, mloc);
    float sum = 0.f; unsigned pw[8];
#pragma unroll
    for (int e = 0; e < 16; e += 2) {
        const float p0 = ok[e] ? __expf(s[e] - mnew) : 0.f, p1 = ok[e + 1] ? __expf(s[e + 1] - mnew) : 0.f;
        sum += p0 + p1; pw[e >> 1] = pk_bf16(p0, p1);
    }
    sum += __shfl_xor(sum, 1); sum += __shfl_xor(sum, 2);
    const float alpha = __expf(mold - mnew);
    if (PASS == 1) {
        u32x4 w0, w1; w0.x = pw[0]; w0.y = pw[1]; w0.z = pw[2]; w0.w = pw[3]; w1.x = pw[4]; w1.y = pw[5]; w1.z = pw[6]; w1.w = pw[7];
        *(LAS u32x4*)(c.lds + NS_P + row * 144 + part * 32) = w0; *(LAS u32x4*)(c.lds + NS_P + row * 144 + part * 32 + 16) = w1;
    }
    if (part == 0) { Mr[row] = mnew; Lr[row] = lold * alpha + sum; Ar[row] = alpha; }
}
__device__ __forceinline__ f32x16 ns_pv(const Ctx& c, f32x16 acc, bool rescale) {
    const int wm = c.wave >> 1, wn = c.wave & 1, r = c.lane & 31;
    if (rescale) { const float a = ((LAS const float*)(c.lds + NS_A))[wm * 32 + r];
#pragma unroll
        for (int e = 0; e < 16; ++e) acc[e] *= a; }
    return mma_lds(acc, c.lds + NS_P + wm * 32 * 144, 144, c.lds + NS_VT + wn * 32 * 144, 144, 64, c.lane);
}
__device__ __forceinline__ void ns_reset_stats(const Ctx& c) {
    if (c.tid < 128) { ((LAS float*)(c.lds + NS_M))[c.tid] = NEGF; ((LAS float*)(c.lds + NS_L))[c.tid] = 0.f; ((LAS float*)(c.lds + NS_A))[c.tid] = 1.f; }
}

__device__ __forceinline__ void phase_nsa(const Ctx& c, const bf16_t* Y, const bf16_t* KC, const bf16_t* VC, bf16_t* O) {
    LAS float* Sf = (LAS float*)(c.lds + NS_S);
    LAS float* Gt = (LAS float*)(c.lds + NS_G);
    LAS float* Imp = (LAS float*)(c.lds + NS_IMP);
    LAS unsigned* Sel = (LAS unsigned*)(c.lds + NS_SEL);
    LAS unsigned* Um = (LAS unsigned*)(c.lds + NS_UM);
    LAS float* Carry = (LAS float*)(c.lds + NS_CARRY);
    const int wm = c.wave >> 1, wn = c.wave & 1, r = c.lane & 31, h = c.lane >> 5;
    for (int u = c.blk; u < 512; u += c.nblk) {
        const int tq = u & 255, b = u >> 8;
        const int t0 = tq * 32;
        const size_t row0 = (size_t)b * SEQ + t0;
        {
            const int row = c.tid >> 2, dc = (c.tid & 3) * 16, tok = row & 31, hh = row >> 5;
            const u32x4* qp = (const u32x4*)(Y + (row0 + tok) * NY + C_NQ + hh * 64 + dc);
            *(LAS u32x4*)(c.lds + NS_Q + row * 144 + dc * 2) = qp[0]; *(LAS u32x4*)(c.lds + NS_Q + row * 144 + dc * 2 + 16) = qp[1];
            if (c.tid < 384) { const int rw = c.tid / 3, gi = c.tid % 3; Gt[rw * 4 + gi] = sigmoidf_(bf2f(Y[(row0 + (rw & 31)) * NY + C_NG + (rw >> 5) * 3 + gi])); }
            for (int i = c.tid; i < 32 * 128; i += NTHREADS) Imp[i] = 0.f;
            if (c.tid < 32) Carry[c.tid] = 0.f;
            if (c.tid < 4) Um[c.tid] = 0u;
            ns_reset_stats(c);
        }
        __syncthreads();
        f32x16 outacc = zero16();
        const int ncmp = min(t0 / 16 + 1, 511);
        const int nct = (ncmp + 63) / 64;
        const bf16_t* kcb = KC + (size_t)b * 512 * 64; const bf16_t* vcb = VC + (size_t)b * 512 * 64;
        for (int ct = 0; ct < nct; ++ct) {
            ns_stage_rows(c, c.lds + NS_K, kcb + (size_t)ct * 64 * 64, 64);
            __syncthreads();
            ns_scores(c);
            __syncthreads();
            ns_softmax<0, 0>(c, t0, ct * 64);
            __syncthreads();
        }
        {
            f32x16 acc = zero16();
            for (int ct = 0; ct < nct; ++ct) {
                ns_stage_rows(c, c.lds + NS_K, kcb + (size_t)ct * 64 * 64, 64);
                ns_stage_T(c, c.lds + NS_VT, vcb + (size_t)ct * 64 * 64, 64);
                __syncthreads();
                ns_scores(c);
                __syncthreads();
                ns_softmax<0, 2>(c, t0, ct * 64);
                __syncthreads();
                acc = ns_pv(c, acc, false);
                {
                    const int tok = c.tid >> 4, g = c.tid & 15;
                    float a = 0.f, last = 0.f, prev = 0.f;
#pragma unroll
                    for (int hh = 0; hh < 4; ++hh) {
                        const LAS float* pr = Sf + (hh * 32 + tok) * 68 + 4 * g;
                        a += (pr[0] + pr[1]) + (pr[2] + pr[3]);
                        last += pr[3];
                        if (g > 0) prev += pr[-1];
                    }
                    if (g == 0) prev = Carry[tok];
                    Imp[tok * 128 + ct * 16 + g] += a + prev;
                    __syncthreads();
                    if (g == 15) Carry[tok] = last;
                }
                __syncthreads();
            }
            const float g0 = Gt[(wm * 32 + r) * 4 + 0];
#pragma unroll
            for (int e = 0; e < 16; ++e) outacc[e] += g0 * acc[e];
        }
        for (int tk = 0; tk < 4; ++tk) {
            const int tok = c.wave * 4 + tk, t = t0 + tok, cur = t >> 6;
            float v0 = Imp[tok * 128 + c.lane], v1 = Imp[tok * 128 + 64 + c.lane];
            const int n0 = c.lane, n1 = c.lane + 64;
            if (n0 > cur) v0 = NEGF; if (n1 > cur) v1 = NEGF;
            if (n0 == cur) v0 = 1e30f; if (n1 == cur) v1 = 1e30f;
            unsigned m0 = 0u, m1 = 0u, m2 = 0u, m3 = 0u;
            for (int it = 0; it < 16; ++it) {
                const float mx = wave_max(fmaxf(v0, v1));
                if (mx <= NEGF) break;
                const unsigned long long b0 = __ballot(v0 == mx);
                int nsel;
                if (b0) { nsel = __ffsll((long long)b0) - 1; if (c.lane == nsel) v0 = -3e38f; }
                else { const unsigned long long b1 = __ballot(v1 == mx); const int l1 = __ffsll((long long)b1) - 1; nsel = 64 + l1; if (c.lane == l1) v1 = -3e38f; }
                if (nsel < 32) m0 |= 1u << nsel; else if (nsel < 64) m1 |= 1u << (nsel - 32); else if (nsel < 96) m2 |= 1u << (nsel - 64); else m3 |= 1u << (nsel - 96);
            }
            if (c.lane == 0) {
                Sel[tok * 4 + 0] = m0; Sel[tok * 4 + 1] = m1; Sel[tok * 4 + 2] = m2; Sel[tok * 4 + 3] = m3;
                atomicOr((unsigned*)&Um[0], m0); atomicOr((unsigned*)&Um[1], m1); atomicOr((unsigned*)&Um[2], m2); atomicOr((unsigned*)&Um[3], m3);
            }
        }
        ns_reset_stats(c);
        __syncthreads();
        {
            f32x16 acc = zero16();
            const bf16_t* ksb = Y + (size_t)b * SEQ * NY + C_NKS; const bf16_t* vsb = Y + (size_t)b * SEQ * NY + C_NVS;
            for (int wd = 0; wd < 4; ++wd) {
                unsigned bits = Um[wd];
                while (bits) {
                    const int nb = wd * 32 + __ffs((int)bits) - 1; bits &= bits - 1;
                    ns_stage_rows(c, c.lds + NS_K, ksb + (size_t)nb * 64 * NY, NY);
                    ns_stage_T(c, c.lds + NS_VT, vsb + (size_t)nb * 64 * NY, NY);
                    __syncthreads();
                    ns_scores(c);
                    __syncthreads();
                    ns_softmax<1, 1>(c, t0, nb * 64);
                    __syncthreads();
                    acc = ns_pv(c, acc, true);
                    __syncthreads();
                }
            }
            const float l = ((LAS const float*)(c.lds + NS_L))[wm * 32 + r];
            const float g1 = Gt[(wm * 32 + r) * 4 + 1] * (l > 0.f ? 1.0f / l : 0.f);
#pragma unroll
            for (int e = 0; e < 16; ++e) outacc[e] += g1 * acc[e];
        }
        __syncthreads();
        ns_reset_stats(c);
        __syncthreads();
        {
            f32x16 acc = zero16();
            const bf16_t* kwb = Y + (size_t)b * SEQ * NY + C_NKW; const bf16_t* vwb = Y + (size_t)b * SEQ * NY + C_NVW;
            const int kt1 = t0 >> 6, kt0 = max(0, kt1 - 8);
            for (int kt = kt0; kt <= kt1; ++kt) {
                ns_stage_rows(c, c.lds + NS_K, kwb + (size_t)kt * 64 * NY, NY);
                ns_stage_T(c, c.lds + NS_VT, vwb + (size_t)kt * 64 * NY, NY);
                __syncthreads();
                ns_scores(c);
                __syncthreads();
                ns_softmax<2, 1>(c, t0, kt * 64);
                __syncthreads();
                acc = ns_pv(c, acc, true);
                __syncthreads();
            }
            const float l = ((LAS const float*)(c.lds + NS_L))[wm * 32 + r];
            const float g2 = Gt[(wm * 32 + r) * 4 + 2] * (l > 0.f ? 1.0f / l : 0.f);
#pragma unroll
            for (int e = 0; e < 16; ++e) outacc[e] += g2 * acc[e];
        }
        {
            bf16_t* op = O + (row0 + r) * DM + 256 + wm * 64 + wn * 32 + 4 * h;
#pragma unroll
            for (int g = 0; g < 4; ++g) { u32x2 w; w.x = pk_bf16(outacc[4 * g], outacc[4 * g + 1]); w.y = pk_bf16(outacc[4 * g + 2], outacc[4 * g + 3]); *(u32x2*)(op + 8 * g) = w; }
        }
        __syncthreads();
    }
}

__device__ __forceinline__ void phase_sb2(const Ctx& c, const bf16_t* Y, bf16_t* O) {
    LAS float* Sf = (LAS float*)(c.lds + NS_S);
    LAS float* Cr = (LAS float*)(c.lds + NS_M);
    const int wm = c.wave >> 1, wn = c.wave & 1, r = c.lane & 31, h = c.lane >> 5;
    for (int u = c.blk; u < 512; u += c.nblk) {
        const int qt = 63 - (u & 63), hh = (u >> 6) & 3, b = u >> 8;
        const int t0 = qt * 128;
        const size_t row0 = (size_t)b * SEQ + t0;
        {
            const int row = c.tid >> 2, dc = (c.tid & 3) * 16;
            const u32x4* qp = (const u32x4*)(Y + (row0 + row) * NY + C_SBQ + hh * 64 + dc);
            *(LAS u32x4*)(c.lds + NS_Q + row * 144 + dc * 2) = qp[0]; *(LAS u32x4*)(c.lds + NS_Q + row * 144 + dc * 2 + 16) = qp[1];
            if (c.tid < 128) Cr[c.tid] = 0.f;
        }
        f32x16 acc = zero16();
        const bf16_t* kb = Y + (size_t)b * SEQ * NY + C_SBK + hh * 64; const bf16_t* vb = Y + (size_t)b * SEQ * NY + C_SBV + hh * 64;
        for (int kt = 2 * qt + 1; kt >= 0; --kt) {
            ns_stage_rows(c, c.lds + NS_K, kb + (size_t)kt * 64 * NY, NY);
            ns_stage_T(c, c.lds + NS_VT, vb + (size_t)kt * 64 * NY, NY);
            __syncthreads();
            ns_scores(c);
            __syncthreads();
            int done;
            {
                const int row = c.tid >> 2, part = c.tid & 3, t = t0 + row;
                float z[16], suf[16]; bool ok[16];
                float run = 0.f;
#pragma unroll
                for (int e = 15; e >= 0; --e) {
                    const int pos = kt * 64 + part * 16 + e;
                    z[e] = Sf[row * 68 + part * 16 + e] * 0.125f;
                    ok[e] = pos < t;
                    run += ok[e] ? -softplusf_(z[e]) : 0.f;
                    suf[e] = run;
                }
                const float tot = run;
                const float t1 = __shfl_down(tot, 1), t2 = __shfl_down(tot, 2), t3 = __shfl_down(tot, 3);
                const float thigh = (part < 3 ? t1 : 0.f) + (part < 2 ? t2 : 0.f) + (part < 1 ? t3 : 0.f);
                const float carry = Cr[row];
                unsigned pw[8];
#pragma unroll
                for (int e = 0; e < 16; e += 2) {
                    const float w0 = ok[e] ? __expf(z[e] + carry + thigh + suf[e]) : 0.f, w1 = ok[e + 1] ? __expf(z[e + 1] + carry + thigh + suf[e + 1]) : 0.f;
                    pw[e >> 1] = pk_bf16(w0, w1);
                }
                u32x4 w0, w1; w0.x = pw[0]; w0.y = pw[1]; w0.z = pw[2]; w0.w = pw[3]; w1.x = pw[4]; w1.y = pw[5]; w1.z = pw[6]; w1.w = pw[7];
                *(LAS u32x4*)(c.lds + NS_P + row * 144 + part * 32) = w0; *(LAS u32x4*)(c.lds + NS_P + row * 144 + part * 32 + 16) = w1;
                const float cn = carry + thigh + tot;
                if (part == 0) Cr[row] = cn;
                done = (part != 0) || (cn < -104.0f);
            }
            const int alldone = __syncthreads_and(done);
            acc = ns_pv(c, acc, false);
            __syncthreads();
            if (alldone) break;
        }
        {
            bf16_t* op = O + (row0 + wm * 32 + r) * DM + hh * 64 + wn * 32 + 4 * h;
#pragma unroll
            for (int g = 0; g < 4; ++g) { u32x2 w; w.x = pk_bf16(acc[4 * g], acc[4 * g + 1]); w.y = pk_bf16(acc[4 * g + 2], acc[4 * g + 3]); *(u32x2*)(op + 8 * g) = w; }
        }
        __syncthreads();
    }
}

__device__ __forceinline__ void phase_subkey(const Ctx& c, const bf16_t* QV, const bf16_t* KEYS, float* TOPS, int* TOPI) {
    constexpr int SC_OFF = 73728;
    LAS float* Sc = (LAS float*)(c.lds + SC_OFF);
    const int wm = c.wave >> 1, wn = c.wave & 1, r = c.lane & 31, h = c.lane >> 5;
    for (int u = c.blk; u < 128 * 16; u += c.nblk) {
        const int hp = u & 15, pm = u >> 4;
        f32x16 acc[1][2]; acc_zero<1, 2>(acc);
        gemm_kloop<1, 2>(c, acc, QV + (size_t)pm * 128 * 2048 + hp * 128, 2048, KEYS + (size_t)hp * 128 * 128, 128, 128);
        EPI_LOOP(1, 2) {
            const int m = (wm + i) * 32 + r, n = (wn * 2 + j) * 32 + 8 * g + 4 * h;
            f32x4 o; o[0] = acc[i][j][4 * g]; o[1] = acc[i][j][4 * g + 1]; o[2] = acc[i][j][4 * g + 2]; o[3] = acc[i][j][4 * g + 3];
            *(LAS f32x4*)(Sc + m * 132 + n) = o;
        }
        __syncthreads();
        for (int rr = 0; rr < 16; ++rr) {
            const int row = c.wave * 16 + rr;
            float v0 = Sc[row * 132 + c.lane], v1 = Sc[row * 132 + 64 + c.lane];
            float ks = 0.f; int ki = 0;
            for (int it = 0; it < 16; ++it) {
                const float mx = wave_max(fmaxf(v0, v1));
                const unsigned long long b0 = __ballot(v0 == mx);
                int nsel;
                if (b0) { nsel = __ffsll((long long)b0) - 1; if (c.lane == nsel) v0 = -3e38f; }
                else { const unsigned long long b1 = __ballot(v1 == mx); const int l1 = __ffsll((long long)b1) - 1; nsel = 64 + l1; if (c.lane == l1) v1 = -3e38f; }
                if (c.lane == it) { ks = mx; ki = nsel; }
            }
            if (c.lane < 16) {
                const size_t o = ((size_t)(pm * 128 + row) * 16 + hp) * 16 + c.lane;
                TOPS[o] = ks; TOPI[o] = ki;
            }
        }
        __syncthreads();
    }
}


__device__ __forceinline__ unsigned ord_key(float s) { const unsigned u = __float_as_uint(s); return u ^ ((unsigned)((int)u >> 31) | 0x80000000u); }
__device__ __forceinline__ float unord_key(unsigned k) { const unsigned u = (k & 0x80000000u) ? (k ^ 0x80000000u) : ~k; return __uint_as_float(u); }
#define CE_DESC(a, b) do { const unsigned _hi = max((a), (b)), _lo = min((a), (b)); (a) = _hi; (b) = _lo; } while (0)
__device__ __forceinline__ void sort16_desc(unsigned (&k)[16]) {
#pragma unroll
    for (int size = 2; size <= 16; size <<= 1)
#pragma unroll
        for (int stride = size >> 1; stride > 0; stride >>= 1)
#pragma unroll
            for (int i = 0; i < 16; ++i) {
                const int j = i ^ stride;
                if (j > i) { if ((i & size) == 0) CE_DESC(k[i], k[j]); else CE_DESC(k[j], k[i]); }
            }
}
__device__ __forceinline__ void bitonic_merge16_desc(unsigned (&k)[16]) {
#pragma unroll
    for (int stride = 8; stride > 0; stride >>= 1)
#pragma unroll
        for (int i = 0; i < 16; ++i) { const int j = i ^ stride; if (j > i) CE_DESC(k[i], k[j]); }
}
__device__ __forceinline__ void top16_merge(unsigned (&a)[16], const unsigned (&b)[16]) {
#pragma unroll
    for (int i = 0; i < 16; ++i) a[i] = max(a[i], b[15 - i]);
    bitonic_merge16_desc(a);
}

__device__ __forceinline__ void phase_subkey2(const Ctx& c, const bf16_t* QV, const bf16_t* KEYS, float* TOPS, int* TOPI) {
    const lptr Ab = c.lds, Bb = c.lds + 256 * 272;
    const int r = c.lane & 31, h = c.lane >> 5;
    int cur_hp = -1;
    for (int u = c.blk; u < 64 * 16; u += c.nblk) {
        const int hp = u & 15, pm = u >> 4;
        if (hp != cur_hp) {
            cur_hp = hp;
#pragma unroll
            for (int i = 0; i < 4; ++i) { const int id = c.tid + i * NTHREADS; *(LAS u32x4*)(Bb + (id >> 4) * 272 + (id & 15) * 16) = *(const u32x4*)(KEYS + (size_t)hp * 128 * 128 + (size_t)(id >> 4) * 128 + (id & 15) * 8); }
        }
#pragma unroll
        for (int i = 0; i < 8; ++i) { const int id = c.tid + i * NTHREADS; *(LAS u32x4*)(Ab + (id >> 4) * 272 + (id & 15) * 16) = *(const u32x4*)(QV + (size_t)(pm * 256 + (id >> 4)) * 2048 + hp * 128 + (id & 15) * 8); }
        __syncthreads();
        f32x16 acc[4];
#pragma unroll
        for (int j = 0; j < 4; ++j) acc[j] = zero16();
#pragma unroll
        for (int s = 0; s < 8; ++s) {
            const bf16x8 fa = *(LAS const bf16x8*)(Ab + (c.wave * 32 + r) * 272 + s * 32 + h * 16);
#pragma unroll
            for (int j = 0; j < 4; ++j) {
                const bf16x8 fb = *(LAS const bf16x8*)(Bb + (j * 32 + r) * 272 + s * 32 + h * 16);
                acc[j] = __builtin_amdgcn_mfma_f32_32x32x16_bf16(fb, fa, acc[j], 0, 0, 0);
            }
        }
        unsigned best[16];
#pragma unroll
        for (int j = 0; j < 4; ++j) {
            unsigned k[16];
#pragma unroll
            for (int g = 0; g < 4; ++g)
#pragma unroll
                for (int e = 0; e < 4; ++e) { const int n = j * 32 + 8 * g + 4 * h + e; k[4 * g + e] = (ord_key(acc[j][4 * g + e]) & ~127u) | (unsigned)(127 - n); }
            sort16_desc(k);
            if (j == 0) {
#pragma unroll
                for (int i = 0; i < 16; ++i) best[i] = k[i];
            } else top16_merge(best, k);
        }
        {
            unsigned other[16];
#pragma unroll
            for (int i = 0; i < 16; ++i) other[i] = (unsigned)__shfl_xor((int)best[i], 32);
            top16_merge(best, other);
        }
        {
            const size_t o = ((size_t)(pm * 256 + c.wave * 32 + r) * 16 + hp) * 16 + 8 * h;
            f32x4 s0, s1; int i0[4], i1[4];
#pragma unroll
            for (int i = 0; i < 4; ++i) {
                const unsigned ka = h ? best[8 + i] : best[i], kb = h ? best[12 + i] : best[4 + i];
                s0[i] = unord_key((ka & ~127u) | 64u); s1[i] = unord_key((kb & ~127u) | 64u);
                i0[i] = 127 - (int)(ka & 127u); i1[i] = 127 - (int)(kb & 127u);
            }
            *(f32x4*)(TOPS + o) = s0; *(f32x4*)(TOPS + o + 4) = s1;
            int4 w0 = make_int4(i0[0], i0[1], i0[2], i0[3]), w1 = make_int4(i1[0], i1[1], i1[2], i1[3]);
            *(int4*)(TOPI + o) = w0; *(int4*)(TOPI + o + 4) = w1;
        }
        __syncthreads();
    }
}

__device__ __forceinline__ float gelu_erf(float x) { return 0.5f * x * (1.0f + erff(x * 0.70710678118654752f)); }
__device__ __forceinline__ void phase_peer(const Ctx& c, const float* XF, const bf16_t* XB, const float* TOPS, const int* TOPI, const bf16_t* UB, const bf16_t* VB,
                                           const float* ln_g, const float* ln_b, float* outf, bf16_t* outb, bool store) {
    LAS int* eidx = (LAS int*)(c.lds + c.wave * 1024);
    LAS float* ewt = (LAS float*)(c.lds + c.wave * 1024 + 512);
    const int lane = c.lane;
    for (int tok = c.blk * 8 + c.wave; tok < NTOK; tok += c.nblk * 8) {
        for (int hh = 0; hh < 8; ++hh) {
            const float* ts = TOPS + ((size_t)tok * 16 + hh * 2) * 16; const int* ti = TOPI + ((size_t)tok * 16 + hh * 2) * 16;
            const int a = lane >> 2, bq = (lane & 3) * 4;
            const float sa = ts[a];
            const f32x4 sb = *(const f32x4*)(ts + 16 + bq);
            float v[4] = {sa + sb[0], sa + sb[1], sa + sb[2], sa + sb[3]};
            float ks = 0.f; int kf = 0;
            for (int it = 0; it < 16; ++it) {
                const float lm = fmaxf(fmaxf(v[0], v[1]), fmaxf(v[2], v[3]));
                const float mx = wave_max(lm);
                const unsigned long long bl = __ballot(lm == mx);
                const int wl = (__ffsll((long long)bl) - 1) & 63;
                int li = (v[0] == mx) ? 0 : (v[1] == mx) ? 1 : (v[2] == mx) ? 2 : 3;
                li = __builtin_amdgcn_readlane(li, wl);
                if (lane == wl) { if (li == 0) v[0] = -3e38f; else if (li == 1) v[1] = -3e38f; else if (li == 2) v[2] = -3e38f; else v[3] = -3e38f; }
                if (lane == it) { ks = mx; kf = wl * 4 + li; }
            }
            float mx16 = (lane < 16) ? ks : -3e38f;
            mx16 = wave_max(mx16);
            const float ex = (lane < 16) ? __expf(ks - mx16) : 0.f;
            const float den = wave_sum(ex);
            if (lane < 16) {
                const int ia = ti[kf >> 4], ib = ti[16 + (kf & 15)];
                eidx[hh * 16 + lane] = (ia * 128 + ib) & 16383;
                ewt[hh * 16 + lane] = ex / den;
            }
        }
        asm volatile("s_waitcnt lgkmcnt(0)" ::: "memory");
        unsigned xb[8];
        {
            const u32x4 x0 = *(const u32x4*)(XB + (size_t)tok * DM + lane * 8), x1 = *(const u32x4*)(XB + (size_t)tok * DM + 512 + lane * 8);
            xb[0] = x0.x; xb[1] = x0.y; xb[2] = x0.z; xb[3] = x0.w; xb[4] = x1.x; xb[5] = x1.y; xb[6] = x1.z; xb[7] = x1.w;
        }
        for (int e0 = 0; e0 < 128; e0 += 8) {
            u32x4 ua[8], ub2[8];
#pragma unroll
            for (int j = 0; j < 8; ++j) {
                const int ex = __builtin_amdgcn_readfirstlane(eidx[e0 + j]);
                const bf16_t* up = UB + (size_t)ex * DM;
                ua[j] = *(const u32x4*)(up + lane * 8); ub2[j] = *(const u32x4*)(up + 512 + lane * 8);
            }
            float p[8];
#pragma unroll
            for (int j = 0; j < 8; ++j) {
                float s0 = dot2bf(xb[0], ua[j].x, 0.f), s1 = dot2bf(xb[1], ua[j].y, 0.f);
                s0 = dot2bf(xb[2], ua[j].z, s0); s1 = dot2bf(xb[3], ua[j].w, s1);
                s0 = dot2bf(xb[4], ub2[j].x, s0); s1 = dot2bf(xb[5], ub2[j].y, s1);
                s0 = dot2bf(xb[6], ub2[j].z, s0); s1 = dot2bf(xb[7], ub2[j].w, s1);
                p[j] = s0 + s1;
            }
            const bool b5 = lane & 32, b4 = lane & 16, b3 = lane & 8;
            float q4[4], q2[2], q1;
#pragma unroll
            for (int j = 0; j < 4; ++j) { const float send = b5 ? p[j] : p[j + 4], keep = b5 ? p[j + 4] : p[j]; q4[j] = keep + __shfl_xor(send, 32); }
#pragma unroll
            for (int j = 0; j < 2; ++j) { const float send = b4 ? q4[j] : q4[j + 2], keep = b4 ? q4[j + 2] : q4[j]; q2[j] = keep + __shfl_xor(send, 16); }
            { const float send = b3 ? q2[0] : q2[1], keep = b3 ? q2[1] : q2[0]; q1 = keep + __shfl_xor(send, 8); }
            q1 += __shfl_xor(q1, 4); q1 += __shfl_xor(q1, 2); q1 += __shfl_xor(q1, 1);
            const int jx = (b5 ? 4 : 0) + (b4 ? 2 : 0) + (b3 ? 1 : 0);
            if ((lane & 7) == 0) ewt[e0 + jx] = ewt[e0 + jx] * gelu_erf(q1);
        }
        asm volatile("s_waitcnt lgkmcnt(0)" ::: "memory");
        float y[16];
#pragma unroll
        for (int i = 0; i < 16; ++i) y[i] = 0.f;
        for (int e0 = 0; e0 < 128; e0 += 8) {
            u32x4 va[8], vb2[8];
#pragma unroll
            for (int j = 0; j < 8; ++j) {
                const int ex = __builtin_amdgcn_readfirstlane(eidx[e0 + j]);
                const bf16_t* vp = VB + (size_t)ex * DM;
                va[j] = *(const u32x4*)(vp + lane * 8); vb2[j] = *(const u32x4*)(vp + 512 + lane * 8);
            }
#pragma unroll
            for (int j = 0; j < 8; ++j) {
                const float w = ewt[e0 + j];
                y[0] += w * bf_lo(va[j].x); y[1] += w * bf_hi(va[j].x); y[2] += w * bf_lo(va[j].y); y[3] += w * bf_hi(va[j].y);
                y[4] += w * bf_lo(va[j].z); y[5] += w * bf_hi(va[j].z); y[6] += w * bf_lo(va[j].w); y[7] += w * bf_hi(va[j].w);
                y[8] += w * bf_lo(vb2[j].x); y[9] += w * bf_hi(vb2[j].x); y[10] += w * bf_lo(vb2[j].y); y[11] += w * bf_hi(vb2[j].y);
                y[12] += w * bf_lo(vb2[j].z); y[13] += w * bf_hi(vb2[j].z); y[14] += w * bf_lo(vb2[j].w); y[15] += w * bf_hi(vb2[j].w);
            }
        }
        {
            const float* xr = XF + (size_t)tok * DM;
            const f32x4 a0 = *(const f32x4*)(xr + lane * 8), a1 = *(const f32x4*)(xr + lane * 8 + 4), a2 = *(const f32x4*)(xr + 512 + lane * 8), a3 = *(const f32x4*)(xr + 512 + lane * 8 + 4);
            const float xs[16] = {a0[0], a0[1], a0[2], a0[3], a1[0], a1[1], a1[2], a1[3], a2[0], a2[1], a2[2], a2[3], a3[0], a3[1], a3[2], a3[3]};
            float s = 0.f;
#pragma unroll
            for (int i = 0; i < 16; ++i) { y[i] = DN_ALPHA * xs[i] + y[i]; s += y[i]; }
            const float mean = wave_sum(s) * (1.0f / 1024.0f);
            float q = 0.f;
#pragma unroll
            for (int i = 0; i < 16; ++i) { const float d = y[i] - mean; q += d * d; }
            const float rstd = rsqrtf(wave_sum(q) * (1.0f / 1024.0f) + LN_EPS);
            float o[16];
#pragma unroll
            for (int i = 0; i < 16; ++i) { const int ch = (i < 8) ? lane * 8 + i : 512 + lane * 8 + (i - 8); o[i] = (y[i] - mean) * rstd * ln_g[ch] + ln_b[ch]; }
            if (store) {
            float* of = outf + (size_t)tok * DM;
            f32x4 w;
            w[0] = o[0]; w[1] = o[1]; w[2] = o[2]; w[3] = o[3]; *(f32x4*)(of + lane * 8) = w;
            w[0] = o[4]; w[1] = o[5]; w[2] = o[6]; w[3] = o[7]; *(f32x4*)(of + lane * 8 + 4) = w;
            w[0] = o[8]; w[1] = o[9]; w[2] = o[10]; w[3] = o[11]; *(f32x4*)(of + 512 + lane * 8) = w;
            w[0] = o[12]; w[1] = o[13]; w[2] = o[14]; w[3] = o[15]; *(f32x4*)(of + 512 + lane * 8 + 4) = w;
            if (outb) {
                u32x4 pb; pb.x = pk_bf16(o[0], o[1]); pb.y = pk_bf16(o[2], o[3]); pb.z = pk_bf16(o[4], o[5]); pb.w = pk_bf16(o[6], o[7]);
                *(u32x4*)(outb + (size_t)tok * DM + lane * 8) = pb;
                pb.x = pk_bf16(o[8], o[9]); pb.y = pk_bf16(o[10], o[11]); pb.z = pk_bf16(o[12], o[13]); pb.w = pk_bf16(o[14], o[15]);
                *(u32x4*)(outb + (size_t)tok * DM + 512 + lane * 8) = pb;
            }
            }
        }
        asm volatile("s_waitcnt lgkmcnt(0)" ::: "memory");
    }
}


__device__ __forceinline__ void phase_peer2(const Ctx& c, const float* XF, const bf16_t* XB, const float* TOPS, const int* TOPI, const unsigned char* U8, const unsigned char* V8,
                                            const float* SU, const float* SV, const float* ln_g, const float* ln_b, float* outf, bf16_t* outb, bool store) {
    LAS int* ent_e = (LAS int*)(c.lds + c.wave * 16384);
    LAS float* ent_g = (LAS float*)(c.lds + c.wave * 16384 + 4096);
    LAS float* ent_su = (LAS float*)(c.lds + c.wave * 16384 + 8192);
    LAS float* ent_sv = (LAS float*)(c.lds + c.wave * 16384 + 12288);
    const int lane = c.lane;
    for (int base = (c.blk * 8 + c.wave) * 8; base < NTOK; base += c.nblk * 64) {
        {
            const int ti_ = lane >> 3, hh = lane & 7, t = base + ti_;
            const float* ts = TOPS + ((size_t)t * 16 + hh * 2) * 16; const int* tix = TOPI + ((size_t)t * 16 + hh * 2) * 16;
            float s0[16], s1[16];
#pragma unroll
            for (int i = 0; i < 4; ++i) { const f32x4 a = *(const f32x4*)(ts + 4 * i), b = *(const f32x4*)(ts + 16 + 4 * i);
                s0[4 * i] = a[0]; s0[4 * i + 1] = a[1]; s0[4 * i + 2] = a[2]; s0[4 * i + 3] = a[3]; s1[4 * i] = b[0]; s1[4 * i + 1] = b[1]; s1[4 * i + 2] = b[2]; s1[4 * i + 3] = b[3]; }
            unsigned best[16];
#pragma unroll
            for (int g = 0; g < 4; ++g) {
                unsigned k[16];
#pragma unroll
                for (int j = 0; j < 16; ++j) {
                    constexpr int cnt[16] = {16, 8, 5, 4, 3, 2, 2, 2, 1, 1, 1, 1, 1, 1, 1, 1};
                    int idx = 16 * g + j, a = -1, b = 0;
#pragma unroll
                    for (int aa = 0; aa < 16; ++aa) { if (a < 0) { if (idx < cnt[aa]) { a = aa; b = idx; } else idx -= cnt[aa]; } }
                    if (a >= 0) k[j] = (ord_key(s0[a] + s1[b]) & ~255u) | (unsigned)(255 - (a * 16 + b)); else k[j] = 0u;
                }
                sort16_desc(k);
                if (g == 0) {
#pragma unroll
                    for (int i = 0; i < 16; ++i) best[i] = k[i];
                } else top16_merge(best, k);
            }
            float sc[16]; int ee[16]; float mx = -3e38f;
#pragma unroll
            for (int k = 0; k < 16; ++k) {
                const int f = 255 - (int)(best[k] & 255u), a = f >> 4, b = f & 15;
                sc[k] = ts[a] + ts[16 + b]; ee[k] = tix[a] * 128 + tix[16 + b];
                mx = fmaxf(mx, sc[k]);
            }
            float den = 0.f;
#pragma unroll
            for (int k = 0; k < 16; ++k) { sc[k] = __expf(sc[k] - mx); den += sc[k]; }
            const float rden = 1.0f / den;
#pragma unroll
            for (int k = 0; k < 16; ++k) {
                const int e = ee[k] & 16383, slot = ti_ * 128 + hh * 16 + k;
                ent_e[slot] = e; ent_g[slot] = sc[k] * rden; ent_su[slot] = SU[e]; ent_sv[slot] = SV[e];
            }
        }
        asm volatile("s_waitcnt lgkmcnt(0)" ::: "memory");
#pragma unroll 1
        for (int ti_ = 0; ti_ < 8; ++ti_) {
            const int tok = base + ti_;
            LAS const int* ee = ent_e + ti_ * 128; LAS float* eg = ent_g + ti_ * 128; LAS const float* esu = ent_su + ti_ * 128; LAS const float* esv = ent_sv + ti_ * 128;
            int xq[4]; float sx;
            {
                const u32x4 x0 = *(const u32x4*)(XB + (size_t)tok * DM + lane * 16), x1 = *(const u32x4*)(XB + (size_t)tok * DM + lane * 16 + 8);
                const unsigned xw[8] = {x0.x, x0.y, x0.z, x0.w, x1.x, x1.y, x1.z, x1.w};
                float xv[16]; float am = 0.f;
#pragma unroll
                for (int i = 0; i < 8; ++i) { xv[2 * i] = bf_lo(xw[i]); xv[2 * i + 1] = bf_hi(xw[i]); am = fmaxf(am, fmaxf(fabsf(xv[2 * i]), fabsf(xv[2 * i + 1]))); }
                am = wave_max(am);
                const float inv = am > 0.f ? 127.0f / am : 0.f; sx = am * (1.0f / 127.0f);
#pragma unroll
                for (int i = 0; i < 4; ++i) {
                    unsigned pk = 0u;
#pragma unroll
                    for (int e = 0; e < 4; ++e) { const int q = (int)__builtin_rintf(xv[4 * i + e] * inv); pk |= ((unsigned)q & 0xffu) << (8 * e); }
                    xq[i] = (int)pk;
                }
            }
#pragma unroll 1
            for (int e0 = 0; e0 < 128; e0 += 16) {
                u32x4 ur[16];
#pragma unroll
                for (int j = 0; j < 16; ++j) { const int ex = __builtin_amdgcn_readfirstlane(ee[e0 + j]); ur[j] = *(const u32x4*)(U8 + (size_t)ex * 1024 + lane * 16); }
                int p[16];
#pragma unroll
                for (int j = 0; j < 16; ++j) {
                    int a = __builtin_amdgcn_sdot4(xq[0], (int)ur[j].x, 0, false);
                    a = __builtin_amdgcn_sdot4(xq[1], (int)ur[j].y, a, false);
                    a = __builtin_amdgcn_sdot4(xq[2], (int)ur[j].z, a, false);
                    p[j] = __builtin_amdgcn_sdot4(xq[3], (int)ur[j].w, a, false);
                }
                const bool b5 = lane & 32, b4 = lane & 16, b3 = lane & 8, b2 = lane & 4;
                int q8[8], q4[4], q2[2], q1;
#pragma unroll
                for (int j = 0; j < 8; ++j) { const int send = b5 ? p[j] : p[j + 8], keep = b5 ? p[j + 8] : p[j]; q8[j] = keep + __shfl_xor(send, 32); }
#pragma unroll
                for (int j = 0; j < 4; ++j) { const int send = b4 ? q8[j] : q8[j + 4], keep = b4 ? q8[j + 4] : q8[j]; q4[j] = keep + __shfl_xor(send, 16); }
#pragma unroll
                for (int j = 0; j < 2; ++j) { const int send = b3 ? q4[j] : q4[j + 2], keep = b3 ? q4[j + 2] : q4[j]; q2[j] = keep + __shfl_xor(send, 8); }
                { const int send = b2 ? q2[0] : q2[1], keep = b2 ? q2[1] : q2[0]; q1 = keep + __shfl_xor(send, 4); }
                q1 += __shfl_xor(q1, 2); q1 += __shfl_xor(q1, 1);
                if ((lane & 3) == 0) {
                    const int jx = e0 + (lane >> 2);
                    const float dot = esu[jx] * sx * (float)q1;
                    eg[jx] = eg[jx] * gelu_erf(dot) * esv[jx];
                }
            }
            asm volatile("s_waitcnt lgkmcnt(0)" ::: "memory");
            float y[16]; float sw = 0.f;
#pragma unroll
            for (int i = 0; i < 16; ++i) y[i] = 0.f;
#pragma unroll 1
            for (int e0 = 0; e0 < 128; e0 += 16) {
                u32x4 vr[16];
#pragma unroll
                for (int j = 0; j < 16; ++j) { const int ex = __builtin_amdgcn_readfirstlane(ee[e0 + j]); vr[j] = *(const u32x4*)(V8 + (size_t)ex * 1024 + lane * 16); }
#pragma unroll
                for (int j = 0; j < 16; ++j) {
                    const float w = eg[e0 + j]; sw += w;
                    const unsigned vw[4] = {vr[j].x, vr[j].y, vr[j].z, vr[j].w};
#pragma unroll
                    for (int i = 0; i < 4; ++i) {
                        y[4 * i + 0] += w * (float)(vw[i] & 0xffu); y[4 * i + 1] += w * (float)((vw[i] >> 8) & 0xffu);
                        y[4 * i + 2] += w * (float)((vw[i] >> 16) & 0xffu); y[4 * i + 3] += w * (float)(vw[i] >> 24);
                    }
                }
            }
            {
                const float* xr = XF + (size_t)tok * DM + lane * 16;
                const f32x4 a0 = *(const f32x4*)(xr), a1 = *(const f32x4*)(xr + 4), a2 = *(const f32x4*)(xr + 8), a3 = *(const f32x4*)(xr + 12);
                const float xs[16] = {a0[0], a0[1], a0[2], a0[3], a1[0], a1[1], a1[2], a1[3], a2[0], a2[1], a2[2], a2[3], a3[0], a3[1], a3[2], a3[3]};
                float s = 0.f;
#pragma unroll
                for (int i = 0; i < 16; ++i) { y[i] = DN_ALPHA * xs[i] + (y[i] - 128.0f * sw); s += y[i]; }
                const float mean = wave_sum(s) * (1.0f / 1024.0f);
                float q = 0.f;
#pragma unroll
                for (int i = 0; i < 16; ++i) { const float d = y[i] - mean; q += d * d; }
                const float rstd = rsqrtf(wave_sum(q) * (1.0f / 1024.0f) + LN_EPS);
                float o[16];
#pragma unroll
                for (int i = 0; i < 4; ++i) {
                    const f32x4 gg = *(const f32x4*)(ln_g + lane * 16 + 4 * i), bb = *(const f32x4*)(ln_b + lane * 16 + 4 * i);
#pragma unroll
                    for (int e = 0; e < 4; ++e) o[4 * i + e] = (y[4 * i + e] - mean) * rstd * gg[e] + bb[e];
                }
                if (store) {
                    float* of = outf + (size_t)tok * DM + lane * 16;
#pragma unroll
                    for (int i = 0; i < 4; ++i) { f32x4 w; w[0] = o[4 * i]; w[1] = o[4 * i + 1]; w[2] = o[4 * i + 2]; w[3] = o[4 * i + 3]; *(f32x4*)(of + 4 * i) = w; }
                    if (outb) {
                        u32x4 pb; pb.x = pk_bf16(o[0], o[1]); pb.y = pk_bf16(o[2], o[3]); pb.z = pk_bf16(o[4], o[5]); pb.w = pk_bf16(o[6], o[7]);
                        *(u32x4*)(outb + (size_t)tok * DM + lane * 16) = pb;
                        pb.x = pk_bf16(o[8], o[9]); pb.y = pk_bf16(o[10], o[11]); pb.z = pk_bf16(o[12], o[13]); pb.w = pk_bf16(o[14], o[15]);
                        *(u32x4*)(outb + (size_t)tok * DM + lane * 16 + 8) = pb;
                    }
                }
            }
        }
        asm volatile("s_waitcnt lgkmcnt(0)" ::: "memory");
    }
}

__device__ __forceinline__ void quant_rows(const Ctx& c, const float* src, unsigned char* dst, float* scale, int R, int bias) {
    const int gw = c.blk * 8 + c.wave, nw = c.nblk * 8;
    for (int row = gw; row < R; row += nw) {
        const f32x4* p = (const f32x4*)(src + (size_t)row * 1024 + c.lane * 16);
        f32x4 v[4]; float am = 0.f;
#pragma unroll
        for (int i = 0; i < 4; ++i) { v[i] = p[i]; am = fmaxf(am, fmaxf(fmaxf(fabsf(v[i][0]), fabsf(v[i][1])), fmaxf(fabsf(v[i][2]), fabsf(v[i][3])))); }
        am = wave_max(am);
        const float inv = am > 0.f ? 127.0f / am : 0.f;
        unsigned w[4];
#pragma unroll
        for (int i = 0; i < 4; ++i) {
            unsigned pk = 0u;
#pragma unroll
            for (int e = 0; e < 4; ++e) { const int q = (int)__builtin_rintf(v[i][e] * inv) + bias; pk |= ((unsigned)q & 0xffu) << (8 * e); }
            w[i] = pk;
        }
        u32x4 o; o.x = w[0]; o.y = w[1]; o.z = w[2]; o.w = w[3];
        *(u32x4*)(dst + (size_t)row * 1024 + c.lane * 16) = o;
        if (c.lane == 0) scale[row] = am > 0.f ? am * (1.0f / 127.0f) : 1.0f;
    }
}

__device__ __forceinline__ void phase_prologue(const Ctx& c, const Args& a, bf16_t* WIN, bf16_t* WG, bf16_t* WB, bf16_t* WO, bf16_t* WQ, bf16_t* KEYS, bf16_t* UB, bf16_t* VB, float* HF, bf16_t* HB) {
#pragma unroll 1
    for (int l = 0; l < 2; ++l) {
        transpose_cvt(c, a.in[3] + (size_t)l * 1024 * W_IN_LD, W_IN_LD, 1024, 0, 3228, NY, 1, WIN + (size_t)l * NY * 1024, 1024);
        transpose_cvt(c, a.in[3] + (size_t)l * 1024 * W_IN_LD, W_IN_LD, 1024, W_MG, 4096, 4096, 0, WG + (size_t)l * 4096 * 1024, 1024);
#pragma unroll 1
        for (int nb = 0; nb < 4; ++nb)
            transpose_cvt(c, a.in[12] + (size_t)(l * 4 + nb) * 256 * 1024, 1024, 256, 0, 1024, 1024, 0, WB + (size_t)(l * 4 + nb) * 1024 * 256, 256);
        transpose_cvt(c, a.in[13] + (size_t)l * 1024 * 1024, 1024, 1024, 0, 1024, 1024, 0, WO + (size_t)l * 1024 * 1024, 1024);
        transpose_cvt(c, a.in[16] + (size_t)l * 1024 * 2048, 2048, 1024, 0, 2048, 2048, 0, WQ + (size_t)l * 2048 * 1024, 1024);
    }
    convert_flat(c, a.in[17], KEYS, (size_t)2 * 16 * 128 * 128);
    quant_rows(c, a.in[18], (unsigned char*)UB, (float*)((unsigned char*)UB + 32 * MB), 2 * 16384, 0);
    quant_rows(c, a.in[19], (unsigned char*)VB, (float*)((unsigned char*)VB + 32 * MB), 2 * 16384, 128);
    ln_rows(c, a.in[0], a.in[1], a.in[2], HF, HB);
}

constexpr int PH_PER_LAYER = 10, N_PHASES = 1 + 2 * PH_PER_LAYER;

__global__ void __launch_bounds__(NTHREADS, 2) mk_fwd(Args a) {
    extern __shared__ __attribute__((aligned(16))) unsigned char lds_raw[];
    Ctx c0;
    c0.lds = (lptr)lds_raw; c0.tid = threadIdx.x; c0.lane = c0.tid & 63; c0.wave = __builtin_amdgcn_readfirstlane(c0.tid >> 6);
    c0.nblk = gridDim.x; c0.blk = blockIdx.x; c0.ws = a.ws;
    volatile LAS unsigned* st = (volatile LAS unsigned*)(c0.lds + LDS_BYTES - 16);
    if (c0.tid == 0) { st[0] = 0u; st[1] = 0u; st[2] = 0u; st[3] = 0u; }
    __syncthreads();
    const int lo = a.ph_lo, hi = a.ph_hi;
    XcdBarrier bar; bar.bar = (unsigned*)(a.ws + WS_CTL); bar.x = 0; bar.st = st;
    if (hi - lo > 1) bar = xcd_barrier_post((unsigned*)(a.ws + WS_CTL), st);
#define IN(k) (lo <= (k) && (k) < hi)
#ifndef ONLY_PHASE
#define ONLY_PHASE -1
#endif
#define EN(j) (ONLY_PHASE < 0 || ONLY_PHASE == (j))
#define SEAM(k) do { if (IN(k) && IN((k) + 1)) xcd_barrier(bar); } while (0)
#define FRESH() Ctx c = c0; asm volatile("" : "+v"(c.tid)); c.lane = c.tid & 63; asm volatile("" : "+s"(c.wave), "+s"(c.blk), "+s"(c.nblk))

    unsigned char* ws = a.ws;
    float* HF = (float*)(ws + WS_HF); bf16_t* HB = (bf16_t*)(ws + WS_HB); bf16_t* Y = (bf16_t*)(ws + WS_Y); float* Z = (float*)(ws + WS_Z);
    float* TOPS = (float*)(ws + WS_TOPS); int* TOPI = (int*)(ws + WS_TOPI); bf16_t* O = (bf16_t*)(ws + WS_O); bf16_t* MIX = (bf16_t*)(ws + WS_MIX);
    bf16_t* QV = (bf16_t*)(ws + WS_QV); float* UST = (float*)(ws + WS_UST); float* RST = (float*)(ws + WS_RST); float* UGLA = (float*)(ws + WS_UGLA);
    float* SGLA = (float*)(ws + WS_SGLA); float* BL = (float*)(ws + WS_BL); bf16_t* KC = (bf16_t*)(ws + WS_KC); bf16_t* VC = (bf16_t*)(ws + WS_VC);
    bf16_t* WIN = (bf16_t*)(ws + WS_WIN); bf16_t* WG = (bf16_t*)(ws + WS_WG); bf16_t* WB = (bf16_t*)(ws + WS_WB); bf16_t* WO = (bf16_t*)(ws + WS_WO);
    bf16_t* WQ = (bf16_t*)(ws + WS_WQ); bf16_t* KEYS = (bf16_t*)(ws + WS_KEYS); bf16_t* UB = (bf16_t*)(ws + WS_UB); bf16_t* VB = (bf16_t*)(ws + WS_VB);

#ifndef REP_MASK
#define REP_MASK 0
#endif
#define NREP(j) (((REP_MASK >> (j)) & 1) ? 2 : 1)
#define RUN(j, k, body) do { if (IN(k) && EN(j)) { _Pragma("unroll 1") for (int rr = 0; rr < NREP(j); ++rr) { if (rr) xcd_barrier(bar); FRESH(); body; } } } while (0)
    RUN(10, 0, phase_prologue(c, a, WIN, WG, WB, WO, WQ, KEYS, UB, VB, HF, HB));
    SEAM(0);
#ifndef SUB1
#define SUB1 15
#endif
#ifndef SUB
#define SUB 7
#endif
#pragma unroll 1
    for (int l = 0; l < 2; ++l) {
        const int pb = 1 + l * PH_PER_LAYER;
        RUN(0, pb + 0, phase_inproj(c, HB, WIN + (size_t)l * NY * 1024, Y));
        SEAM(pb + 0);
        RUN(1, pb + 1, {
            if (SUB1 & 1) phase_sb2(c, Y, O);
#ifdef PROBE_SB
            phase_sb2(c, Y, O);
#endif
            if (SUB1 & 2) phase_compress(c, Y, a.in[4] + (size_t)l * 32 * 64, a.in[5] + (size_t)l * 2048 * 64, a.in[6] + (size_t)l * 2048 * 64, KC, VC);
            if (SUB1 & 4) phase_ret_local(c, Y, UST);
            if (SUB1 & 8) phase_gla_local(c, Y, a.in[9] + (size_t)l * 16 * 128, a.in[10] + (size_t)l * 128, UGLA, BL);
        });
        SEAM(pb + 1);
        RUN(2, pb + 2, phase_scans(c, UST, RST, UGLA, SGLA, BL));
        SEAM(pb + 2);
        RUN(3, pb + 3, {
            if (SUB & 1) phase_nsa(c, Y, KC, VC, O);
#ifdef PROBE_NSA
            phase_nsa(c, Y, KC, VC, O);
#endif
            if (SUB & 2) phase_ret_out(c, Y, RST, a.in[7] + (size_t)l * 256, a.in[8] + (size_t)l * 256, O);
            if (SUB & 4) phase_gla_out(c, Y, a.in[9] + (size_t)l * 16 * 128, a.in[10] + (size_t)l * 128, SGLA, a.in[11] + (size_t)l * 256, O);
        });
        SEAM(pb + 3);
        RUN(4, pb + 4, phase_merge(c, HB, WG + (size_t)l * 4096 * 1024, O, WB + (size_t)l * 4 * 1024 * 256, MIX));
        SEAM(pb + 4);
        RUN(5, pb + 5, phase_outproj(c, MIX, WO + (size_t)l * 1024 * 1024, HF, Z));
        SEAM(pb + 5);
        RUN(6, pb + 6, ln_rows(c, Z, a.in[14] + (size_t)l * 1024, a.in[15] + (size_t)l * 1024, HF, HB));
        SEAM(pb + 6);
        RUN(7, pb + 7, phase_wq(c, HB, WQ + (size_t)l * 2048 * 1024, QV));
        SEAM(pb + 7);
        RUN(8, pb + 8, phase_subkey2(c, QV, KEYS + (size_t)l * 16 * 128 * 128, TOPS, TOPI));
        SEAM(pb + 8);
        RUN(9, pb + 9, phase_peer2(c, HF, HB, TOPS, TOPI, (const unsigned char*)UB + (size_t)l * 16384 * 1024, (const unsigned char*)VB + (size_t)l * 16384 * 1024,
                                   (const float*)(ws + WS_SU) + (size_t)l * 16384, (const float*)(ws + WS_SV) + (size_t)l * 16384,
                                   a.in[20] + (size_t)l * 1024, a.in[21] + (size_t)l * 1024, (l == 1) ? a.out : HF, (l == 1) ? (bf16_t*)nullptr : HB,
                                   (rr == NREP(9) - 1) || (lo > 1000)));
        SEAM(pb + 9);
    }
#undef RUN
#undef IN
#undef SEAM
#undef FRESH
}


#ifndef DBG_DUMP
#define DBG_DUMP 0
#endif
#ifndef DBG_C0
#define DBG_C0 0
#endif
#ifndef DBG_C1
#define DBG_C1 1024
#endif
__global__ void dbg_dump(const unsigned char* ws, float* out, int sel) {
    const size_t n = (size_t)NTOK * DM;
    for (size_t i = (size_t)blockIdx.x * blockDim.x + threadIdx.x; i < n; i += (size_t)gridDim.x * blockDim.x) {
        const int col = (int)(i & 1023);
        float v = 0.f;
        if (col >= DBG_C0 && col < DBG_C1) {
            if (sel == 1) v = bf2f(((const bf16_t*)(ws + WS_O))[i]);
            else if (sel == 2) v = ((const float*)(ws + WS_HF))[i];
            else if (sel == 3) v = bf2f(((const bf16_t*)(ws + WS_Y))[(i >> 10) * NY + col]);
            else if (sel == 4) v = bf2f(((const bf16_t*)(ws + WS_Y))[(i >> 10) * NY + 1024 + col]);
            else if (sel == 5) v = bf2f(((const bf16_t*)(ws + WS_Y))[(i >> 10) * NY + 2048 + col]);
            else if (sel == 6) v = bf2f(((const bf16_t*)(ws + WS_MIX))[i]);
            else if (sel == 7) v = ((const float*)(ws + WS_Z))[i];
        }
        out[i] = v;
    }
}

extern "C" void kernel_launch(void* const* d_in, const int* in_sizes, int n_in, void* d_out, int out_size, void* d_ws, size_t ws_size, hipStream_t stream) {
    static int grid = 0;
    if (grid == 0) {
        if (n_in != 22 || out_size != NTOK * DM || ws_size < WS_END) { fprintf(stderr, "kernel_launch: unexpected shapes (n_in %d out %d ws %zu need %zu)\n", n_in, out_size, ws_size, (size_t)WS_END); grid = -1; return; }
        int dev = 0, cus = 0, per_cu = 0;
        if (hipGetDevice(&dev) != hipSuccess || hipDeviceGetAttribute(&cus, hipDeviceAttributeMultiprocessorCount, dev) != hipSuccess) { grid = -1; return; }
        if (hipFuncSetAttribute((const void*)mk_fwd, hipFuncAttributeMaxDynamicSharedMemorySize, LDS_BYTES) != hipSuccess) { fprintf(stderr, "kernel_launch: hipFuncSetAttribute failed\n"); grid = -1; return; }
        if (hipOccupancyMaxActiveBlocksPerMultiprocessor(&per_cu, (const void*)mk_fwd, NTHREADS, LDS_BYTES) != hipSuccess || per_cu < 1) { fprintf(stderr, "kernel_launch: occupancy query says %d\n", per_cu); }
        (void)hipGetLastError();
        grid = cus;
    }
    if (grid < 0) return;
    (void)hipMemsetAsync((char*)d_ws + WS_CTL, 0, XCD_BAR_WORDS * sizeof(unsigned), stream);
    Args a{};
    for (int i = 0; i < 22; ++i) a.in[i] = (const float*)d_in[i];
    a.out = (float*)d_out; a.ws = (unsigned char*)d_ws;
#if ONE_LAUNCH
    a.ph_lo = 0; a.ph_hi = N_PHASES;
    hipLaunchKernelGGL(mk_fwd, dim3(grid), dim3(NTHREADS), LDS_BYTES, stream, a);
#else
#ifndef DBG_PH_HI
#define DBG_PH_HI N_PHASES
#endif
#ifndef DBG_PH_LO
#define DBG_PH_LO 0
#endif
    for (int p = DBG_PH_LO; p < DBG_PH_HI; ++p) {
        a.ph_lo = p; a.ph_hi = p + 1;
        hipLaunchKernelGGL(mk_fwd, dim3(grid), dim3(NTHREADS), LDS_BYTES, stream, a);
    }
    if (DBG_DUMP) hipLaunchKernelGGL(dbg_dump, dim3(1024), dim3(256), 0, stream, (const unsigned char*)d_ws, (float*)d_out, (int)DBG_DUMP);
#endif
}
```

```cpp
#include <hip/hip_runtime.h>
#include <stdint.h>
#include <stdio.h>

#ifndef ONE_LAUNCH
#define ONE_LAUNCH 1
#endif

#define LAS __attribute__((address_space(3)))
typedef unsigned short bf16_t;
typedef short bf16x8 __attribute__((ext_vector_type(8)));
typedef float f32x4 __attribute__((ext_vector_type(4)));
typedef float f32x16 __attribute__((ext_vector_type(16)));
typedef unsigned u32x4 __attribute__((ext_vector_type(4)));
typedef unsigned u32x2 __attribute__((ext_vector_type(2)));
typedef __bf16 bf2_t __attribute__((ext_vector_type(2)));
typedef LAS unsigned char* lptr;

constexpr int NTOK = 16384, SEQ = 8192, DM = 1024, NB = 2;
constexpr int NY = 3328;
constexpr int W_IN_LD = 7324;
constexpr int C_SBQ = 0, C_SBK = 256, C_SBV = 512, C_NQ = 768, C_NKC = 1024, C_NVC = 1088, C_NKS = 1152, C_NVS = 1216, C_NKW = 1280, C_NVW = 1344;
constexpr int C_RQ = 1408, C_RK = 1664, C_RV = 1920, C_RG = 2176, C_GQ = 2432, C_GK = 2560, C_GV = 2688, C_GR = 2944, C_NG = 3200, C_GLR = 3216;
constexpr int W_MG = 3228;
constexpr float NEGF = -1e30f;
constexpr float LN_EPS = 1e-5f;
constexpr float DN_ALPHA = 1.41421356237f;

constexpr int NTHREADS = 512;
constexpr int LDS_BYTES = 147456;

constexpr size_t MB = 1024 * 1024;
constexpr size_t WS_CTL   = 0;
constexpr size_t WS_HF    = 1 * MB;
constexpr size_t WS_HB    = WS_HF + 64 * MB;
constexpr size_t WS_Y     = WS_HB + 32 * MB;
constexpr size_t WS_Z     = WS_Y;
constexpr size_t WS_TOPS  = WS_Y + 64 * MB;
constexpr size_t WS_TOPI  = WS_TOPS + 16 * MB;
constexpr size_t WS_O     = WS_Y + 104 * MB;
constexpr size_t WS_MIX   = WS_O + 32 * MB;
constexpr size_t WS_QV    = WS_O;
constexpr size_t WS_UST   = WS_MIX + 32 * MB;
constexpr size_t WS_RST   = WS_UST + 8 * MB;
constexpr size_t WS_UGLA  = WS_RST + 8 * MB;
constexpr size_t WS_SGLA  = WS_UGLA + 8 * MB;
constexpr size_t WS_BL    = WS_SGLA + 8 * MB;
constexpr size_t WS_KC    = WS_BL + 1 * MB;
constexpr size_t WS_VC    = WS_KC + 1 * MB;
constexpr size_t WS_WIN   = WS_VC + 1 * MB;
constexpr size_t WS_WG    = WS_WIN + 14 * MB;
constexpr size_t WS_WB    = WS_WG + 16 * MB;
constexpr size_t WS_WO    = WS_WB + 4 * MB;
constexpr size_t WS_WQ    = WS_WO + 4 * MB;
constexpr size_t WS_KEYS  = WS_WQ + 8 * MB;
constexpr size_t WS_UB    = WS_KEYS + 1 * MB;
constexpr size_t WS_VB    = WS_UB + 64 * MB;
constexpr size_t WS_SU    = WS_UB + 32 * MB;
constexpr size_t WS_SV    = WS_VB + 32 * MB;
constexpr size_t WS_END   = WS_VB + 64 * MB;

typedef float f32x2_t __attribute__((ext_vector_type(2)));
__device__ __forceinline__ unsigned pk_bf16(float lo, float hi) { f32x2_t v = {lo, hi}; bf2_t b = __builtin_convertvector(v, bf2_t); return __builtin_bit_cast(unsigned, b); }
__device__ __forceinline__ float bf_lo(unsigned u) { return __uint_as_float(u << 16); }
__device__ __forceinline__ float bf_hi(unsigned u) { return __uint_as_float(u & 0xffff0000u); }
__device__ __forceinline__ bf16_t f2bf(float f) { return (bf16_t)(pk_bf16(f, f) & 0xffffu); }
__device__ __forceinline__ float bf2f(bf16_t b) { return __uint_as_float(((unsigned)b) << 16); }
__device__ __forceinline__ float wave_sum(float v) {
#pragma unroll
    for (int o = 32; o; o >>= 1) v += __shfl_xor(v, o);
    return v;
}
__device__ __forceinline__ float wave_max(float v) {
#pragma unroll
    for (int o = 32; o; o >>= 1) v = fmaxf(v, __shfl_xor(v, o));
    return v;
}
__device__ __forceinline__ float sigmoidf_(float x) { return 1.0f / (1.0f + __expf(-x)); }
__device__ __forceinline__ float softplusf_(float x) { return fmaxf(x, 0.f) + __logf(1.0f + __expf(-fabsf(x))); }
__device__ __forceinline__ float siluf_(float x) { return x * sigmoidf_(x); }
__device__ __forceinline__ float dot2bf(unsigned a, unsigned b, float c) {
    return __builtin_amdgcn_fdot2_f32_bf16(__builtin_bit_cast(bf2_t, a), __builtin_bit_cast(bf2_t, b), c, false);
}

#define XB_TMO      128
#define XB_XCNT(j)  (256  + 64 * (j))
#define XB_XSUB(j)  (1280 + 64 * (j))
#define XB_XGEN(j)  (2304 + 64 * (j))
#define XB_TOP      3328
#define XB_TOPGEN   3392
#define XCD_BAR_WORDS 3456
#define XB_SPIN_CAP (1u << 22)

__device__ __forceinline__ unsigned xb_ld(unsigned* p)              { return __hip_atomic_load(p, __ATOMIC_RELAXED, __HIP_MEMORY_SCOPE_AGENT); }
__device__ __forceinline__ unsigned xb_add(unsigned* p, unsigned v) { return __hip_atomic_fetch_add(p, v, __ATOMIC_RELAXED, __HIP_MEMORY_SCOPE_AGENT); }
__device__ __forceinline__ unsigned xb_xcc_id() { return (unsigned)__builtin_amdgcn_s_getreg((3 << 11) | 20) & 0xFu; }
#define XB_SPIN(cond, bar) do { unsigned _sp = 0; while (cond) { __builtin_amdgcn_s_sleep(1); \
    if ((++_sp & 255u) == 0u) { if (xb_ld(&(bar)[XB_TMO])) break; if (_sp > XB_SPIN_CAP) { atomicAdd(&(bar)[XB_TMO], 1u); break; } } } } while (0)

struct XcdBarrier { unsigned* bar; unsigned x; volatile LAS unsigned* st; };

__device__ __forceinline__ XcdBarrier xcd_barrier_post(unsigned* bar, volatile LAS unsigned* st) {
    XcdBarrier b; b.bar = bar; b.x = xb_xcc_id(); b.st = st;
    if (threadIdx.x == 0) (void)xb_add(&bar[XB_XCNT(b.x)], 1u);
    return b;
}
__device__ __forceinline__ void xcd_barrier_complete(unsigned* bar, unsigned x, unsigned& nloc, unsigned& nx) {
    const unsigned G = gridDim.x * gridDim.y * gridDim.z;
    unsigned sum, cnt, mine, sp = 0u;
    for (;;) {
        sum = 0u; cnt = 0u; mine = 0u;
#pragma unroll
        for (unsigned j = 0; j < 16; ++j) { const unsigned c = xb_ld(&bar[XB_XCNT(j)]); sum += c; cnt += (c > 0u) ? 1u : 0u; mine = (j == x) ? c : mine; }
        if (sum == G) break;
        __builtin_amdgcn_s_sleep(1);
        if ((++sp & 255u) == 0u) { if (xb_ld(&bar[XB_TMO])) break; if (sp > XB_SPIN_CAP) { atomicAdd(&bar[XB_TMO], 1u); break; } }
    }
    nloc = mine > 0u ? mine : 1u; nx = cnt > 0u ? cnt : 1u;
}
__device__ __forceinline__ void xcd_barrier(const XcdBarrier& b) {
    asm volatile("s_waitcnt vmcnt(0)" ::: "memory");
    __syncthreads();
    if (threadIdx.x == 0) {
        unsigned* bar = b.bar;
        __builtin_amdgcn_s_waitcnt(0);
        unsigned nloc = b.st[0], nx = b.st[1];
        if (nloc == 0u) { xcd_barrier_complete(bar, b.x, nloc, nx); b.st[0] = nloc; b.st[1] = nx; }
        const unsigned old = xb_add(&bar[XB_XSUB(b.x)], 1u);
        const unsigned gen = old / nloc;
        if (old + 1u == (gen + 1u) * nloc) {
            __builtin_amdgcn_fence(__ATOMIC_RELEASE, "agent");
            asm volatile("s_waitcnt vmcnt(0)" ::: "memory");
            const unsigned og = xb_add(&bar[XB_TOP], 1u);
            const unsigned tg = og / nx;
            if (og + 1u == (tg + 1u) * nx) xb_add(&bar[XB_TOPGEN], 1u);
            else XB_SPIN(xb_ld(&bar[XB_TOPGEN]) == tg, bar);
            __builtin_amdgcn_fence(__ATOMIC_ACQUIRE, "agent");
            xb_add(&bar[XB_XGEN(b.x)], 1u);
            asm volatile("s_waitcnt vmcnt(0)" ::: "memory");
        } else {
            XB_SPIN(xb_ld(&bar[XB_XGEN(b.x)]) == gen, bar);
            __builtin_amdgcn_fence(__ATOMIC_ACQUIRE, "agent");
            asm volatile("s_waitcnt vmcnt(0)" ::: "memory");
        }
    }
    __syncthreads();
}

struct Args { const float* in[22]; float* out; unsigned char* ws; int ph_lo, ph_hi; };
struct Ctx {
    lptr lds; int tid, lane, wave, nblk, blk;
    unsigned char* ws;
};

__device__ __forceinline__ void ln_rows(const Ctx& c, const float* src, const float* g, const float* b, float* outf, bf16_t* outb) {
    const int gw = c.blk * 8 + c.wave, nw = c.nblk * 8;
    for (int row = gw; row < NTOK; row += nw) {
        const f32x4* p = (const f32x4*)(src + (size_t)row * DM);
        f32x4 v[4]; float s = 0.f;
#pragma unroll
        for (int i = 0; i < 4; ++i) { v[i] = p[i * 64 + c.lane]; s += (v[i][0] + v[i][1]) + (v[i][2] + v[i][3]); }
        const float mean = wave_sum(s) * (1.0f / 1024.0f);
        float q = 0.f;
#pragma unroll
        for (int i = 0; i < 4; ++i) { const f32x4 d = v[i] - mean; q += (d[0] * d[0] + d[1] * d[1]) + (d[2] * d[2] + d[3] * d[3]); }
        const float rstd = rsqrtf(wave_sum(q) * (1.0f / 1024.0f) + LN_EPS);
#pragma unroll
        for (int i = 0; i < 4; ++i) {
            const int idx = i * 64 + c.lane;
            const f32x4 gg = ((const f32x4*)g)[idx], bb = ((const f32x4*)b)[idx];
            const f32x4 y = (v[i] - mean) * rstd * gg + bb;
            if (outf) ((f32x4*)(outf + (size_t)row * DM))[idx] = y;
            if (outb) { u32x2 w; w.x = pk_bf16(y[0], y[1]); w.y = pk_bf16(y[2], y[3]); ((u32x2*)(outb + (size_t)row * DM))[idx] = w; }
        }
    }
}

__device__ __forceinline__ int ycol_to_wcol(int j) {
    if (j < 1408) return j;
    if (j < 3200) return j + 12;
    if (j < 3212) return 1408 + (j - 3200);
    if (j < 3216) return -1;
    if (j < 3232) return 3212 + (j - 3216);
    return -1;
}
__device__ __forceinline__ void transpose_cvt(const Ctx& c, const float* src, int ld_src, int R, int c_off, int C, int Cpad, int mode, bf16_t* dst, int ld_dst) {
    LAS float* buf = (LAS float*)c.lds;
    const int nRt = R / 64, nCt = Cpad / 64;
    for (int tile = c.blk; tile < nRt * nCt; tile += c.nblk) {
        const int rt = tile % nRt, ct = tile / nRt;
        const int r0 = rt * 64, c0 = ct * 64;
        {
            const int row = c.tid >> 3, cc = (c.tid & 7) * 8;
            const float* sp = src + (size_t)(r0 + row) * ld_src;
            float v[8];
            bool fast = false; int sc0 = 0;
            if (mode == 0) { fast = (c0 + 64 <= C); sc0 = c_off + c0 + cc; }
            else { if (c0 + 64 <= 1408) { fast = true; sc0 = c0 + cc; } else if (c0 >= 1408 && c0 + 64 <= 3200) { fast = true; sc0 = c0 + cc + 12; } }
            if (fast) {
                const f32x4 a = *(const f32x4*)(sp + sc0), b = *(const f32x4*)(sp + sc0 + 4);
                v[0] = a[0]; v[1] = a[1]; v[2] = a[2]; v[3] = a[3]; v[4] = b[0]; v[5] = b[1]; v[6] = b[2]; v[7] = b[3];
            } else {
#pragma unroll
                for (int i = 0; i < 8; ++i) {
                    const int n = c0 + cc + i; int sc;
                    if (mode == 0) sc = (n < C) ? c_off + n : -1; else sc = ycol_to_wcol(n);
                    v[i] = (sc >= 0) ? sp[sc] : 0.f;
                }
            }
#pragma unroll
            for (int i = 0; i < 8; ++i) buf[row * 65 + cc + i] = v[i];
        }
        __syncthreads();
        {
            const int n = c.tid >> 3, kc = (c.tid & 7) * 8;
            float v[8];
#pragma unroll
            for (int i = 0; i < 8; ++i) v[i] = buf[(kc + i) * 65 + n];
            u32x4 w; w.x = pk_bf16(v[0], v[1]); w.y = pk_bf16(v[2], v[3]); w.z = pk_bf16(v[4], v[5]); w.w = pk_bf16(v[6], v[7]);
            *(u32x4*)(dst + (size_t)(c0 + n) * ld_dst + r0 + kc) = w;
        }
        __syncthreads();
    }
}
__device__ __forceinline__ void convert_flat(const Ctx& c, const float* src, bf16_t* dst, size_t n) {
    const size_t stride = (size_t)c.nblk * NTHREADS;
    for (size_t i = (size_t)c.blk * NTHREADS + c.tid; i < n / 8; i += stride) {
        const f32x4 a = ((const f32x4*)src)[2 * i], b = ((const f32x4*)src)[2 * i + 1];
        u32x4 w; w.x = pk_bf16(a[0], a[1]); w.y = pk_bf16(a[2], a[3]); w.z = pk_bf16(b[0], b[1]); w.w = pk_bf16(b[2], b[3]);
        ((u32x4*)dst)[i] = w;
    }
}

template <int WM, int WN>
__device__ __forceinline__ void gemm_kloop(const Ctx& c, f32x16 (&acc)[WM][WN], const bf16_t* A, int lda, const bf16_t* Bt, int ldb, int K) {
    constexpr int BMt = 128 * WM, BNt = 64 * WN, STAGE = (BMt + BNt) * 144;
    constexpr int NA = BMt * 8 / NTHREADS, NBc = BNt * 8 / NTHREADS;
    static_assert(NBc >= 1, "tile too small");
    const lptr lds = c.lds;
    const int wm = c.wave >> 1, wn = c.wave & 1, r = c.lane & 31, h = c.lane >> 5;
    u32x4 ra[NA], rb[NBc];
    const int nk = K / 64;
#pragma unroll
    for (int i = 0; i < NA; ++i) { const int id = c.tid + i * NTHREADS; ra[i] = *(const u32x4*)(A + (size_t)(id >> 3) * lda + (id & 7) * 8); }
#pragma unroll
    for (int i = 0; i < NBc; ++i) { const int id = c.tid + i * NTHREADS; rb[i] = *(const u32x4*)(Bt + (size_t)(id >> 3) * ldb + (id & 7) * 8); }
#pragma unroll
    for (int i = 0; i < NA; ++i) { const int id = c.tid + i * NTHREADS; *(LAS u32x4*)(lds + (id >> 3) * 144 + (id & 7) * 16) = ra[i]; }
#pragma unroll
    for (int i = 0; i < NBc; ++i) { const int id = c.tid + i * NTHREADS; *(LAS u32x4*)(lds + BMt * 144 + (id >> 3) * 144 + (id & 7) * 16) = rb[i]; }
    __syncthreads();
    for (int kt = 0; kt < nk; ++kt) {
        const lptr cur = lds + (kt & 1) * STAGE, nxt = lds + ((kt + 1) & 1) * STAGE;
        const bool more = (kt + 1 < nk);
        if (more) {
            const int k0 = (kt + 1) * 64;
#pragma unroll
            for (int i = 0; i < NA; ++i) { const int id = c.tid + i * NTHREADS; ra[i] = *(const u32x4*)(A + (size_t)(id >> 3) * lda + k0 + (id & 7) * 8); }
#pragma unroll
            for (int i = 0; i < NBc; ++i) { const int id = c.tid + i * NTHREADS; rb[i] = *(const u32x4*)(Bt + (size_t)(id >> 3) * ldb + k0 + (id & 7) * 8); }
        }
        const lptr pa = cur + (wm * WM * 32 + r) * 144 + h * 16;
        const lptr pb = cur + BMt * 144 + (wn * WN * 32 + r) * 144 + h * 16;
#pragma unroll
        for (int s = 0; s < 4; ++s) {
            bf16x8 fa[WM], fb[WN];
#pragma unroll
            for (int i = 0; i < WM; ++i) fa[i] = *(LAS const bf16x8*)(pa + i * 32 * 144 + s * 32);
#pragma unroll
            for (int j = 0; j < WN; ++j) fb[j] = *(LAS const bf16x8*)(pb + j * 32 * 144 + s * 32);
#pragma unroll
            for (int i = 0; i < WM; ++i)
#pragma unroll
                for (int j = 0; j < WN; ++j) acc[i][j] = __builtin_amdgcn_mfma_f32_32x32x16_bf16(fb[j], fa[i], acc[i][j], 0, 0, 0);
        }
        if (more) {
#pragma unroll
            for (int i = 0; i < NA; ++i) { const int id = c.tid + i * NTHREADS; *(LAS u32x4*)(nxt + (id >> 3) * 144 + (id & 7) * 16) = ra[i]; }
#pragma unroll
            for (int i = 0; i < NBc; ++i) { const int id = c.tid + i * NTHREADS; *(LAS u32x4*)(nxt + BMt * 144 + (id >> 3) * 144 + (id & 7) * 16) = rb[i]; }
        }
        __syncthreads();
    }
}
template <int WM, int WN>
__device__ __forceinline__ void acc_zero(f32x16 (&acc)[WM][WN]) {
#pragma unroll
    for (int i = 0; i < WM; ++i)
#pragma unroll
        for (int j = 0; j < WN; ++j)
#pragma unroll
            for (int e = 0; e < 16; ++e) acc[i][j][e] = 0.f;
}

#define EPI_LOOP(WM_, WN_)                                                                  \
    _Pragma("unroll") for (int i = 0; i < WM_; ++i)                                         \
    _Pragma("unroll") for (int j = 0; j < WN_; ++j)                                         \
    _Pragma("unroll") for (int g = 0; g < 4; ++g)

__device__ __forceinline__ void phase_inproj(const Ctx& c, const bf16_t* hb, const bf16_t* Wt, bf16_t* Y) {
    constexpr int NTN = NY / 128;
    const int wm = c.wave >> 1, wn = c.wave & 1, r = c.lane & 31, h = c.lane >> 5;
    for (int u = c.blk; u < 64 * NTN; u += c.nblk) {
        const int pm = u / NTN, pn = u % NTN;
        f32x16 acc[2][2]; acc_zero<2, 2>(acc);
        gemm_kloop<2, 2>(c, acc, hb + (size_t)pm * 256 * DM, DM, Wt + (size_t)pn * 128 * DM, DM, DM);
        EPI_LOOP(2, 2) {
            const int m = pm * 256 + (wm * 2 + i) * 32 + r, n = pn * 128 + (wn * 2 + j) * 32 + 8 * g + 4 * h;
            u32x2 w; w.x = pk_bf16(acc[i][j][4 * g], acc[i][j][4 * g + 1]); w.y = pk_bf16(acc[i][j][4 * g + 2], acc[i][j][4 * g + 3]);
            *(u32x2*)(Y + (size_t)m * NY + n) = w;
        }
    }
}
__device__ __forceinline__ void phase_merge(const Ctx& c, const bf16_t* hb, const bf16_t* Wg, const bf16_t* O, const bf16_t* Wb, bf16_t* MIX) {
    const int wm = c.wave >> 1, wn = c.wave & 1, r = c.lane & 31, h = c.lane >> 5;
    for (int u = c.blk; u < 128 * 8; u += c.nblk) {
        const int pm = u >> 3, pn = u & 7;
        f32x16 mix[1][2]; acc_zero<1, 2>(mix);
#pragma unroll 1
        for (int nb = 0; nb < 4; ++nb) {
            f32x16 ag[1][2]; acc_zero<1, 2>(ag);
            gemm_kloop<1, 2>(c, ag, hb + (size_t)pm * 128 * DM, DM, Wg + ((size_t)nb * 1024 + pn * 128) * DM, DM, DM);
            f32x16 ap[1][2]; acc_zero<1, 2>(ap);
            gemm_kloop<1, 2>(c, ap, O + (size_t)pm * 128 * DM + nb * 256, DM, Wb + ((size_t)nb * 1024 + pn * 128) * 256, 256, 256);
#pragma unroll
            for (int j = 0; j < 2; ++j)
#pragma unroll
                for (int e = 0; e < 16; ++e) mix[0][j][e] += sigmoidf_(ag[0][j][e]) * ap[0][j][e];
        }
        EPI_LOOP(1, 2) {
            const int m = pm * 128 + (wm + i) * 32 + r, n = pn * 128 + (wn * 2 + j) * 32 + 8 * g + 4 * h;
            u32x2 w; w.x = pk_bf16(mix[i][j][4 * g], mix[i][j][4 * g + 1]); w.y = pk_bf16(mix[i][j][4 * g + 2], mix[i][j][4 * g + 3]);
            *(u32x2*)(MIX + (size_t)m * DM + n) = w;
        }
    }
}
__device__ __forceinline__ void phase_outproj(const Ctx& c, const bf16_t* MIX, const bf16_t* Wo, const float* hf, float* Z) {
    const int wm = c.wave >> 1, wn = c.wave & 1, r = c.lane & 31, h = c.lane >> 5;
    for (int u = c.blk; u < 64 * 8; u += c.nblk) {
        const int pm = u >> 3, pn = u & 7;
        f32x16 acc[2][2]; acc_zero<2, 2>(acc);
        gemm_kloop<2, 2>(c, acc, MIX + (size_t)pm * 256 * DM, DM, Wo + (size_t)pn * 128 * DM, DM, DM);
        EPI_LOOP(2, 2) {
            const int m = pm * 256 + (wm * 2 + i) * 32 + r, n = pn * 128 + (wn * 2 + j) * 32 + 8 * g + 4 * h;
            const f32x4 x = *(const f32x4*)(hf + (size_t)m * DM + n);
            f32x4 y; y[0] = DN_ALPHA * x[0] + acc[i][j][4 * g]; y[1] = DN_ALPHA * x[1] + acc[i][j][4 * g + 1]; y[2] = DN_ALPHA * x[2] + acc[i][j][4 * g + 2]; y[3] = DN_ALPHA * x[3] + acc[i][j][4 * g + 3];
            *(f32x4*)(Z + (size_t)m * DM + n) = y;
        }
    }
}
__device__ __forceinline__ void phase_wq(const Ctx& c, const bf16_t* hb, const bf16_t* Wq, bf16_t* QV) {
    const int wm = c.wave >> 1, wn = c.wave & 1, r = c.lane & 31, h = c.lane >> 5;
    for (int u = c.blk; u < 64 * 16; u += c.nblk) {
        const int pm = u >> 4, pn = u & 15;
        f32x16 acc[2][2]; acc_zero<2, 2>(acc);
        gemm_kloop<2, 2>(c, acc, hb + (size_t)pm * 256 * DM, DM, Wq + (size_t)pn * 128 * DM, DM, DM);
        EPI_LOOP(2, 2) {
            const int m = pm * 256 + (wm * 2 + i) * 32 + r, n = pn * 128 + (wn * 2 + j) * 32 + 8 * g + 4 * h;
            u32x2 w; w.x = pk_bf16(acc[i][j][4 * g], acc[i][j][4 * g + 1]); w.y = pk_bf16(acc[i][j][4 * g + 2], acc[i][j][4 * g + 3]);
            *(u32x2*)(QV + (size_t)m * 2048 + n) = w;
        }
    }
}

__device__ __forceinline__ f32x16 mma_lds(f32x16 acc, lptr A, int sa, lptr B, int sb, int K, int lane) {
    const int r = lane & 31, h = lane >> 5;
    const lptr pa = A + r * sa + h * 16, pb = B + r * sb + h * 16;
    for (int k = 0; k < K; k += 16) {
        const bf16x8 a = *(LAS const bf16x8*)(pa + k * 2), b = *(LAS const bf16x8*)(pb + k * 2);
        acc = __builtin_amdgcn_mfma_f32_32x32x16_bf16(b, a, acc, 0, 0, 0);
    }
    return acc;
}
__device__ __forceinline__ f32x16 zero16() { f32x16 z;
#pragma unroll
    for (int e = 0; e < 16; ++e) z[e] = 0.f; return z; }

__device__ __forceinline__ void sb_wave_unit(const bf16_t* Y, bf16_t* O, int b, int hh, int qt, lptr wl, int lane) {
    const int t = qt * 64 + lane;
    const size_t row = (size_t)b * SEQ + t;
    unsigned q[32];
    {
        const u32x4* qp = (const u32x4*)(Y + row * NY + C_SBQ + hh * 64);
#pragma unroll
        for (int i = 0; i < 8; ++i) { const u32x4 v = qp[i]; q[4 * i] = v.x; q[4 * i + 1] = v.y; q[4 * i + 2] = v.z; q[4 * i + 3] = v.w; }
    }
    float acc[64];
#pragma unroll
    for (int e = 0; e < 64; ++e) acc[e] = 0.f;
    float C = 0.f;
    for (int kt = qt; kt >= 0; --kt) {
        {
            const size_t krow = (size_t)b * SEQ + kt * 64 + lane;
            const u32x4* kp = (const u32x4*)(Y + krow * NY + C_SBK + hh * 64);
            const u32x4* vp = (const u32x4*)(Y + krow * NY + C_SBV + hh * 64);
            u32x4 kr[8], vr[8];
#pragma unroll
            for (int i = 0; i < 8; ++i) { kr[i] = kp[i]; vr[i] = vp[i]; }
#pragma unroll
            for (int i = 0; i < 8; ++i) { *(LAS u32x4*)(wl + lane * 144 + i * 16) = kr[i]; *(LAS u32x4*)(wl + 9216 + lane * 144 + i * 16) = vr[i]; }
        }
        asm volatile("s_waitcnt lgkmcnt(0)" ::: "memory");
        const int s_hi = (kt == qt) ? 62 : 63;
#pragma unroll 1
        for (int s = s_hi; s >= 0; --s) {
            const int pos = kt * 64 + s;
            float z0 = 0.f, z1 = 0.f;
#pragma unroll
            for (int i = 0; i < 8; ++i) {
                const u32x4 kv = *(LAS const u32x4*)(wl + s * 144 + i * 16);
                z0 = dot2bf(q[4 * i], kv.x, z0); z1 = dot2bf(q[4 * i + 1], kv.y, z1); z0 = dot2bf(q[4 * i + 2], kv.z, z0); z1 = dot2bf(q[4 * i + 3], kv.w, z1);
            }
            const float z = (z0 + z1) * 0.125f;
            const bool valid = pos < t;
            const float Cn = C - softplusf_(z);
            const float w = valid ? __expf(z + Cn) : 0.f;
            C = valid ? Cn : C;
#pragma unroll
            for (int i = 0; i < 8; ++i) {
                const u32x4 vv = *(LAS const u32x4*)(wl + 9216 + s * 144 + i * 16);
                acc[8 * i + 0] += w * bf_lo(vv.x); acc[8 * i + 1] += w * bf_hi(vv.x); acc[8 * i + 2] += w * bf_lo(vv.y); acc[8 * i + 3] += w * bf_hi(vv.y);
                acc[8 * i + 4] += w * bf_lo(vv.z); acc[8 * i + 5] += w * bf_hi(vv.z); acc[8 * i + 6] += w * bf_lo(vv.w); acc[8 * i + 7] += w * bf_hi(vv.w);
            }
        }
        asm volatile("" ::: "memory");
        if (__all(C < -104.0f)) break;
    }
    u32x4* op = (u32x4*)(O + row * DM + 0 * 256 + hh * 64);
#pragma unroll
    for (int i = 0; i < 8; ++i) {
        u32x4 w; w.x = pk_bf16(acc[8 * i], acc[8 * i + 1]); w.y = pk_bf16(acc[8 * i + 2], acc[8 * i + 3]); w.z = pk_bf16(acc[8 * i + 4], acc[8 * i + 5]); w.w = pk_bf16(acc[8 * i + 6], acc[8 * i + 7]);
        op[i] = w;
    }
}
__device__ __forceinline__ void phase_sb(const Ctx& c, const bf16_t* Y, bf16_t* O) {
    const lptr wl = c.lds + c.wave * 18432;
    for (int u = c.blk * 8 + c.wave; u < 1024; u += c.nblk * 8) {
        const int qt = u & 127, hh = (u >> 7) & 3, b = u >> 9;
        sb_wave_unit(Y, O, b, hh, qt, wl, c.lane);
    }
    __syncthreads();
}

__device__ __forceinline__ void phase_compress(const Ctx& c, const bf16_t* Y, const float* pos, const float* wk, const float* wv, bf16_t* KC, bf16_t* VC) {
    LAS float* kl = (LAS float*)c.lds;
    LAS float* pl = (LAS float*)(c.lds + 144 * 64 * 4);
    for (int u = c.blk; u < 256; u += c.nblk) {
        const int cg = u & 63, kv = (u >> 6) & 1, b = u >> 7;
        const int c0 = cg * 8;
        const int col = kv ? C_NVC : C_NKC;
        for (int i = c.tid; i < 144 * 64; i += NTHREADS) {
            const int tr = i >> 6, d = i & 63, tok = c0 * 16 + tr;
            kl[i] = (tok < SEQ) ? bf2f(Y[((size_t)b * SEQ + tok) * NY + col + d]) : 0.f;
        }
        for (int i = c.tid; i < 32 * 64; i += NTHREADS) pl[i] = pos[i];
        __syncthreads();
        const int cl = c.tid >> 6, d = c.tid & 63, cc = c0 + cl;
        const float* w = kv ? wv : wk;
        float a0 = 0.f, a1 = 0.f;
#pragma unroll 4
        for (int l = 0; l < 32; ++l) {
            const LAS float* kr = kl + (cl * 16 + l) * 64;
            const LAS float* pr = pl + l * 64;
            const float* wr = w + (size_t)l * 64 * 64 + d;
#pragma unroll 8
            for (int dp = 0; dp < 64; dp += 2) {
                a0 += (kr[dp] + pr[dp]) * wr[(size_t)dp * 64];
                a1 += (kr[dp + 1] + pr[dp + 1]) * wr[(size_t)(dp + 1) * 64];
            }
        }
        bf16_t* dst = kv ? VC : KC;
        dst[((size_t)b * 512 + cc) * 64 + d] = (cc < 511) ? f2bf(a0 + a1) : (bf16_t)0;
        __syncthreads();
    }
}

__device__ __forceinline__ float ret_logg(int h) { return log1pf(-exp2f(-5.0f - (float)h)); }
__device__ __forceinline__ void phase_ret_local(const Ctx& c, const bf16_t* Y, float* UST) {
    const lptr Kt = c.lds, Vt = c.lds + 64 * 272;
    for (int u = c.blk; u < 512; u += c.nblk) {
        const int i = u & 63, hh = (u >> 6) & 3, b = u >> 8;
        const float lg = ret_logg(hh);
        {
            const int j = c.tid >> 2, dc = (c.tid & 3) * 16;
            const size_t row = (size_t)b * SEQ + i * 128 + j;
            const float kd = __expf(lg * (float)(127 - j)) * 0.125f;
            const u32x4* kp = (const u32x4*)(Y + row * NY + C_RK + hh * 64 + dc);
            const u32x4* vp = (const u32x4*)(Y + row * NY + C_RV + hh * 64 + dc);
            const u32x4 k0 = kp[0], k1 = kp[1], v0 = vp[0], v1 = vp[1];
            const unsigned kk[8] = {k0.x, k0.y, k0.z, k0.w, k1.x, k1.y, k1.z, k1.w};
            const unsigned vv[8] = {v0.x, v0.y, v0.z, v0.w, v1.x, v1.y, v1.z, v1.w};
#pragma unroll
            for (int e = 0; e < 8; ++e) {
                *(LAS bf16_t*)(Kt + (dc + 2 * e) * 272 + j * 2) = f2bf(bf_lo(kk[e]) * kd);
                *(LAS bf16_t*)(Kt + (dc + 2 * e + 1) * 272 + j * 2) = f2bf(bf_hi(kk[e]) * kd);
                *(LAS bf16_t*)(Vt + (dc + 2 * e) * 272 + j * 2) = (bf16_t)(vv[e] & 0xffffu);
                *(LAS bf16_t*)(Vt + (dc + 2 * e + 1) * 272 + j * 2) = (bf16_t)(vv[e] >> 16);
            }
        }
        __syncthreads();
        if (c.wave < 4) {
            const int wm = c.wave >> 1, wn = c.wave & 1, r = c.lane & 31, h = c.lane >> 5;
            f32x16 acc = mma_lds(zero16(), Kt + wm * 32 * 272, 272, Vt + wn * 32 * 272, 272, 128, c.lane);
            float* dst = UST + (((size_t)(b * 4 + hh) * 64 + i) * 64 + wm * 32 + r) * 64 + wn * 32 + 4 * h;
#pragma unroll
            for (int g = 0; g < 4; ++g) { f32x4 o; o[0] = acc[4 * g]; o[1] = acc[4 * g + 1]; o[2] = acc[4 * g + 2]; o[3] = acc[4 * g + 3]; *(f32x4*)(dst + 8 * g) = o; }
        }
        __syncthreads();
    }
}
__device__ __forceinline__ void phase_scans(const Ctx& c, const float* UST, float* RST, const float* UGLA, float* SGLA, const float* BL) {
    for (int u = c.blk; u < 96; u += c.nblk) {
        if (u < 64) {
            const int ch = u * NTHREADS + c.tid;
            const int bh = ch >> 12, de = ch & 4095;
            const float cd = __expf(ret_logg(bh & 3) * 128.0f);
            const float* up = UST + (size_t)bh * 64 * 4096 + de; float* rp = RST + (size_t)bh * 64 * 4096 + de;
            float R = 0.f;
            for (int i0 = 0; i0 < 64; i0 += 16) {
                float uv[16];
#pragma unroll
                for (int j = 0; j < 16; ++j) uv[j] = up[(size_t)(i0 + j) * 4096];
#pragma unroll
                for (int j = 0; j < 16; ++j) { rp[(size_t)(i0 + j) * 4096] = R; R = cd * R + uv[j]; }
            }
        } else {
            const int ch = (u - 64) * NTHREADS + c.tid;
            const int bh = ch >> 11, ke = ch & 2047, k = ke >> 6;
            const float* up = UGLA + (size_t)bh * 128 * 2048 + ke; float* sp = SGLA + (size_t)bh * 128 * 2048 + ke;
            const float* bl = BL + (size_t)bh * 128 * 32 + k;
            float S = 0.f;
            for (int i0 = 0; i0 < 128; i0 += 16) {
                float uv[16], dv[16];
#pragma unroll
                for (int j = 0; j < 16; ++j) { uv[j] = up[(size_t)(i0 + j) * 2048]; dv[j] = bl[(i0 + j) * 32]; }
#pragma unroll
                for (int j = 0; j < 16; ++j) { sp[(size_t)(i0 + j) * 2048] = S; S = __expf(dv[j]) * S + uv[j]; }
            }
        }
    }
}
__device__ __forceinline__ void phase_ret_out(const Ctx& c, const bf16_t* Y, const float* RST, const float* gn_g, const float* gn_b, bf16_t* O) {
    const lptr Qs = c.lds, Ks = c.lds + 18432, Vt = c.lds + 36864, Rt = c.lds + 54272, Att = c.lds + 63488;
    LAS float* Of = (LAS float*)(c.lds + 98304);
    for (int u = c.blk; u < 512; u += c.nblk) {
        const int i = u & 63, hh = (u >> 6) & 3, b = u >> 8;
        const float lg = ret_logg(hh);
        const size_t row0 = (size_t)b * SEQ + i * 128;
        {
            const int j = c.tid >> 2, dc = (c.tid & 3) * 16;
            const size_t row = row0 + j;
            const u32x4* qp = (const u32x4*)(Y + row * NY + C_RQ + hh * 64 + dc);
            const u32x4* kp = (const u32x4*)(Y + row * NY + C_RK + hh * 64 + dc);
            const u32x4* vp = (const u32x4*)(Y + row * NY + C_RV + hh * 64 + dc);
            const u32x4 q0 = qp[0], q1 = qp[1], k0 = kp[0], k1 = kp[1], v0 = vp[0], v1 = vp[1];
            *(LAS u32x4*)(Qs + j * 144 + dc * 2) = q0; *(LAS u32x4*)(Qs + j * 144 + dc * 2 + 16) = q1;
            *(LAS u32x4*)(Ks + j * 144 + dc * 2) = k0; *(LAS u32x4*)(Ks + j * 144 + dc * 2 + 16) = k1;
            const unsigned vv[8] = {v0.x, v0.y, v0.z, v0.w, v1.x, v1.y, v1.z, v1.w};
#pragma unroll
            for (int e = 0; e < 8; ++e) {
                *(LAS bf16_t*)(Vt + (dc + 2 * e) * 272 + j * 2) = (bf16_t)(vv[e] & 0xffffu);
                *(LAS bf16_t*)(Vt + (dc + 2 * e + 1) * 272 + j * 2) = (bf16_t)(vv[e] >> 16);
            }
            const int d = c.tid >> 3, ec = (c.tid & 7) * 8;
            const float* rp = RST + (((size_t)(b * 4 + hh) * 64 + i) * 64 + d) * 64 + ec;
            const f32x4 r0 = *(const f32x4*)rp, r1 = *(const f32x4*)(rp + 4);
            const float rv[8] = {r0[0], r0[1], r0[2], r0[3], r1[0], r1[1], r1[2], r1[3]};
#pragma unroll
            for (int e = 0; e < 8; ++e) *(LAS bf16_t*)(Rt + (ec + e) * 144 + d * 2) = f2bf(rv[e]);
        }
        __syncthreads();
        const int r = c.lane & 31, h = c.lane >> 5;
        {
            const int mi = c.wave >> 1;
#pragma unroll
            for (int jj = 0; jj < 2; ++jj) {
                const int nj = (c.wave & 1) * 2 + jj;
                if (nj <= mi) {
                    f32x16 s = mma_lds(zero16(), Qs + mi * 32 * 144, 144, Ks + nj * 32 * 144, 144, 64, c.lane);
                    const int ii = mi * 32 + r;
#pragma unroll
                    for (int g = 0; g < 4; ++g) {
                        float p[4];
#pragma unroll
                        for (int e = 0; e < 4; ++e) { const int jx = nj * 32 + 8 * g + 4 * h + e; const int df = ii - jx; p[e] = (df >= 0) ? s[4 * g + e] * 0.125f * __expf(lg * (float)df) : 0.f; }
                        u32x2 w; w.x = pk_bf16(p[0], p[1]); w.y = pk_bf16(p[2], p[3]);
                        *(LAS u32x2*)(Att + ii * 272 + (nj * 32 + 8 * g + 4 * h) * 2) = w;
                    }
                }
            }
        }
        __syncthreads();
        {
            const int wm = c.wave >> 1, wn = c.wave & 1;
            f32x16 acc = mma_lds(zero16(), Qs + wm * 32 * 144, 144, Rt + wn * 32 * 144, 144, 64, c.lane);
            const int ii = wm * 32 + r;
            const float qd = __expf(lg * (float)(ii + 1));
#pragma unroll
            for (int e = 0; e < 16; ++e) acc[e] *= qd;
            acc = mma_lds(acc, Att + wm * 32 * 272, 272, Vt + wn * 32 * 272, 272, (wm + 1) * 32, c.lane);
#pragma unroll
            for (int g = 0; g < 4; ++g) { f32x4 o; o[0] = acc[4 * g]; o[1] = acc[4 * g + 1]; o[2] = acc[4 * g + 2]; o[3] = acc[4 * g + 3]; *(LAS f32x4*)(Of + ii * 68 + wn * 32 + 8 * g + 4 * h) = o; }
        }
        __syncthreads();
        {
            const int rw = c.tid >> 2, part = c.tid & 3;
            float v[16]; float s = 0.f;
#pragma unroll
            for (int e = 0; e < 16; ++e) { v[e] = Of[rw * 68 + part * 16 + e]; s += v[e]; }
            s += __shfl_xor(s, 1); s += __shfl_xor(s, 2);
            const float mu = s * (1.0f / 64.0f);
            float q = 0.f;
#pragma unroll
            for (int e = 0; e < 16; ++e) { const float d = v[e] - mu; q += d * d; }
            q += __shfl_xor(q, 1); q += __shfl_xor(q, 2);
            const float rstd = rsqrtf(q * (1.0f / 64.0f) + LN_EPS);
            const size_t row = row0 + rw;
            const int ch = hh * 64 + part * 16;
            const u32x4* gp = (const u32x4*)(Y + row * NY + C_RG + ch);
            const u32x4 g0 = gp[0], g1 = gp[1];
            const unsigned gg[8] = {g0.x, g0.y, g0.z, g0.w, g1.x, g1.y, g1.z, g1.w};
            unsigned ow[8];
#pragma unroll
            for (int e = 0; e < 8; ++e) {
                const float y0 = ((v[2 * e] - mu) * rstd * gn_g[ch + 2 * e] + gn_b[ch + 2 * e]) * siluf_(bf_lo(gg[e]));
                const float y1 = ((v[2 * e + 1] - mu) * rstd * gn_g[ch + 2 * e + 1] + gn_b[ch + 2 * e + 1]) * siluf_(bf_hi(gg[e]));
                ow[e] = pk_bf16(y0, y1);
            }
            u32x4* op = (u32x4*)(O + row * DM + 2 * 256 + ch);
            u32x4 w0, w1; w0.x = ow[0]; w0.y = ow[1]; w0.z = ow[2]; w0.w = ow[3]; w1.x = ow[4]; w1.y = ow[5]; w1.z = ow[6]; w1.w = ow[7];
            op[0] = w0; op[1] = w1;
        }
        __syncthreads();
    }
}

template <int NH>
__device__ __forceinline__ void gla_decays(const Ctx& c, const bf16_t* Y, size_t row0, int h0, const float* w_alpha, const float* b_alpha, LAS float* Ab, LAS float* lrs) {
    for (int i = c.tid; i < 64 * 16; i += NTHREADS) lrs[i] = bf2f(Y[(row0 + (i >> 4)) * NY + C_GLR + (i & 15)]);
    __syncthreads();
    for (int i = c.tid; i < NH * 64 * 32; i += NTHREADS) {
        const int k = i & 31, t = (i >> 5) & 63, hl = i >> 11;
        const int col = (h0 + hl) * 32 + k;
        float x = b_alpha[col];
#pragma unroll
        for (int rr = 0; rr < 16; ++rr) x += lrs[t * 16 + rr] * w_alpha[rr * 128 + col];
        Ab[i] = -softplusf_(-x) * (1.0f / 16.0f);
    }
    __syncthreads();
    if (c.tid < NH * 32) {
        const int k = c.tid & 31, hl = c.tid >> 5;
        float s = 0.f;
        for (int t = 0; t < 64; ++t) { s += Ab[(hl * 64 + t) * 32 + k]; Ab[(hl * 64 + t) * 32 + k] = s; }
    }
    __syncthreads();
}
__device__ __forceinline__ void phase_gla_local(const Ctx& c, const bf16_t* Y, const float* w_alpha, const float* b_alpha, float* UGLA, float* BL) {
    LAS float* Ab = (LAS float*)c.lds;
    LAS float* lrs = (LAS float*)(c.lds + 32768);
    const lptr Kt = c.lds + 36864;
    const lptr Vt = c.lds + 36864 + 18432;
    for (int u = c.blk; u < 256; u += c.nblk) {
        const int i = u & 127, b = u >> 7;
        const size_t row0 = (size_t)b * SEQ + i * 64;
        gla_decays<4>(c, Y, row0, 0, w_alpha, b_alpha, Ab, lrs);
        {
            const int s = c.tid >> 3, cc = (c.tid & 7) * 16;
            const u32x4* kp = (const u32x4*)(Y + (row0 + s) * NY + C_GK + cc);
            const u32x4 k0 = kp[0], k1 = kp[1];
            const unsigned kk[8] = {k0.x, k0.y, k0.z, k0.w, k1.x, k1.y, k1.z, k1.w};
#pragma unroll
            for (int e = 0; e < 16; ++e) {
                const int col = cc + e, hl = col >> 5, k = col & 31;
                const float kvf = (e & 1) ? bf_hi(kk[e >> 1]) : bf_lo(kk[e >> 1]);
                const float dec = __expf(Ab[(hl * 64 + 63) * 32 + k] - Ab[(hl * 64 + s) * 32 + k]);
                *(LAS bf16_t*)(Kt + hl * 4608 + k * 144 + s * 2) = f2bf(kvf * dec);
            }
            const int vc = (c.tid & 7) * 32;
            const u32x4* vp = (const u32x4*)(Y + (row0 + s) * NY + C_GV + vc);
#pragma unroll
            for (int q4 = 0; q4 < 4; ++q4) {
                const u32x4 v = vp[q4];
                const unsigned vv[4] = {v.x, v.y, v.z, v.w};
#pragma unroll
                for (int e = 0; e < 4; ++e) {
                    const int col = vc + q4 * 8 + 2 * e, hl = col >> 6, ee = col & 63;
                    *(LAS bf16_t*)(Vt + hl * 9216 + ee * 144 + s * 2) = (bf16_t)(vv[e] & 0xffffu);
                    *(LAS bf16_t*)(Vt + hl * 9216 + (ee + 1) * 144 + s * 2) = (bf16_t)(vv[e] >> 16);
                }
            }
        }
        __syncthreads();
        {
            const int hl = c.wave >> 1, wn = c.wave & 1, r = c.lane & 31, h = c.lane >> 5;
            f32x16 acc = mma_lds(zero16(), Kt + hl * 4608, 144, Vt + hl * 9216 + wn * 32 * 144, 144, 64, c.lane);
            float* dst = UGLA + (((size_t)(b * 4 + hl) * 128 + i) * 32 + r) * 64 + wn * 32 + 4 * h;
#pragma unroll
            for (int g = 0; g < 4; ++g) { f32x4 o; o[0] = acc[4 * g]; o[1] = acc[4 * g + 1]; o[2] = acc[4 * g + 2]; o[3] = acc[4 * g + 3]; *(f32x4*)(dst + 8 * g) = o; }
            if (c.tid < 128) { const int hl2 = c.tid >> 5, k = c.tid & 31; BL[((size_t)(b * 4 + hl2) * 128 + i) * 32 + k] = Ab[(hl2 * 64 + 63) * 32 + k]; }
        }
        __syncthreads();
    }
}
__device__ __forceinline__ void phase_gla_out(const Ctx& c, const bf16_t* Y, const float* w_alpha, const float* b_alpha, const float* SGLA, const float* norm_g, bf16_t* O) {
    LAS float* Ab = (LAS float*)c.lds;
    LAS float* lrs = (LAS float*)(c.lds + 16384);
    const lptr Qp = c.lds + 20480;
    const lptr Kp = Qp + 10240;
    const lptr Vt = Kp + 10240;
    const lptr St = Vt + 18432;
    const lptr Att = St + 10240;
    LAS float* Of = (LAS float*)(Att + 18432);
    for (int u = c.blk; u < 512; u += c.nblk) {
        const int hp = u & 1, i = (u >> 1) & 127, b = u >> 8;
        const size_t row0 = (size_t)b * SEQ + i * 64;
        gla_decays<2>(c, Y, row0, hp * 2, w_alpha, b_alpha, Ab, lrs);
        {
            const int s = c.tid >> 3, cc = (c.tid & 7) * 8;
            const int hl = cc >> 5, k0 = cc & 31;
            const u32x4 qv = *(const u32x4*)(Y + (row0 + s) * NY + C_GQ + hp * 64 + cc);
            const u32x4 kv = *(const u32x4*)(Y + (row0 + s) * NY + C_GK + hp * 64 + cc);
            const unsigned qq[4] = {qv.x, qv.y, qv.z, qv.w}, kk[4] = {kv.x, kv.y, kv.z, kv.w};
            unsigned qo[4], ko[4];
#pragma unroll
            for (int e = 0; e < 4; ++e) {
                const float b0 = Ab[(hl * 64 + s) * 32 + k0 + 2 * e], b1 = Ab[(hl * 64 + s) * 32 + k0 + 2 * e + 1];
                const float e0 = __expf(b0), e1 = __expf(b1);
                qo[e] = pk_bf16(bf_lo(qq[e]) * 0.17677669529663687f * e0, bf_hi(qq[e]) * 0.17677669529663687f * e1);
                ko[e] = pk_bf16(bf_lo(kk[e]) / e0, bf_hi(kk[e]) / e1);
            }
            u32x4 w; w.x = qo[0]; w.y = qo[1]; w.z = qo[2]; w.w = qo[3];
            *(LAS u32x4*)(Qp + hl * 5120 + s * 80 + k0 * 2) = w;
            w.x = ko[0]; w.y = ko[1]; w.z = ko[2]; w.w = ko[3];
            *(LAS u32x4*)(Kp + hl * 5120 + s * 80 + k0 * 2) = w;
            const int vc = (c.tid & 7) * 16;
            const u32x4* vp = (const u32x4*)(Y + (row0 + s) * NY + C_GV + hp * 128 + vc);
#pragma unroll
            for (int q4 = 0; q4 < 2; ++q4) {
                const u32x4 v = vp[q4];
                const unsigned vv[4] = {v.x, v.y, v.z, v.w};
#pragma unroll
                for (int e = 0; e < 4; ++e) {
                    const int col = vc + q4 * 8 + 2 * e, hl2 = col >> 6, ee = col & 63;
                    *(LAS bf16_t*)(Vt + hl2 * 9216 + ee * 144 + s * 2) = (bf16_t)(vv[e] & 0xffffu);
                    *(LAS bf16_t*)(Vt + hl2 * 9216 + (ee + 1) * 144 + s * 2) = (bf16_t)(vv[e] >> 16);
                }
            }
            const int sh = c.tid >> 8, sk = (c.tid >> 3) & 31, se = (c.tid & 7) * 8;
            const float* spp = SGLA + (((size_t)(b * 4 + hp * 2 + sh) * 128 + i) * 32 + sk) * 64 + se;
            const f32x4 s0 = *(const f32x4*)spp, s1 = *(const f32x4*)(spp + 4);
            const float sv[8] = {s0[0], s0[1], s0[2], s0[3], s1[0], s1[1], s1[2], s1[3]};
#pragma unroll
            for (int e = 0; e < 8; ++e) *(LAS bf16_t*)(St + sh * 5120 + (se + e) * 80 + sk * 2) = f2bf(sv[e]);
        }
        __syncthreads();
        const int hl = c.wave >> 2, mi = (c.wave >> 1) & 1, nj = c.wave & 1, r = c.lane & 31, h = c.lane >> 5;
        if (nj <= mi) {
            f32x16 s = mma_lds(zero16(), Qp + hl * 5120 + mi * 32 * 80, 80, Kp + hl * 5120 + nj * 32 * 80, 80, 32, c.lane);
            const int tt = mi * 32 + r;
#pragma unroll
            for (int g = 0; g < 4; ++g) {
                float p[4];
#pragma unroll
                for (int e = 0; e < 4; ++e) { const int sx = nj * 32 + 8 * g + 4 * h + e; p[e] = (sx <= tt) ? s[4 * g + e] : 0.f; }
                u32x2 w; w.x = pk_bf16(p[0], p[1]); w.y = pk_bf16(p[2], p[3]);
                *(LAS u32x2*)(Att + hl * 9216 + tt * 144 + (nj * 32 + 8 * g + 4 * h) * 2) = w;
            }
        }
        __syncthreads();
        {
            f32x16 acc = mma_lds(zero16(), Qp + hl * 5120 + mi * 32 * 80, 80, St + hl * 5120 + nj * 32 * 80, 80, 32, c.lane);
            acc = mma_lds(acc, Att + hl * 9216 + mi * 32 * 144, 144, Vt + hl * 9216 + nj * 32 * 144, 144, (mi + 1) * 32, c.lane);
            const int tt = mi * 32 + r;
#pragma unroll
            for (int g = 0; g < 4; ++g) { f32x4 o; o[0] = acc[4 * g]; o[1] = acc[4 * g + 1]; o[2] = acc[4 * g + 2]; o[3] = acc[4 * g + 3]; *(LAS f32x4*)(Of + (hl * 64 + tt) * 68 + nj * 32 + 8 * g + 4 * h) = o; }
        }
        __syncthreads();
        {
            const int rw = c.tid >> 2, part = c.tid & 3;
            const int hl2 = rw >> 6, tt = rw & 63, hh = hp * 2 + hl2;
            float v[16]; float q = 0.f;
#pragma unroll
            for (int e = 0; e < 16; ++e) { v[e] = Of[rw * 68 + part * 16 + e]; q += v[e] * v[e]; }
            q += __shfl_xor(q, 1); q += __shfl_xor(q, 2);
            const float rstd = rsqrtf(q * (1.0f / 64.0f) + LN_EPS);
            const size_t row = row0 + tt;
            const int ch = hh * 64 + part * 16;
            const u32x4* gp = (const u32x4*)(Y + row * NY + C_GR + ch);
            const u32x4 g0 = gp[0], g1 = gp[1];
            const unsigned gg[8] = {g0.x, g0.y, g0.z, g0.w, g1.x, g1.y, g1.z, g1.w};
            unsigned ow[8];
#pragma unroll
            for (int e = 0; e < 8; ++e) {
                const float y0 = v[2 * e] * rstd * norm_g[ch + 2 * e] * siluf_(bf_lo(gg[e]));
                const float y1 = v[2 * e + 1] * rstd * norm_g[ch + 2 * e + 1] * siluf_(bf_hi(gg[e]));
                ow[e] = pk_bf16(y0, y1);
            }
            u32x4* op = (u32x4*)(O + row * DM + 3 * 256 + ch);
            u32x4 w0, w1; w0.x = ow[0]; w0.y = ow[1]; w0.z = ow[2]; w0.w = ow[3]; w1.x = ow[4]; w1.y = ow[5]; w1.z = ow[6]; w1.w = ow[7];
            op[0] = w0; op[1] = w1;
        }
        __syncthreads();
    }
}

constexpr int NS_Q = 0;
constexpr int NS_K = 18432;
constexpr int NS_VT = 27648;
constexpr int NS_S = 36864;
constexpr int NS_P = 71680;
constexpr int NS_M = 90112;
constexpr int NS_L = NS_M + 512;
constexpr int NS_A = NS_L + 512;
constexpr int NS_G = NS_A + 512;
constexpr int NS_IMP = NS_G + 2048;
constexpr int NS_SEL = NS_IMP + 16384;
constexpr int NS_UM = NS_SEL + 512;
constexpr int NS_CARRY = NS_UM + 64;
constexpr int NS_END = NS_CARRY + 128;

__device__ __forceinline__ void ns_stage_rows(const Ctx& c, lptr dst, const bf16_t* src, size_t ld) {
    const int rr = c.tid >> 3, cc = (c.tid & 7) * 8;
    *(LAS u32x4*)(dst + rr * 144 + cc * 2) = *(const u32x4*)(src + (size_t)rr * ld + cc);
}
__device__ __forceinline__ void ns_stage_T(const Ctx& c, lptr dst, const bf16_t* src, size_t ld) {
    const int rr = c.tid >> 3, cc = (c.tid & 7) * 8;
    const u32x4 v = *(const u32x4*)(src + (size_t)rr * ld + cc);
    const unsigned vv[4] = {v.x, v.y, v.z, v.w};
#pragma unroll
    for (int e = 0; e < 4; ++e) {
        *(LAS bf16_t*)(dst + (cc + 2 * e) * 144 + rr * 2) = (bf16_t)(vv[e] & 0xffffu);
        *(LAS bf16_t*)(dst + (cc + 2 * e + 1) * 144 + rr * 2) = (bf16_t)(vv[e] >> 16);
    }
}
__device__ __forceinline__ void ns_scores(const Ctx& c) {
    const int wm = c.wave >> 1, wn = c.wave & 1, r = c.lane & 31, h = c.lane >> 5;
    const f32x16 s = mma_lds(zero16(), c.lds + NS_Q + wm * 32 * 144, 144, c.lds + NS_K + wn * 32 * 144, 144, 64, c.lane);
    LAS float* Sf = (LAS float*)(c.lds + NS_S);
#pragma unroll
    for (int g = 0; g < 4; ++g) { f32x4 o; o[0] = s[4 * g]; o[1] = s[4 * g + 1]; o[2] = s[4 * g + 2]; o[3] = s[4 * g + 3]; *(LAS f32x4*)(Sf + (wm * 32 + r) * 68 + wn * 32 + 8 * g + 4 * h) = o; }
}
template <int MODE>
__device__ __forceinline__ bool ns_valid(int t, int kidx, int tok, const Ctx& c, float& dist) {
    if (MODE == 0) { const int d = t - 16 * kidx - 31; dist = (float)d; return d >= 0 && kidx < 511; }
    if (MODE == 1) { const int nb = kidx >> 6; const unsigned m = ((LAS const unsigned*)(c.lds + NS_SEL))[tok * 4 + (nb >> 5)]; const int d = t - kidx; dist = (float)d; return ((m >> (nb & 31)) & 1u) && d >= 0; }
    const int d = t - kidx; dist = (float)d; return d >= 0 && d < 512;
}
template <int MODE, int PASS>
__device__ __forceinline__ void ns_softmax(const Ctx& c, int t0, int k0) {
    LAS float* Sf = (LAS float*)(c.lds + NS_S);
    LAS float* Mr = (LAS float*)(c.lds + NS_M); LAS float* Lr = (LAS float*)(c.lds + NS_L); LAS float* Ar = (LAS float*)(c.lds + NS_A);
    const int row = c.tid >> 2, part = c.tid & 3, tok = row & 31, hh = row >> 5, t = t0 + tok;
    const float slope = exp2f(-2.0f * (float)(hh + 1));
    float s[16]; bool ok[16]; float mloc = NEGF;
#pragma unroll
    for (int e = 0; e < 16; ++e) {
        const int j = part * 16 + e; float dist;
        ok[e] = ns_valid<MODE>(t, k0 + j, tok, c, dist);
        s[e] = Sf[row * 68 + j] * 0.125f - slope * dist;
        if (ok[e]) mloc = fmaxf(mloc, s[e]);
    }
    mloc = fmaxf(mloc, __shfl_xor(mloc, 1)); mloc = fmaxf(mloc, __shfl_xor(mloc, 2));
    const float mold = Mr[row], lold = Lr[row];
    if (PASS == 2) {
        const float inv = lold > 0.f ? 1.0f / lold : 0.f;
        unsigned pw[8];
#pragma unroll
        for (int e = 0; e < 16; e += 2) {
            const float p0 = ok[e] ? __expf(s[e] - mold) * inv : 0.f, p1 = ok[e + 1] ? __expf(s[e + 1] - mold) * inv : 0.f;
            Sf[row * 68 + part * 16 + e] = p0; Sf[row * 68 + part * 16 + e + 1] = p1;
            pw[e >> 1] = pk_bf16(p0, p1);
        }
        u32x4 w0, w1; w0.x = pw[0]; w0.y = pw[1]; w0.z = pw[2]; w0.w = pw[3]; w1.x = pw[4]; w1.y = pw[5]; w1.z = pw[6]; w1.w = pw[7];
        *(LAS u32x4*)(c.lds + NS_P + row * 144 + part * 32) = w0; *(LAS u32x4*)(c.lds + NS_P + row * 144 + part * 32 + 16) = w1;
        return;
    }
    const float mnew = fmaxf(mold, mloc);
    float sum = 0.f; unsigned pw[8];
#pragma unroll
    for (int e = 0; e < 16; e += 2) {
        const float p0 = ok[e] ? __expf(s[e] - mnew) : 0.f, p1 = ok[e + 1] ? __expf(s[e + 1] - mnew) : 0.f;
        sum += p0 + p1; pw[e >> 1] = pk_bf16(p0, p1);
    }
    sum += __shfl_xor(sum, 1); sum += __shfl_xor(sum, 2);
    const float alpha = __expf(mold - mnew);
    if (PASS == 1) {
        u32x4 w0, w1; w0.x = pw[0]; w0.y = pw[1]; w0.z = pw[2]; w0.w = pw[3]; w1.x = pw[4]; w1.y = pw[5]; w1.z = pw[6]; w1.w = pw[7];
        *(LAS u32x4*)(c.lds + NS_P + row * 144 + part * 32) = w0; *(LAS u32x4*)(c.lds + NS_P + row * 144 + part * 32 + 16) = w1;
    }
    if (part == 0) { Mr[row] = mnew; Lr[row] = lold * alpha + sum; Ar[row] = alpha; }
}
__device__ __forceinline__ f32x16 ns_pv(const Ctx& c, f32x16 acc, bool rescale) {
    const int wm = c.wave >> 1, wn = c.wave & 1, r = c.lane & 31;
    if (rescale) { const float a = ((LAS const float*)(c.lds + NS_A))[wm * 32 + r];
#pragma unroll
        for (int e = 0; e < 16; ++e) acc[e] *= a; }
    return mma_lds(acc, c.lds + NS_P + wm * 32 * 144, 144, c.lds + NS_VT + wn * 32 * 144, 144, 64, c.lane);
}
__device__ __forceinline__ void ns_reset_stats(const Ctx& c) {
    if (c.tid < 128) { ((LAS float*)(c.lds + NS_M))[c.tid] = NEGF; ((LAS float*)(c.lds + NS_L))[c.tid] = 0.f; ((LAS float*)(c.lds + NS_A))[c.tid] = 1.f; }
}

__device__ __forceinline__ void phase_nsa(const Ctx& c, const bf16_t* Y, const bf16_t* KC, const bf16_t* VC, bf16_t* O) {
    LAS float* Sf = (LAS float*)(c.lds + NS_S);
    LAS float* Gt = (LAS float*)(c.lds + NS_G);
    LAS float* Imp = (LAS float*)(c.lds + NS_IMP);
    LAS unsigned* Sel = (LAS unsigned*)(c.lds + NS_SEL);
    LAS unsigned* Um = (LAS unsigned*)(c.lds + NS_UM);
    LAS float* Carry = (LAS float*)(c.lds + NS_CARRY);
    const int wm = c.wave >> 1, wn = c.wave & 1, r = c.lane & 31, h = c.lane >> 5;
    for (int u = c.blk; u < 512; u += c.nblk) {
        const int tq = u & 255, b = u >> 8;
        const int t0 = tq * 32;
        const size_t row0 = (size_t)b * SEQ + t0;
        {
            const int row = c.tid >> 2, dc = (c.tid & 3) * 16, tok = row & 31, hh = row >> 5;
            const u32x4* qp = (const u32x4*)(Y + (row0 + tok) * NY + C_NQ + hh * 64 + dc);
            *(LAS u32x4*)(c.lds + NS_Q + row * 144 + dc * 2) = qp[0]; *(LAS u32x4*)(c.lds + NS_Q + row * 144 + dc * 2 + 16) = qp[1];
            if (c.tid < 384) { const int rw = c.tid / 3, gi = c.tid % 3; Gt[rw * 4 + gi] = sigmoidf_(bf2f(Y[(row0 + (rw & 31)) * NY + C_NG + (rw >> 5) * 3 + gi])); }
            for (int i = c.tid; i < 32 * 128; i += NTHREADS) Imp[i] = 0.f;
            if (c.tid < 32) Carry[c.tid] = 0.f;
            if (c.tid < 4) Um[c.tid] = 0u;
            ns_reset_stats(c);
        }
        __syncthreads();
        f32x16 outacc = zero16();
        const int ncmp = min(t0 / 16 + 1, 511);
        const int nct = (ncmp + 63) / 64;
        const bf16_t* kcb = KC + (size_t)b * 512 * 64; const bf16_t* vcb = VC + (size_t)b * 512 * 64;
        for (int ct = 0; ct < nct; ++ct) {
            ns_stage_rows(c, c.lds + NS_K, kcb + (size_t)ct * 64 * 64, 64);
            __syncthreads();
            ns_scores(c);
            __syncthreads();
            ns_softmax<0, 0>(c, t0, ct * 64);
            __syncthreads();
        }
        {
            f32x16 acc = zero16();
            for (int ct = 0; ct < nct; ++ct) {
                ns_stage_rows(c, c.lds + NS_K, kcb + (size_t)ct * 64 * 64, 64);
                ns_stage_T(c, c.lds + NS_VT, vcb + (size_t)ct * 64 * 64, 64);
                __syncthreads();
                ns_scores(c);
                __syncthreads();
                ns_softmax<0, 2>(c, t0, ct * 64);
                __syncthreads();
                acc = ns_pv(c, acc, false);
                {
                    const int tok = c.tid >> 4, g = c.tid & 15;
                    float a = 0.f, last = 0.f, prev = 0.f;
#pragma unroll
                    for (int hh = 0; hh < 4; ++hh) {
                        const LAS float* pr = Sf + (hh * 32 + tok) * 68 + 4 * g;
                        a += (pr[0] + pr[1]) + (pr[2] + pr[3]);
                        last += pr[3];
                        if (g > 0) prev += pr[-1];
                    }
                    if (g == 0) prev = Carry[tok];
                    Imp[tok * 128 + ct * 16 + g] += a + prev;
                    __syncthreads();
                    if (g == 15) Carry[tok] = last;
                }
                __syncthreads();
            }
            const float g0 = Gt[(wm * 32 + r) * 4 + 0];
#pragma unroll
            for (int e = 0; e < 16; ++e) outacc[e] += g0 * acc[e];
        }
        for (int tk = 0; tk < 4; ++tk) {
            const int tok = c.wave * 4 + tk, t = t0 + tok, cur = t >> 6;
            float v0 = Imp[tok * 128 + c.lane], v1 = Imp[tok * 128 + 64 + c.lane];
            const int n0 = c.lane, n1 = c.lane + 64;
            if (n0 > cur) v0 = NEGF; if (n1 > cur) v1 = NEGF;
            if (n0 == cur) v0 = 1e30f; if (n1 == cur) v1 = 1e30f;
            unsigned m0 = 0u, m1 = 0u, m2 = 0u, m3 = 0u;
            for (int it = 0; it < 16; ++it) {
                const float mx = wave_max(fmaxf(v0, v1));
                if (mx <= NEGF) break;
                const unsigned long long b0 = __ballot(v0 == mx);
                int nsel;
                if (b0) { nsel = __ffsll((long long)b0) - 1; if (c.lane == nsel) v0 = -3e38f; }
                else { const unsigned long long b1 = __ballot(v1 == mx); const int l1 = __ffsll((long long)b1) - 1; nsel = 64 + l1; if (c.lane == l1) v1 = -3e38f; }
                if (nsel < 32) m0 |= 1u << nsel; else if (nsel < 64) m1 |= 1u << (nsel - 32); else if (nsel < 96) m2 |= 1u << (nsel - 64); else m3 |= 1u << (nsel - 96);
            }
            if (c.lane == 0) {
                Sel[tok * 4 + 0] = m0; Sel[tok * 4 + 1] = m1; Sel[tok * 4 + 2] = m2; Sel[tok * 4 + 3] = m3;
                atomicOr((unsigned*)&Um[0], m0); atomicOr((unsigned*)&Um[1], m1); atomicOr((unsigned*)&Um[2], m2); atomicOr((unsigned*)&Um[3], m3);
            }
        }
        ns_reset_stats(c);
        __syncthreads();
        {
            f32x16 acc = zero16();
            const bf16_t* ksb = Y + (size_t)b * SEQ * NY + C_NKS; const bf16_t* vsb = Y + (size_t)b * SEQ * NY + C_NVS;
            for (int wd = 0; wd < 4; ++wd) {
                unsigned bits = Um[wd];
                while (bits) {
                    const int nb = wd * 32 + __ffs((int)bits) - 1; bits &= bits - 1;
                    ns_stage_rows(c, c.lds + NS_K, ksb + (size_t)nb * 64 * NY, NY);
                    ns_stage_T(c, c.lds + NS_VT, vsb + (size_t)nb * 64 * NY, NY);
                    __syncthreads();
                    ns_scores(c);
                    __syncthreads();
                    ns_softmax<1, 1>(c, t0, nb * 64);
                    __syncthreads();
                    acc = ns_pv(c, acc, true);
                    __syncthreads();
                }
            }
            const float l = ((LAS const float*)(c.lds + NS_L))[wm * 32 + r];
            const float g1 = Gt[(wm * 32 + r) * 4 + 1] * (l > 0.f ? 1.0f / l : 0.f);
#pragma unroll
            for (int e = 0; e < 16; ++e) outacc[e] += g1 * acc[e];
        }
        __syncthreads();
        ns_reset_stats(c);
        __syncthreads();
        {
            f32x16 acc = zero16();
            const bf16_t* kwb = Y + (size_t)b * SEQ * NY + C_NKW; const bf16_t* vwb = Y + (size_t)b * SEQ * NY + C_NVW;
            const int kt1 = t0 >> 6, kt0 = max(0, kt1 - 8);
            for (int kt = kt0; kt <= kt1; ++kt) {
                ns_stage_rows(c, c.lds + NS_K, kwb + (size_t)kt * 64 * NY, NY);
                ns_stage_T(c, c.lds + NS_VT, vwb + (size_t)kt * 64 * NY, NY);
                __syncthreads();
                ns_scores(c);
                __syncthreads();
                ns_softmax<2, 1>(c, t0, kt * 64);
                __syncthreads();
                acc = ns_pv(c, acc, true);
                __syncthreads();
            }
            const float l = ((LAS const float*)(c.lds + NS_L))[wm * 32 + r];
            const float g2 = Gt[(wm * 32 + r) * 4 + 2] * (l > 0.f ? 1.0f / l : 0.f);
#pragma unroll
            for (int e = 0; e < 16; ++e) outacc[e] += g2 * acc[e];
        }
        {
            bf16_t* op = O + (row0 + r) * DM + 256 + wm * 64 + wn * 32 + 4 * h;
#pragma unroll
            for (int g = 0; g < 4; ++g) { u32x2 w; w.x = pk_bf16(outacc[4 * g], outacc[4 * g + 1]); w.y = pk_bf16(outacc[4 * g + 2], outacc[4 * g + 3]); *(u32x2*)(op + 8 * g) = w; }
        }
        __syncthreads();
    }
}

__device__ __forceinline__ void phase_sb2(const Ctx& c, const bf16_t* Y, bf16_t* O) {
    LAS float* Sf = (LAS float*)(c.lds + NS_S);
    LAS float* Cr = (LAS float*)(c.lds + NS_M);
    const int wm = c.wave >> 1, wn = c.wave & 1, r = c.lane & 31, h = c.lane >> 5;
    for (int u = c.blk; u < 512; u += c.nblk) {
        const int b = u >> 8, hh = (u >> 6) & 3, qt = b ? 63 - (u & 63) : (u & 63);
        const int t0 = qt * 128;
        const size_t row0 = (size_t)b * SEQ + t0;
        {
            const int row = c.tid >> 2, dc = (c.tid & 3) * 16;
            const u32x4* qp = (const u32x4*)(Y + (row0 + row) * NY + C_SBQ + hh * 64 + dc);
            *(LAS u32x4*)(c.lds + NS_Q + row * 144 + dc * 2) = qp[0]; *(LAS u32x4*)(c.lds + NS_Q + row * 144 + dc * 2 + 16) = qp[1];
            if (c.tid < 128) Cr[c.tid] = 0.f;
        }
        LAS volatile unsigned* NotDone = (LAS volatile unsigned*)(c.lds + NS_L);
        f32x16 acc = zero16();
        const bf16_t* kb = Y + (size_t)b * SEQ * NY + C_SBK + hh * 64; const bf16_t* vb = Y + (size_t)b * SEQ * NY + C_SBV + hh * 64;
        for (int kt = 2 * qt + 1; kt >= 0; --kt) {
            ns_stage_rows(c, c.lds + NS_K, kb + (size_t)kt * 64 * NY, NY);
            ns_stage_T(c, c.lds + NS_VT, vb + (size_t)kt * 64 * NY, NY);
            if (c.tid == 0) NotDone[0] = 0u;
            __syncthreads();
            ns_scores(c);
            __syncthreads();
            {
                const int row = c.tid >> 2, part = c.tid & 3, t = t0 + row;
                float z[16], suf[16]; bool ok[16];
                float run = 0.f;
#pragma unroll
                for (int e = 15; e >= 0; --e) {
                    const int pos = kt * 64 + part * 16 + e;
                    z[e] = Sf[row * 68 + part * 16 + e] * 0.125f;
                    ok[e] = pos < t;
                    run += ok[e] ? -softplusf_(z[e]) : 0.f;
                    suf[e] = run;
                }
                const float tot = run;
                const float t1 = __shfl_down(tot, 1), t2 = __shfl_down(tot, 2), t3 = __shfl_down(tot, 3);
                const float thigh = (part < 3 ? t1 : 0.f) + (part < 2 ? t2 : 0.f) + (part < 1 ? t3 : 0.f);
                const float carry = Cr[row];
                unsigned pw[8];
#pragma unroll
                for (int e = 0; e < 16; e += 2) {
                    const float w0 = ok[e] ? __expf(z[e] + carry + thigh + suf[e]) : 0.f, w1 = ok[e + 1] ? __expf(z[e + 1] + carry + thigh + suf[e + 1]) : 0.f;
                    pw[e >> 1] = pk_bf16(w0, w1);
                }
                u32x4 w0, w1; w0.x = pw[0]; w0.y = pw[1]; w0.z = pw[2]; w0.w = pw[3]; w1.x = pw[4]; w1.y = pw[5]; w1.z = pw[6]; w1.w = pw[7];
                *(LAS u32x4*)(c.lds + NS_P + row * 144 + part * 32) = w0; *(LAS u32x4*)(c.lds + NS_P + row * 144 + part * 32 + 16) = w1;
                const float cn = carry + thigh + tot;
                if (part == 0) { Cr[row] = cn; if (!(cn < -104.0f)) NotDone[0] = 1u; }
            }
            __syncthreads();
            const bool alldone = (NotDone[0] == 0u);
            acc = ns_pv(c, acc, false);
            __syncthreads();
            if (alldone) break;
        }
        {
            bf16_t* op = O + (row0 + wm * 32 + r) * DM + hh * 64 + wn * 32 + 4 * h;
#pragma unroll
            for (int g = 0; g < 4; ++g) { u32x2 w; w.x = pk_bf16(acc[4 * g], acc[4 * g + 1]); w.y = pk_bf16(acc[4 * g + 2], acc[4 * g + 3]); *(u32x2*)(op + 8 * g) = w; }
        }
        __syncthreads();
    }
}

__device__ __forceinline__ void phase_subkey(const Ctx& c, const bf16_t* QV, const bf16_t* KEYS, float* TOPS, int* TOPI) {
    constexpr int SC_OFF = 73728;
    LAS float* Sc = (LAS float*)(c.lds + SC_OFF);
    const int wm = c.wave >> 1, wn = c.wave & 1, r = c.lane & 31, h = c.lane >> 5;
    for (int u = c.blk; u < 128 * 16; u += c.nblk) {
        const int hp = u & 15, pm = u >> 4;
        f32x16 acc[1][2]; acc_zero<1, 2>(acc);
        gemm_kloop<1, 2>(c, acc, QV + (size_t)pm * 128 * 2048 + hp * 128, 2048, KEYS + (size_t)hp * 128 * 128, 128, 128);
        EPI_LOOP(1, 2) {
            const int m = (wm + i) * 32 + r, n = (wn * 2 + j) * 32 + 8 * g + 4 * h;
            f32x4 o; o[0] = acc[i][j][4 * g]; o[1] = acc[i][j][4 * g + 1]; o[2] = acc[i][j][4 * g + 2]; o[3] = acc[i][j][4 * g + 3];
            *(LAS f32x4*)(Sc + m * 132 + n) = o;
        }
        __syncthreads();
        for (int rr = 0; rr < 16; ++rr) {
            const int row = c.wave * 16 + rr;
            float v0 = Sc[row * 132 + c.lane], v1 = Sc[row * 132 + 64 + c.lane];
            float ks = 0.f; int ki = 0;
            for (int it = 0; it < 16; ++it) {
                const float mx = wave_max(fmaxf(v0, v1));
                const unsigned long long b0 = __ballot(v0 == mx);
                int nsel;
                if (b0) { nsel = __ffsll((long long)b0) - 1; if (c.lane == nsel) v0 = -3e38f; }
                else { const unsigned long long b1 = __ballot(v1 == mx); const int l1 = __ffsll((long long)b1) - 1; nsel = 64 + l1; if (c.lane == l1) v1 = -3e38f; }
                if (c.lane == it) { ks = mx; ki = nsel; }
            }
            if (c.lane < 16) {
                const size_t o = ((size_t)(pm * 128 + row) * 16 + hp) * 16 + c.lane;
                TOPS[o] = ks; TOPI[o] = ki;
            }
        }
        __syncthreads();
    }
}


__device__ __forceinline__ unsigned ord_key(float s) { const unsigned u = __float_as_uint(s); return u ^ ((unsigned)((int)u >> 31) | 0x80000000u); }
__device__ __forceinline__ float unord_key(unsigned k) { const unsigned u = (k & 0x80000000u) ? (k ^ 0x80000000u) : ~k; return __uint_as_float(u); }
#define CE_DESC(a, b) do { const unsigned _hi = max((a), (b)), _lo = min((a), (b)); (a) = _hi; (b) = _lo; } while (0)
__device__ __forceinline__ void sort16_desc(unsigned (&k)[16]) {
#pragma unroll
    for (int size = 2; size <= 16; size <<= 1)
#pragma unroll
        for (int stride = size >> 1; stride > 0; stride >>= 1)
#pragma unroll
            for (int i = 0; i < 16; ++i) {
                const int j = i ^ stride;
                if (j > i) { if ((i & size) == 0) CE_DESC(k[i], k[j]); else CE_DESC(k[j], k[i]); }
            }
}
__device__ __forceinline__ void bitonic_merge16_desc(unsigned (&k)[16]) {
#pragma unroll
    for (int stride = 8; stride > 0; stride >>= 1)
#pragma unroll
        for (int i = 0; i < 16; ++i) { const int j = i ^ stride; if (j > i) CE_DESC(k[i], k[j]); }
}
__device__ __forceinline__ void top16_merge(unsigned (&a)[16], const unsigned (&b)[16]) {
#pragma unroll
    for (int i = 0; i < 16; ++i) a[i] = max(a[i], b[15 - i]);
    bitonic_merge16_desc(a);
}

__device__ __forceinline__ void phase_subkey2(const Ctx& c, const bf16_t* QV, const bf16_t* KEYS, float* TOPS, int* TOPI) {
    const lptr Ab = c.lds, Bb = c.lds + 256 * 272;
    const int r = c.lane & 31, h = c.lane >> 5;
    int cur_hp = -1;
    for (int u = c.blk; u < 64 * 16; u += c.nblk) {
        const int hp = u & 15, pm = u >> 4;
        if (hp != cur_hp) {
            cur_hp = hp;
#pragma unroll
            for (int i = 0; i < 4; ++i) { const int id = c.tid + i * NTHREADS; *(LAS u32x4*)(Bb + (id >> 4) * 272 + (id & 15) * 16) = *(const u32x4*)(KEYS + (size_t)hp * 128 * 128 + (size_t)(id >> 4) * 128 + (id & 15) * 8); }
        }
#pragma unroll
        for (int i = 0; i < 8; ++i) { const int id = c.tid + i * NTHREADS; *(LAS u32x4*)(Ab + (id >> 4) * 272 + (id & 15) * 16) = *(const u32x4*)(QV + (size_t)(pm * 256 + (id >> 4)) * 2048 + hp * 128 + (id & 15) * 8); }
        __syncthreads();
        f32x16 acc[4];
#pragma unroll
        for (int j = 0; j < 4; ++j) acc[j] = zero16();
#pragma unroll
        for (int s = 0; s < 8; ++s) {
            const bf16x8 fa = *(LAS const bf16x8*)(Ab + (c.wave * 32 + r) * 272 + s * 32 + h * 16);
#pragma unroll
            for (int j = 0; j < 4; ++j) {
                const bf16x8 fb = *(LAS const bf16x8*)(Bb + (j * 32 + r) * 272 + s * 32 + h * 16);
                acc[j] = __builtin_amdgcn_mfma_f32_32x32x16_bf16(fb, fa, acc[j], 0, 0, 0);
            }
        }
        unsigned best[16];
#pragma unroll
        for (int j = 0; j < 4; ++j) {
            unsigned k[16];
#pragma unroll
            for (int g = 0; g < 4; ++g)
#pragma unroll
                for (int e = 0; e < 4; ++e) { const int n = j * 32 + 8 * g + 4 * h + e; k[4 * g + e] = (ord_key(acc[j][4 * g + e]) & ~127u) | (unsigned)(127 - n); }
            sort16_desc(k);
            if (j == 0) {
#pragma unroll
                for (int i = 0; i < 16; ++i) best[i] = k[i];
            } else top16_merge(best, k);
        }
        {
            unsigned other[16];
#pragma unroll
            for (int i = 0; i < 16; ++i) other[i] = (unsigned)__shfl_xor((int)best[i], 32);
            top16_merge(best, other);
        }
        {
            const size_t o = ((size_t)(pm * 256 + c.wave * 32 + r) * 16 + hp) * 16 + 8 * h;
            f32x4 s0, s1; int i0[4], i1[4];
#pragma unroll
            for (int i = 0; i < 4; ++i) {
                const unsigned ka = h ? best[8 + i] : best[i], kb = h ? best[12 + i] : best[4 + i];
                s0[i] = unord_key((ka & ~127u) | 64u); s1[i] = unord_key((kb & ~127u) | 64u);
                i0[i] = 127 - (int)(ka & 127u); i1[i] = 127 - (int)(kb & 127u);
            }
            *(f32x4*)(TOPS + o) = s0; *(f32x4*)(TOPS + o + 4) = s1;
            int4 w0 = make_int4(i0[0], i0[1], i0[2], i0[3]), w1 = make_int4(i1[0], i1[1], i1[2], i1[3]);
            *(int4*)(TOPI + o) = w0; *(int4*)(TOPI + o + 4) = w1;
        }
        __syncthreads();
    }
}

__device__ __forceinline__ float gelu_erf(float x) { return 0.5f * x * (1.0f + erff(x * 0.70710678118654752f)); }
__device__ __forceinline__ void phase_peer(const Ctx& c, const float* XF, const bf16_t* XB, const float* TOPS, const int* TOPI, const bf16_t* UB, const bf16_t* VB,
                                           const float* ln_g, const float* ln_b, float* outf, bf16_t* outb, bool store) {
    LAS int* eidx = (LAS int*)(c.lds + c.wave * 1024);
    LAS float* ewt = (LAS float*)(c.lds + c.wave * 1024 + 512);
    const int lane = c.lane;
    for (int tok = c.blk * 8 + c.wave; tok < NTOK; tok += c.nblk * 8) {
        for (int hh = 0; hh < 8; ++hh) {
            const float* ts = TOPS + ((size_t)tok * 16 + hh * 2) * 16; const int* ti = TOPI + ((size_t)tok * 16 + hh * 2) * 16;
            const int a = lane >> 2, bq = (lane & 3) * 4;
            const float sa = ts[a];
            const f32x4 sb = *(const f32x4*)(ts + 16 + bq);
            float v[4] = {sa + sb[0], sa + sb[1], sa + sb[2], sa + sb[3]};
            float ks = 0.f; int kf = 0;
            for (int it = 0; it < 16; ++it) {
                const float lm = fmaxf(fmaxf(v[0], v[1]), fmaxf(v[2], v[3]));
                const float mx = wave_max(lm);
                const unsigned long long bl = __ballot(lm == mx);
                const int wl = (__ffsll((long long)bl) - 1) & 63;
                int li = (v[0] == mx) ? 0 : (v[1] == mx) ? 1 : (v[2] == mx) ? 2 : 3;
                li = __builtin_amdgcn_readlane(li, wl);
                if (lane == wl) { if (li == 0) v[0] = -3e38f; else if (li == 1) v[1] = -3e38f; else if (li == 2) v[2] = -3e38f; else v[3] = -3e38f; }
                if (lane == it) { ks = mx; kf = wl * 4 + li; }
            }
            float mx16 = (lane < 16) ? ks : -3e38f;
            mx16 = wave_max(mx16);
            const float ex = (lane < 16) ? __expf(ks - mx16) : 0.f;
            const float den = wave_sum(ex);
            if (lane < 16) {
                const int ia = ti[kf >> 4], ib = ti[16 + (kf & 15)];
                eidx[hh * 16 + lane] = (ia * 128 + ib) & 16383;
                ewt[hh * 16 + lane] = ex / den;
            }
        }
        asm volatile("s_waitcnt lgkmcnt(0)" ::: "memory");
        unsigned xb[8];
        {
            const u32x4 x0 = *(const u32x4*)(XB + (size_t)tok * DM + lane * 8), x1 = *(const u32x4*)(XB + (size_t)tok * DM + 512 + lane * 8);
            xb[0] = x0.x; xb[1] = x0.y; xb[2] = x0.z; xb[3] = x0.w; xb[4] = x1.x; xb[5] = x1.y; xb[6] = x1.z; xb[7] = x1.w;
        }
        for (int e0 = 0; e0 < 128; e0 += 8) {
            u32x4 ua[8], ub2[8];
#pragma unroll
            for (int j = 0; j < 8; ++j) {
                const int ex = __builtin_amdgcn_readfirstlane(eidx[e0 + j]);
                const bf16_t* up = UB + (size_t)ex * DM;
                ua[j] = *(const u32x4*)(up + lane * 8); ub2[j] = *(const u32x4*)(up + 512 + lane * 8);
            }
            float p[8];
#pragma unroll
            for (int j = 0; j < 8; ++j) {
                float s0 = dot2bf(xb[0], ua[j].x, 0.f), s1 = dot2bf(xb[1], ua[j].y, 0.f);
                s0 = dot2bf(xb[2], ua[j].z, s0); s1 = dot2bf(xb[3], ua[j].w, s1);
                s0 = dot2bf(xb[4], ub2[j].x, s0); s1 = dot2bf(xb[5], ub2[j].y, s1);
                s0 = dot2bf(xb[6], ub2[j].z, s0); s1 = dot2bf(xb[7], ub2[j].w, s1);
                p[j] = s0 + s1;
            }
            const bool b5 = lane & 32, b4 = lane & 16, b3 = lane & 8;
            float q4[4], q2[2], q1;
#pragma unroll
            for (int j = 0; j < 4; ++j) { const float send = b5 ? p[j] : p[j + 4], keep = b5 ? p[j + 4] : p[j]; q4[j] = keep + __shfl_xor(send, 32); }
#pragma unroll
            for (int j = 0; j < 2; ++j) { const float send = b4 ? q4[j] : q4[j + 2], keep = b4 ? q4[j + 2] : q4[j]; q2[j] = keep + __shfl_xor(send, 16); }
            { const float send = b3 ? q2[0] : q2[1], keep = b3 ? q2[1] : q2[0]; q1 = keep + __shfl_xor(send, 8); }
            q1 += __shfl_xor(q1, 4); q1 += __shfl_xor(q1, 2); q1 += __shfl_xor(q1, 1);
            const int jx = (b5 ? 4 : 0) + (b4 ? 2 : 0) + (b3 ? 1 : 0);
            if ((lane & 7) == 0) ewt[e0 + jx] = ewt[e0 + jx] * gelu_erf(q1);
        }
        asm volatile("s_waitcnt lgkmcnt(0)" ::: "memory");
        float y[16];
#pragma unroll
        for (int i = 0; i < 16; ++i) y[i] = 0.f;
        for (int e0 = 0; e0 < 128; e0 += 8) {
            u32x4 va[8], vb2[8];
#pragma unroll
            for (int j = 0; j < 8; ++j) {
                const int ex = __builtin_amdgcn_readfirstlane(eidx[e0 + j]);
                const bf16_t* vp = VB + (size_t)ex * DM;
                va[j] = *(const u32x4*)(vp + lane * 8); vb2[j] = *(const u32x4*)(vp + 512 + lane * 8);
            }
#pragma unroll
            for (int j = 0; j < 8; ++j) {
                const float w = ewt[e0 + j];
                y[0] += w * bf_lo(va[j].x); y[1] += w * bf_hi(va[j].x); y[2] += w * bf_lo(va[j].y); y[3] += w * bf_hi(va[j].y);
                y[4] += w * bf_lo(va[j].z); y[5] += w * bf_hi(va[j].z); y[6] += w * bf_lo(va[j].w); y[7] += w * bf_hi(va[j].w);
                y[8] += w * bf_lo(vb2[j].x); y[9] += w * bf_hi(vb2[j].x); y[10] += w * bf_lo(vb2[j].y); y[11] += w * bf_hi(vb2[j].y);
                y[12] += w * bf_lo(vb2[j].z); y[13] += w * bf_hi(vb2[j].z); y[14] += w * bf_lo(vb2[j].w); y[15] += w * bf_hi(vb2[j].w);
            }
        }
        {
            const float* xr = XF + (size_t)tok * DM;
            const f32x4 a0 = *(const f32x4*)(xr + lane * 8), a1 = *(const f32x4*)(xr + lane * 8 + 4), a2 = *(const f32x4*)(xr + 512 + lane * 8), a3 = *(const f32x4*)(xr + 512 + lane * 8 + 4);
            const float xs[16] = {a0[0], a0[1], a0[2], a0[3], a1[0], a1[1], a1[2], a1[3], a2[0], a2[1], a2[2], a2[3], a3[0], a3[1], a3[2], a3[3]};
            float s = 0.f;
#pragma unroll
            for (int i = 0; i < 16; ++i) { y[i] = DN_ALPHA * xs[i] + y[i]; s += y[i]; }
            const float mean = wave_sum(s) * (1.0f / 1024.0f);
            float q = 0.f;
#pragma unroll
            for (int i = 0; i < 16; ++i) { const float d = y[i] - mean; q += d * d; }
            const float rstd = rsqrtf(wave_sum(q) * (1.0f / 1024.0f) + LN_EPS);
            float o[16];
#pragma unroll
            for (int i = 0; i < 16; ++i) { const int ch = (i < 8) ? lane * 8 + i : 512 + lane * 8 + (i - 8); o[i] = (y[i] - mean) * rstd * ln_g[ch] + ln_b[ch]; }
            if (store) {
            float* of = outf + (size_t)tok * DM;
            f32x4 w;
            w[0] = o[0]; w[1] = o[1]; w[2] = o[2]; w[3] = o[3]; *(f32x4*)(of + lane * 8) = w;
            w[0] = o[4]; w[1] = o[5]; w[2] = o[6]; w[3] = o[7]; *(f32x4*)(of + lane * 8 + 4) = w;
            w[0] = o[8]; w[1] = o[9]; w[2] = o[10]; w[3] = o[11]; *(f32x4*)(of + 512 + lane * 8) = w;
            w[0] = o[12]; w[1] = o[13]; w[2] = o[14]; w[3] = o[15]; *(f32x4*)(of + 512 + lane * 8 + 4) = w;
            if (outb) {
                u32x4 pb; pb.x = pk_bf16(o[0], o[1]); pb.y = pk_bf16(o[2], o[3]); pb.z = pk_bf16(o[4], o[5]); pb.w = pk_bf16(o[6], o[7]);
                *(u32x4*)(outb + (size_t)tok * DM + lane * 8) = pb;
                pb.x = pk_bf16(o[8], o[9]); pb.y = pk_bf16(o[10], o[11]); pb.z = pk_bf16(o[12], o[13]); pb.w = pk_bf16(o[14], o[15]);
                *(u32x4*)(outb + (size_t)tok * DM + 512 + lane * 8) = pb;
            }
            }
        }
        asm volatile("s_waitcnt lgkmcnt(0)" ::: "memory");
    }
}


__device__ __forceinline__ void phase_peer2(const Ctx& c, const float* XF, const bf16_t* XB, const float* TOPS, const int* TOPI, const unsigned char* U8, const unsigned char* V8,
                                            const float* SU, const float* SV, const float* ln_g, const float* ln_b, float* outf, bf16_t* outb, bool store) {
    LAS int* ent_e = (LAS int*)(c.lds + c.wave * 16384);
    LAS float* ent_g = (LAS float*)(c.lds + c.wave * 16384 + 4096);
    LAS float* ent_su = (LAS float*)(c.lds + c.wave * 16384 + 8192);
    LAS float* ent_sv = (LAS float*)(c.lds + c.wave * 16384 + 12288);
    const int lane = c.lane;
    for (int base = (c.blk * 8 + c.wave) * 8; base < NTOK; base += c.nblk * 64) {
        {
            const int ti_ = lane >> 3, hh = lane & 7, t = base + ti_;
            const float* ts = TOPS + ((size_t)t * 16 + hh * 2) * 16; const int* tix = TOPI + ((size_t)t * 16 + hh * 2) * 16;
            float s0[16], s1[16];
#pragma unroll
            for (int i = 0; i < 4; ++i) { const f32x4 a = *(const f32x4*)(ts + 4 * i), b = *(const f32x4*)(ts + 16 + 4 * i);
                s0[4 * i] = a[0]; s0[4 * i + 1] = a[1]; s0[4 * i + 2] = a[2]; s0[4 * i + 3] = a[3]; s1[4 * i] = b[0]; s1[4 * i + 1] = b[1]; s1[4 * i + 2] = b[2]; s1[4 * i + 3] = b[3]; }
            unsigned best[16];
#pragma unroll
            for (int g = 0; g < 4; ++g) {
                unsigned k[16];
#pragma unroll
                for (int j = 0; j < 16; ++j) {
                    constexpr int cnt[16] = {16, 8, 5, 4, 3, 2, 2, 2, 1, 1, 1, 1, 1, 1, 1, 1};
                    int idx = 16 * g + j, a = -1, b = 0;
#pragma unroll
                    for (int aa = 0; aa < 16; ++aa) { if (a < 0) { if (idx < cnt[aa]) { a = aa; b = idx; } else idx -= cnt[aa]; } }
                    if (a >= 0) k[j] = (ord_key(s0[a] + s1[b]) & ~255u) | (unsigned)(255 - (a * 16 + b)); else k[j] = 0u;
                }
                sort16_desc(k);
                if (g == 0) {
#pragma unroll
                    for (int i = 0; i < 16; ++i) best[i] = k[i];
                } else top16_merge(best, k);
            }
            float sc[16]; int ee[16]; float mx = -3e38f;
#pragma unroll
            for (int k = 0; k < 16; ++k) {
                const int f = 255 - (int)(best[k] & 255u), a = f >> 4, b = f & 15;
                sc[k] = ts[a] + ts[16 + b]; ee[k] = tix[a] * 128 + tix[16 + b];
                mx = fmaxf(mx, sc[k]);
            }
            float den = 0.f;
#pragma unroll
            for (int k = 0; k < 16; ++k) { sc[k] = __expf(sc[k] - mx); den += sc[k]; }
            const float rden = 1.0f / den;
#pragma unroll
            for (int k = 0; k < 16; ++k) {
                const int e = ee[k] & 16383, slot = ti_ * 128 + hh * 16 + k;
                ent_e[slot] = e; ent_g[slot] = sc[k] * rden; ent_su[slot] = SU[e]; ent_sv[slot] = SV[e];
            }
        }
        asm volatile("s_waitcnt lgkmcnt(0)" ::: "memory");
#pragma unroll 1
        for (int ti_ = 0; ti_ < 8; ++ti_) {
            const int tok = base + ti_;
            LAS const int* ee = ent_e + ti_ * 128; LAS float* eg = ent_g + ti_ * 128; LAS const float* esu = ent_su + ti_ * 128; LAS const float* esv = ent_sv + ti_ * 128;
            int xq[4]; float sx;
            {
                const u32x4 x0 = *(const u32x4*)(XB + (size_t)tok * DM + lane * 16), x1 = *(const u32x4*)(XB + (size_t)tok * DM + lane * 16 + 8);
                const unsigned xw[8] = {x0.x, x0.y, x0.z, x0.w, x1.x, x1.y, x1.z, x1.w};
                float xv[16]; float am = 0.f;
#pragma unroll
                for (int i = 0; i < 8; ++i) { xv[2 * i] = bf_lo(xw[i]); xv[2 * i + 1] = bf_hi(xw[i]); am = fmaxf(am, fmaxf(fabsf(xv[2 * i]), fabsf(xv[2 * i + 1]))); }
                am = wave_max(am);
                const float inv = am > 0.f ? 127.0f / am : 0.f; sx = am * (1.0f / 127.0f);
#pragma unroll
                for (int i = 0; i < 4; ++i) {
                    unsigned pk = 0u;
#pragma unroll
                    for (int e = 0; e < 4; ++e) { const int q = (int)__builtin_rintf(xv[4 * i + e] * inv); pk |= ((unsigned)q & 0xffu) << (8 * e); }
                    xq[i] = (int)pk;
                }
            }
#pragma unroll 1
            for (int e0 = 0; e0 < 128; e0 += 16) {
                u32x4 ur[16];
#pragma unroll
                for (int j = 0; j < 16; ++j) { const int ex = __builtin_amdgcn_readfirstlane(ee[e0 + j]); ur[j] = *(const u32x4*)(U8 + (size_t)ex * 1024 + lane * 16); }
                int p[16];
#pragma unroll
                for (int j = 0; j < 16; ++j) {
                    int a = __builtin_amdgcn_sdot4(xq[0], (int)ur[j].x, 0, false);
                    a = __builtin_amdgcn_sdot4(xq[1], (int)ur[j].y, a, false);
                    a = __builtin_amdgcn_sdot4(xq[2], (int)ur[j].z, a, false);
                    p[j] = __builtin_amdgcn_sdot4(xq[3], (int)ur[j].w, a, false);
                }
                const bool b5 = lane & 32, b4 = lane & 16, b3 = lane & 8, b2 = lane & 4;
                int q8[8], q4[4], q2[2], q1;
#pragma unroll
                for (int j = 0; j < 8; ++j) { const int send = b5 ? p[j] : p[j + 8], keep = b5 ? p[j + 8] : p[j]; q8[j] = keep + __shfl_xor(send, 32); }
#pragma unroll
                for (int j = 0; j < 4; ++j) { const int send = b4 ? q8[j] : q8[j + 4], keep = b4 ? q8[j + 4] : q8[j]; q4[j] = keep + __shfl_xor(send, 16); }
#pragma unroll
                for (int j = 0; j < 2; ++j) { const int send = b3 ? q4[j] : q4[j + 2], keep = b3 ? q4[j + 2] : q4[j]; q2[j] = keep + __shfl_xor(send, 8); }
                { const int send = b2 ? q2[0] : q2[1], keep = b2 ? q2[1] : q2[0]; q1 = keep + __shfl_xor(send, 4); }
                q1 += __shfl_xor(q1, 2); q1 += __shfl_xor(q1, 1);
                if ((lane & 3) == 0) {
                    const int jx = e0 + (lane >> 2);
                    const float dot = esu[jx] * sx * (float)q1;
                    eg[jx] = eg[jx] * gelu_erf(dot) * esv[jx];
                }
            }
            asm volatile("s_waitcnt lgkmcnt(0)" ::: "memory");
            float y[16]; float sw = 0.f;
#pragma unroll
            for (int i = 0; i < 16; ++i) y[i] = 0.f;
#pragma unroll 1
            for (int e0 = 0; e0 < 128; e0 += 16) {
                u32x4 vr[16];
#pragma unroll
                for (int j = 0; j < 16; ++j) { const int ex = __builtin_amdgcn_readfirstlane(ee[e0 + j]); vr[j] = *(const u32x4*)(V8 + (size_t)ex * 1024 + lane * 16); }
#pragma unroll
                for (int j = 0; j < 16; ++j) {
                    const float w = eg[e0 + j]; sw += w;
                    const unsigned vw[4] = {vr[j].x, vr[j].y, vr[j].z, vr[j].w};
#pragma unroll
                    for (int i = 0; i < 4; ++i) {
                        y[4 * i + 0] += w * (float)(vw[i] & 0xffu); y[4 * i + 1] += w * (float)((vw[i] >> 8) & 0xffu);
                        y[4 * i + 2] += w * (float)((vw[i] >> 16) & 0xffu); y[4 * i + 3] += w * (float)(vw[i] >> 24);
                    }
                }
            }
            {
                const float* xr = XF + (size_t)tok * DM + lane * 16;
                const f32x4 a0 = *(const f32x4*)(xr), a1 = *(const f32x4*)(xr + 4), a2 = *(const f32x4*)(xr + 8), a3 = *(const f32x4*)(xr + 12);
                const float xs[16] = {a0[0], a0[1], a0[2], a0[3], a1[0], a1[1], a1[2], a1[3], a2[0], a2[1], a2[2], a2[3], a3[0], a3[1], a3[2], a3[3]};
                float s = 0.f;
#pragma unroll
                for (int i = 0; i < 16; ++i) { y[i] = DN_ALPHA * xs[i] + (y[i] - 128.0f * sw); s += y[i]; }
                const float mean = wave_sum(s) * (1.0f / 1024.0f);
                float q = 0.f;
#pragma unroll
                for (int i = 0; i < 16; ++i) { const float d = y[i] - mean; q += d * d; }
                const float rstd = rsqrtf(wave_sum(q) * (1.0f / 1024.0f) + LN_EPS);
                float o[16];
#pragma unroll
                for (int i = 0; i < 4; ++i) {
                    const f32x4 gg = *(const f32x4*)(ln_g + lane * 16 + 4 * i), bb = *(const f32x4*)(ln_b + lane * 16 + 4 * i);
#pragma unroll
                    for (int e = 0; e < 4; ++e) o[4 * i + e] = (y[4 * i + e] - mean) * rstd * gg[e] + bb[e];
                }
                if (store) {
                    float* of = outf + (size_t)tok * DM + lane * 16;
#pragma unroll
                    for (int i = 0; i < 4; ++i) { f32x4 w; w[0] = o[4 * i]; w[1] = o[4 * i + 1]; w[2] = o[4 * i + 2]; w[3] = o[4 * i + 3]; *(f32x4*)(of + 4 * i) = w; }
                    if (outb) {
                        u32x4 pb; pb.x = pk_bf16(o[0], o[1]); pb.y = pk_bf16(o[2], o[3]); pb.z = pk_bf16(o[4], o[5]); pb.w = pk_bf16(o[6], o[7]);
                        *(u32x4*)(outb + (size_t)tok * DM + lane * 16) = pb;
                        pb.x = pk_bf16(o[8], o[9]); pb.y = pk_bf16(o[10], o[11]); pb.z = pk_bf16(o[12], o[13]); pb.w = pk_bf16(o[14], o[15]);
                        *(u32x4*)(outb + (size_t)tok * DM + lane * 16 + 8) = pb;
                    }
                }
            }
        }
        asm volatile("s_waitcnt lgkmcnt(0)" ::: "memory");
    }
}

__device__ __forceinline__ void quant_rows(const Ctx& c, const float* src, unsigned char* dst, float* scale, int R, int bias) {
    const int gw = c.blk * 8 + c.wave, nw = c.nblk * 8;
    for (int row = gw; row < R; row += nw) {
        const f32x4* p = (const f32x4*)(src + (size_t)row * 1024 + c.lane * 16);
        f32x4 v[4]; float am = 0.f;
#pragma unroll
        for (int i = 0; i < 4; ++i) { v[i] = p[i]; am = fmaxf(am, fmaxf(fmaxf(fabsf(v[i][0]), fabsf(v[i][1])), fmaxf(fabsf(v[i][2]), fabsf(v[i][3])))); }
        am = wave_max(am);
        const float inv = am > 0.f ? 127.0f / am : 0.f;
        unsigned w[4];
#pragma unroll
        for (int i = 0; i < 4; ++i) {
            unsigned pk = 0u;
#pragma unroll
            for (int e = 0; e < 4; ++e) { const int q = (int)__builtin_rintf(v[i][e] * inv) + bias; pk |= ((unsigned)q & 0xffu) << (8 * e); }
            w[i] = pk;
        }
        u32x4 o; o.x = w[0]; o.y = w[1]; o.z = w[2]; o.w = w[3];
        *(u32x4*)(dst + (size_t)row * 1024 + c.lane * 16) = o;
        if (c.lane == 0) scale[row] = am > 0.f ? am * (1.0f / 127.0f) : 1.0f;
    }
}

__device__ __forceinline__ void phase_prologue(const Ctx& c, const Args& a, bf16_t* WIN, bf16_t* WG, bf16_t* WB, bf16_t* WO, bf16_t* WQ, bf16_t* KEYS, bf16_t* UB, bf16_t* VB, float* HF, bf16_t* HB) {
#pragma unroll 1
    for (int l = 0; l < 2; ++l) {
        transpose_cvt(c, a.in[3] + (size_t)l * 1024 * W_IN_LD, W_IN_LD, 1024, 0, 3228, NY, 1, WIN + (size_t)l * NY * 1024, 1024);
        transpose_cvt(c, a.in[3] + (size_t)l * 1024 * W_IN_LD, W_IN_LD, 1024, W_MG, 4096, 4096, 0, WG + (size_t)l * 4096 * 1024, 1024);
#pragma unroll 1
        for (int nb = 0; nb < 4; ++nb)
            transpose_cvt(c, a.in[12] + (size_t)(l * 4 + nb) * 256 * 1024, 1024, 256, 0, 1024, 1024, 0, WB + (size_t)(l * 4 + nb) * 1024 * 256, 256);
        transpose_cvt(c, a.in[13] + (size_t)l * 1024 * 1024, 1024, 1024, 0, 1024, 1024, 0, WO + (size_t)l * 1024 * 1024, 1024);
        transpose_cvt(c, a.in[16] + (size_t)l * 1024 * 2048, 2048, 1024, 0, 2048, 2048, 0, WQ + (size_t)l * 2048 * 1024, 1024);
    }
    convert_flat(c, a.in[17], KEYS, (size_t)2 * 16 * 128 * 128);
    quant_rows(c, a.in[18], (unsigned char*)UB, (float*)((unsigned char*)UB + 32 * MB), 2 * 16384, 0);
    quant_rows(c, a.in[19], (unsigned char*)VB, (float*)((unsigned char*)VB + 32 * MB), 2 * 16384, 128);
    ln_rows(c, a.in[0], a.in[1], a.in[2], HF, HB);
}

constexpr int PH_PER_LAYER = 10, N_PHASES = 1 + 2 * PH_PER_LAYER;

__global__ void __launch_bounds__(NTHREADS, 2) mk_fwd(Args a) {
    extern __shared__ __attribute__((aligned(16))) unsigned char lds_raw[];
    Ctx c0;
    c0.lds = (lptr)lds_raw; c0.tid = threadIdx.x; c0.lane = c0.tid & 63; c0.wave = __builtin_amdgcn_readfirstlane(c0.tid >> 6);
    c0.nblk = gridDim.x; c0.blk = blockIdx.x; c0.ws = a.ws;
    volatile LAS unsigned* st = (volatile LAS unsigned*)(c0.lds + LDS_BYTES - 16);
    if (c0.tid == 0) { st[0] = 0u; st[1] = 0u; st[2] = 0u; st[3] = 0u; }
    __syncthreads();
    const int lo = a.ph_lo, hi = a.ph_hi;
    XcdBarrier bar; bar.bar = (unsigned*)(a.ws + WS_CTL); bar.x = 0; bar.st = st;
    if (hi - lo > 1) bar = xcd_barrier_post((unsigned*)(a.ws + WS_CTL), st);
#define IN(k) (lo <= (k) && (k) < hi)
#ifndef ONLY_PHASE
#define ONLY_PHASE -1
#endif
#define EN(j) (ONLY_PHASE < 0 || ONLY_PHASE == (j))
#define SEAM(k) do { if (IN(k) && IN((k) + 1)) xcd_barrier(bar); } while (0)
#define FRESH() Ctx c = c0; asm volatile("" : "+v"(c.tid)); c.lane = c.tid & 63; asm volatile("" : "+s"(c.wave), "+s"(c.blk), "+s"(c.nblk))

    unsigned char* ws = a.ws;
    float* HF = (float*)(ws + WS_HF); bf16_t* HB = (bf16_t*)(ws + WS_HB); bf16_t* Y = (bf16_t*)(ws + WS_Y); float* Z = (float*)(ws + WS_Z);
    float* TOPS = (float*)(ws + WS_TOPS); int* TOPI = (int*)(ws + WS_TOPI); bf16_t* O = (bf16_t*)(ws + WS_O); bf16_t* MIX = (bf16_t*)(ws + WS_MIX);
    bf16_t* QV = (bf16_t*)(ws + WS_QV); float* UST = (float*)(ws + WS_UST); float* RST = (float*)(ws + WS_RST); float* UGLA = (float*)(ws + WS_UGLA);
    float* SGLA = (float*)(ws + WS_SGLA); float* BL = (float*)(ws + WS_BL); bf16_t* KC = (bf16_t*)(ws + WS_KC); bf16_t* VC = (bf16_t*)(ws + WS_VC);
    bf16_t* WIN = (bf16_t*)(ws + WS_WIN); bf16_t* WG = (bf16_t*)(ws + WS_WG); bf16_t* WB = (bf16_t*)(ws + WS_WB); bf16_t* WO = (bf16_t*)(ws + WS_WO);
    bf16_t* WQ = (bf16_t*)(ws + WS_WQ); bf16_t* KEYS = (bf16_t*)(ws + WS_KEYS); bf16_t* UB = (bf16_t*)(ws + WS_UB); bf16_t* VB = (bf16_t*)(ws + WS_VB);

#ifndef REP_MASK
#define REP_MASK 0
#endif
#define NREP(j) (((REP_MASK >> (j)) & 1) ? 2 : 1)
#define RUN(j, k, body) do { if (IN(k) && EN(j)) { _Pragma("unroll 1") for (int rr = 0; rr < NREP(j); ++rr) { if (rr) xcd_barrier(bar); FRESH(); body; } } } while (0)
    RUN(10, 0, phase_prologue(c, a, WIN, WG, WB, WO, WQ, KEYS, UB, VB, HF, HB));
    SEAM(0);
#ifndef SUB1
#define SUB1 15
#endif
#ifndef SUB
#define SUB 7
#endif
#pragma unroll 1
    for (int l = 0; l < 2; ++l) {
        const int pb = 1 + l * PH_PER_LAYER;
        RUN(0, pb + 0, phase_inproj(c, HB, WIN + (size_t)l * NY * 1024, Y));
        SEAM(pb + 0);
        RUN(1, pb + 1, {
            if (SUB1 & 1) phase_sb2(c, Y, O);
#ifdef PROBE_SB
            phase_sb2(c, Y, O);
#endif
            if (SUB1 & 2) phase_compress(c, Y, a.in[4] + (size_t)l * 32 * 64, a.in[5] + (size_t)l * 2048 * 64, a.in[6] + (size_t)l * 2048 * 64, KC, VC);
            if (SUB1 & 4) phase_ret_local(c, Y, UST);
            if (SUB1 & 8) phase_gla_local(c, Y, a.in[9] + (size_t)l * 16 * 128, a.in[10] + (size_t)l * 128, UGLA, BL);
        });
        SEAM(pb + 1);
        RUN(2, pb + 2, phase_scans(c, UST, RST, UGLA, SGLA, BL));
        SEAM(pb + 2);
        RUN(3, pb + 3, {
            if (SUB & 1) phase_nsa(c, Y, KC, VC, O);
#ifdef PROBE_NSA
            phase_nsa(c, Y, KC, VC, O);
#endif
            if (SUB & 2) phase_ret_out(c, Y, RST, a.in[7] + (size_t)l * 256, a.in[8] + (size_t)l * 256, O);
            if (SUB & 4) phase_gla_out(c, Y, a.in[9] + (size_t)l * 16 * 128, a.in[10] + (size_t)l * 128, SGLA, a.in[11] + (size_t)l * 256, O);
        });
        SEAM(pb + 3);
        RUN(4, pb + 4, phase_merge(c, HB, WG + (size_t)l * 4096 * 1024, O, WB + (size_t)l * 4 * 1024 * 256, MIX));
        SEAM(pb + 4);
        RUN(5, pb + 5, phase_outproj(c, MIX, WO + (size_t)l * 1024 * 1024, HF, Z));
        SEAM(pb + 5);
        RUN(6, pb + 6, ln_rows(c, Z, a.in[14] + (size_t)l * 1024, a.in[15] + (size_t)l * 1024, HF, HB));
        SEAM(pb + 6);
        RUN(7, pb + 7, phase_wq(c, HB, WQ + (size_t)l * 2048 * 1024, QV));
        SEAM(pb + 7);
        RUN(8, pb + 8, phase_subkey2(c, QV, KEYS + (size_t)l * 16 * 128 * 128, TOPS, TOPI));
        SEAM(pb + 8);
        RUN(9, pb + 9, phase_peer2(c, HF, HB, TOPS, TOPI, (const unsigned char*)UB + (size_t)l * 16384 * 1024, (const unsigned char*)VB + (size_t)l * 16384 * 1024,
                                   (const float*)(ws + WS_SU) + (size_t)l * 16384, (const float*)(ws + WS_SV) + (size_t)l * 16384,
                                   a.in[20] + (size_t)l * 1024, a.in[21] + (size_t)l * 1024, (l == 1) ? a.out : HF, (l == 1) ? (bf16_t*)nullptr : HB,
                                   (rr == NREP(9) - 1) || (lo > 1000)));
        SEAM(pb + 9);
    }
#undef RUN
#undef IN
#undef SEAM
#undef FRESH
}


#ifndef DBG_DUMP
#define DBG_DUMP 0
#endif
#ifndef DBG_C0
#define DBG_C0 0
#endif
#ifndef DBG_C1
#define DBG_C1 1024
#endif
__global__ void dbg_dump(const unsigned char* ws, float* out, int sel) {
    const size_t n = (size_t)NTOK * DM;
    for (size_t i = (size_t)blockIdx.x * blockDim.x + threadIdx.x; i < n; i += (size_t)gridDim.x * blockDim.x) {
        const int col = (int)(i & 1023);
        float v = 0.f;
        if (col >= DBG_C0 && col < DBG_C1) {
            if (sel == 1) v = bf2f(((const bf16_t*)(ws + WS_O))[i]);
            else if (sel == 2) v = ((const float*)(ws + WS_HF))[i];
            else if (sel == 3) v = bf2f(((const bf16_t*)(ws + WS_Y))[(i >> 10) * NY + col]);
            else if (sel == 4) v = bf2f(((const bf16_t*)(ws + WS_Y))[(i >> 10) * NY + 1024 + col]);
            else if (sel == 5) v = bf2f(((const bf16_t*)(ws + WS_Y))[(i >> 10) * NY + 2048 + col]);
            else if (sel == 6) v = bf2f(((const bf16_t*)(ws + WS_MIX))[i]);
            else if (sel == 7) v = ((const float*)(ws + WS_Z))[i];
        }
        out[i] = v;
    }
}

extern "C" void kernel_launch(void* const* d_in, const int* in_sizes, int n_in, void* d_out, int out_size, void* d_ws, size_t ws_size, hipStream_t stream) {
    static int grid = 0;
    if (grid == 0) {
        if (n_in != 22 || out_size != NTOK * DM || ws_size < WS_END) { fprintf(stderr, "kernel_launch: unexpected shapes (n_in %d out %d ws %zu need %zu)\n", n_in, out_size, ws_size, (size_t)WS_END); grid = -1; return; }
        int dev = 0, cus = 0, per_cu = 0;
        if (hipGetDevice(&dev) != hipSuccess || hipDeviceGetAttribute(&cus, hipDeviceAttributeMultiprocessorCount, dev) != hipSuccess) { grid = -1; return; }
        if (hipFuncSetAttribute((const void*)mk_fwd, hipFuncAttributeMaxDynamicSharedMemorySize, LDS_BYTES) != hipSuccess) { fprintf(stderr, "kernel_launch: hipFuncSetAttribute failed\n"); grid = -1; return; }
        if (hipOccupancyMaxActiveBlocksPerMultiprocessor(&per_cu, (const void*)mk_fwd, NTHREADS, LDS_BYTES) != hipSuccess || per_cu < 1) { fprintf(stderr, "kernel_launch: occupancy query says %d\n", per_cu); }
        (void)hipGetLastError();
        grid = cus;
    }
    if (grid < 0) return;
    (void)hipMemsetAsync((char*)d_ws + WS_CTL, 0, XCD_BAR_WORDS * sizeof(unsigned), stream);
    Args a{};
    for (int i = 0; i < 22; ++i) a.in[i] = (const float*)d_in[i];
    a.out = (float*)d_out; a.ws = (unsigned char*)d_ws;
#if ONE_LAUNCH
    a.ph_lo = 0; a.ph_hi = N_PHASES;
    hipLaunchKernelGGL(mk_fwd, dim3(grid), dim3(NTHREADS), LDS_BYTES, stream, a);
#else
#ifndef DBG_PH_HI
#define DBG_PH_HI N_PHASES
#endif
#ifndef DBG_PH_LO
#define DBG_PH_LO 0
#endif
    for (int p = DBG_PH_LO; p < DBG_PH_HI; ++p) {
        a.ph_lo = p; a.ph_hi = p + 1;
        hipLaunchKernelGGL(mk_fwd, dim3(grid), dim3(NTHREADS), LDS_BYTES, stream, a);
    }
    if (DBG_DUMP) hipLaunchKernelGGL(dbg_dump, dim3(1024), dim3(256), 0, stream, (const unsigned char*)d_ws, (float*)d_out, (int)DBG_DUMP);
#endif
}
```

```cpp
#include <hip/hip_runtime.h>
#include <stdint.h>
#include <stdio.h>

#ifndef ONE_LAUNCH
#define ONE_LAUNCH 1
#endif

#define LAS __attribute__((address_space(3)))
typedef unsigned short bf16_t;
typedef short bf16x8 __attribute__((ext_vector_type(8)));
typedef float f32x4 __attribute__((ext_vector_type(4)));
typedef float f32x16 __attribute__((ext_vector_type(16)));
typedef unsigned u32x4 __attribute__((ext_vector_type(4)));
typedef unsigned u32x2 __attribute__((ext_vector_type(2)));
typedef __bf16 bf2_t __attribute__((ext_vector_type(2)));
typedef LAS unsigned char* lptr;

constexpr int NTOK = 16384, SEQ = 8192, DM = 1024, NB = 2;
constexpr int NY = 3328;
constexpr int W_IN_LD = 7324;
constexpr int C_SBQ = 0, C_SBK = 256, C_SBV = 512, C_NQ = 768, C_NKC = 1024, C_NVC = 1088, C_NKS = 1152, C_NVS = 1216, C_NKW = 1280, C_NVW = 1344;
constexpr int C_RQ = 1408, C_RK = 1664, C_RV = 1920, C_RG = 2176, C_GQ = 2432, C_GK = 2560, C_GV = 2688, C_GR = 2944, C_NG = 3200, C_GLR = 3216;
constexpr int W_MG = 3228;
constexpr float NEGF = -1e30f;
constexpr float LN_EPS = 1e-5f;
constexpr float DN_ALPHA = 1.41421356237f;

constexpr int NTHREADS = 512;
constexpr int LDS_BYTES = 147456;

constexpr size_t MB = 1024 * 1024;
constexpr size_t WS_CTL   = 0;
constexpr size_t WS_HF    = 1 * MB;
constexpr size_t WS_HB    = WS_HF + 64 * MB;
constexpr size_t WS_Y     = WS_HB + 32 * MB;
constexpr size_t WS_Z     = WS_Y;
constexpr size_t WS_TOPS  = WS_Y + 64 * MB;
constexpr size_t WS_TOPI  = WS_TOPS + 16 * MB;
constexpr size_t WS_O     = WS_Y + 104 * MB;
constexpr size_t WS_MIX   = WS_O + 32 * MB;
constexpr size_t WS_QV    = WS_O;
constexpr size_t WS_UST   = WS_MIX + 32 * MB;
constexpr size_t WS_RST   = WS_UST + 8 * MB;
constexpr size_t WS_UGLA  = WS_RST + 8 * MB;
constexpr size_t WS_SGLA  = WS_UGLA + 8 * MB;
constexpr size_t WS_BL    = WS_SGLA + 8 * MB;
constexpr size_t WS_KC    = WS_BL + 1 * MB;
constexpr size_t WS_VC    = WS_KC + 1 * MB;
constexpr size_t WS_WIN   = WS_VC + 1 * MB;
constexpr size_t WS_WG    = WS_WIN + 14 * MB;
constexpr size_t WS_WB    = WS_WG + 16 * MB;
constexpr size_t WS_WO    = WS_WB + 4 * MB;
constexpr size_t WS_WQ    = WS_WO + 4 * MB;
constexpr size_t WS_KEYS  = WS_WQ + 8 * MB;
constexpr size_t WS_UB    = WS_KEYS + 1 * MB;
constexpr size_t WS_VB    = WS_UB + 64 * MB;
constexpr size_t WS_SU    = WS_UB + 32 * MB;
constexpr size_t WS_SV    = WS_VB + 32 * MB;
constexpr size_t WS_WC    = WS_VB + 64 * MB;
constexpr size_t WS_RC    = WS_WC + 1 * MB;
constexpr size_t WS_CB    = WS_RC + 1 * MB;
constexpr size_t WS_END   = WS_CB + 1 * MB;

typedef float f32x2_t __attribute__((ext_vector_type(2)));
__device__ __forceinline__ unsigned pk_bf16(float lo, float hi) { f32x2_t v = {lo, hi}; bf2_t b = __builtin_convertvector(v, bf2_t); return __builtin_bit_cast(unsigned, b); }
__device__ __forceinline__ float bf_lo(unsigned u) { return __uint_as_float(u << 16); }
__device__ __forceinline__ float bf_hi(unsigned u) { return __uint_as_float(u & 0xffff0000u); }
__device__ __forceinline__ bf16_t f2bf(float f) { return (bf16_t)(pk_bf16(f, f) & 0xffffu); }
__device__ __forceinline__ float bf2f(bf16_t b) { return __uint_as_float(((unsigned)b) << 16); }
__device__ __forceinline__ float wave_sum(float v) {
#pragma unroll
    for (int o = 32; o; o >>= 1) v += __shfl_xor(v, o);
    return v;
}
__device__ __forceinline__ float wave_max(float v) {
#pragma unroll
    for (int o = 32; o; o >>= 1) v = fmaxf(v, __shfl_xor(v, o));
    return v;
}
__device__ __forceinline__ float sigmoidf_(float x) { return 1.0f / (1.0f + __expf(-x)); }
__device__ __forceinline__ float softplusf_(float x) { return fmaxf(x, 0.f) + __logf(1.0f + __expf(-fabsf(x))); }
__device__ __forceinline__ float siluf_(float x) { return x * sigmoidf_(x); }
__device__ __forceinline__ float dot2bf(unsigned a, unsigned b, float c) {
    return __builtin_amdgcn_fdot2_f32_bf16(__builtin_bit_cast(bf2_t, a), __builtin_bit_cast(bf2_t, b), c, false);
}

#define XB_TMO      128
#define XB_XCNT(j)  (256  + 64 * (j))
#define XB_XSUB(j)  (1280 + 64 * (j))
#define XB_XGEN(j)  (2304 + 64 * (j))
#define XB_TOP      3328
#define XB_TOPGEN   3392
#define XCD_BAR_WORDS 3456
#define XB_SPIN_CAP (1u << 22)

__device__ __forceinline__ unsigned xb_ld(unsigned* p)              { return __hip_atomic_load(p, __ATOMIC_RELAXED, __HIP_MEMORY_SCOPE_AGENT); }
__device__ __forceinline__ unsigned xb_add(unsigned* p, unsigned v) { return __hip_atomic_fetch_add(p, v, __ATOMIC_RELAXED, __HIP_MEMORY_SCOPE_AGENT); }
__device__ __forceinline__ unsigned xb_xcc_id() { return (unsigned)__builtin_amdgcn_s_getreg((3 << 11) | 20) & 0xFu; }
#define XB_SPIN(cond, bar) do { unsigned _sp = 0; while (cond) { __builtin_amdgcn_s_sleep(1); \
    if ((++_sp & 255u) == 0u) { if (xb_ld(&(bar)[XB_TMO])) break; if (_sp > XB_SPIN_CAP) { atomicAdd(&(bar)[XB_TMO], 1u); break; } } } } while (0)

struct XcdBarrier { unsigned* bar; unsigned x; volatile LAS unsigned* st; };

__device__ __forceinline__ XcdBarrier xcd_barrier_post(unsigned* bar, volatile LAS unsigned* st) {
    XcdBarrier b; b.bar = bar; b.x = xb_xcc_id(); b.st = st;
    if (threadIdx.x == 0) (void)xb_add(&bar[XB_XCNT(b.x)], 1u);
    return b;
}
__device__ __forceinline__ void xcd_barrier_complete(unsigned* bar, unsigned x, unsigned& nloc, unsigned& nx) {
    const unsigned G = gridDim.x * gridDim.y * gridDim.z;
    unsigned sum, cnt, mine, sp = 0u;
    for (;;) {
        sum = 0u; cnt = 0u; mine = 0u;
#pragma unroll
        for (unsigned j = 0; j < 16; ++j) { const unsigned c = xb_ld(&bar[XB_XCNT(j)]); sum += c; cnt += (c > 0u) ? 1u : 0u; mine = (j == x) ? c : mine; }
        if (sum == G) break;
        __builtin_amdgcn_s_sleep(1);
        if ((++sp & 255u) == 0u) { if (xb_ld(&bar[XB_TMO])) break; if (sp > XB_SPIN_CAP) { atomicAdd(&bar[XB_TMO], 1u); break; } }
    }
    nloc = mine > 0u ? mine : 1u; nx = cnt > 0u ? cnt : 1u;
}
__device__ __forceinline__ void xcd_barrier(const XcdBarrier& b) {
    asm volatile("s_waitcnt vmcnt(0)" ::: "memory");
    __syncthreads();
    if (threadIdx.x == 0) {
        unsigned* bar = b.bar;
        __builtin_amdgcn_s_waitcnt(0);
        unsigned nloc = b.st[0], nx = b.st[1];
        if (nloc == 0u) { xcd_barrier_complete(bar, b.x, nloc, nx); b.st[0] = nloc; b.st[1] = nx; }
        const unsigned old = xb_add(&bar[XB_XSUB(b.x)], 1u);
        const unsigned gen = old / nloc;
        if (old + 1u == (gen + 1u) * nloc) {
            __builtin_amdgcn_fence(__ATOMIC_RELEASE, "agent");
            asm volatile("s_waitcnt vmcnt(0)" ::: "memory");
            const unsigned og = xb_add(&bar[XB_TOP], 1u);
            const unsigned tg = og / nx;
            if (og + 1u == (tg + 1u) * nx) xb_add(&bar[XB_TOPGEN], 1u);
            else XB_SPIN(xb_ld(&bar[XB_TOPGEN]) == tg, bar);
            __builtin_amdgcn_fence(__ATOMIC_ACQUIRE, "agent");
            xb_add(&bar[XB_XGEN(b.x)], 1u);
            asm volatile("s_waitcnt vmcnt(0)" ::: "memory");
        } else {
            XB_SPIN(xb_ld(&bar[XB_XGEN(b.x)]) == gen, bar);
            __builtin_amdgcn_fence(__ATOMIC_ACQUIRE, "agent");
            asm volatile("s_waitcnt vmcnt(0)" ::: "memory");
        }
    }
    __syncthreads();
}

struct Args { const float* in[22]; float* out; unsigned char* ws; int ph_lo, ph_hi; };
struct Ctx {
    lptr lds; int tid, lane, wave, nblk, blk;
    unsigned char* ws;
};

__device__ __forceinline__ void ln_rows(const Ctx& c, const float* src, const float* g, const float* b, float* outf, bf16_t* outb) {
    const int gw = c.blk * 8 + c.wave, nw = c.nblk * 8;
    for (int row = gw; row < NTOK; row += nw) {
        const f32x4* p = (const f32x4*)(src + (size_t)row * DM);
        f32x4 v[4]; float s = 0.f;
#pragma unroll
        for (int i = 0; i < 4; ++i) { v[i] = p[i * 64 + c.lane]; s += (v[i][0] + v[i][1]) + (v[i][2] + v[i][3]); }
        const float mean = wave_sum(s) * (1.0f / 1024.0f);
        float q = 0.f;
#pragma unroll
        for (int i = 0; i < 4; ++i) { const f32x4 d = v[i] - mean; q += (d[0] * d[0] + d[1] * d[1]) + (d[2] * d[2] + d[3] * d[3]); }
        const float rstd = rsqrtf(wave_sum(q) * (1.0f / 1024.0f) + LN_EPS);
#pragma unroll
        for (int i = 0; i < 4; ++i) {
            const int idx = i * 64 + c.lane;
            const f32x4 gg = ((const f32x4*)g)[idx], bb = ((const f32x4*)b)[idx];
            const f32x4 y = (v[i] - mean) * rstd * gg + bb;
            if (outf) ((f32x4*)(outf + (size_t)row * DM))[idx] = y;
            if (outb) { u32x2 w; w.x = pk_bf16(y[0], y[1]); w.y = pk_bf16(y[2], y[3]); ((u32x2*)(outb + (size_t)row * DM))[idx] = w; }
        }
    }
}

__device__ __forceinline__ int ycol_to_wcol(int j) {
    if (j < 1408) return j;
    if (j < 3200) return j + 12;
    if (j < 3212) return 1408 + (j - 3200);
    if (j < 3216) return -1;
    if (j < 3232) return 3212 + (j - 3216);
    return -1;
}
__device__ __forceinline__ void transpose_cvt(const Ctx& c, const float* src, int ld_src, int R, int c_off, int C, int Cpad, int mode, bf16_t* dst, int ld_dst) {
    LAS float* buf = (LAS float*)c.lds;
    const int nRt = R / 64, nCt = Cpad / 64;
    for (int tile = c.blk; tile < nRt * nCt; tile += c.nblk) {
        const int rt = tile % nRt, ct = tile / nRt;
        const int r0 = rt * 64, c0 = ct * 64;
        {
            const int row = c.tid >> 3, cc = (c.tid & 7) * 8;
            const float* sp = src + (size_t)(r0 + row) * ld_src;
            float v[8];
            bool fast = false; int sc0 = 0;
            if (mode == 0) { fast = (c0 + 64 <= C); sc0 = c_off + c0 + cc; }
            else { if (c0 + 64 <= 1408) { fast = true; sc0 = c0 + cc; } else if (c0 >= 1408 && c0 + 64 <= 3200) { fast = true; sc0 = c0 + cc + 12; } }
            if (fast) {
                const f32x4 a = *(const f32x4*)(sp + sc0), b = *(const f32x4*)(sp + sc0 + 4);
                v[0] = a[0]; v[1] = a[1]; v[2] = a[2]; v[3] = a[3]; v[4] = b[0]; v[5] = b[1]; v[6] = b[2]; v[7] = b[3];
            } else {
#pragma unroll
                for (int i = 0; i < 8; ++i) {
                    const int n = c0 + cc + i; int sc;
                    if (mode == 0) sc = (n < C) ? c_off + n : -1; else sc = ycol_to_wcol(n);
                    v[i] = (sc >= 0) ? sp[sc] : 0.f;
                }
            }
#pragma unroll
            for (int i = 0; i < 8; ++i) buf[row * 65 + cc + i] = v[i];
        }
        __syncthreads();
        {
            const int n = c.tid >> 3, kc = (c.tid & 7) * 8;
            float v[8];
#pragma unroll
            for (int i = 0; i < 8; ++i) v[i] = buf[(kc + i) * 65 + n];
            u32x4 w; w.x = pk_bf16(v[0], v[1]); w.y = pk_bf16(v[2], v[3]); w.z = pk_bf16(v[4], v[5]); w.w = pk_bf16(v[6], v[7]);
            *(u32x4*)(dst + (size_t)(c0 + n) * ld_dst + r0 + kc) = w;
        }
        __syncthreads();
    }
}
__device__ __forceinline__ void convert_flat(const Ctx& c, const float* src, bf16_t* dst, size_t n) {
    const size_t stride = (size_t)c.nblk * NTHREADS;
    for (size_t i = (size_t)c.blk * NTHREADS + c.tid; i < n / 8; i += stride) {
        const f32x4 a = ((const f32x4*)src)[2 * i], b = ((const f32x4*)src)[2 * i + 1];
        u32x4 w; w.x = pk_bf16(a[0], a[1]); w.y = pk_bf16(a[2], a[3]); w.z = pk_bf16(b[0], b[1]); w.w = pk_bf16(b[2], b[3]);
        ((u32x4*)dst)[i] = w;
    }
}

template <int WM, int WN>
__device__ __forceinline__ void gemm_kloop(const Ctx& c, f32x16 (&acc)[WM][WN], const bf16_t* A, int lda, const bf16_t* Bt, int ldb, int K, int kstepA = 64) {
    constexpr int BMt = 128 * WM, BNt = 64 * WN, STAGE = (BMt + BNt) * 144;
    constexpr int NA = BMt * 8 / NTHREADS, NBc = BNt * 8 / NTHREADS;
    static_assert(NBc >= 1, "tile too small");
    const lptr lds = c.lds;
    const int wm = c.wave >> 1, wn = c.wave & 1, r = c.lane & 31, h = c.lane >> 5;
    u32x4 ra[NA], rb[NBc];
    const int nk = K / 64;
#pragma unroll
    for (int i = 0; i < NA; ++i) { const int id = c.tid + i * NTHREADS; ra[i] = *(const u32x4*)(A + (size_t)(id >> 3) * lda + (id & 7) * 8); }
#pragma unroll
    for (int i = 0; i < NBc; ++i) { const int id = c.tid + i * NTHREADS; rb[i] = *(const u32x4*)(Bt + (size_t)(id >> 3) * ldb + (id & 7) * 8); }
#pragma unroll
    for (int i = 0; i < NA; ++i) { const int id = c.tid + i * NTHREADS; *(LAS u32x4*)(lds + (id >> 3) * 144 + (id & 7) * 16) = ra[i]; }
#pragma unroll
    for (int i = 0; i < NBc; ++i) { const int id = c.tid + i * NTHREADS; *(LAS u32x4*)(lds + BMt * 144 + (id >> 3) * 144 + (id & 7) * 16) = rb[i]; }
    __syncthreads();
    for (int kt = 0; kt < nk; ++kt) {
        const lptr cur = lds + (kt & 1) * STAGE, nxt = lds + ((kt + 1) & 1) * STAGE;
        const bool more = (kt + 1 < nk);
        if (more) {
            const int k0 = (kt + 1) * 64; const size_t k0a = (size_t)(kt + 1) * kstepA;
#pragma unroll
            for (int i = 0; i < NA; ++i) { const int id = c.tid + i * NTHREADS; ra[i] = *(const u32x4*)(A + (size_t)(id >> 3) * lda + k0a + (id & 7) * 8); }
#pragma unroll
            for (int i = 0; i < NBc; ++i) { const int id = c.tid + i * NTHREADS; rb[i] = *(const u32x4*)(Bt + (size_t)(id >> 3) * ldb + k0 + (id & 7) * 8); }
        }
        const lptr pa = cur + (wm * WM * 32 + r) * 144 + h * 16;
        const lptr pb = cur + BMt * 144 + (wn * WN * 32 + r) * 144 + h * 16;
#pragma unroll
        for (int s = 0; s < 4; ++s) {
            bf16x8 fa[WM], fb[WN];
#pragma unroll
            for (int i = 0; i < WM; ++i) fa[i] = *(LAS const bf16x8*)(pa + i * 32 * 144 + s * 32);
#pragma unroll
            for (int j = 0; j < WN; ++j) fb[j] = *(LAS const bf16x8*)(pb + j * 32 * 144 + s * 32);
#pragma unroll
            for (int i = 0; i < WM; ++i)
#pragma unroll
                for (int j = 0; j < WN; ++j) acc[i][j] = __builtin_amdgcn_mfma_f32_32x32x16_bf16(fb[j], fa[i], acc[i][j], 0, 0, 0);
        }
        if (more) {
#pragma unroll
            for (int i = 0; i < NA; ++i) { const int id = c.tid + i * NTHREADS; *(LAS u32x4*)(nxt + (id >> 3) * 144 + (id & 7) * 16) = ra[i]; }
#pragma unroll
            for (int i = 0; i < NBc; ++i) { const int id = c.tid + i * NTHREADS; *(LAS u32x4*)(nxt + BMt * 144 + (id >> 3) * 144 + (id & 7) * 16) = rb[i]; }
        }
        __syncthreads();
    }
}
template <int WM, int WN>
__device__ __forceinline__ void acc_zero(f32x16 (&acc)[WM][WN]) {
#pragma unroll
    for (int i = 0; i < WM; ++i)
#pragma unroll
        for (int j = 0; j < WN; ++j)
#pragma unroll
            for (int e = 0; e < 16; ++e) acc[i][j][e] = 0.f;
}

#define EPI_LOOP(WM_, WN_)                                                                  \
    _Pragma("unroll") for (int i = 0; i < WM_; ++i)                                         \
    _Pragma("unroll") for (int j = 0; j < WN_; ++j)                                         \
    _Pragma("unroll") for (int g = 0; g < 4; ++g)

__device__ __forceinline__ void phase_inproj(const Ctx& c, const bf16_t* hb, const bf16_t* Wt, bf16_t* Y) {
    constexpr int NTN = NY / 128;
    const int wm = c.wave >> 1, wn = c.wave & 1, r = c.lane & 31, h = c.lane >> 5;
    for (int u = c.blk; u < 64 * NTN; u += c.nblk) {
        const int pm = u / NTN, pn = u % NTN;
        f32x16 acc[2][2]; acc_zero<2, 2>(acc);
        gemm_kloop<2, 2>(c, acc, hb + (size_t)pm * 256 * DM, DM, Wt + (size_t)pn * 128 * DM, DM, DM);
        EPI_LOOP(2, 2) {
            const int m = pm * 256 + (wm * 2 + i) * 32 + r, n = pn * 128 + (wn * 2 + j) * 32 + 8 * g + 4 * h;
            u32x2 w; w.x = pk_bf16(acc[i][j][4 * g], acc[i][j][4 * g + 1]); w.y = pk_bf16(acc[i][j][4 * g + 2], acc[i][j][4 * g + 3]);
            *(u32x2*)(Y + (size_t)m * NY + n) = w;
        }
    }
}
__device__ __forceinline__ void phase_merge(const Ctx& c, const bf16_t* hb, const bf16_t* Wg, const bf16_t* O, const bf16_t* Wb, bf16_t* MIX) {
    const int wm = c.wave >> 1, wn = c.wave & 1, r = c.lane & 31, h = c.lane >> 5;
    for (int u = c.blk; u < 128 * 8; u += c.nblk) {
        const int pm = u >> 3, pn = u & 7;
        f32x16 mix[1][2]; acc_zero<1, 2>(mix);
#pragma unroll 1
        for (int nb = 0; nb < 4; ++nb) {
            f32x16 ag[1][2]; acc_zero<1, 2>(ag);
            gemm_kloop<1, 2>(c, ag, hb + (size_t)pm * 128 * DM, DM, Wg + ((size_t)nb * 1024 + pn * 128) * DM, DM, DM);
            f32x16 ap[1][2]; acc_zero<1, 2>(ap);
            gemm_kloop<1, 2>(c, ap, O + (size_t)pm * 128 * DM + nb * 256, DM, Wb + ((size_t)nb * 1024 + pn * 128) * 256, 256, 256);
#pragma unroll
            for (int j = 0; j < 2; ++j)
#pragma unroll
                for (int e = 0; e < 16; ++e) mix[0][j][e] += sigmoidf_(ag[0][j][e]) * ap[0][j][e];
        }
        EPI_LOOP(1, 2) {
            const int m = pm * 128 + (wm + i) * 32 + r, n = pn * 128 + (wn * 2 + j) * 32 + 8 * g + 4 * h;
            u32x2 w; w.x = pk_bf16(mix[i][j][4 * g], mix[i][j][4 * g + 1]); w.y = pk_bf16(mix[i][j][4 * g + 2], mix[i][j][4 * g + 3]);
            *(u32x2*)(MIX + (size_t)m * DM + n) = w;
        }
    }
}
__device__ __forceinline__ void phase_outproj(const Ctx& c, const bf16_t* MIX, const bf16_t* Wo, const float* hf, float* Z) {
    const int wm = c.wave >> 1, wn = c.wave & 1, r = c.lane & 31, h = c.lane >> 5;
    for (int u = c.blk; u < 64 * 8; u += c.nblk) {
        const int pm = u >> 3, pn = u & 7;
        f32x16 acc[2][2]; acc_zero<2, 2>(acc);
        gemm_kloop<2, 2>(c, acc, MIX + (size_t)pm * 256 * DM, DM, Wo + (size_t)pn * 128 * DM, DM, DM);
        EPI_LOOP(2, 2) {
            const int m = pm * 256 + (wm * 2 + i) * 32 + r, n = pn * 128 + (wn * 2 + j) * 32 + 8 * g + 4 * h;
            const f32x4 x = *(const f32x4*)(hf + (size_t)m * DM + n);
            f32x4 y; y[0] = DN_ALPHA * x[0] + acc[i][j][4 * g]; y[1] = DN_ALPHA * x[1] + acc[i][j][4 * g + 1]; y[2] = DN_ALPHA * x[2] + acc[i][j][4 * g + 2]; y[3] = DN_ALPHA * x[3] + acc[i][j][4 * g + 3];
            *(f32x4*)(Z + (size_t)m * DM + n) = y;
        }
    }
}
__device__ __forceinline__ void phase_wq(const Ctx& c, const bf16_t* hb, const bf16_t* Wq, bf16_t* QV) {
    const int wm = c.wave >> 1, wn = c.wave & 1, r = c.lane & 31, h = c.lane >> 5;
    for (int u = c.blk; u < 64 * 16; u += c.nblk) {
        const int pm = u >> 4, pn = u & 15;
        f32x16 acc[2][2]; acc_zero<2, 2>(acc);
        gemm_kloop<2, 2>(c, acc, hb + (size_t)pm * 256 * DM, DM, Wq + (size_t)pn * 128 * DM, DM, DM);
        EPI_LOOP(2, 2) {
            const int m = pm * 256 + (wm * 2 + i) * 32 + r, n = pn * 128 + (wn * 2 + j) * 32 + 8 * g + 4 * h;
            u32x2 w; w.x = pk_bf16(acc[i][j][4 * g], acc[i][j][4 * g + 1]); w.y = pk_bf16(acc[i][j][4 * g + 2], acc[i][j][4 * g + 3]);
            *(u32x2*)(QV + (size_t)m * 2048 + n) = w;
        }
    }
}

__device__ __forceinline__ f32x16 mma_lds(f32x16 acc, lptr A, int sa, lptr B, int sb, int K, int lane) {
    const int r = lane & 31, h = lane >> 5;
    const lptr pa = A + r * sa + h * 16, pb = B + r * sb + h * 16;
    for (int k = 0; k < K; k += 16) {
        const bf16x8 a = *(LAS const bf16x8*)(pa + k * 2), b = *(LAS const bf16x8*)(pb + k * 2);
        acc = __builtin_amdgcn_mfma_f32_32x32x16_bf16(b, a, acc, 0, 0, 0);
    }
    return acc;
}
__device__ __forceinline__ f32x16 zero16() { f32x16 z;
#pragma unroll
    for (int e = 0; e < 16; ++e) z[e] = 0.f; return z; }

__device__ __forceinline__ void sb_wave_unit(const bf16_t* Y, bf16_t* O, int b, int hh, int qt, lptr wl, int lane) {
    const int t = qt * 64 + lane;
    const size_t row = (size_t)b * SEQ + t;
    unsigned q[32];
    {
        const u32x4* qp = (const u32x4*)(Y + row * NY + C_SBQ + hh * 64);
#pragma unroll
        for (int i = 0; i < 8; ++i) { const u32x4 v = qp[i]; q[4 * i] = v.x; q[4 * i + 1] = v.y; q[4 * i + 2] = v.z; q[4 * i + 3] = v.w; }
    }
    float acc[64];
#pragma unroll
    for (int e = 0; e < 64; ++e) acc[e] = 0.f;
    float C = 0.f;
    for (int kt = qt; kt >= 0; --kt) {
        {
            const size_t krow = (size_t)b * SEQ + kt * 64 + lane;
            const u32x4* kp = (const u32x4*)(Y + krow * NY + C_SBK + hh * 64);
            const u32x4* vp = (const u32x4*)(Y + krow * NY + C_SBV + hh * 64);
            u32x4 kr[8], vr[8];
#pragma unroll
            for (int i = 0; i < 8; ++i) { kr[i] = kp[i]; vr[i] = vp[i]; }
#pragma unroll
            for (int i = 0; i < 8; ++i) { *(LAS u32x4*)(wl + lane * 144 + i * 16) = kr[i]; *(LAS u32x4*)(wl + 9216 + lane * 144 + i * 16) = vr[i]; }
        }
        asm volatile("s_waitcnt lgkmcnt(0)" ::: "memory");
        const int s_hi = (kt == qt) ? 62 : 63;
#pragma unroll 1
        for (int s = s_hi; s >= 0; --s) {
            const int pos = kt * 64 + s;
            float z0 = 0.f, z1 = 0.f;
#pragma unroll
            for (int i = 0; i < 8; ++i) {
                const u32x4 kv = *(LAS const u32x4*)(wl + s * 144 + i * 16);
                z0 = dot2bf(q[4 * i], kv.x, z0); z1 = dot2bf(q[4 * i + 1], kv.y, z1); z0 = dot2bf(q[4 * i + 2], kv.z, z0); z1 = dot2bf(q[4 * i + 3], kv.w, z1);
            }
            const float z = (z0 + z1) * 0.125f;
            const bool valid = pos < t;
            const float Cn = C - softplusf_(z);
            const float w = valid ? __expf(z + Cn) : 0.f;
            C = valid ? Cn : C;
#pragma unroll
            for (int i = 0; i < 8; ++i) {
                const u32x4 vv = *(LAS const u32x4*)(wl + 9216 + s * 144 + i * 16);
                acc[8 * i + 0] += w * bf_lo(vv.x); acc[8 * i + 1] += w * bf_hi(vv.x); acc[8 * i + 2] += w * bf_lo(vv.y); acc[8 * i + 3] += w * bf_hi(vv.y);
                acc[8 * i + 4] += w * bf_lo(vv.z); acc[8 * i + 5] += w * bf_hi(vv.z); acc[8 * i + 6] += w * bf_lo(vv.w); acc[8 * i + 7] += w * bf_hi(vv.w);
            }
        }
        asm volatile("" ::: "memory");
        if (__all(C < -104.0f)) break;
    }
    u32x4* op = (u32x4*)(O + row * DM + 0 * 256 + hh * 64);
#pragma unroll
    for (int i = 0; i < 8; ++i) {
        u32x4 w; w.x = pk_bf16(acc[8 * i], acc[8 * i + 1]); w.y = pk_bf16(acc[8 * i + 2], acc[8 * i + 3]); w.z = pk_bf16(acc[8 * i + 4], acc[8 * i + 5]); w.w = pk_bf16(acc[8 * i + 6], acc[8 * i + 7]);
        op[i] = w;
    }
}
__device__ __forceinline__ void phase_sb(const Ctx& c, const bf16_t* Y, bf16_t* O) {
    const lptr wl = c.lds + c.wave * 18432;
    for (int u = c.blk * 8 + c.wave; u < 1024; u += c.nblk * 8) {
        const int qt = u & 127, hh = (u >> 7) & 3, b = u >> 9;
        sb_wave_unit(Y, O, b, hh, qt, wl, c.lane);
    }
    __syncthreads();
}

__device__ __forceinline__ void phase_compress(const Ctx& c, const bf16_t* Y, const float* pos, const float* wk, const float* wv, bf16_t* KC, bf16_t* VC) {
    LAS float* kl = (LAS float*)c.lds;
    LAS float* pl = (LAS float*)(c.lds + 144 * 64 * 4);
    for (int u = c.blk; u < 256; u += c.nblk) {
        const int cg = u & 63, kv = (u >> 6) & 1, b = u >> 7;
        const int c0 = cg * 8;
        const int col = kv ? C_NVC : C_NKC;
        for (int i = c.tid; i < 144 * 64; i += NTHREADS) {
            const int tr = i >> 6, d = i & 63, tok = c0 * 16 + tr;
            kl[i] = (tok < SEQ) ? bf2f(Y[((size_t)b * SEQ + tok) * NY + col + d]) : 0.f;
        }
        for (int i = c.tid; i < 32 * 64; i += NTHREADS) pl[i] = pos[i];
        __syncthreads();
        const int cl = c.tid >> 6, d = c.tid & 63, cc = c0 + cl;
        const float* w = kv ? wv : wk;
        float a0 = 0.f, a1 = 0.f;
#pragma unroll 4
        for (int l = 0; l < 32; ++l) {
            const LAS float* kr = kl + (cl * 16 + l) * 64;
            const LAS float* pr = pl + l * 64;
            const float* wr = w + (size_t)l * 64 * 64 + d;
#pragma unroll 8
            for (int dp = 0; dp < 64; dp += 2) {
                a0 += (kr[dp] + pr[dp]) * wr[(size_t)dp * 64];
                a1 += (kr[dp + 1] + pr[dp + 1]) * wr[(size_t)(dp + 1) * 64];
            }
        }
        bf16_t* dst = kv ? VC : KC;
        dst[((size_t)b * 512 + cc) * 64 + d] = (cc < 511) ? f2bf(a0 + a1) : (bf16_t)0;
        __syncthreads();
    }
}

__device__ __forceinline__ void phase_compress2(const Ctx& c, const bf16_t* Y, const bf16_t* WC, float* RC) {
    const int wm = c.wave >> 1, wn = c.wave & 1, r = c.lane & 31, h = c.lane >> 5;
    for (int u = c.blk; u < 16; u += c.nblk) {
        const int rt = u & 3, kv = (u >> 2) & 1, b = u >> 3;
        f32x16 acc[1][2]; acc_zero<1, 2>(acc);
        gemm_kloop<1, 2>(c, acc, Y + ((size_t)b * SEQ + (size_t)rt * 128 * 16) * NY + (kv ? C_NVC : C_NKC), 16 * NY, WC + (size_t)kv * 128 * 1024, 1024, 1024, NY);
        EPI_LOOP(1, 2) {
            const int m = rt * 128 + (wm + i) * 32 + r, n = (wn * 2 + j) * 32 + 8 * g + 4 * h;
            f32x4 o; o[0] = acc[i][j][4 * g]; o[1] = acc[i][j][4 * g + 1]; o[2] = acc[i][j][4 * g + 2]; o[3] = acc[i][j][4 * g + 3];
            *(f32x4*)(RC + ((size_t)(b * 2 + kv) * 512 + m) * 128 + n) = o;
        }
    }
}
__device__ __forceinline__ void phase_compress_combine(const Ctx& c, const float* RC, const float* CB, bf16_t* KC, bf16_t* VC) {
    for (int i = c.blk * NTHREADS + c.tid; i < 2 * 2 * 512 * 64; i += c.nblk * NTHREADS) {
        const int d = i & 63, cc = (i >> 6) & 511, kv = (i >> 15) & 1, b = i >> 16;
        const float* R = RC + (size_t)(b * 2 + kv) * 512 * 128;
        const float v = (cc < 511) ? R[cc * 128 + d] + R[(cc + 1) * 128 + 64 + d] + CB[kv * 64 + d] : 0.f;
        (kv ? VC : KC)[((size_t)b * 512 + cc) * 64 + d] = f2bf(v);
    }
}

__device__ __forceinline__ float ret_logg(int h) { return log1pf(-exp2f(-5.0f - (float)h)); }
__device__ __forceinline__ void phase_ret_local(const Ctx& c, const bf16_t* Y, float* UST) {
    const lptr Kt = c.lds, Vt = c.lds + 64 * 272;
    for (int u = c.blk; u < 512; u += c.nblk) {
        const int i = u & 63, hh = (u >> 6) & 3, b = u >> 8;
        const float lg = ret_logg(hh);
        {
            const int j = c.tid >> 2, dc = (c.tid & 3) * 16;
            const size_t row = (size_t)b * SEQ + i * 128 + j;
            const float kd = __expf(lg * (float)(127 - j)) * 0.125f;
            const u32x4* kp = (const u32x4*)(Y + row * NY + C_RK + hh * 64 + dc);
            const u32x4* vp = (const u32x4*)(Y + row * NY + C_RV + hh * 64 + dc);
            const u32x4 k0 = kp[0], k1 = kp[1], v0 = vp[0], v1 = vp[1];
            const unsigned kk[8] = {k0.x, k0.y, k0.z, k0.w, k1.x, k1.y, k1.z, k1.w};
            const unsigned vv[8] = {v0.x, v0.y, v0.z, v0.w, v1.x, v1.y, v1.z, v1.w};
#pragma unroll
            for (int e = 0; e < 8; ++e) {
                *(LAS bf16_t*)(Kt + (dc + 2 * e) * 272 + j * 2) = f2bf(bf_lo(kk[e]) * kd);
                *(LAS bf16_t*)(Kt + (dc + 2 * e + 1) * 272 + j * 2) = f2bf(bf_hi(kk[e]) * kd);
                *(LAS bf16_t*)(Vt + (dc + 2 * e) * 272 + j * 2) = (bf16_t)(vv[e] & 0xffffu);
                *(LAS bf16_t*)(Vt + (dc + 2 * e + 1) * 272 + j * 2) = (bf16_t)(vv[e] >> 16);
            }
        }
        __syncthreads();
        if (c.wave < 4) {
            const int wm = c.wave >> 1, wn = c.wave & 1, r = c.lane & 31, h = c.lane >> 5;
            f32x16 acc = mma_lds(zero16(), Kt + wm * 32 * 272, 272, Vt + wn * 32 * 272, 272, 128, c.lane);
            float* dst = UST + (((size_t)(b * 4 + hh) * 64 + i) * 64 + wm * 32 + r) * 64 + wn * 32 + 4 * h;
#pragma unroll
            for (int g = 0; g < 4; ++g) { f32x4 o; o[0] = acc[4 * g]; o[1] = acc[4 * g + 1]; o[2] = acc[4 * g + 2]; o[3] = acc[4 * g + 3]; *(f32x4*)(dst + 8 * g) = o; }
        }
        __syncthreads();
    }
}
__device__ __forceinline__ void phase_scans(const Ctx& c, const float* UST, float* RST, const float* UGLA, float* SGLA, const float* BL) {
    for (int u = c.blk; u < 96; u += c.nblk) {
        if (u < 64) {
            const int ch = u * NTHREADS + c.tid;
            const int bh = ch >> 12, de = ch & 4095;
            const float cd = __expf(ret_logg(bh & 3) * 128.0f);
            const float* up = UST + (size_t)bh * 64 * 4096 + de; float* rp = RST + (size_t)bh * 64 * 4096 + de;
            float R = 0.f;
            for (int i0 = 0; i0 < 64; i0 += 16) {
                float uv[16];
#pragma unroll
                for (int j = 0; j < 16; ++j) uv[j] = up[(size_t)(i0 + j) * 4096];
#pragma unroll
                for (int j = 0; j < 16; ++j) { rp[(size_t)(i0 + j) * 4096] = R; R = cd * R + uv[j]; }
            }
        } else {
            const int ch = (u - 64) * NTHREADS + c.tid;
            const int bh = ch >> 11, ke = ch & 2047, k = ke >> 6;
            const float* up = UGLA + (size_t)bh * 128 * 2048 + ke; float* sp = SGLA + (size_t)bh * 128 * 2048 + ke;
            const float* bl = BL + (size_t)bh * 128 * 32 + k;
            float S = 0.f;
            for (int i0 = 0; i0 < 128; i0 += 16) {
                float uv[16], dv[16];
#pragma unroll
                for (int j = 0; j < 16; ++j) { uv[j] = up[(size_t)(i0 + j) * 2048]; dv[j] = bl[(i0 + j) * 32]; }
#pragma unroll
                for (int j = 0; j < 16; ++j) { sp[(size_t)(i0 + j) * 2048] = S; S = __expf(dv[j]) * S + uv[j]; }
            }
        }
    }
}
__device__ __forceinline__ void phase_ret_out(const Ctx& c, const bf16_t* Y, const float* RST, const float* gn_g, const float* gn_b, bf16_t* O) {
    const lptr Qs = c.lds, Ks = c.lds + 18432, Vt = c.lds + 36864, Rt = c.lds + 54272, Att = c.lds + 63488;
    LAS float* Of = (LAS float*)(c.lds + 98304);
    for (int u = c.blk; u < 512; u += c.nblk) {
        const int i = u & 63, hh = (u >> 6) & 3, b = u >> 8;
        const float lg = ret_logg(hh);
        const size_t row0 = (size_t)b * SEQ + i * 128;
        {
            const int j = c.tid >> 2, dc = (c.tid & 3) * 16;
            const size_t row = row0 + j;
            const u32x4* qp = (const u32x4*)(Y + row * NY + C_RQ + hh * 64 + dc);
            const u32x4* kp = (const u32x4*)(Y + row * NY + C_RK + hh * 64 + dc);
            const u32x4* vp = (const u32x4*)(Y + row * NY + C_RV + hh * 64 + dc);
            const u32x4 q0 = qp[0], q1 = qp[1], k0 = kp[0], k1 = kp[1], v0 = vp[0], v1 = vp[1];
            *(LAS u32x4*)(Qs + j * 144 + dc * 2) = q0; *(LAS u32x4*)(Qs + j * 144 + dc * 2 + 16) = q1;
            *(LAS u32x4*)(Ks + j * 144 + dc * 2) = k0; *(LAS u32x4*)(Ks + j * 144 + dc * 2 + 16) = k1;
            const unsigned vv[8] = {v0.x, v0.y, v0.z, v0.w, v1.x, v1.y, v1.z, v1.w};
#pragma unroll
            for (int e = 0; e < 8; ++e) {
                *(LAS bf16_t*)(Vt + (dc + 2 * e) * 272 + j * 2) = (bf16_t)(vv[e] & 0xffffu);
                *(LAS bf16_t*)(Vt + (dc + 2 * e + 1) * 272 + j * 2) = (bf16_t)(vv[e] >> 16);
            }
            const int d = c.tid >> 3, ec = (c.tid & 7) * 8;
            const float* rp = RST + (((size_t)(b * 4 + hh) * 64 + i) * 64 + d) * 64 + ec;
            const f32x4 r0 = *(const f32x4*)rp, r1 = *(const f32x4*)(rp + 4);
            const float rv[8] = {r0[0], r0[1], r0[2], r0[3], r1[0], r1[1], r1[2], r1[3]};
#pragma unroll
            for (int e = 0; e < 8; ++e) *(LAS bf16_t*)(Rt + (ec + e) * 144 + d * 2) = f2bf(rv[e]);
        }
        __syncthreads();
        const int r = c.lane & 31, h = c.lane >> 5;
        {
            const int mi = c.wave >> 1;
#pragma unroll
            for (int jj = 0; jj < 2; ++jj) {
                const int nj = (c.wave & 1) * 2 + jj;
                if (nj <= mi) {
                    f32x16 s = mma_lds(zero16(), Qs + mi * 32 * 144, 144, Ks + nj * 32 * 144, 144, 64, c.lane);
                    const int ii = mi * 32 + r;
#pragma unroll
                    for (int g = 0; g < 4; ++g) {
                        float p[4];
#pragma unroll
                        for (int e = 0; e < 4; ++e) { const int jx = nj * 32 + 8 * g + 4 * h + e; const int df = ii - jx; p[e] = (df >= 0) ? s[4 * g + e] * 0.125f * __expf(lg * (float)df) : 0.f; }
                        u32x2 w; w.x = pk_bf16(p[0], p[1]); w.y = pk_bf16(p[2], p[3]);
                        *(LAS u32x2*)(Att + ii * 272 + (nj * 32 + 8 * g + 4 * h) * 2) = w;
                    }
                }
            }
        }
        __syncthreads();
        {
            const int wm = c.wave >> 1, wn = c.wave & 1;
            f32x16 acc = mma_lds(zero16(), Qs + wm * 32 * 144, 144, Rt + wn * 32 * 144, 144, 64, c.lane);
            const int ii = wm * 32 + r;
            const float qd = __expf(lg * (float)(ii + 1));
#pragma unroll
            for (int e = 0; e < 16; ++e) acc[e] *= qd;
            acc = mma_lds(acc, Att + wm * 32 * 272, 272, Vt + wn * 32 * 272, 272, (wm + 1) * 32, c.lane);
#pragma unroll
            for (int g = 0; g < 4; ++g) { f32x4 o; o[0] = acc[4 * g]; o[1] = acc[4 * g + 1]; o[2] = acc[4 * g + 2]; o[3] = acc[4 * g + 3]; *(LAS f32x4*)(Of + ii * 68 + wn * 32 + 8 * g + 4 * h) = o; }
        }
        __syncthreads();
        {
            const int rw = c.tid >> 2, part = c.tid & 3;
            float v[16]; float s = 0.f;
#pragma unroll
            for (int e = 0; e < 16; ++e) { v[e] = Of[rw * 68 + part * 16 + e]; s += v[e]; }
            s += __shfl_xor(s, 1); s += __shfl_xor(s, 2);
            const float mu = s * (1.0f / 64.0f);
            float q = 0.f;
#pragma unroll
            for (int e = 0; e < 16; ++e) { const float d = v[e] - mu; q += d * d; }
            q += __shfl_xor(q, 1); q += __shfl_xor(q, 2);
            const float rstd = rsqrtf(q * (1.0f / 64.0f) + LN_EPS);
            const size_t row = row0 + rw;
            const int ch = hh * 64 + part * 16;
            const u32x4* gp = (const u32x4*)(Y + row * NY + C_RG + ch);
            const u32x4 g0 = gp[0], g1 = gp[1];
            const unsigned gg[8] = {g0.x, g0.y, g0.z, g0.w, g1.x, g1.y, g1.z, g1.w};
            unsigned ow[8];
#pragma unroll
            for (int e = 0; e < 8; ++e) {
                const float y0 = ((v[2 * e] - mu) * rstd * gn_g[ch + 2 * e] + gn_b[ch + 2 * e]) * siluf_(bf_lo(gg[e]));
                const float y1 = ((v[2 * e + 1] - mu) * rstd * gn_g[ch + 2 * e + 1] + gn_b[ch + 2 * e + 1]) * siluf_(bf_hi(gg[e]));
                ow[e] = pk_bf16(y0, y1);
            }
            u32x4* op = (u32x4*)(O + row * DM + 2 * 256 + ch);
            u32x4 w0, w1; w0.x = ow[0]; w0.y = ow[1]; w0.z = ow[2]; w0.w = ow[3]; w1.x = ow[4]; w1.y = ow[5]; w1.z = ow[6]; w1.w = ow[7];
            op[0] = w0; op[1] = w1;
        }
        __syncthreads();
    }
}

template <int NH>
__device__ __forceinline__ void gla_decays(const Ctx& c, const bf16_t* Y, size_t row0, int h0, const float* w_alpha, const float* b_alpha, LAS float* Ab, LAS float* lrs) {
    for (int i = c.tid; i < 64 * 16; i += NTHREADS) lrs[i] = bf2f(Y[(row0 + (i >> 4)) * NY + C_GLR + (i & 15)]);
    __syncthreads();
    for (int i = c.tid; i < NH * 64 * 32; i += NTHREADS) {
        const int k = i & 31, t = (i >> 5) & 63, hl = i >> 11;
        const int col = (h0 + hl) * 32 + k;
        float x = b_alpha[col];
#pragma unroll
        for (int rr = 0; rr < 16; ++rr) x += lrs[t * 16 + rr] * w_alpha[rr * 128 + col];
        Ab[i] = -softplusf_(-x) * (1.0f / 16.0f);
    }
    __syncthreads();
    if (c.tid < NH * 32) {
        const int k = c.tid & 31, hl = c.tid >> 5;
        float s = 0.f;
        for (int t = 0; t < 64; ++t) { s += Ab[(hl * 64 + t) * 32 + k]; Ab[(hl * 64 + t) * 32 + k] = s; }
    }
    __syncthreads();
}
__device__ __forceinline__ void phase_gla_local(const Ctx& c, const bf16_t* Y, const float* w_alpha, const float* b_alpha, float* UGLA, float* BL) {
    LAS float* Ab = (LAS float*)c.lds;
    LAS float* lrs = (LAS float*)(c.lds + 32768);
    const lptr Kt = c.lds + 36864;
    const lptr Vt = c.lds + 36864 + 18432;
    for (int u = c.blk; u < 256; u += c.nblk) {
        const int i = u & 127, b = u >> 7;
        const size_t row0 = (size_t)b * SEQ + i * 64;
        gla_decays<4>(c, Y, row0, 0, w_alpha, b_alpha, Ab, lrs);
        {
            const int s = c.tid >> 3, cc = (c.tid & 7) * 16;
            const u32x4* kp = (const u32x4*)(Y + (row0 + s) * NY + C_GK + cc);
            const u32x4 k0 = kp[0], k1 = kp[1];
            const unsigned kk[8] = {k0.x, k0.y, k0.z, k0.w, k1.x, k1.y, k1.z, k1.w};
#pragma unroll
            for (int e = 0; e < 16; ++e) {
                const int col = cc + e, hl = col >> 5, k = col & 31;
                const float kvf = (e & 1) ? bf_hi(kk[e >> 1]) : bf_lo(kk[e >> 1]);
                const float dec = __expf(Ab[(hl * 64 + 63) * 32 + k] - Ab[(hl * 64 + s) * 32 + k]);
                *(LAS bf16_t*)(Kt + hl * 4608 + k * 144 + s * 2) = f2bf(kvf * dec);
            }
            const int vc = (c.tid & 7) * 32;
            const u32x4* vp = (const u32x4*)(Y + (row0 + s) * NY + C_GV + vc);
#pragma unroll
            for (int q4 = 0; q4 < 4; ++q4) {
                const u32x4 v = vp[q4];
                const unsigned vv[4] = {v.x, v.y, v.z, v.w};
#pragma unroll
                for (int e = 0; e < 4; ++e) {
                    const int col = vc + q4 * 8 + 2 * e, hl = col >> 6, ee = col & 63;
                    *(LAS bf16_t*)(Vt + hl * 9216 + ee * 144 + s * 2) = (bf16_t)(vv[e] & 0xffffu);
                    *(LAS bf16_t*)(Vt + hl * 9216 + (ee + 1) * 144 + s * 2) = (bf16_t)(vv[e] >> 16);
                }
            }
        }
        __syncthreads();
        {
            const int hl = c.wave >> 1, wn = c.wave & 1, r = c.lane & 31, h = c.lane >> 5;
            f32x16 acc = mma_lds(zero16(), Kt + hl * 4608, 144, Vt + hl * 9216 + wn * 32 * 144, 144, 64, c.lane);
            float* dst = UGLA + (((size_t)(b * 4 + hl) * 128 + i) * 32 + r) * 64 + wn * 32 + 4 * h;
#pragma unroll
            for (int g = 0; g < 4; ++g) { f32x4 o; o[0] = acc[4 * g]; o[1] = acc[4 * g + 1]; o[2] = acc[4 * g + 2]; o[3] = acc[4 * g + 3]; *(f32x4*)(dst + 8 * g) = o; }
            if (c.tid < 128) { const int hl2 = c.tid >> 5, k = c.tid & 31; BL[((size_t)(b * 4 + hl2) * 128 + i) * 32 + k] = Ab[(hl2 * 64 + 63) * 32 + k]; }
        }
        __syncthreads();
    }
}
__device__ __forceinline__ void phase_gla_out(const Ctx& c, const bf16_t* Y, const float* w_alpha, const float* b_alpha, const float* SGLA, const float* norm_g, bf16_t* O) {
    LAS float* Ab = (LAS float*)c.lds;
    LAS float* lrs = (LAS float*)(c.lds + 16384);
    const lptr Qp = c.lds + 20480;
    const lptr Kp = Qp + 10240;
    const lptr Vt = Kp + 10240;
    const lptr St = Vt + 18432;
    const lptr Att = St + 10240;
    LAS float* Of = (LAS float*)(Att + 18432);
    for (int u = c.blk; u < 512; u += c.nblk) {
        const int hp = u & 1, i = (u >> 1) & 127, b = u >> 8;
        const size_t row0 = (size_t)b * SEQ + i * 64;
        gla_decays<2>(c, Y, row0, hp * 2, w_alpha, b_alpha, Ab, lrs);
        {
            const int s = c.tid >> 3, cc = (c.tid & 7) * 8;
            const int hl = cc >> 5, k0 = cc & 31;
            const u32x4 qv = *(const u32x4*)(Y + (row0 + s) * NY + C_GQ + hp * 64 + cc);
            const u32x4 kv = *(const u32x4*)(Y + (row0 + s) * NY + C_GK + hp * 64 + cc);
            const unsigned qq[4] = {qv.x, qv.y, qv.z, qv.w}, kk[4] = {kv.x, kv.y, kv.z, kv.w};
            unsigned qo[4], ko[4];
#pragma unroll
            for (int e = 0; e < 4; ++e) {
                const float b0 = Ab[(hl * 64 + s) * 32 + k0 + 2 * e], b1 = Ab[(hl * 64 + s) * 32 + k0 + 2 * e + 1];
                const float e0 = __expf(b0), e1 = __expf(b1);
                qo[e] = pk_bf16(bf_lo(qq[e]) * 0.17677669529663687f * e0, bf_hi(qq[e]) * 0.17677669529663687f * e1);
                ko[e] = pk_bf16(bf_lo(kk[e]) / e0, bf_hi(kk[e]) / e1);
            }
            u32x4 w; w.x = qo[0]; w.y = qo[1]; w.z = qo[2]; w.w = qo[3];
            *(LAS u32x4*)(Qp + hl * 5120 + s * 80 + k0 * 2) = w;
            w.x = ko[0]; w.y = ko[1]; w.z = ko[2]; w.w = ko[3];
            *(LAS u32x4*)(Kp + hl * 5120 + s * 80 + k0 * 2) = w;
            const int vc = (c.tid & 7) * 16;
            const u32x4* vp = (const u32x4*)(Y + (row0 + s) * NY + C_GV + hp * 128 + vc);
#pragma unroll
            for (int q4 = 0; q4 < 2; ++q4) {
                const u32x4 v = vp[q4];
                const unsigned vv[4] = {v.x, v.y, v.z, v.w};
#pragma unroll
                for (int e = 0; e < 4; ++e) {
                    const int col = vc + q4 * 8 + 2 * e, hl2 = col >> 6, ee = col & 63;
                    *(LAS bf16_t*)(Vt + hl2 * 9216 + ee * 144 + s * 2) = (bf16_t)(vv[e] & 0xffffu);
                    *(LAS bf16_t*)(Vt + hl2 * 9216 + (ee + 1) * 144 + s * 2) = (bf16_t)(vv[e] >> 16);
                }
            }
            const int sh = c.tid >> 8, sk = (c.tid >> 3) & 31, se = (c.tid & 7) * 8;
            const float* spp = SGLA + (((size_t)(b * 4 + hp * 2 + sh) * 128 + i) * 32 + sk) * 64 + se;
            const f32x4 s0 = *(const f32x4*)spp, s1 = *(const f32x4*)(spp + 4);
            const float sv[8] = {s0[0], s0[1], s0[2], s0[3], s1[0], s1[1], s1[2], s1[3]};
#pragma unroll
            for (int e = 0; e < 8; ++e) *(LAS bf16_t*)(St + sh * 5120 + (se + e) * 80 + sk * 2) = f2bf(sv[e]);
        }
        __syncthreads();
        const int hl = c.wave >> 2, mi = (c.wave >> 1) & 1, nj = c.wave & 1, r = c.lane & 31, h = c.lane >> 5;
        if (nj <= mi) {
            f32x16 s = mma_lds(zero16(), Qp + hl * 5120 + mi * 32 * 80, 80, Kp + hl * 5120 + nj * 32 * 80, 80, 32, c.lane);
            const int tt = mi * 32 + r;
#pragma unroll
            for (int g = 0; g < 4; ++g) {
                float p[4];
#pragma unroll
                for (int e = 0; e < 4; ++e) { const int sx = nj * 32 + 8 * g + 4 * h + e; p[e] = (sx <= tt) ? s[4 * g + e] : 0.f; }
                u32x2 w; w.x = pk_bf16(p[0], p[1]); w.y = pk_bf16(p[2], p[3]);
                *(LAS u32x2*)(Att + hl * 9216 + tt * 144 + (nj * 32 + 8 * g + 4 * h) * 2) = w;
            }
        }
        __syncthreads();
        {
            f32x16 acc = mma_lds(zero16(), Qp + hl * 5120 + mi * 32 * 80, 80, St + hl * 5120 + nj * 32 * 80, 80, 32, c.lane);
            acc = mma_lds(acc, Att + hl * 9216 + mi * 32 * 144, 144, Vt + hl * 9216 + nj * 32 * 144, 144, (mi + 1) * 32, c.lane);
            const int tt = mi * 32 + r;
#pragma unroll
            for (int g = 0; g < 4; ++g) { f32x4 o; o[0] = acc[4 * g]; o[1] = acc[4 * g + 1]; o[2] = acc[4 * g + 2]; o[3] = acc[4 * g + 3]; *(LAS f32x4*)(Of + (hl * 64 + tt) * 68 + nj * 32 + 8 * g + 4 * h) = o; }
        }
        __syncthreads();
        {
            const int rw = c.tid >> 2, part = c.tid & 3;
            const int hl2 = rw >> 6, tt = rw & 63, hh = hp * 2 + hl2;
            float v[16]; float q = 0.f;
#pragma unroll
            for (int e = 0; e < 16; ++e) { v[e] = Of[rw * 68 + part * 16 + e]; q += v[e] * v[e]; }
            q += __shfl_xor(q, 1); q += __shfl_xor(q, 2);
            const float rstd = rsqrtf(q * (1.0f / 64.0f) + LN_EPS);
            const size_t row = row0 + tt;
            const int ch = hh * 64 + part * 16;
            const u32x4* gp = (const u32x4*)(Y + row * NY + C_GR + ch);
            const u32x4 g0 = gp[0], g1 = gp[1];
            const unsigned gg[8] = {g0.x, g0.y, g0.z, g0.w, g1.x, g1.y, g1.z, g1.w};
            unsigned ow[8];
#pragma unroll
            for (int e = 0; e < 8; ++e) {
                const float y0 = v[2 * e] * rstd * norm_g[ch + 2 * e] * siluf_(bf_lo(gg[e]));
                const float y1 = v[2 * e + 1] * rstd * norm_g[ch + 2 * e + 1] * siluf_(bf_hi(gg[e]));
                ow[e] = pk_bf16(y0, y1);
            }
            u32x4* op = (u32x4*)(O + row * DM + 3 * 256 + ch);
            u32x4 w0, w1; w0.x = ow[0]; w0.y = ow[1]; w0.z = ow[2]; w0.w = ow[3]; w1.x = ow[4]; w1.y = ow[5]; w1.z = ow[6]; w1.w = ow[7];
            op[0] = w0; op[1] = w1;
        }
        __syncthreads();
    }
}

constexpr int NS_Q = 0;
constexpr int NS_K = 18432;
constexpr int NS_VT = 27648;
constexpr int NS_S = 36864;
constexpr int NS_P = 71680;
constexpr int NS_M = 90112;
constexpr int NS_L = NS_M + 512;
constexpr int NS_A = NS_L + 512;
constexpr int NS_G = NS_A + 512;
constexpr int NS_IMP = NS_G + 2048;
constexpr int NS_SEL = NS_IMP + 16384;
constexpr int NS_UM = NS_SEL + 512;
constexpr int NS_CARRY = NS_UM + 64;
constexpr int NS_END = NS_CARRY + 128;

__device__ __forceinline__ void ns_stage_rows(const Ctx& c, lptr dst, const bf16_t* src, size_t ld) {
    const int rr = c.tid >> 3, cc = (c.tid & 7) * 8;
    *(LAS u32x4*)(dst + rr * 144 + cc * 2) = *(const u32x4*)(src + (size_t)rr * ld + cc);
}
__device__ __forceinline__ void ns_stage_T(const Ctx& c, lptr dst, const bf16_t* src, size_t ld) {
    const int rr = c.tid >> 3, cc = (c.tid & 7) * 8;
    const u32x4 v = *(const u32x4*)(src + (size_t)rr * ld + cc);
    const unsigned vv[4] = {v.x, v.y, v.z, v.w};
#pragma unroll
    for (int e = 0; e < 4; ++e) {
        *(LAS bf16_t*)(dst + (cc + 2 * e) * 144 + rr * 2) = (bf16_t)(vv[e] & 0xffffu);
        *(LAS bf16_t*)(dst + (cc + 2 * e + 1) * 144 + rr * 2) = (bf16_t)(vv[e] >> 16);
    }
}
__device__ __forceinline__ void ns_scores(const Ctx& c) {
    const int wm = c.wave >> 1, wn = c.wave & 1, r = c.lane & 31, h = c.lane >> 5;
    const f32x16 s = mma_lds(zero16(), c.lds + NS_Q + wm * 32 * 144, 144, c.lds + NS_K + wn * 32 * 144, 144, 64, c.lane);
    LAS float* Sf = (LAS float*)(c.lds + NS_S);
#pragma unroll
    for (int g = 0; g < 4; ++g) { f32x4 o; o[0] = s[4 * g]; o[1] = s[4 * g + 1]; o[2] = s[4 * g + 2]; o[3] = s[4 * g + 3]; *(LAS f32x4*)(Sf + (wm * 32 + r) * 68 + wn * 32 + 8 * g + 4 * h) = o; }
}
template <int MODE>
__device__ __forceinline__ bool ns_valid(int t, int kidx, int tok, const Ctx& c, float& dist) {
    if (MODE == 0) { const int d = t - 16 * kidx - 31; dist = (float)d; return d >= 0 && kidx < 511; }
    if (MODE == 1) { const int nb = kidx >> 6; const unsigned m = ((LAS const unsigned*)(c.lds + NS_SEL))[tok * 4 + (nb >> 5)]; const int d = t - kidx; dist = (float)d; return ((m >> (nb & 31)) & 1u) && d >= 0; }
    const int d = t - kidx; dist = (float)d; return d >= 0 && d < 512;
}
template <int MODE, int PASS>
__device__ __forceinline__ void ns_softmax(const Ctx& c, int t0, int k0) {
    LAS float* Sf = (LAS float*)(c.lds + NS_S);
    LAS float* Mr = (LAS float*)(c.lds + NS_M); LAS float* Lr = (LAS float*)(c.lds + NS_L); LAS float* Ar = (LAS float*)(c.lds + NS_A);
    const int row = c.tid >> 2, part = c.tid & 3, tok = row & 31, hh = row >> 5, t = t0 + tok;
    const float slope = exp2f(-2.0f * (float)(hh + 1));
    float s[16]; bool ok[16]; float mloc = NEGF;
#pragma unroll
    for (int e = 0; e < 16; ++e) {
        const int j = part * 16 + e; float dist;
        ok[e] = ns_valid<MODE>(t, k0 + j, tok, c, dist);
        s[e] = Sf[row * 68 + j] * 0.125f - slope * dist;
        if (ok[e]) mloc = fmaxf(mloc, s[e]);
    }
    mloc = fmaxf(mloc, __shfl_xor(mloc, 1)); mloc = fmaxf(mloc, __shfl_xor(mloc, 2));
    const float mold = Mr[row], lold = Lr[row];
    if (PASS == 2) {
        const float inv = lold > 0.f ? 1.0f / lold : 0.f;
        unsigned pw[8];
#pragma unroll
        for (int e = 0; e < 16; e += 2) {
            const float p0 = ok[e] ? __expf(s[e] - mold) * inv : 0.f, p1 = ok[e + 1] ? __expf(s[e + 1] - mold) * inv : 0.f;
            Sf[row * 68 + part * 16 + e] = p0; Sf[row * 68 + part * 16 + e + 1] = p1;
            pw[e >> 1] = pk_bf16(p0, p1);
        }
        u32x4 w0, w1; w0.x = pw[0]; w0.y = pw[1]; w0.z = pw[2]; w0.w = pw[3]; w1.x = pw[4]; w1.y = pw[5]; w1.z = pw[6]; w1.w = pw[7];
        *(LAS u32x4*)(c.lds + NS_P + row * 144 + part * 32) = w0; *(LAS u32x4*)(c.lds + NS_P + row * 144 + part * 32 + 16) = w1;
        return;
    }
    const float mnew = fmaxf(mold, mloc);
    float sum = 0.f; unsigned pw[8];
#pragma unroll
    for (int e = 0; e < 16; e += 2) {
        const float p0 = ok[e] ? __expf(s[e] - mnew) : 0.f, p1 = ok[e + 1] ? __expf(s[e + 1] - mnew) : 0.f;
        sum += p0 + p1; pw[e >> 1] = pk_bf16(p0, p1);
    }
    sum += __shfl_xor(sum, 1); sum += __shfl_xor(sum, 2);
    const float alpha = __expf(mold - mnew);
    if (PASS == 1) {
        u32x4 w0, w1; w0.x = pw[0]; w0.y = pw[1]; w0.z = pw[2]; w0.w = pw[3]; w1.x = pw[4]; w1.y = pw[5]; w1.z = pw[6]; w1.w = pw[7];
        *(LAS u32x4*)(c.lds + NS_P + row * 144 + part * 32) = w0; *(LAS u32x4*)(c.lds + NS_P + row * 144 + part * 32 + 16) = w1;
    }
    if (part == 0) { Mr[row] = mnew; Lr[row] = lold * alpha + sum; Ar[row] = alpha; }
}
__device__ __forceinline__ f32x16 ns_pv(const Ctx& c, f32x16 acc, bool rescale) {
    const int wm = c.wave >> 1, wn = c.wave & 1, r = c.lane & 31;
    if (rescale) { const float a = ((LAS const float*)(c.lds + NS_A))[wm * 32 + r];
#pragma unroll
        for (int e = 0; e < 16; ++e) acc[e] *= a; }
    return mma_lds(acc, c.lds + NS_P + wm * 32 * 144, 144, c.lds + NS_VT + wn * 32 * 144, 144, 64, c.lane);
}
__device__ __forceinline__ void ns_reset_stats(const Ctx& c) {
    if (c.tid < 128) { ((LAS float*)(c.lds + NS_M))[c.tid] = NEGF; ((LAS float*)(c.lds + NS_L))[c.tid] = 0.f; ((LAS float*)(c.lds + NS_A))[c.tid] = 1.f; }
}

__device__ __forceinline__ void phase_nsa(const Ctx& c, const bf16_t* Y, const bf16_t* KC, const bf16_t* VC, bf16_t* O) {
    LAS float* Sf = (LAS float*)(c.lds + NS_S);
    LAS float* Gt = (LAS float*)(c.lds + NS_G);
    LAS float* Imp = (LAS float*)(c.lds + NS_IMP);
    LAS unsigned* Sel = (LAS unsigned*)(c.lds + NS_SEL);
    LAS unsigned* Um = (LAS unsigned*)(c.lds + NS_UM);
    LAS float* Carry = (LAS float*)(c.lds + NS_CARRY);
    const int wm = c.wave >> 1, wn = c.wave & 1, r = c.lane & 31, h = c.lane >> 5;
    for (int u = c.blk; u < 512; u += c.nblk) {
        const int tq = u & 255, b = u >> 8;
        const int t0 = tq * 32;
        const size_t row0 = (size_t)b * SEQ + t0;
        {
            const int row = c.tid >> 2, dc = (c.tid & 3) * 16, tok = row & 31, hh = row >> 5;
            const u32x4* qp = (const u32x4*)(Y + (row0 + tok) * NY + C_NQ + hh * 64 + dc);
            *(LAS u32x4*)(c.lds + NS_Q + row * 144 + dc * 2) = qp[0]; *(LAS u32x4*)(c.lds + NS_Q + row * 144 + dc * 2 + 16) = qp[1];
            if (c.tid < 384) { const int rw = c.tid / 3, gi = c.tid % 3; Gt[rw * 4 + gi] = sigmoidf_(bf2f(Y[(row0 + (rw & 31)) * NY + C_NG + (rw >> 5) * 3 + gi])); }
            for (int i = c.tid; i < 32 * 128; i += NTHREADS) Imp[i] = 0.f;
            if (c.tid < 32) Carry[c.tid] = 0.f;
            if (c.tid < 4) Um[c.tid] = 0u;
            ns_reset_stats(c);
        }
        __syncthreads();
        f32x16 outacc = zero16();
        const int ncmp = min(t0 / 16 + 1, 511);
        const int nct = (ncmp + 63) / 64;
        const bf16_t* kcb = KC + (size_t)b * 512 * 64; const bf16_t* vcb = VC + (size_t)b * 512 * 64;
        for (int ct = 0; ct < nct; ++ct) {
            ns_stage_rows(c, c.lds + NS_K, kcb + (size_t)ct * 64 * 64, 64);
            __syncthreads();
            ns_scores(c);
            __syncthreads();
            ns_softmax<0, 0>(c, t0, ct * 64);
            __syncthreads();
        }
        {
            f32x16 acc = zero16();
            for (int ct = 0; ct < nct; ++ct) {
                ns_stage_rows(c, c.lds + NS_K, kcb + (size_t)ct * 64 * 64, 64);
                ns_stage_T(c, c.lds + NS_VT, vcb + (size_t)ct * 64 * 64, 64);
                __syncthreads();
                ns_scores(c);
                __syncthreads();
                ns_softmax<0, 2>(c, t0, ct * 64);
                __syncthreads();
                acc = ns_pv(c, acc, false);
                {
                    const int tok = c.tid >> 4, g = c.tid & 15;
                    float a = 0.f, last = 0.f, prev = 0.f;
#pragma unroll
                    for (int hh = 0; hh < 4; ++hh) {
                        const LAS float* pr = Sf + (hh * 32 + tok) * 68 + 4 * g;
                        a += (pr[0] + pr[1]) + (pr[2] + pr[3]);
                        last += pr[3];
                        if (g > 0) prev += pr[-1];
                    }
                    if (g == 0) prev = Carry[tok];
                    Imp[tok * 128 + ct * 16 + g] += a + prev;
                    __syncthreads();
                    if (g == 15) Carry[tok] = last;
                }
                __syncthreads();
            }
            const float g0 = Gt[(wm * 32 + r) * 4 + 0];
#pragma unroll
            for (int e = 0; e < 16; ++e) outacc[e] += g0 * acc[e];
        }
        for (int tk = 0; tk < 4; ++tk) {
            const int tok = c.wave * 4 + tk, t = t0 + tok, cur = t >> 6;
            float v0 = Imp[tok * 128 + c.lane], v1 = Imp[tok * 128 + 64 + c.lane];
            const int n0 = c.lane, n1 = c.lane + 64;
            if (n0 > cur) v0 = NEGF; if (n1 > cur) v1 = NEGF;
            if (n0 == cur) v0 = 1e30f; if (n1 == cur) v1 = 1e30f;
            unsigned m0 = 0u, m1 = 0u, m2 = 0u, m3 = 0u;
            for (int it = 0; it < 16; ++it) {
                const float mx = wave_max(fmaxf(v0, v1));
                if (mx <= NEGF) break;
                const unsigned long long b0 = __ballot(v0 == mx);
                int nsel;
                if (b0) { nsel = __ffsll((long long)b0) - 1; if (c.lane == nsel) v0 = -3e38f; }
                else { const unsigned long long b1 = __ballot(v1 == mx); const int l1 = __ffsll((long long)b1) - 1; nsel = 64 + l1; if (c.lane == l1) v1 = -3e38f; }
                if (nsel < 32) m0 |= 1u << nsel; else if (nsel < 64) m1 |= 1u << (nsel - 32); else if (nsel < 96) m2 |= 1u << (nsel - 64); else m3 |= 1u << (nsel - 96);
            }
            if (c.lane == 0) {
                Sel[tok * 4 + 0] = m0; Sel[tok * 4 + 1] = m1; Sel[tok * 4 + 2] = m2; Sel[tok * 4 + 3] = m3;
                atomicOr((unsigned*)&Um[0], m0); atomicOr((unsigned*)&Um[1], m1); atomicOr((unsigned*)&Um[2], m2); atomicOr((unsigned*)&Um[3], m3);
            }
        }
        ns_reset_stats(c);
        __syncthreads();
        {
            f32x16 acc = zero16();
            const bf16_t* ksb = Y + (size_t)b * SEQ * NY + C_NKS; const bf16_t* vsb = Y + (size_t)b * SEQ * NY + C_NVS;
            for (int wd = 0; wd < 4; ++wd) {
                unsigned bits = Um[wd];
                while (bits) {
                    const int nb = wd * 32 + __ffs((int)bits) - 1; bits &= bits - 1;
                    ns_stage_rows(c, c.lds + NS_K, ksb + (size_t)nb * 64 * NY, NY);
                    ns_stage_T(c, c.lds + NS_VT, vsb + (size_t)nb * 64 * NY, NY);
                    __syncthreads();
                    ns_scores(c);
                    __syncthreads();
                    ns_softmax<1, 1>(c, t0, nb * 64);
                    __syncthreads();
                    acc = ns_pv(c, acc, true);
                    __syncthreads();
                }
            }
            const float l = ((LAS const float*)(c.lds + NS_L))[wm * 32 + r];
            const float g1 = Gt[(wm * 32 + r) * 4 + 1] * (l > 0.f ? 1.0f / l : 0.f);
#pragma unroll
            for (int e = 0; e < 16; ++e) outacc[e] += g1 * acc[e];
        }
        __syncthreads();
        ns_reset_stats(c);
        __syncthreads();
        {
            f32x16 acc = zero16();
            const bf16_t* kwb = Y + (size_t)b * SEQ * NY + C_NKW; const bf16_t* vwb = Y + (size_t)b * SEQ * NY + C_NVW;
            const int kt1 = t0 >> 6, kt0 = max(0, kt1 - 8);
            for (int kt = kt0; kt <= kt1; ++kt) {
                ns_stage_rows(c, c.lds + NS_K, kwb + (size_t)kt * 64 * NY, NY);
                ns_stage_T(c, c.lds + NS_VT, vwb + (size_t)kt * 64 * NY, NY);
                __syncthreads();
                ns_scores(c);
                __syncthreads();
                ns_softmax<2, 1>(c, t0, kt * 64);
                __syncthreads();
                acc = ns_pv(c, acc, true);
                __syncthreads();
            }
            const float l = ((LAS const float*)(c.lds + NS_L))[wm * 32 + r];
            const float g2 = Gt[(wm * 32 + r) * 4 + 2] * (l > 0.f ? 1.0f / l : 0.f);
#pragma unroll
            for (int e = 0; e < 16; ++e) outacc[e] += g2 * acc[e];
        }
        {
            bf16_t* op = O + (row0 + r) * DM + 256 + wm * 64 + wn * 32 + 4 * h;
#pragma unroll
            for (int g = 0; g < 4; ++g) { u32x2 w; w.x = pk_bf16(outacc[4 * g], outacc[4 * g + 1]); w.y = pk_bf16(outacc[4 * g + 2], outacc[4 * g + 3]); *(u32x2*)(op + 8 * g) = w; }
        }
        __syncthreads();
    }
}

__device__ __forceinline__ void phase_sb2(const Ctx& c, const bf16_t* Y, bf16_t* O) {
    LAS float* Sf = (LAS float*)(c.lds + NS_S);
    LAS float* Cr = (LAS float*)(c.lds + NS_M);
    const int wm = c.wave >> 1, wn = c.wave & 1, r = c.lane & 31, h = c.lane >> 5;
    for (int u = c.blk; u < 512; u += c.nblk) {
        const int b = u >> 8, hh = (u >> 6) & 3, qt = b ? 63 - (u & 63) : (u & 63);
        const int t0 = qt * 128;
        const size_t row0 = (size_t)b * SEQ + t0;
        {
            const int row = c.tid >> 2, dc = (c.tid & 3) * 16;
            const u32x4* qp = (const u32x4*)(Y + (row0 + row) * NY + C_SBQ + hh * 64 + dc);
            *(LAS u32x4*)(c.lds + NS_Q + row * 144 + dc * 2) = qp[0]; *(LAS u32x4*)(c.lds + NS_Q + row * 144 + dc * 2 + 16) = qp[1];
            if (c.tid < 128) Cr[c.tid] = 0.f;
        }
        LAS volatile unsigned* NotDone = (LAS volatile unsigned*)(c.lds + NS_L);
        f32x16 acc = zero16();
        const bf16_t* kb = Y + (size_t)b * SEQ * NY + C_SBK + hh * 64; const bf16_t* vb = Y + (size_t)b * SEQ * NY + C_SBV + hh * 64;
        for (int kt = 2 * qt + 1; kt >= 0; --kt) {
            ns_stage_rows(c, c.lds + NS_K, kb + (size_t)kt * 64 * NY, NY);
            ns_stage_T(c, c.lds + NS_VT, vb + (size_t)kt * 64 * NY, NY);
            if (c.tid == 0) NotDone[0] = 0u;
            __syncthreads();
            ns_scores(c);
            __syncthreads();
            {
                const int row = c.tid >> 2, part = c.tid & 3, t = t0 + row;
                float z[16], suf[16]; bool ok[16];
                float run = 0.f;
#pragma unroll
                for (int e = 15; e >= 0; --e) {
                    const int pos = kt * 64 + part * 16 + e;
                    z[e] = Sf[row * 68 + part * 16 + e] * 0.125f;
                    ok[e] = pos < t;
                    run += ok[e] ? -softplusf_(z[e]) : 0.f;
                    suf[e] = run;
                }
                const float tot = run;
                const float t1 = __shfl_down(tot, 1), t2 = __shfl_down(tot, 2), t3 = __shfl_down(tot, 3);
                const float thigh = (part < 3 ? t1 : 0.f) + (part < 2 ? t2 : 0.f) + (part < 1 ? t3 : 0.f);
                const float carry = Cr[row];
                unsigned pw[8];
#pragma unroll
                for (int e = 0; e < 16; e += 2) {
                    const float w0 = ok[e] ? __expf(z[e] + carry + thigh + suf[e]) : 0.f, w1 = ok[e + 1] ? __expf(z[e + 1] + carry + thigh + suf[e + 1]) : 0.f;
                    pw[e >> 1] = pk_bf16(w0, w1);
                }
                u32x4 w0, w1; w0.x = pw[0]; w0.y = pw[1]; w0.z = pw[2]; w0.w = pw[3]; w1.x = pw[4]; w1.y = pw[5]; w1.z = pw[6]; w1.w = pw[7];
                *(LAS u32x4*)(c.lds + NS_P + row * 144 + part * 32) = w0; *(LAS u32x4*)(c.lds + NS_P + row * 144 + part * 32 + 16) = w1;
                const float cn = carry + thigh + tot;
                if (part == 0) { Cr[row] = cn; if (!(cn < -104.0f)) NotDone[0] = 1u; }
            }
            __syncthreads();
            const bool alldone = (NotDone[0] == 0u);
            acc = ns_pv(c, acc, false);
            __syncthreads();
            if (alldone) break;
        }
        {
            bf16_t* op = O + (row0 + wm * 32 + r) * DM + hh * 64 + wn * 32 + 4 * h;
#pragma unroll
            for (int g = 0; g < 4; ++g) { u32x2 w; w.x = pk_bf16(acc[4 * g], acc[4 * g + 1]); w.y = pk_bf16(acc[4 * g + 2], acc[4 * g + 3]); *(u32x2*)(op + 8 * g) = w; }
        }
        __syncthreads();
    }
}

__device__ __forceinline__ void phase_subkey(const Ctx& c, const bf16_t* QV, const bf16_t* KEYS, float* TOPS, int* TOPI) {
    constexpr int SC_OFF = 73728;
    LAS float* Sc = (LAS float*)(c.lds + SC_OFF);
    const int wm = c.wave >> 1, wn = c.wave & 1, r = c.lane & 31, h = c.lane >> 5;
    for (int u = c.blk; u < 128 * 16; u += c.nblk) {
        const int hp = u & 15, pm = u >> 4;
        f32x16 acc[1][2]; acc_zero<1, 2>(acc);
        gemm_kloop<1, 2>(c, acc, QV + (size_t)pm * 128 * 2048 + hp * 128, 2048, KEYS + (size_t)hp * 128 * 128, 128, 128);
        EPI_LOOP(1, 2) {
            const int m = (wm + i) * 32 + r, n = (wn * 2 + j) * 32 + 8 * g + 4 * h;
            f32x4 o; o[0] = acc[i][j][4 * g]; o[1] = acc[i][j][4 * g + 1]; o[2] = acc[i][j][4 * g + 2]; o[3] = acc[i][j][4 * g + 3];
            *(LAS f32x4*)(Sc + m * 132 + n) = o;
        }
        __syncthreads();
        for (int rr = 0; rr < 16; ++rr) {
            const int row = c.wave * 16 + rr;
            float v0 = Sc[row * 132 + c.lane], v1 = Sc[row * 132 + 64 + c.lane];
            float ks = 0.f; int ki = 0;
            for (int it = 0; it < 16; ++it) {
                const float mx = wave_max(fmaxf(v0, v1));
                const unsigned long long b0 = __ballot(v0 == mx);
                int nsel;
                if (b0) { nsel = __ffsll((long long)b0) - 1; if (c.lane == nsel) v0 = -3e38f; }
                else { const unsigned long long b1 = __ballot(v1 == mx); const int l1 = __ffsll((long long)b1) - 1; nsel = 64 + l1; if (c.lane == l1) v1 = -3e38f; }
                if (c.lane == it) { ks = mx; ki = nsel; }
            }
            if (c.lane < 16) {
                const size_t o = ((size_t)(pm * 128 + row) * 16 + hp) * 16 + c.lane;
                TOPS[o] = ks; TOPI[o] = ki;
            }
        }
        __syncthreads();
    }
}


__device__ __forceinline__ unsigned ord_key(float s) { const unsigned u = __float_as_uint(s); return u ^ ((unsigned)((int)u >> 31) | 0x80000000u); }
__device__ __forceinline__ float unord_key(unsigned k) { const unsigned u = (k & 0x80000000u) ? (k ^ 0x80000000u) : ~k; return __uint_as_float(u); }
#define CE_DESC(a, b) do { const unsigned _hi = max((a), (b)), _lo = min((a), (b)); (a) = _hi; (b) = _lo; } while (0)
__device__ __forceinline__ void sort16_desc(unsigned (&k)[16]) {
#pragma unroll
    for (int size = 2; size <= 16; size <<= 1)
#pragma unroll
        for (int stride = size >> 1; stride > 0; stride >>= 1)
#pragma unroll
            for (int i = 0; i < 16; ++i) {
                const int j = i ^ stride;
                if (j > i) { if ((i & size) == 0) CE_DESC(k[i], k[j]); else CE_DESC(k[j], k[i]); }
            }
}
__device__ __forceinline__ void bitonic_merge16_desc(unsigned (&k)[16]) {
#pragma unroll
    for (int stride = 8; stride > 0; stride >>= 1)
#pragma unroll
        for (int i = 0; i < 16; ++i) { const int j = i ^ stride; if (j > i) CE_DESC(k[i], k[j]); }
}
__device__ __forceinline__ void top16_merge(unsigned (&a)[16], const unsigned (&b)[16]) {
#pragma unroll
    for (int i = 0; i < 16; ++i) a[i] = max(a[i], b[15 - i]);
    bitonic_merge16_desc(a);
}

__device__ __forceinline__ void phase_subkey2(const Ctx& c, const bf16_t* QV, const bf16_t* KEYS, float* TOPS, int* TOPI) {
    const lptr Ab = c.lds, Bb = c.lds + 256 * 272;
    const int r = c.lane & 31, h = c.lane >> 5;
    int cur_hp = -1;
    for (int u = c.blk; u < 64 * 16; u += c.nblk) {
        const int hp = u & 15, pm = u >> 4;
        if (hp != cur_hp) {
            cur_hp = hp;
#pragma unroll
            for (int i = 0; i < 4; ++i) { const int id = c.tid + i * NTHREADS; *(LAS u32x4*)(Bb + (id >> 4) * 272 + (id & 15) * 16) = *(const u32x4*)(KEYS + (size_t)hp * 128 * 128 + (size_t)(id >> 4) * 128 + (id & 15) * 8); }
        }
#pragma unroll
        for (int i = 0; i < 8; ++i) { const int id = c.tid + i * NTHREADS; *(LAS u32x4*)(Ab + (id >> 4) * 272 + (id & 15) * 16) = *(const u32x4*)(QV + (size_t)(pm * 256 + (id >> 4)) * 2048 + hp * 128 + (id & 15) * 8); }
        __syncthreads();
        f32x16 acc[4];
#pragma unroll
        for (int j = 0; j < 4; ++j) acc[j] = zero16();
#pragma unroll
        for (int s = 0; s < 8; ++s) {
            const bf16x8 fa = *(LAS const bf16x8*)(Ab + (c.wave * 32 + r) * 272 + s * 32 + h * 16);
#pragma unroll
            for (int j = 0; j < 4; ++j) {
                const bf16x8 fb = *(LAS const bf16x8*)(Bb + (j * 32 + r) * 272 + s * 32 + h * 16);
                acc[j] = __builtin_amdgcn_mfma_f32_32x32x16_bf16(fb, fa, acc[j], 0, 0, 0);
            }
        }
        unsigned best[16];
#pragma unroll
        for (int j = 0; j < 4; ++j) {
            unsigned k[16];
#pragma unroll
            for (int g = 0; g < 4; ++g)
#pragma unroll
                for (int e = 0; e < 4; ++e) { const int n = j * 32 + 8 * g + 4 * h + e; k[4 * g + e] = (ord_key(acc[j][4 * g + e]) & ~127u) | (unsigned)(127 - n); }
            sort16_desc(k);
            if (j == 0) {
#pragma unroll
                for (int i = 0; i < 16; ++i) best[i] = k[i];
            } else top16_merge(best, k);
        }
        {
            unsigned other[16];
#pragma unroll
            for (int i = 0; i < 16; ++i) other[i] = (unsigned)__shfl_xor((int)best[i], 32);
            top16_merge(best, other);
        }
        {
            const size_t o = ((size_t)(pm * 256 + c.wave * 32 + r) * 16 + hp) * 16 + 8 * h;
            f32x4 s0, s1; int i0[4], i1[4];
#pragma unroll
            for (int i = 0; i < 4; ++i) {
                const unsigned ka = h ? best[8 + i] : best[i], kb = h ? best[12 + i] : best[4 + i];
                s0[i] = unord_key((ka & ~127u) | 64u); s1[i] = unord_key((kb & ~127u) | 64u);
                i0[i] = 127 - (int)(ka & 127u); i1[i] = 127 - (int)(kb & 127u);
            }
            *(f32x4*)(TOPS + o) = s0; *(f32x4*)(TOPS + o + 4) = s1;
            int4 w0 = make_int4(i0[0], i0[1], i0[2], i0[3]), w1 = make_int4(i1[0], i1[1], i1[2], i1[3]);
            *(int4*)(TOPI + o) = w0; *(int4*)(TOPI + o + 4) = w1;
        }
        __syncthreads();
    }
}

__device__ __forceinline__ float gelu_erf(float x) { return 0.5f * x * (1.0f + erff(x * 0.70710678118654752f)); }
__device__ __forceinline__ void phase_peer(const Ctx& c, const float* XF, const bf16_t* XB, const float* TOPS, const int* TOPI, const bf16_t* UB, const bf16_t* VB,
                                           const float* ln_g, const float* ln_b, float* outf, bf16_t* outb, bool store) {
    LAS int* eidx = (LAS int*)(c.lds + c.wave * 1024);
    LAS float* ewt = (LAS float*)(c.lds + c.wave * 1024 + 512);
    const int lane = c.lane;
    for (int tok = c.blk * 8 + c.wave; tok < NTOK; tok += c.nblk * 8) {
        for (int hh = 0; hh < 8; ++hh) {
            const float* ts = TOPS + ((size_t)tok * 16 + hh * 2) * 16; const int* ti = TOPI + ((size_t)tok * 16 + hh * 2) * 16;
            const int a = lane >> 2, bq = (lane & 3) * 4;
            const float sa = ts[a];
            const f32x4 sb = *(const f32x4*)(ts + 16 + bq);
            float v[4] = {sa + sb[0], sa + sb[1], sa + sb[2], sa + sb[3]};
            float ks = 0.f; int kf = 0;
            for (int it = 0; it < 16; ++it) {
                const float lm = fmaxf(fmaxf(v[0], v[1]), fmaxf(v[2], v[3]));
                const float mx = wave_max(lm);
                const unsigned long long bl = __ballot(lm == mx);
                const int wl = (__ffsll((long long)bl) - 1) & 63;
                int li = (v[0] == mx) ? 0 : (v[1] == mx) ? 1 : (v[2] == mx) ? 2 : 3;
                li = __builtin_amdgcn_readlane(li, wl);
                if (lane == wl) { if (li == 0) v[0] = -3e38f; else if (li == 1) v[1] = -3e38f; else if (li == 2) v[2] = -3e38f; else v[3] = -3e38f; }
                if (lane == it) { ks = mx; kf = wl * 4 + li; }
            }
            float mx16 = (lane < 16) ? ks : -3e38f;
            mx16 = wave_max(mx16);
            const float ex = (lane < 16) ? __expf(ks - mx16) : 0.f;
            const float den = wave_sum(ex);
            if (lane < 16) {
                const int ia = ti[kf >> 4], ib = ti[16 + (kf & 15)];
                eidx[hh * 16 + lane] = (ia * 128 + ib) & 16383;
                ewt[hh * 16 + lane] = ex / den;
            }
        }
        asm volatile("s_waitcnt lgkmcnt(0)" ::: "memory");
        unsigned xb[8];
        {
            const u32x4 x0 = *(const u32x4*)(XB + (size_t)tok * DM + lane * 8), x1 = *(const u32x4*)(XB + (size_t)tok * DM + 512 + lane * 8);
            xb[0] = x0.x; xb[1] = x0.y; xb[2] = x0.z; xb[3] = x0.w; xb[4] = x1.x; xb[5] = x1.y; xb[6] = x1.z; xb[7] = x1.w;
        }
        for (int e0 = 0; e0 < 128; e0 += 8) {
            u32x4 ua[8], ub2[8];
#pragma unroll
            for (int j = 0; j < 8; ++j) {
                const int ex = __builtin_amdgcn_readfirstlane(eidx[e0 + j]);
                const bf16_t* up = UB + (size_t)ex * DM;
                ua[j] = *(const u32x4*)(up + lane * 8); ub2[j] = *(const u32x4*)(up + 512 + lane * 8);
            }
            float p[8];
#pragma unroll
            for (int j = 0; j < 8; ++j) {
                float s0 = dot2bf(xb[0], ua[j].x, 0.f), s1 = dot2bf(xb[1], ua[j].y, 0.f);
                s0 = dot2bf(xb[2], ua[j].z, s0); s1 = dot2bf(xb[3], ua[j].w, s1);
                s0 = dot2bf(xb[4], ub2[j].x, s0); s1 = dot2bf(xb[5], ub2[j].y, s1);
                s0 = dot2bf(xb[6], ub2[j].z, s0); s1 = dot2bf(xb[7], ub2[j].w, s1);
                p[j] = s0 + s1;
            }
            const bool b5 = lane & 32, b4 = lane & 16, b3 = lane & 8;
            float q4[4], q2[2], q1;
#pragma unroll
            for (int j = 0; j < 4; ++j) { const float send = b5 ? p[j] : p[j + 4], keep = b5 ? p[j + 4] : p[j]; q4[j] = keep + __shfl_xor(send, 32); }
#pragma unroll
            for (int j = 0; j < 2; ++j) { const float send = b4 ? q4[j] : q4[j + 2], keep = b4 ? q4[j + 2] : q4[j]; q2[j] = keep + __shfl_xor(send, 16); }
            { const float send = b3 ? q2[0] : q2[1], keep = b3 ? q2[1] : q2[0]; q1 = keep + __shfl_xor(send, 8); }
            q1 += __shfl_xor(q1, 4); q1 += __shfl_xor(q1, 2); q1 += __shfl_xor(q1, 1);
            const int jx = (b5 ? 4 : 0) + (b4 ? 2 : 0) + (b3 ? 1 : 0);
            if ((lane & 7) == 0) ewt[e0 + jx] = ewt[e0 + jx] * gelu_erf(q1);
        }
        asm volatile("s_waitcnt lgkmcnt(0)" ::: "memory");
        float y[16];
#pragma unroll
        for (int i = 0; i < 16; ++i) y[i] = 0.f;
        for (int e0 = 0; e0 < 128; e0 += 8) {
            u32x4 va[8], vb2[8];
#pragma unroll
            for (int j = 0; j < 8; ++j) {
                const int ex = __builtin_amdgcn_readfirstlane(eidx[e0 + j]);
                const bf16_t* vp = VB + (size_t)ex * DM;
                va[j] = *(const u32x4*)(vp + lane * 8); vb2[j] = *(const u32x4*)(vp + 512 + lane * 8);
            }
#pragma unroll
            for (int j = 0; j < 8; ++j) {
                const float w = ewt[e0 + j];
                y[0] += w * bf_lo(va[j].x); y[1] += w * bf_hi(va[j].x); y[2] += w * bf_lo(va[j].y); y[3] += w * bf_hi(va[j].y);
                y[4] += w * bf_lo(va[j].z); y[5] += w * bf_hi(va[j].z); y[6] += w * bf_lo(va[j].w); y[7] += w * bf_hi(va[j].w);
                y[8] += w * bf_lo(vb2[j].x); y[9] += w * bf_hi(vb2[j].x); y[10] += w * bf_lo(vb2[j].y); y[11] += w * bf_hi(vb2[j].y);
                y[12] += w * bf_lo(vb2[j].z); y[13] += w * bf_hi(vb2[j].z); y[14] += w * bf_lo(vb2[j].w); y[15] += w * bf_hi(vb2[j].w);
            }
        }
        {
            const float* xr = XF + (size_t)tok * DM;
            const f32x4 a0 = *(const f32x4*)(xr + lane * 8), a1 = *(const f32x4*)(xr + lane * 8 + 4), a2 = *(const f32x4*)(xr + 512 + lane * 8), a3 = *(const f32x4*)(xr + 512 + lane * 8 + 4);
            const float xs[16] = {a0[0], a0[1], a0[2], a0[3], a1[0], a1[1], a1[2], a1[3], a2[0], a2[1], a2[2], a2[3], a3[0], a3[1], a3[2], a3[3]};
            float s = 0.f;
#pragma unroll
            for (int i = 0; i < 16; ++i) { y[i] = DN_ALPHA * xs[i] + y[i]; s += y[i]; }
            const float mean = wave_sum(s) * (1.0f / 1024.0f);
            float q = 0.f;
#pragma unroll
            for (int i = 0; i < 16; ++i) { const float d = y[i] - mean; q += d * d; }
            const float rstd = rsqrtf(wave_sum(q) * (1.0f / 1024.0f) + LN_EPS);
            float o[16];
#pragma unroll
            for (int i = 0; i < 16; ++i) { const int ch = (i < 8) ? lane * 8 + i : 512 + lane * 8 + (i - 8); o[i] = (y[i] - mean) * rstd * ln_g[ch] + ln_b[ch]; }
            if (store) {
            float* of = outf + (size_t)tok * DM;
            f32x4 w;
            w[0] = o[0]; w[1] = o[1]; w[2] = o[2]; w[3] = o[3]; *(f32x4*)(of + lane * 8) = w;
            w[0] = o[4]; w[1] = o[5]; w[2] = o[6]; w[3] = o[7]; *(f32x4*)(of + lane * 8 + 4) = w;
            w[0] = o[8]; w[1] = o[9]; w[2] = o[10]; w[3] = o[11]; *(f32x4*)(of + 512 + lane * 8) = w;
            w[0] = o[12]; w[1] = o[13]; w[2] = o[14]; w[3] = o[15]; *(f32x4*)(of + 512 + lane * 8 + 4) = w;
            if (outb) {
                u32x4 pb; pb.x = pk_bf16(o[0], o[1]); pb.y = pk_bf16(o[2], o[3]); pb.z = pk_bf16(o[4], o[5]); pb.w = pk_bf16(o[6], o[7]);
                *(u32x4*)(outb + (size_t)tok * DM + lane * 8) = pb;
                pb.x = pk_bf16(o[8], o[9]); pb.y = pk_bf16(o[10], o[11]); pb.z = pk_bf16(o[12], o[13]); pb.w = pk_bf16(o[14], o[15]);
                *(u32x4*)(outb + (size_t)tok * DM + 512 + lane * 8) = pb;
            }
            }
        }
        asm volatile("s_waitcnt lgkmcnt(0)" ::: "memory");
    }
}


__device__ __forceinline__ void phase_peer2(const Ctx& c, const float* XF, const bf16_t* XB, const float* TOPS, const int* TOPI, const unsigned char* U8, const unsigned char* V8,
                                            const float* SU, const float* SV, const float* ln_g, const float* ln_b, float* outf, bf16_t* outb, bool store) {
    LAS int* ent_e = (LAS int*)(c.lds + c.wave * 16384);
    LAS float* ent_g = (LAS float*)(c.lds + c.wave * 16384 + 4096);
    LAS float* ent_su = (LAS float*)(c.lds + c.wave * 16384 + 8192);
    LAS float* ent_sv = (LAS float*)(c.lds + c.wave * 16384 + 12288);
    const int lane = c.lane;
    for (int base = (c.blk * 8 + c.wave) * 8; base < NTOK; base += c.nblk * 64) {
        {
            const int ti_ = lane >> 3, hh = lane & 7, t = base + ti_;
            const float* ts = TOPS + ((size_t)t * 16 + hh * 2) * 16; const int* tix = TOPI + ((size_t)t * 16 + hh * 2) * 16;
            float s0[16], s1[16];
#pragma unroll
            for (int i = 0; i < 4; ++i) { const f32x4 a = *(const f32x4*)(ts + 4 * i), b = *(const f32x4*)(ts + 16 + 4 * i);
                s0[4 * i] = a[0]; s0[4 * i + 1] = a[1]; s0[4 * i + 2] = a[2]; s0[4 * i + 3] = a[3]; s1[4 * i] = b[0]; s1[4 * i + 1] = b[1]; s1[4 * i + 2] = b[2]; s1[4 * i + 3] = b[3]; }
            unsigned best[16];
#pragma unroll
            for (int g = 0; g < 4; ++g) {
                unsigned k[16];
#pragma unroll
                for (int j = 0; j < 16; ++j) {
                    constexpr int cnt[16] = {16, 8, 5, 4, 3, 2, 2, 2, 1, 1, 1, 1, 1, 1, 1, 1};
                    int idx = 16 * g + j, a = -1, b = 0;
#pragma unroll
                    for (int aa = 0; aa < 16; ++aa) { if (a < 0) { if (idx < cnt[aa]) { a = aa; b = idx; } else idx -= cnt[aa]; } }
                    if (a >= 0) k[j] = (ord_key(s0[a] + s1[b]) & ~255u) | (unsigned)(255 - (a * 16 + b)); else k[j] = 0u;
                }
                sort16_desc(k);
                if (g == 0) {
#pragma unroll
                    for (int i = 0; i < 16; ++i) best[i] = k[i];
                } else top16_merge(best, k);
            }
            float sc[16]; int ee[16]; float mx = -3e38f;
#pragma unroll
            for (int k = 0; k < 16; ++k) {
                const int f = 255 - (int)(best[k] & 255u), a = f >> 4, b = f & 15;
                sc[k] = ts[a] + ts[16 + b]; ee[k] = tix[a] * 128 + tix[16 + b];
                mx = fmaxf(mx, sc[k]);
            }
            float den = 0.f;
#pragma unroll
            for (int k = 0; k < 16; ++k) { sc[k] = __expf(sc[k] - mx); den += sc[k]; }
            const float rden = 1.0f / den;
#pragma unroll
            for (int k = 0; k < 16; ++k) {
                const int e = ee[k] & 16383, slot = ti_ * 128 + hh * 16 + k;
                ent_e[slot] = e; ent_g[slot] = sc[k] * rden; ent_su[slot] = SU[e]; ent_sv[slot] = SV[e];
            }
        }
        asm volatile("s_waitcnt lgkmcnt(0)" ::: "memory");
#pragma unroll 1
        for (int ti_ = 0; ti_ < 8; ++ti_) {
            const int tok = base + ti_;
            LAS const int* ee = ent_e + ti_ * 128; LAS float* eg = ent_g + ti_ * 128; LAS const float* esu = ent_su + ti_ * 128; LAS const float* esv = ent_sv + ti_ * 128;
            int xq[4]; float sx;
            {
                const u32x4 x0 = *(const u32x4*)(XB + (size_t)tok * DM + lane * 16), x1 = *(const u32x4*)(XB + (size_t)tok * DM + lane * 16 + 8);
                const unsigned xw[8] = {x0.x, x0.y, x0.z, x0.w, x1.x, x1.y, x1.z, x1.w};
                float xv[16]; float am = 0.f;
#pragma unroll
                for (int i = 0; i < 8; ++i) { xv[2 * i] = bf_lo(xw[i]); xv[2 * i + 1] = bf_hi(xw[i]); am = fmaxf(am, fmaxf(fabsf(xv[2 * i]), fabsf(xv[2 * i + 1]))); }
                am = wave_max(am);
                const float inv = am > 0.f ? 127.0f / am : 0.f; sx = am * (1.0f / 127.0f);
#pragma unroll
                for (int i = 0; i < 4; ++i) {
                    unsigned pk = 0u;
#pragma unroll
                    for (int e = 0; e < 4; ++e) { const int q = (int)__builtin_rintf(xv[4 * i + e] * inv); pk |= ((unsigned)q & 0xffu) << (8 * e); }
                    xq[i] = (int)pk;
                }
            }
#pragma unroll 1
            for (int e0 = 0; e0 < 128; e0 += 16) {
                u32x4 ur[16];
#pragma unroll
                for (int j = 0; j < 16; ++j) { const int ex = __builtin_amdgcn_readfirstlane(ee[e0 + j]); ur[j] = *(const u32x4*)(U8 + (size_t)ex * 1024 + lane * 16); }
                int p[16];
#pragma unroll
                for (int j = 0; j < 16; ++j) {
                    int a = __builtin_amdgcn_sdot4(xq[0], (int)ur[j].x, 0, false);
                    a = __builtin_amdgcn_sdot4(xq[1], (int)ur[j].y, a, false);
                    a = __builtin_amdgcn_sdot4(xq[2], (int)ur[j].z, a, false);
                    p[j] = __builtin_amdgcn_sdot4(xq[3], (int)ur[j].w, a, false);
                }
                const bool b5 = lane & 32, b4 = lane & 16, b3 = lane & 8, b2 = lane & 4;
                int q8[8], q4[4], q2[2], q1;
#pragma unroll
                for (int j = 0; j < 8; ++j) { const int send = b5 ? p[j] : p[j + 8], keep = b5 ? p[j + 8] : p[j]; q8[j] = keep + __shfl_xor(send, 32); }
#pragma unroll
                for (int j = 0; j < 4; ++j) { const int send = b4 ? q8[j] : q8[j + 4], keep = b4 ? q8[j + 4] : q8[j]; q4[j] = keep + __shfl_xor(send, 16); }
#pragma unroll
                for (int j = 0; j < 2; ++j) { const int send = b3 ? q4[j] : q4[j + 2], keep = b3 ? q4[j + 2] : q4[j]; q2[j] = keep + __shfl_xor(send, 8); }
                { const int send = b2 ? q2[0] : q2[1], keep = b2 ? q2[1] : q2[0]; q1 = keep + __shfl_xor(send, 4); }
                q1 += __shfl_xor(q1, 2); q1 += __shfl_xor(q1, 1);
                if ((lane & 3) == 0) {
                    const int jx = e0 + (lane >> 2);
                    const float dot = esu[jx] * sx * (float)q1;
                    eg[jx] = eg[jx] * gelu_erf(dot) * esv[jx];
                }
            }
            asm volatile("s_waitcnt lgkmcnt(0)" ::: "memory");
            float y[16]; float sw = 0.f;
#pragma unroll
            for (int i = 0; i < 16; ++i) y[i] = 0.f;
#pragma unroll 1
            for (int e0 = 0; e0 < 128; e0 += 16) {
                u32x4 vr[16];
#pragma unroll
                for (int j = 0; j < 16; ++j) { const int ex = __builtin_amdgcn_readfirstlane(ee[e0 + j]); vr[j] = *(const u32x4*)(V8 + (size_t)ex * 1024 + lane * 16); }
#pragma unroll
                for (int j = 0; j < 16; ++j) {
                    const float w = eg[e0 + j]; sw += w;
                    const unsigned vw[4] = {vr[j].x, vr[j].y, vr[j].z, vr[j].w};
#pragma unroll
                    for (int i = 0; i < 4; ++i) {
                        y[4 * i + 0] += w * (float)(vw[i] & 0xffu); y[4 * i + 1] += w * (float)((vw[i] >> 8) & 0xffu);
                        y[4 * i + 2] += w * (float)((vw[i] >> 16) & 0xffu); y[4 * i + 3] += w * (float)(vw[i] >> 24);
                    }
                }
            }
            {
                const float* xr = XF + (size_t)tok * DM + lane * 16;
                const f32x4 a0 = *(const f32x4*)(xr), a1 = *(const f32x4*)(xr + 4), a2 = *(const f32x4*)(xr + 8), a3 = *(const f32x4*)(xr + 12);
                const float xs[16] = {a0[0], a0[1], a0[2], a0[3], a1[0], a1[1], a1[2], a1[3], a2[0], a2[1], a2[2], a2[3], a3[0], a3[1], a3[2], a3[3]};
                float s = 0.f;
#pragma unroll
                for (int i = 0; i < 16; ++i) { y[i] = DN_ALPHA * xs[i] + (y[i] - 128.0f * sw); s += y[i]; }
                const float mean = wave_sum(s) * (1.0f / 1024.0f);
                float q = 0.f;
#pragma unroll
                for (int i = 0; i < 16; ++i) { const float d = y[i] - mean; q += d * d; }
                const float rstd = rsqrtf(wave_sum(q) * (1.0f / 1024.0f) + LN_EPS);
                float o[16];
#pragma unroll
                for (int i = 0; i < 4; ++i) {
                    const f32x4 gg = *(const f32x4*)(ln_g + lane * 16 + 4 * i), bb = *(const f32x4*)(ln_b + lane * 16 + 4 * i);
#pragma unroll
                    for (int e = 0; e < 4; ++e) o[4 * i + e] = (y[4 * i + e] - mean) * rstd * gg[e] + bb[e];
                }
                if (store) {
                    float* of = outf + (size_t)tok * DM + lane * 16;
#pragma unroll
                    for (int i = 0; i < 4; ++i) { f32x4 w; w[0] = o[4 * i]; w[1] = o[4 * i + 1]; w[2] = o[4 * i + 2]; w[3] = o[4 * i + 3]; *(f32x4*)(of + 4 * i) = w; }
                    if (outb) {
                        u32x4 pb; pb.x = pk_bf16(o[0], o[1]); pb.y = pk_bf16(o[2], o[3]); pb.z = pk_bf16(o[4], o[5]); pb.w = pk_bf16(o[6], o[7]);
                        *(u32x4*)(outb + (size_t)tok * DM + lane * 16) = pb;
                        pb.x = pk_bf16(o[8], o[9]); pb.y = pk_bf16(o[10], o[11]); pb.z = pk_bf16(o[12], o[13]); pb.w = pk_bf16(o[14], o[15]);
                        *(u32x4*)(outb + (size_t)tok * DM + lane * 16 + 8) = pb;
                    }
                }
            }
        }
        asm volatile("s_waitcnt lgkmcnt(0)" ::: "memory");
    }
}

__device__ __forceinline__ void quant_rows(const Ctx& c, const float* src, unsigned char* dst, float* scale, int R, int bias) {
    const int gw = c.blk * 8 + c.wave, nw = c.nblk * 8;
    for (int row = gw; row < R; row += nw) {
        const f32x4* p = (const f32x4*)(src + (size_t)row * 1024 + c.lane * 16);
        f32x4 v[4]; float am = 0.f;
#pragma unroll
        for (int i = 0; i < 4; ++i) { v[i] = p[i]; am = fmaxf(am, fmaxf(fmaxf(fabsf(v[i][0]), fabsf(v[i][1])), fmaxf(fabsf(v[i][2]), fabsf(v[i][3])))); }
        am = wave_max(am);
        const float inv = am > 0.f ? 127.0f / am : 0.f;
        unsigned w[4];
#pragma unroll
        for (int i = 0; i < 4; ++i) {
            unsigned pk = 0u;
#pragma unroll
            for (int e = 0; e < 4; ++e) { const int q = (int)__builtin_rintf(v[i][e] * inv) + bias; pk |= ((unsigned)q & 0xffu) << (8 * e); }
            w[i] = pk;
        }
        u32x4 o; o.x = w[0]; o.y = w[1]; o.z = w[2]; o.w = w[3];
        *(u32x4*)(dst + (size_t)row * 1024 + c.lane * 16) = o;
        if (c.lane == 0) scale[row] = am > 0.f ? am * (1.0f / 127.0f) : 1.0f;
    }
}

__device__ __forceinline__ void phase_prologue(const Ctx& c, const Args& a, bf16_t* WC, float* CB, bf16_t* WIN, bf16_t* WG, bf16_t* WB, bf16_t* WO, bf16_t* WQ, bf16_t* KEYS, bf16_t* UB, bf16_t* VB, float* HF, bf16_t* HB) {
#pragma unroll 1
    for (int l = 0; l < 2; ++l) {
        transpose_cvt(c, a.in[3] + (size_t)l * 1024 * W_IN_LD, W_IN_LD, 1024, 0, 3228, NY, 1, WIN + (size_t)l * NY * 1024, 1024);
        transpose_cvt(c, a.in[3] + (size_t)l * 1024 * W_IN_LD, W_IN_LD, 1024, W_MG, 4096, 4096, 0, WG + (size_t)l * 4096 * 1024, 1024);
#pragma unroll 1
        for (int nb = 0; nb < 4; ++nb)
            transpose_cvt(c, a.in[12] + (size_t)(l * 4 + nb) * 256 * 1024, 1024, 256, 0, 1024, 1024, 0, WB + (size_t)(l * 4 + nb) * 1024 * 256, 256);
        transpose_cvt(c, a.in[13] + (size_t)l * 1024 * 1024, 1024, 1024, 0, 1024, 1024, 0, WO + (size_t)l * 1024 * 1024, 1024);
        transpose_cvt(c, a.in[16] + (size_t)l * 1024 * 2048, 2048, 1024, 0, 2048, 2048, 0, WQ + (size_t)l * 2048 * 1024, 1024);
#pragma unroll 1
        for (int kv = 0; kv < 2; ++kv) {
            const float* w = a.in[5 + kv] + (size_t)l * 2048 * 64;
            transpose_cvt(c, w, 64, 1024, 0, 64, 64, 0, WC + (size_t)(l * 2 + kv) * 128 * 1024, 1024);
            transpose_cvt(c, w + 1024 * 64, 64, 1024, 0, 64, 64, 0, WC + (size_t)(l * 2 + kv) * 128 * 1024 + 64 * 1024, 1024);
        }
    }
    {
        const int gw = c.blk * 8 + c.wave;
        if (gw < 256) {
            const int d = gw & 63, kv = (gw >> 6) & 1, l = gw >> 7;
            const float* w = a.in[5 + kv] + (size_t)l * 2048 * 64; const float* pos = a.in[4] + (size_t)l * 2048;
            float sacc = 0.f;
            for (int k = c.lane; k < 2048; k += 64) sacc += pos[k] * w[(size_t)k * 64 + d];
            sacc = wave_sum(sacc);
            if (c.lane == 0) CB[gw] = sacc;
        }
    }
    convert_flat(c, a.in[17], KEYS, (size_t)2 * 16 * 128 * 128);
    quant_rows(c, a.in[18], (unsigned char*)UB, (float*)((unsigned char*)UB + 32 * MB), 2 * 16384, 0);
    quant_rows(c, a.in[19], (unsigned char*)VB, (float*)((unsigned char*)VB + 32 * MB), 2 * 16384, 128);
    ln_rows(c, a.in[0], a.in[1], a.in[2], HF, HB);
}

constexpr int PH_PER_LAYER = 10, N_PHASES = 1 + 2 * PH_PER_LAYER;

__global__ void __launch_bounds__(NTHREADS, 2) mk_fwd(Args a) {
    extern __shared__ __attribute__((aligned(16))) unsigned char lds_raw[];
    Ctx c0;
    c0.lds = (lptr)lds_raw; c0.tid = threadIdx.x; c0.lane = c0.tid & 63; c0.wave = __builtin_amdgcn_readfirstlane(c0.tid >> 6);
    c0.nblk = gridDim.x; c0.blk = blockIdx.x; c0.ws = a.ws;
    volatile LAS unsigned* st = (volatile LAS unsigned*)(c0.lds + LDS_BYTES - 16);
    if (c0.tid == 0) { st[0] = 0u; st[1] = 0u; st[2] = 0u; st[3] = 0u; }
    __syncthreads();
    const int lo = a.ph_lo, hi = a.ph_hi;
    XcdBarrier bar; bar.bar = (unsigned*)(a.ws + WS_CTL); bar.x = 0; bar.st = st;
    if (hi - lo > 1) bar = xcd_barrier_post((unsigned*)(a.ws + WS_CTL), st);
#define IN(k) (lo <= (k) && (k) < hi)
#ifndef ONLY_PHASE
#define ONLY_PHASE -1
#endif
#define EN(j) (ONLY_PHASE < 0 || ONLY_PHASE == (j))
#define SEAM(k) do { if (IN(k) && IN((k) + 1)) xcd_barrier(bar); } while (0)
#define FRESH() Ctx c = c0; asm volatile("" : "+v"(c.tid)); c.lane = c.tid & 63; asm volatile("" : "+s"(c.wave), "+s"(c.blk), "+s"(c.nblk))

    unsigned char* ws = a.ws;
    float* HF = (float*)(ws + WS_HF); bf16_t* HB = (bf16_t*)(ws + WS_HB); bf16_t* Y = (bf16_t*)(ws + WS_Y); float* Z = (float*)(ws + WS_Z);
    float* TOPS = (float*)(ws + WS_TOPS); int* TOPI = (int*)(ws + WS_TOPI); bf16_t* O = (bf16_t*)(ws + WS_O); bf16_t* MIX = (bf16_t*)(ws + WS_MIX);
    bf16_t* QV = (bf16_t*)(ws + WS_QV); float* UST = (float*)(ws + WS_UST); float* RST = (float*)(ws + WS_RST); float* UGLA = (float*)(ws + WS_UGLA);
    float* SGLA = (float*)(ws + WS_SGLA); float* BL = (float*)(ws + WS_BL); bf16_t* KC = (bf16_t*)(ws + WS_KC); bf16_t* VC = (bf16_t*)(ws + WS_VC);
    bf16_t* WIN = (bf16_t*)(ws + WS_WIN); bf16_t* WG = (bf16_t*)(ws + WS_WG); bf16_t* WB = (bf16_t*)(ws + WS_WB); bf16_t* WO = (bf16_t*)(ws + WS_WO);
    bf16_t* WQ = (bf16_t*)(ws + WS_WQ); bf16_t* KEYS = (bf16_t*)(ws + WS_KEYS); bf16_t* UB = (bf16_t*)(ws + WS_UB); bf16_t* VB = (bf16_t*)(ws + WS_VB);

#ifndef REP_MASK
#define REP_MASK 0
#endif
#define NREP(j) (((REP_MASK >> (j)) & 1) ? 2 : 1)
#define RUN(j, k, body) do { if (IN(k) && EN(j)) { _Pragma("unroll 1") for (int rr = 0; rr < NREP(j); ++rr) { if (rr) xcd_barrier(bar); FRESH(); body; } } } while (0)
    RUN(10, 0, phase_prologue(c, a, (bf16_t*)(ws + WS_WC), (float*)(ws + WS_CB), WIN, WG, WB, WO, WQ, KEYS, UB, VB, HF, HB));
    SEAM(0);
#ifndef SUB1
#define SUB1 15
#endif
#ifndef SUB
#define SUB 7
#endif
#pragma unroll 1
    for (int l = 0; l < 2; ++l) {
        const int pb = 1 + l * PH_PER_LAYER;
        RUN(0, pb + 0, phase_inproj(c, HB, WIN + (size_t)l * NY * 1024, Y));
        SEAM(pb + 0);
        RUN(1, pb + 1, {
            if (SUB1 & 1) phase_sb2(c, Y, O);
#ifdef PROBE_SB
            phase_sb2(c, Y, O);
#endif
            if (SUB1 & 2) phase_compress2(c, Y, (const bf16_t*)(ws + WS_WC) + (size_t)l * 2 * 128 * 1024, (float*)(ws + WS_RC));
            if (SUB1 & 4) phase_ret_local(c, Y, UST);
            if (SUB1 & 8) phase_gla_local(c, Y, a.in[9] + (size_t)l * 16 * 128, a.in[10] + (size_t)l * 128, UGLA, BL);
        });
        SEAM(pb + 1);
        RUN(2, pb + 2, { phase_scans(c, UST, RST, UGLA, SGLA, BL); phase_compress_combine(c, (const float*)(ws + WS_RC), (const float*)(ws + WS_CB) + l * 128, KC, VC); });
        SEAM(pb + 2);
        RUN(3, pb + 3, {
            if (SUB & 1) phase_nsa(c, Y, KC, VC, O);
#ifdef PROBE_NSA
            phase_nsa(c, Y, KC, VC, O);
#endif
            if (SUB & 2) phase_ret_out(c, Y, RST, a.in[7] + (size_t)l * 256, a.in[8] + (size_t)l * 256, O);
            if (SUB & 4) phase_gla_out(c, Y, a.in[9] + (size_t)l * 16 * 128, a.in[10] + (size_t)l * 128, SGLA, a.in[11] + (size_t)l * 256, O);
        });
        SEAM(pb + 3);
        RUN(4, pb + 4, phase_merge(c, HB, WG + (size_t)l * 4096 * 1024, O, WB + (size_t)l * 4 * 1024 * 256, MIX));
        SEAM(pb + 4);
        RUN(5, pb + 5, phase_outproj(c, MIX, WO + (size_t)l * 1024 * 1024, HF, Z));
        SEAM(pb + 5);
        RUN(6, pb + 6, ln_rows(c, Z, a.in[14] + (size_t)l * 1024, a.in[15] + (size_t)l * 1024, HF, HB));
        SEAM(pb + 6);
        RUN(7, pb + 7, phase_wq(c, HB, WQ + (size_t)l * 2048 * 1024, QV));
        SEAM(pb + 7);
        RUN(8, pb + 8, phase_subkey2(c, QV, KEYS + (size_t)l * 16 * 128 * 128, TOPS, TOPI));
        SEAM(pb + 8);
        RUN(9, pb + 9, phase_peer2(c, HF, HB, TOPS, TOPI, (const unsigned char*)UB + (size_t)l * 16384 * 1024, (const unsigned char*)VB + (size_t)l * 16384 * 1024,
                                   (const float*)(ws + WS_SU) + (size_t)l * 16384, (const float*)(ws + WS_SV) + (size_t)l * 16384,
                                   a.in[20] + (size_t)l * 1024, a.in[21] + (size_t)l * 1024, (l == 1) ? a.out : HF, (l == 1) ? (bf16_t*)nullptr : HB,
                                   (rr == NREP(9) - 1) || (lo > 1000)));
        SEAM(pb + 9);
    }
#undef RUN
#undef IN
#undef SEAM
#undef FRESH
}


#ifndef DBG_DUMP
#define DBG_DUMP 0
#endif
#ifndef DBG_C0
#define DBG_C0 0
#endif
#ifndef DBG_C1
#define DBG_C1 1024
#endif
__global__ void dbg_dump(const unsigned char* ws, float* out, int sel) {
    const size_t n = (size_t)NTOK * DM;
    for (size_t i = (size_t)blockIdx.x * blockDim.x + threadIdx.x; i < n; i += (size_t)gridDim.x * blockDim.x) {
        const int col = (int)(i & 1023);
        float v = 0.f;
        if (col >= DBG_C0 && col < DBG_C1) {
            if (sel == 1) v = bf2f(((const bf16_t*)(ws + WS_O))[i]);
            else if (sel == 2) v = ((const float*)(ws + WS_HF))[i];
            else if (sel == 3) v = bf2f(((const bf16_t*)(ws + WS_Y))[(i >> 10) * NY + col]);
            else if (sel == 4) v = bf2f(((const bf16_t*)(ws + WS_Y))[(i >> 10) * NY + 1024 + col]);
            else if (sel == 5) v = bf2f(((const bf16_t*)(ws + WS_Y))[(i >> 10) * NY + 2048 + col]);
            else if (sel == 6) v = bf2f(((const bf16_t*)(ws + WS_MIX))[i]);
            else if (sel == 7) v = ((const float*)(ws + WS_Z))[i];
        }
        out[i] = v;
    }
}

extern "C" void kernel_launch(void* const* d_in, const int* in_sizes, int n_in, void* d_out, int out_size, void* d_ws, size_t ws_size, hipStream_t stream) {
    static int grid = 0;
    if (grid == 0) {
        if (n_in != 22 || out_size != NTOK * DM || ws_size < WS_END) { fprintf(stderr, "kernel_launch: unexpected shapes (n_in %d out %d ws %zu need %zu)\n", n_in, out_size, ws_size, (size_t)WS_END); grid = -1; return; }
        int dev = 0, cus = 0, per_cu = 0;
        if (hipGetDevice(&dev) != hipSuccess || hipDeviceGetAttribute(&cus, hipDeviceAttributeMultiprocessorCount, dev) != hipSuccess) { grid = -1; return; }
        if (hipFuncSetAttribute((const void*)mk_fwd, hipFuncAttributeMaxDynamicSharedMemorySize, LDS_BYTES) != hipSuccess) { fprintf(stderr, "kernel_launch: hipFuncSetAttribute failed\n"); grid = -1; return; }
        if (hipOccupancyMaxActiveBlocksPerMultiprocessor(&per_cu, (const void*)mk_fwd, NTHREADS, LDS_BYTES) != hipSuccess || per_cu < 1) { fprintf(stderr, "kernel_launch: occupancy query says %d\n", per_cu); }
        (void)hipGetLastError();
        grid = cus;
    }
    if (grid < 0) return;
    (void)hipMemsetAsync((char*)d_ws + WS_CTL, 0, XCD_BAR_WORDS * sizeof(unsigned), stream);
    Args a{};
    for (int i = 0; i < 22; ++i) a.in[i] = (const float*)d_in[i];
    a.out = (float*)d_out; a.ws = (unsigned char*)d_ws;
#if ONE_LAUNCH
    a.ph_lo = 0; a.ph_hi = N_PHASES;
    hipLaunchKernelGGL(mk_fwd, dim3(grid), dim3(NTHREADS), LDS_BYTES, stream, a);
#else
#ifndef DBG_PH_HI
#define DBG_PH_HI N_PHASES
#endif
#ifndef DBG_PH_LO
#define DBG_PH_LO 0
#endif
    for (int p = DBG_PH_LO; p < DBG_PH_HI; ++p) {
        a.ph_lo = p; a.ph_hi = p + 1;
        hipLaunchKernelGGL(mk_fwd, dim3(grid), dim3(NTHREADS), LDS_BYTES, stream, a);
    }
    if (DBG_DUMP) hipLaunchKernelGGL(dbg_dump, dim3(1024), dim3(256), 0, stream, (const unsigned char*)d_ws, (float*)d_out, (int)DBG_DUMP);
#endif
}
```

```cpp
#include <hip/hip_runtime.h>
#include <stdint.h>
#include <stdio.h>

#ifndef ONE_LAUNCH
#define ONE_LAUNCH 1
#endif

#define LAS __attribute__((address_space(3)))
typedef unsigned short bf16_t;
typedef short bf16x8 __attribute__((ext_vector_type(8)));
typedef float f32x4 __attribute__((ext_vector_type(4)));
typedef float f32x16 __attribute__((ext_vector_type(16)));
typedef unsigned u32x4 __attribute__((ext_vector_type(4)));
typedef unsigned u32x2 __attribute__((ext_vector_type(2)));
typedef __bf16 bf2_t __attribute__((ext_vector_type(2)));
typedef LAS unsigned char* lptr;

constexpr int NTOK = 16384, SEQ = 8192, DM = 1024, NB = 2;
constexpr int NY = 3328;
constexpr int W_IN_LD = 7324;
constexpr int NIN = NY + 4096;
constexpr int C_SBQ = 0, C_SBK = 256, C_SBV = 512, C_NQ = 768, C_NKC = 1024, C_NVC = 1088, C_NKS = 1152, C_NVS = 1216, C_NKW = 1280, C_NVW = 1344;
constexpr int C_RQ = 1408, C_RK = 1664, C_RV = 1920, C_RG = 2176, C_GQ = 2432, C_GK = 2560, C_GV = 2688, C_GR = 2944, C_NG = 3200, C_GLR = 3216;
constexpr int W_MG = 3228;
constexpr float NEGF = -1e30f;
constexpr float LN_EPS = 1e-5f;
constexpr float DN_ALPHA = 1.41421356237f;

constexpr int NTHREADS = 512;
constexpr int LDS_BYTES = 147456;

constexpr size_t MB = 1024 * 1024;
constexpr size_t WS_CTL   = 0;
constexpr size_t WS_HF    = 1 * MB;
constexpr size_t WS_HB    = WS_HF + 64 * MB;
constexpr size_t WS_Y     = WS_HB + 32 * MB;
constexpr size_t WS_Z     = WS_Y;
constexpr size_t WS_TOPS  = WS_Y + 64 * MB;
constexpr size_t WS_TOPI  = WS_TOPS + 16 * MB;
constexpr size_t WS_O     = WS_Y + 104 * MB;
constexpr size_t WS_MIX   = WS_O + 32 * MB;
constexpr size_t WS_QV    = WS_O;
constexpr size_t WS_UST   = WS_MIX + 32 * MB;
constexpr size_t WS_RST   = WS_UST + 8 * MB;
constexpr size_t WS_UGLA  = WS_RST + 8 * MB;
constexpr size_t WS_SGLA  = WS_UGLA + 8 * MB;
constexpr size_t WS_BL    = WS_SGLA + 8 * MB;
constexpr size_t WS_KC    = WS_BL + 1 * MB;
constexpr size_t WS_VC    = WS_KC + 1 * MB;
constexpr size_t WS_WIN   = WS_VC + 1 * MB;
constexpr size_t WS_WG    = WS_WIN + 14 * MB;
constexpr size_t WS_WB    = WS_WG + 16 * MB;
constexpr size_t WS_WO    = WS_WB + 4 * MB;
constexpr size_t WS_WQ    = WS_WO + 4 * MB;
constexpr size_t WS_KEYS  = WS_WQ + 8 * MB;
constexpr size_t WS_UB    = WS_KEYS + 1 * MB;
constexpr size_t WS_VB    = WS_UB + 32 * MB;
constexpr size_t WS_SU    = WS_UB + 64 * MB;
constexpr size_t WS_SV    = WS_SU + 256 * 1024;
constexpr size_t WS_G     = WS_UB + 65 * MB;
constexpr size_t WS_WC    = WS_G + 64 * MB;
constexpr size_t WS_RC    = WS_WC + 1 * MB;
constexpr size_t WS_CB    = WS_RC + 1 * MB;
constexpr size_t WS_END   = WS_CB + 1 * MB;

typedef float f32x2_t __attribute__((ext_vector_type(2)));
__device__ __forceinline__ unsigned pk_bf16(float lo, float hi) { f32x2_t v = {lo, hi}; bf2_t b = __builtin_convertvector(v, bf2_t); return __builtin_bit_cast(unsigned, b); }
__device__ __forceinline__ float bf_lo(unsigned u) { return __uint_as_float(u << 16); }
__device__ __forceinline__ float bf_hi(unsigned u) { return __uint_as_float(u & 0xffff0000u); }
__device__ __forceinline__ bf16_t f2bf(float f) { return (bf16_t)(pk_bf16(f, f) & 0xffffu); }
__device__ __forceinline__ float bf2f(bf16_t b) { return __uint_as_float(((unsigned)b) << 16); }
__device__ __forceinline__ float wave_sum(float v) {
#pragma unroll
    for (int o = 32; o; o >>= 1) v += __shfl_xor(v, o);
    return v;
}
__device__ __forceinline__ float wave_max(float v) {
#pragma unroll
    for (int o = 32; o; o >>= 1) v = fmaxf(v, __shfl_xor(v, o));
    return v;
}
__device__ __forceinline__ float sigmoidf_(float x) { return 1.0f / (1.0f + __expf(-x)); }
__device__ __forceinline__ float softplusf_(float x) { return fmaxf(x, 0.f) + __logf(1.0f + __expf(-fabsf(x))); }
__device__ __forceinline__ float siluf_(float x) { return x * sigmoidf_(x); }
__device__ __forceinline__ float dot2bf(unsigned a, unsigned b, float c) {
    return __builtin_amdgcn_fdot2_f32_bf16(__builtin_bit_cast(bf2_t, a), __builtin_bit_cast(bf2_t, b), c, false);
}

#define XB_TMO      128
#define XB_XCNT(j)  (256  + 64 * (j))
#define XB_XSUB(j)  (1280 + 64 * (j))
#define XB_XGEN(j)  (2304 + 64 * (j))
#define XB_TOP      3328
#define XB_TOPGEN   3392
#define XCD_BAR_WORDS 3456
#define XB_SPIN_CAP (1u << 22)

__device__ __forceinline__ unsigned xb_ld(unsigned* p)              { return __hip_atomic_load(p, __ATOMIC_RELAXED, __HIP_MEMORY_SCOPE_AGENT); }
__device__ __forceinline__ unsigned xb_add(unsigned* p, unsigned v) { return __hip_atomic_fetch_add(p, v, __ATOMIC_RELAXED, __HIP_MEMORY_SCOPE_AGENT); }
__device__ __forceinline__ unsigned xb_xcc_id() { return (unsigned)__builtin_amdgcn_s_getreg((3 << 11) | 20) & 0xFu; }
#define XB_SPIN(cond, bar) do { unsigned _sp = 0; while (cond) { __builtin_amdgcn_s_sleep(1); \
    if ((++_sp & 255u) == 0u) { if (xb_ld(&(bar)[XB_TMO])) break; if (_sp > XB_SPIN_CAP) { atomicAdd(&(bar)[XB_TMO], 1u); break; } } } } while (0)

struct XcdBarrier { unsigned* bar; unsigned x; volatile LAS unsigned* st; };

__device__ __forceinline__ XcdBarrier xcd_barrier_post(unsigned* bar, volatile LAS unsigned* st) {
    XcdBarrier b; b.bar = bar; b.x = xb_xcc_id(); b.st = st;
    if (threadIdx.x == 0) (void)xb_add(&bar[XB_XCNT(b.x)], 1u);
    return b;
}
__device__ __forceinline__ void xcd_barrier_complete(unsigned* bar, unsigned x, unsigned& nloc, unsigned& nx) {
    const unsigned G = gridDim.x * gridDim.y * gridDim.z;
    unsigned sum, cnt, mine, sp = 0u;
    for (;;) {
        sum = 0u; cnt = 0u; mine = 0u;
#pragma unroll
        for (unsigned j = 0; j < 16; ++j) { const unsigned c = xb_ld(&bar[XB_XCNT(j)]); sum += c; cnt += (c > 0u) ? 1u : 0u; mine = (j == x) ? c : mine; }
        if (sum == G) break;
        __builtin_amdgcn_s_sleep(1);
        if ((++sp & 255u) == 0u) { if (xb_ld(&bar[XB_TMO])) break; if (sp > XB_SPIN_CAP) { atomicAdd(&bar[XB_TMO], 1u); break; } }
    }
    nloc = mine > 0u ? mine : 1u; nx = cnt > 0u ? cnt : 1u;
}
__device__ __forceinline__ void xcd_barrier(const XcdBarrier& b) {
    asm volatile("s_waitcnt vmcnt(0)" ::: "memory");
    __syncthreads();
    if (threadIdx.x == 0) {
        unsigned* bar = b.bar;
        __builtin_amdgcn_s_waitcnt(0);
        unsigned nloc = b.st[0], nx = b.st[1];
        if (nloc == 0u) { xcd_barrier_complete(bar, b.x, nloc, nx); b.st[0] = nloc; b.st[1] = nx; }
        const unsigned old = xb_add(&bar[XB_XSUB(b.x)], 1u);
        const unsigned gen = old / nloc;
        if (old + 1u == (gen + 1u) * nloc) {
            __builtin_amdgcn_fence(__ATOMIC_RELEASE, "agent");
            asm volatile("s_waitcnt vmcnt(0)" ::: "memory");
            const unsigned og = xb_add(&bar[XB_TOP], 1u);
            const unsigned tg = og / nx;
            if (og + 1u == (tg + 1u) * nx) xb_add(&bar[XB_TOPGEN], 1u);
            else XB_SPIN(xb_ld(&bar[XB_TOPGEN]) == tg, bar);
            __builtin_amdgcn_fence(__ATOMIC_ACQUIRE, "agent");
            xb_add(&bar[XB_XGEN(b.x)], 1u);
            asm volatile("s_waitcnt vmcnt(0)" ::: "memory");
        } else {
            XB_SPIN(xb_ld(&bar[XB_XGEN(b.x)]) == gen, bar);
            __builtin_amdgcn_fence(__ATOMIC_ACQUIRE, "agent");
            asm volatile("s_waitcnt vmcnt(0)" ::: "memory");
        }
    }
    __syncthreads();
}

struct Args { const float* in[22]; float* out; unsigned char* ws; int ph_lo, ph_hi; };
struct Ctx {
    lptr lds; int tid, lane, wave, nblk, blk;
    unsigned char* ws;
};

__device__ __forceinline__ void ln_rows(const Ctx& c, const float* src, const float* g, const float* b, float* outf, bf16_t* outb) {
    const int gw = c.blk * 8 + c.wave, nw = c.nblk * 8;
    for (int row0 = gw * 2; row0 < NTOK; row0 += nw * 2) {
        f32x4 v[2][4]; float mean[2], rstd[2];
#pragma unroll
        for (int rr = 0; rr < 2; ++rr) {
            const f32x4* p = (const f32x4*)(src + (size_t)(row0 + rr) * DM);
#pragma unroll
            for (int i = 0; i < 4; ++i) v[rr][i] = p[i * 64 + c.lane];
        }
#pragma unroll
        for (int rr = 0; rr < 2; ++rr) {
            float s = 0.f;
#pragma unroll
            for (int i = 0; i < 4; ++i) s += (v[rr][i][0] + v[rr][i][1]) + (v[rr][i][2] + v[rr][i][3]);
            mean[rr] = wave_sum(s) * (1.0f / 1024.0f);
            float q = 0.f;
#pragma unroll
            for (int i = 0; i < 4; ++i) { const f32x4 d = v[rr][i] - mean[rr]; q += (d[0] * d[0] + d[1] * d[1]) + (d[2] * d[2] + d[3] * d[3]); }
            rstd[rr] = rsqrtf(wave_sum(q) * (1.0f / 1024.0f) + LN_EPS);
        }
#pragma unroll
        for (int i = 0; i < 4; ++i) {
            const int idx = i * 64 + c.lane;
            const f32x4 gg = ((const f32x4*)g)[idx], bb = ((const f32x4*)b)[idx];
#pragma unroll
            for (int rr = 0; rr < 2; ++rr) {
                const f32x4 y = (v[rr][i] - mean[rr]) * rstd[rr] * gg + bb;
                if (outf) ((f32x4*)(outf + (size_t)(row0 + rr) * DM))[idx] = y;
                if (outb) { u32x2 w; w.x = pk_bf16(y[0], y[1]); w.y = pk_bf16(y[2], y[3]); ((u32x2*)(outb + (size_t)(row0 + rr) * DM))[idx] = w; }
            }
        }
    }
}

__device__ __forceinline__ int ycol_to_wcol(int j) {
    if (j < 1408) return j;
    if (j < 3200) return j + 12;
    if (j < 3212) return 1408 + (j - 3200);
    if (j < 3216) return -1;
    if (j < 3232) return 3212 + (j - 3216);
    return -1;
}
__device__ __forceinline__ void transpose_cvt(const Ctx& c, const float* src, int ld_src, int R, int c_off, int C, int Cpad, int mode, bf16_t* dst, int ld_dst) {
    LAS float* buf = (LAS float*)c.lds;
    const int nRt = R / 64, nCt = Cpad / 64;
    for (int tile = c.blk; tile < nRt * nCt; tile += c.nblk) {
        const int rt = tile % nRt, ct = tile / nRt;
        const int r0 = rt * 64, c0 = ct * 64;
        {
            const int row = c.tid >> 3, cc = (c.tid & 7) * 8;
            const float* sp = src + (size_t)(r0 + row) * ld_src;
            float v[8];
            bool fast = false; int sc0 = 0;
            if (mode == 0) { fast = (c0 + 64 <= C); sc0 = c_off + c0 + cc; }
            else { if (c0 + 64 <= 1408) { fast = true; sc0 = c0 + cc; } else if (c0 >= 1408 && c0 + 64 <= 3200) { fast = true; sc0 = c0 + cc + 12; } }
            if (fast) {
                const f32x4 a = *(const f32x4*)(sp + sc0), b = *(const f32x4*)(sp + sc0 + 4);
                v[0] = a[0]; v[1] = a[1]; v[2] = a[2]; v[3] = a[3]; v[4] = b[0]; v[5] = b[1]; v[6] = b[2]; v[7] = b[3];
            } else {
#pragma unroll
                for (int i = 0; i < 8; ++i) {
                    const int n = c0 + cc + i; int sc;
                    if (mode == 0) sc = (n < C) ? c_off + n : -1; else sc = ycol_to_wcol(n);
                    v[i] = (sc >= 0) ? sp[sc] : 0.f;
                }
            }
#pragma unroll
            for (int i = 0; i < 8; ++i) buf[row * 65 + cc + i] = v[i];
        }
        __syncthreads();
        {
            const int n = c.tid >> 3, kc = (c.tid & 7) * 8;
            float v[8];
#pragma unroll
            for (int i = 0; i < 8; ++i) v[i] = buf[(kc + i) * 65 + n];
            u32x4 w; w.x = pk_bf16(v[0], v[1]); w.y = pk_bf16(v[2], v[3]); w.z = pk_bf16(v[4], v[5]); w.w = pk_bf16(v[6], v[7]);
            *(u32x4*)(dst + (size_t)(c0 + n) * ld_dst + r0 + kc) = w;
        }
        __syncthreads();
    }
}
__device__ __forceinline__ void convert_flat(const Ctx& c, const float* src, bf16_t* dst, size_t n) {
    const size_t stride = (size_t)c.nblk * NTHREADS;
    for (size_t i = (size_t)c.blk * NTHREADS + c.tid; i < n / 8; i += stride) {
        const f32x4 a = ((const f32x4*)src)[2 * i], b = ((const f32x4*)src)[2 * i + 1];
        u32x4 w; w.x = pk_bf16(a[0], a[1]); w.y = pk_bf16(a[2], a[3]); w.z = pk_bf16(b[0], b[1]); w.w = pk_bf16(b[2], b[3]);
        ((u32x4*)dst)[i] = w;
    }
}

template <int WM, int WN>
__device__ __forceinline__ void gemm_kloop(const Ctx& c, f32x16 (&acc)[WM][WN], const bf16_t* A, int lda, const bf16_t* Bt, int ldb, int K, int kstepA = 64) {
    constexpr int BMt = 128 * WM, BNt = 64 * WN, STAGE = (BMt + BNt) * 144;
    constexpr int NA = BMt * 8 / NTHREADS, NBc = BNt * 8 / NTHREADS;
    static_assert(NBc >= 1, "tile too small");
    const lptr lds = c.lds;
    const int wm = c.wave >> 1, wn = c.wave & 1, r = c.lane & 31, h = c.lane >> 5;
    u32x4 ra[NA], rb[NBc];
    const int nk = K / 64;
#pragma unroll
    for (int i = 0; i < NA; ++i) { const int id = c.tid + i * NTHREADS; ra[i] = *(const u32x4*)(A + (size_t)(id >> 3) * lda + (id & 7) * 8); }
#pragma unroll
    for (int i = 0; i < NBc; ++i) { const int id = c.tid + i * NTHREADS; rb[i] = *(const u32x4*)(Bt + (size_t)(id >> 3) * ldb + (id & 7) * 8); }
#pragma unroll
    for (int i = 0; i < NA; ++i) { const int id = c.tid + i * NTHREADS; *(LAS u32x4*)(lds + (id >> 3) * 144 + (id & 7) * 16) = ra[i]; }
#pragma unroll
    for (int i = 0; i < NBc; ++i) { const int id = c.tid + i * NTHREADS; *(LAS u32x4*)(lds + BMt * 144 + (id >> 3) * 144 + (id & 7) * 16) = rb[i]; }
    __syncthreads();
    for (int kt = 0; kt < nk; ++kt) {
        const lptr cur = lds + (kt & 1) * STAGE, nxt = lds + ((kt + 1) & 1) * STAGE;
        const bool more = (kt + 1 < nk);
        if (more) {
            const int k0 = (kt + 1) * 64; const size_t k0a = (size_t)(kt + 1) * kstepA;
#pragma unroll
            for (int i = 0; i < NA; ++i) { const int id = c.tid + i * NTHREADS; ra[i] = *(const u32x4*)(A + (size_t)(id >> 3) * lda + k0a + (id & 7) * 8); }
#pragma unroll
            for (int i = 0; i < NBc; ++i) { const int id = c.tid + i * NTHREADS; rb[i] = *(const u32x4*)(Bt + (size_t)(id >> 3) * ldb + k0 + (id & 7) * 8); }
        }
        const lptr pa = cur + (wm * WM * 32 + r) * 144 + h * 16;
        const lptr pb = cur + BMt * 144 + (wn * WN * 32 + r) * 144 + h * 16;
#pragma unroll
        for (int s = 0; s < 4; ++s) {
            bf16x8 fa[WM], fb[WN];
#pragma unroll
            for (int i = 0; i < WM; ++i) fa[i] = *(LAS const bf16x8*)(pa + i * 32 * 144 + s * 32);
#pragma unroll
            for (int j = 0; j < WN; ++j) fb[j] = *(LAS const bf16x8*)(pb + j * 32 * 144 + s * 32);
#pragma unroll
            for (int i = 0; i < WM; ++i)
#pragma unroll
                for (int j = 0; j < WN; ++j) acc[i][j] = __builtin_amdgcn_mfma_f32_32x32x16_bf16(fb[j], fa[i], acc[i][j], 0, 0, 0);
        }
        if (more) {
#pragma unroll
            for (int i = 0; i < NA; ++i) { const int id = c.tid + i * NTHREADS; *(LAS u32x4*)(nxt + (id >> 3) * 144 + (id & 7) * 16) = ra[i]; }
#pragma unroll
            for (int i = 0; i < NBc; ++i) { const int id = c.tid + i * NTHREADS; *(LAS u32x4*)(nxt + BMt * 144 + (id >> 3) * 144 + (id & 7) * 16) = rb[i]; }
        }
        __syncthreads();
    }
}
template <int WM, int WN>
__device__ __forceinline__ void acc_zero(f32x16 (&acc)[WM][WN]) {
#pragma unroll
    for (int i = 0; i < WM; ++i)
#pragma unroll
        for (int j = 0; j < WN; ++j)
#pragma unroll
            for (int e = 0; e < 16; ++e) acc[i][j][e] = 0.f;
}

namespace pg8 {
#define PG8_LAS __attribute__((address_space(3)))
constexpr int BM = 256, BK = 64, HALF = 128, HTB = HALF * BK * 2  , STAGE_BYTES = 8 * HTB, NXCD = 8, WGM = 8;

__host__ __device__ __forceinline__ int lds_byte(int r, int c) { const int st = (r >> 4) * 2 + (c >> 5), rr = r & 15, cc = c & 31, ob = rr * 64 + cc * 2; return st * 1024 + (ob ^ (((ob >> 9) & 1) << 5)); }
__host__ __device__ __forceinline__ void stage_rc(int b, int& R, int& C) { const int st = b / 1024, sb = b % 1024, swz = sb ^ (((sb >> 9) & 1) << 5); R = (st >> 1) * 16 + swz / 64; C = (st & 1) * 32 + (swz % 64) / 2; }
__host__ __device__ __forceinline__ int perm32(int rho) { const int n = rho >> 4, i = rho & 15; return 8 * (i >> 2) + 4 * n + (i & 3); }
struct Unit { int pm, pn; };
struct Gemm { const bf16_t* A; const bf16_t* Bt; int M, N, K; };
struct StaticOrder {
    int nM, nN, nwg, G, c;
    __host__ __device__ void init(int M, int N, int G_, int c_) { nM = M / BM; nN = N / BM; nwg = nM * nN; G = G_; c = c_; }
    __host__ __device__ bool next(int i, Unit& u) const {
        const long L = (long)i * G + c; if (L >= nwg) return false;
        int wgid = (int)L; { const int q = nwg / NXCD, r = nwg % NXCD, xcd = wgid % NXCD, off = wgid / NXCD; wgid = (xcd < r ? xcd * (q + 1) : r * (q + 1) + (xcd - r) * q) + off; }
        const int nig = WGM * nN, gid = wgid / nig, fm = gid * WGM, gsz = (nM - fm) < WGM ? (nM - fm) : WGM;
        u.pm = fm + ((wgid % nig) % gsz); u.pn = (wgid % nig) / gsz; return true;
    }
    __device__ __forceinline__ void a_ready(const Unit&) const {}
    __device__ __forceinline__ void done(const Unit&) const {}
};
template <class Epi, class Sched>
__device__ __forceinline__ void gemm_phase(PG8_LAS unsigned char* lds, const Gemm g, const Sched& S, const Epi& E) {
    const int tid = threadIdx.x, wid = __builtin_amdgcn_readfirstlane(tid >> 6), lane = tid & 63, wr = wid >> 2, wc = wid & 3, fr = lane & 15, fq = lane >> 4;
    const int K = g.K, nt = K / BK;
    unsigned voffA[2], voffB[2];
#pragma unroll
    for (int i = 0; i < 2; ++i) { int R, C; stage_rc(tid * 16 + i * 8192, R, C); const int Rb = Epi::PERM ? ((R & ~31) + perm32(R & 31)) : R;
        voffA[i] = (unsigned)(R * K + C) * 2u; voffB[i] = (unsigned)(Rb * K + C) * 2u; }
    const size_t kstep = (size_t)(BK * 2);
    const size_t hstep = (size_t)HALF * K * 2;
    const size_t tstep = 2 * hstep;
    const unsigned ldsw = (unsigned)wid * 1024u;
    const int aoff = lds_byte(wr * 64 + fr, fq * 8), boff = lds_byte(wc * 32 + fr, fq * 8);
#define PG8_SA(b, h) (((b) * 2 + (h)) * HTB)
#define PG8_SB(b, h) ((4 + (b) * 2 + (h)) * HTB)
#define PG8_STAGE(bufoff, gbase, voff) do { _Pragma("unroll") for (int _i = 0; _i < 2; ++_i) \
        __builtin_amdgcn_global_load_lds((const unsigned*)((const char*)(gbase) + (voff)[_i]), (PG8_LAS unsigned*)(lds + (bufoff) + ldsw + _i * 8192), 16, 0, 0); } while (0)
#define PG8_LDA(dst, b, h) do { _Pragma("unroll") for (int m = 0; m < 4; ++m) _Pragma("unroll") for (int k = 0; k < 2; ++k) dst[m][k] = *(const PG8_LAS bf16x8*)(lds + PG8_SA(b, h) + aoff + m * 2048 + k * 1024); } while (0)
#define PG8_LDB(dst, b, h) do { _Pragma("unroll") for (int n = 0; n < 2; ++n) _Pragma("unroll") for (int k = 0; k < 2; ++k) dst[n][k] = *(const PG8_LAS bf16x8*)(lds + PG8_SB(b, h) + boff + n * 2048 + k * 1024); } while (0)
#define PG8_MMA(ai, bj, At, Bt) do { __builtin_amdgcn_s_setprio(1); _Pragma("unroll") for (int m = 0; m < 4; ++m) _Pragma("unroll") for (int n = 0; n < 2; ++n) _Pragma("unroll") for (int k = 0; k < 2; ++k) \
        acc[ai][bj][m][n] = __builtin_amdgcn_mfma_f32_16x16x32_bf16(Bt[n][k], At[m][k], acc[ai][bj][m][n], 0, 0, 0); __builtin_amdgcn_s_setprio(0); } while (0)
#define PG8_WAIT_V(n) asm volatile("s_waitcnt vmcnt(" #n ")" ::: "memory")
#define PG8_WAIT_L(n) asm volatile("s_waitcnt lgkmcnt(" #n ")" ::: "memory")
#define PG8_BAR __builtin_amdgcn_s_barrier()
#define PG8_SCHED __builtin_amdgcn_sched_barrier(0)
    Unit cur, nxt; int ui = 0;
    if (!S.next(0, cur)) return;
    f32x4 acc[2][2][4][2];
#pragma unroll
    for (int a = 0; a < 2; ++a)
#pragma unroll
        for (int b = 0; b < 2; ++b)
#pragma unroll
            for (int m = 0; m < 4; ++m)
#pragma unroll
                for (int n = 0; n < 2; ++n) acc[a][b][m][n] = (f32x4){0.f, 0.f, 0.f, 0.f};
    bf16x8 At[4][2], B0[2][2], B1[2][2];
    const char* cA = (const char*)g.A + (size_t)cur.pm * tstep; const char* cB = (const char*)g.Bt + (size_t)cur.pn * tstep;
    S.a_ready(cur);
    PG8_STAGE(PG8_SB(0, 0), cB, voffB); PG8_STAGE(PG8_SA(0, 0), cA, voffA); PG8_STAGE(PG8_SB(0, 1), cB + hstep, voffB); PG8_STAGE(PG8_SA(0, 1), cA + hstep, voffA);
    if (wr == 1) PG8_BAR;
    PG8_WAIT_V(4); PG8_BAR;
    PG8_STAGE(PG8_SB(1, 0), cB + kstep, voffB); PG8_STAGE(PG8_SA(1, 0), cA + kstep, voffA); PG8_STAGE(PG8_SB(1, 1), cB + hstep + kstep, voffB);
    PG8_WAIT_V(6); PG8_BAR;
    for (;;) {
        const bool has_next = S.next(ui + 1, nxt);
        const char* nA = has_next ? (const char*)g.A + (size_t)nxt.pm * tstep : cA; const char* nB = has_next ? (const char*)g.Bt + (size_t)nxt.pn * tstep : cB;
        for (int t = 0; t < nt; t += 2) {
            const bool last = (t == nt - 2);
            const char* a1 = cA + (size_t)(t + 1) * kstep;
            const char* a2 = last ? nA : cA + (size_t)(t + 2) * kstep; const char* b2 = last ? nB : cB + (size_t)(t + 2) * kstep;
            const char* a3 = a2 + kstep; const char* b3 = b2 + kstep;
            if (last && has_next) S.a_ready(nxt);
            PG8_LDB(B0, 0, 0); PG8_SCHED; PG8_LDA(At, 0, 0); PG8_STAGE(PG8_SA(1, 1), a1 + hstep, voffA);
            PG8_WAIT_L(8); PG8_BAR; PG8_WAIT_L(0); PG8_MMA(0, 0, At, B0); PG8_BAR; PG8_SCHED;
            PG8_LDB(B1, 0, 1); PG8_STAGE(PG8_SB(0, 0), b2, voffB);
            PG8_BAR; PG8_WAIT_L(0); PG8_MMA(0, 1, At, B1); PG8_BAR;
            PG8_LDA(At, 0, 1); PG8_STAGE(PG8_SA(0, 0), a2, voffA);
            PG8_BAR; PG8_WAIT_L(0); PG8_MMA(1, 0, At, B0); PG8_BAR; PG8_SCHED;
            PG8_STAGE(PG8_SB(0, 1), b2 + hstep, voffB);
            PG8_WAIT_V(6); PG8_BAR; PG8_MMA(1, 1, At, B1); PG8_BAR;
            PG8_LDB(B0, 1, 0); PG8_SCHED; PG8_LDA(At, 1, 0); PG8_STAGE(PG8_SA(0, 1), a2 + hstep, voffA);
            PG8_WAIT_L(8); PG8_BAR; PG8_WAIT_L(0); PG8_MMA(0, 0, At, B0); PG8_BAR; PG8_SCHED;
            PG8_LDB(B1, 1, 1); PG8_STAGE(PG8_SB(1, 0), b3, voffB);
            PG8_BAR; PG8_WAIT_L(0); PG8_MMA(0, 1, At, B1); PG8_BAR;
            PG8_LDA(At, 1, 1); PG8_STAGE(PG8_SA(1, 0), a3, voffA);
            PG8_BAR; PG8_WAIT_L(0); PG8_MMA(1, 0, At, B0); PG8_BAR; PG8_SCHED;
            PG8_STAGE(PG8_SB(1, 1), b3 + hstep, voffB);
            PG8_WAIT_V(6); PG8_BAR; PG8_MMA(1, 1, At, B1); PG8_BAR;
        }
        if constexpr (!Epi::AFTER_DRAIN) { E(acc, cur, wr, wc, fr, fq); S.done(cur); }
        if (!has_next) break;
#pragma unroll
        for (int a = 0; a < 2; ++a)
#pragma unroll
            for (int b = 0; b < 2; ++b)
#pragma unroll
                for (int m = 0; m < 4; ++m)
#pragma unroll
                    for (int n = 0; n < 2; ++n) acc[a][b][m][n] = (f32x4){0.f, 0.f, 0.f, 0.f};
        cur = nxt; cA = nA; cB = nB; ++ui;
    }
    PG8_WAIT_V(0);
    if (wr == 0) PG8_BAR;
    PG8_BAR;
    if constexpr (Epi::AFTER_DRAIN) { E.fused(acc, cur, wr, wc, fr, fq, lds, wid, lane); S.done(cur); }
#undef PG8_SA
#undef PG8_SB
#undef PG8_STAGE
#undef PG8_LDA
#undef PG8_LDB
#undef PG8_MMA
#undef PG8_WAIT_V
#undef PG8_WAIT_L
#undef PG8_BAR
#undef PG8_SCHED
}

struct EpiStoreBf16 {
    static constexpr bool PERM = true, AFTER_DRAIN = false;
    bf16_t* O; int ldc;
    __device__ __forceinline__ void operator()(const f32x4 (&acc)[2][2][4][2], const Unit& u, int wr, int wc, int fr, int fq) const {
        const int row0 = u.pm * BM + wr * 64 + fr, col0 = u.pn * BM + wc * 32 + 8 * fq;
#pragma unroll
        for (int ai = 0; ai < 2; ++ai)
#pragma unroll
            for (int m = 0; m < 4; ++m) { bf16_t* rowp = O + (size_t)(row0 + ai * HALF + m * 16) * ldc + col0;
#pragma unroll
                for (int bj = 0; bj < 2; ++bj) { const f32x4 v0 = acc[ai][bj][m][0], v1 = acc[ai][bj][m][1];
                    u32x4 w; w.x = pk_bf16(v0[0], v0[1]); w.y = pk_bf16(v0[2], v0[3]); w.z = pk_bf16(v1[0], v1[1]); w.w = pk_bf16(v1[2], v1[3]);
                    *(u32x4*)(rowp + bj * HALF) = w; } }
    }
};
struct EpiResidF32 {
    static constexpr bool PERM = false, AFTER_DRAIN = false;
    const float* R; float* C; int ldc; float alpha;
    __device__ __forceinline__ void operator()(const f32x4 (&acc)[2][2][4][2], const Unit& u, int wr, int wc, int fr, int fq) const {
        const int row0 = u.pm * BM + wr * 64 + fr, col0 = u.pn * BM + wc * 32 + 4 * fq;
#pragma unroll
        for (int ai = 0; ai < 2; ++ai)
#pragma unroll
            for (int m = 0; m < 4; ++m) { const size_t ro = (size_t)(row0 + ai * HALF + m * 16) * ldc + col0;
#pragma unroll
                for (int bj = 0; bj < 2; ++bj)
#pragma unroll
                    for (int n = 0; n < 2; ++n) { const f32x4 x = *(const f32x4*)(R + ro + bj * HALF + n * 16); *(f32x4*)(C + ro + bj * HALF + n * 16) = x * alpha + acc[ai][bj][m][n]; } }
    }
};

struct EpiYG {
    static constexpr bool PERM = true, AFTER_DRAIN = false;
    bf16_t* Yp; unsigned char* Gp;
    __device__ __forceinline__ void operator()(const f32x4 (&acc)[2][2][4][2], const Unit& u, int wr, int wc, int fr, int fq) const {
        const int row0 = u.pm * BM + wr * 64 + fr;
        if (u.pn < NY / 256) {
            const int col0 = u.pn * BM + wc * 32 + 8 * fq;
#pragma unroll
            for (int ai = 0; ai < 2; ++ai)
#pragma unroll
                for (int m = 0; m < 4; ++m) { bf16_t* rowp = Yp + (size_t)(row0 + ai * HALF + m * 16) * NY + col0;
#pragma unroll
                    for (int bj = 0; bj < 2; ++bj) { const f32x4 v0 = acc[ai][bj][m][0], v1 = acc[ai][bj][m][1];
                        u32x4 w; w.x = pk_bf16(v0[0], v0[1]); w.y = pk_bf16(v0[2], v0[3]); w.z = pk_bf16(v1[0], v1[1]); w.w = pk_bf16(v1[2], v1[3]);
                        *(u32x4*)(rowp + bj * HALF) = w; } }
        } else {
            const int col0 = (u.pn - NY / 256) * BM + wc * 32 + 8 * fq;
#pragma unroll
            for (int ai = 0; ai < 2; ++ai)
#pragma unroll
                for (int m = 0; m < 4; ++m) { unsigned char* rowp = Gp + (size_t)(row0 + ai * HALF + m * 16) * 4096 + col0;
#pragma unroll
                    for (int bj = 0; bj < 2; ++bj) { const f32x4 v0 = acc[ai][bj][m][0], v1 = acc[ai][bj][m][1];
                        unsigned lo = 0u, hi = 0u;
#pragma unroll
                        for (int e = 0; e < 4; ++e) {
                            lo |= (unsigned)(int)__builtin_rintf(255.0f * sigmoidf_(v0[e])) << (8 * e);
                            hi |= (unsigned)(int)__builtin_rintf(255.0f * sigmoidf_(v1[e])) << (8 * e);
                        }
                        u32x2 w; w.x = lo; w.y = hi;
                        *(u32x2*)(rowp + bj * HALF) = w; } }
        }
    }
};
}

#define EPI_LOOP(WM_, WN_)                                                                  \
    _Pragma("unroll") for (int i = 0; i < WM_; ++i)                                         \
    _Pragma("unroll") for (int j = 0; j < WN_; ++j)                                         \
    _Pragma("unroll") for (int g = 0; g < 4; ++g)

__device__ __forceinline__ void phase_inproj(const Ctx& c, const bf16_t* hb, const bf16_t* Wt, bf16_t* Y) {
    constexpr int NTN = NY / 128;
    const int wm = c.wave >> 1, wn = c.wave & 1, r = c.lane & 31, h = c.lane >> 5;
    for (int u = c.blk; u < 64 * NTN; u += c.nblk) {
        const int pm = u / NTN, pn = u % NTN;
        f32x16 acc[2][2]; acc_zero<2, 2>(acc);
        gemm_kloop<2, 2>(c, acc, hb + (size_t)pm * 256 * DM, DM, Wt + (size_t)pn * 128 * DM, DM, DM);
        EPI_LOOP(2, 2) {
            const int m = pm * 256 + (wm * 2 + i) * 32 + r, n = pn * 128 + (wn * 2 + j) * 32 + 8 * g + 4 * h;
            u32x2 w; w.x = pk_bf16(acc[i][j][4 * g], acc[i][j][4 * g + 1]); w.y = pk_bf16(acc[i][j][4 * g + 2], acc[i][j][4 * g + 3]);
            *(u32x2*)(Y + (size_t)m * NY + n) = w;
        }
    }
}
__device__ __forceinline__ void phase_merge(const Ctx& c, const bf16_t* hb, const bf16_t* Wg, const bf16_t* O, const bf16_t* Wb, bf16_t* MIX) {
    const int wm = c.wave >> 1, wn = c.wave & 1, r = c.lane & 31, h = c.lane >> 5;
    for (int u = c.blk; u < 128 * 8; u += c.nblk) {
        const int pm = u >> 3, pn = u & 7;
        f32x16 mix[1][2]; acc_zero<1, 2>(mix);
#pragma unroll 1
        for (int nb = 0; nb < 4; ++nb) {
            f32x16 ag[1][2]; acc_zero<1, 2>(ag);
            gemm_kloop<1, 2>(c, ag, hb + (size_t)pm * 128 * DM, DM, Wg + ((size_t)nb * 1024 + pn * 128) * DM, DM, DM);
            f32x16 ap[1][2]; acc_zero<1, 2>(ap);
            gemm_kloop<1, 2>(c, ap, O + (size_t)pm * 128 * DM + nb * 256, DM, Wb + ((size_t)nb * 1024 + pn * 128) * 256, 256, 256);
#pragma unroll
            for (int j = 0; j < 2; ++j)
#pragma unroll
                for (int e = 0; e < 16; ++e) mix[0][j][e] += sigmoidf_(ag[0][j][e]) * ap[0][j][e];
        }
        EPI_LOOP(1, 2) {
            const int m = pm * 128 + (wm + i) * 32 + r, n = pn * 128 + (wn * 2 + j) * 32 + 8 * g + 4 * h;
            u32x2 w; w.x = pk_bf16(mix[i][j][4 * g], mix[i][j][4 * g + 1]); w.y = pk_bf16(mix[i][j][4 * g + 2], mix[i][j][4 * g + 3]);
            *(u32x2*)(MIX + (size_t)m * DM + n) = w;
        }
    }
}
__device__ __forceinline__ void phase_outproj(const Ctx& c, const bf16_t* MIX, const bf16_t* Wo, const float* hf, float* Z) {
    const int wm = c.wave >> 1, wn = c.wave & 1, r = c.lane & 31, h = c.lane >> 5;
    for (int u = c.blk; u < 64 * 8; u += c.nblk) {
        const int pm = u >> 3, pn = u & 7;
        f32x16 acc[2][2]; acc_zero<2, 2>(acc);
        gemm_kloop<2, 2>(c, acc, MIX + (size_t)pm * 256 * DM, DM, Wo + (size_t)pn * 128 * DM, DM, DM);
        EPI_LOOP(2, 2) {
            const int m = pm * 256 + (wm * 2 + i) * 32 + r, n = pn * 128 + (wn * 2 + j) * 32 + 8 * g + 4 * h;
            const f32x4 x = *(const f32x4*)(hf + (size_t)m * DM + n);
            f32x4 y; y[0] = DN_ALPHA * x[0] + acc[i][j][4 * g]; y[1] = DN_ALPHA * x[1] + acc[i][j][4 * g + 1]; y[2] = DN_ALPHA * x[2] + acc[i][j][4 * g + 2]; y[3] = DN_ALPHA * x[3] + acc[i][j][4 * g + 3];
            *(f32x4*)(Z + (size_t)m * DM + n) = y;
        }
    }
}
__device__ __forceinline__ void phase_wq(const Ctx& c, const bf16_t* hb, const bf16_t* Wq, bf16_t* QV) {
    const int wm = c.wave >> 1, wn = c.wave & 1, r = c.lane & 31, h = c.lane >> 5;
    for (int u = c.blk; u < 64 * 16; u += c.nblk) {
        const int pm = u >> 4, pn = u & 15;
        f32x16 acc[2][2]; acc_zero<2, 2>(acc);
        gemm_kloop<2, 2>(c, acc, hb + (size_t)pm * 256 * DM, DM, Wq + (size_t)pn * 128 * DM, DM, DM);
        EPI_LOOP(2, 2) {
            const int m = pm * 256 + (wm * 2 + i) * 32 + r, n = pn * 128 + (wn * 2 + j) * 32 + 8 * g + 4 * h;
            u32x2 w; w.x = pk_bf16(acc[i][j][4 * g], acc[i][j][4 * g + 1]); w.y = pk_bf16(acc[i][j][4 * g + 2], acc[i][j][4 * g + 3]);
            *(u32x2*)(QV + (size_t)m * 2048 + n) = w;
        }
    }
}

__device__ __forceinline__ void phase_inproj_pg8(const Ctx& c, const bf16_t* hb, const bf16_t* Wt, bf16_t* Y) {
    pg8::Gemm g{hb, Wt, NTOK, NY, DM}; pg8::StaticOrder S; S.init(NTOK, NY, c.nblk, c.blk);
    pg8::EpiStoreBf16 E{Y, NY};
    pg8::gemm_phase<pg8::EpiStoreBf16, pg8::StaticOrder>(c.lds, g, S, E);
}
__device__ __forceinline__ void phase_wq_pg8(const Ctx& c, const bf16_t* hb, const bf16_t* Wq, bf16_t* QV) {
    pg8::Gemm g{hb, Wq, NTOK, 2048, DM}; pg8::StaticOrder S; S.init(NTOK, 2048, c.nblk, c.blk);
    pg8::EpiStoreBf16 E{QV, 2048};
    pg8::gemm_phase<pg8::EpiStoreBf16, pg8::StaticOrder>(c.lds, g, S, E);
}
__device__ __forceinline__ void phase_outproj_pg8(const Ctx& c, const bf16_t* MIX, const bf16_t* Wo, const float* hf, float* Z) {
    pg8::Gemm g{MIX, Wo, NTOK, DM, DM}; pg8::StaticOrder S; S.init(NTOK, DM, c.nblk, c.blk);
    pg8::EpiResidF32 E{hf, Z, DM, DN_ALPHA};
    pg8::gemm_phase<pg8::EpiResidF32, pg8::StaticOrder>(c.lds, g, S, E);
}

__device__ __forceinline__ void phase_inproj_gates_pg8(const Ctx& c, const bf16_t* hb, const bf16_t* Wt, bf16_t* Yp, unsigned char* Gp) {
    pg8::Gemm g{hb, Wt, NTOK, NIN, DM}; pg8::StaticOrder S; S.init(NTOK, NIN, c.nblk, c.blk);
    pg8::EpiYG E{Yp, Gp};
    pg8::gemm_phase<pg8::EpiYG, pg8::StaticOrder>(c.lds, g, S, E);
}
__device__ __forceinline__ void phase_merge2(const Ctx& c, const unsigned char* Gp, const bf16_t* Op, const bf16_t* Wb, bf16_t* MIXp) {
    const int wm = c.wave >> 1, wn = c.wave & 1, r = c.lane & 31, h = c.lane >> 5;
    for (int u = c.blk; u < 64 * 8; u += c.nblk) {
        const int pm = u >> 3, pn = u & 7;
        f32x16 mix[2][2]; acc_zero<2, 2>(mix);
#pragma unroll 1
        for (int nb = 0; nb < 4; ++nb) {
            f32x16 ap[2][2]; acc_zero<2, 2>(ap);
            gemm_kloop<2, 2>(c, ap, Op + (size_t)pm * 256 * DM + nb * 256, DM, Wb + ((size_t)nb * 1024 + pn * 128) * 256, 256, 256);
            EPI_LOOP(2, 2) {
                const int m = pm * 256 + (wm * 2 + i) * 32 + r, n = pn * 128 + (wn * 2 + j) * 32 + 8 * g + 4 * h;
                const unsigned gq = *(const unsigned*)(Gp + (size_t)m * 4096 + nb * 1024 + n);
                mix[i][j][4 * g + 0] += (float)(gq & 0xffu) * (1.0f / 255.0f) * ap[i][j][4 * g + 0];
                mix[i][j][4 * g + 1] += (float)((gq >> 8) & 0xffu) * (1.0f / 255.0f) * ap[i][j][4 * g + 1];
                mix[i][j][4 * g + 2] += (float)((gq >> 16) & 0xffu) * (1.0f / 255.0f) * ap[i][j][4 * g + 2];
                mix[i][j][4 * g + 3] += (float)(gq >> 24) * (1.0f / 255.0f) * ap[i][j][4 * g + 3];
            }
        }
        EPI_LOOP(2, 2) {
            const int m = pm * 256 + (wm * 2 + i) * 32 + r, n = pn * 128 + (wn * 2 + j) * 32 + 8 * g + 4 * h;
            u32x2 w; w.x = pk_bf16(mix[i][j][4 * g], mix[i][j][4 * g + 1]); w.y = pk_bf16(mix[i][j][4 * g + 2], mix[i][j][4 * g + 3]);
            *(u32x2*)(MIXp + (size_t)m * DM + n) = w;
        }
    }
}

__device__ __forceinline__ f32x16 mma_lds(f32x16 acc, lptr A, int sa, lptr B, int sb, int K, int lane) {
    const int r = lane & 31, h = lane >> 5;
    const lptr pa = A + r * sa + h * 16, pb = B + r * sb + h * 16;
    for (int k = 0; k < K; k += 16) {
        const bf16x8 a = *(LAS const bf16x8*)(pa + k * 2), b = *(LAS const bf16x8*)(pb + k * 2);
        acc = __builtin_amdgcn_mfma_f32_32x32x16_bf16(b, a, acc, 0, 0, 0);
    }
    return acc;
}
__device__ __forceinline__ f32x16 zero16() { f32x16 z;
#pragma unroll
    for (int e = 0; e < 16; ++e) z[e] = 0.f; return z; }

__device__ __forceinline__ void sb_wave_unit(const bf16_t* Y, bf16_t* O, int b, int hh, int qt, lptr wl, int lane) {
    const int t = qt * 64 + lane;
    const size_t row = (size_t)b * SEQ + t;
    unsigned q[32];
    {
        const u32x4* qp = (const u32x4*)(Y + row * NY + C_SBQ + hh * 64);
#pragma unroll
        for (int i = 0; i < 8; ++i) { const u32x4 v = qp[i]; q[4 * i] = v.x; q[4 * i + 1] = v.y; q[4 * i + 2] = v.z; q[4 * i + 3] = v.w; }
    }
    float acc[64];
#pragma unroll
    for (int e = 0; e < 64; ++e) acc[e] = 0.f;
    float C = 0.f;
    for (int kt = qt; kt >= 0; --kt) {
        {
            const size_t krow = (size_t)b * SEQ + kt * 64 + lane;
            const u32x4* kp = (const u32x4*)(Y + krow * NY + C_SBK + hh * 64);
            const u32x4* vp = (const u32x4*)(Y + krow * NY + C_SBV + hh * 64);
            u32x4 kr[8], vr[8];
#pragma unroll
            for (int i = 0; i < 8; ++i) { kr[i] = kp[i]; vr[i] = vp[i]; }
#pragma unroll
            for (int i = 0; i < 8; ++i) { *(LAS u32x4*)(wl + lane * 144 + i * 16) = kr[i]; *(LAS u32x4*)(wl + 9216 + lane * 144 + i * 16) = vr[i]; }
        }
        asm volatile("s_waitcnt lgkmcnt(0)" ::: "memory");
        const int s_hi = (kt == qt) ? 62 : 63;
#pragma unroll 1
        for (int s = s_hi; s >= 0; --s) {
            const int pos = kt * 64 + s;
            float z0 = 0.f, z1 = 0.f;
#pragma unroll
            for (int i = 0; i < 8; ++i) {
                const u32x4 kv = *(LAS const u32x4*)(wl + s * 144 + i * 16);
                z0 = dot2bf(q[4 * i], kv.x, z0); z1 = dot2bf(q[4 * i + 1], kv.y, z1); z0 = dot2bf(q[4 * i + 2], kv.z, z0); z1 = dot2bf(q[4 * i + 3], kv.w, z1);
            }
            const float z = (z0 + z1) * 0.125f;
            const bool valid = pos < t;
            const float Cn = C - softplusf_(z);
            const float w = valid ? __expf(z + Cn) : 0.f;
            C = valid ? Cn : C;
#pragma unroll
            for (int i = 0; i < 8; ++i) {
                const u32x4 vv = *(LAS const u32x4*)(wl + 9216 + s * 144 + i * 16);
                acc[8 * i + 0] += w * bf_lo(vv.x); acc[8 * i + 1] += w * bf_hi(vv.x); acc[8 * i + 2] += w * bf_lo(vv.y); acc[8 * i + 3] += w * bf_hi(vv.y);
                acc[8 * i + 4] += w * bf_lo(vv.z); acc[8 * i + 5] += w * bf_hi(vv.z); acc[8 * i + 6] += w * bf_lo(vv.w); acc[8 * i + 7] += w * bf_hi(vv.w);
            }
        }
        asm volatile("" ::: "memory");
        if (__all(C < -104.0f)) break;
    }
    u32x4* op = (u32x4*)(O + row * DM + 0 * 256 + hh * 64);
#pragma unroll
    for (int i = 0; i < 8; ++i) {
        u32x4 w; w.x = pk_bf16(acc[8 * i], acc[8 * i + 1]); w.y = pk_bf16(acc[8 * i + 2], acc[8 * i + 3]); w.z = pk_bf16(acc[8 * i + 4], acc[8 * i + 5]); w.w = pk_bf16(acc[8 * i + 6], acc[8 * i + 7]);
        op[i] = w;
    }
}
__device__ __forceinline__ void phase_sb(const Ctx& c, const bf16_t* Y, bf16_t* O) {
    const lptr wl = c.lds + c.wave * 18432;
    for (int u = c.blk * 8 + c.wave; u < 1024; u += c.nblk * 8) {
        const int qt = u & 127, hh = (u >> 7) & 3, b = u >> 9;
        sb_wave_unit(Y, O, b, hh, qt, wl, c.lane);
    }
    __syncthreads();
}

__device__ __forceinline__ void phase_compress(const Ctx& c, const bf16_t* Y, const float* pos, const float* wk, const float* wv, bf16_t* KC, bf16_t* VC) {
    LAS float* kl = (LAS float*)c.lds;
    LAS float* pl = (LAS float*)(c.lds + 144 * 64 * 4);
    for (int u = c.blk; u < 256; u += c.nblk) {
        const int cg = u & 63, kv = (u >> 6) & 1, b = u >> 7;
        const int c0 = cg * 8;
        const int col = kv ? C_NVC : C_NKC;
        for (int i = c.tid; i < 144 * 64; i += NTHREADS) {
            const int tr = i >> 6, d = i & 63, tok = c0 * 16 + tr;
            kl[i] = (tok < SEQ) ? bf2f(Y[((size_t)b * SEQ + tok) * NY + col + d]) : 0.f;
        }
        for (int i = c.tid; i < 32 * 64; i += NTHREADS) pl[i] = pos[i];
        __syncthreads();
        const int cl = c.tid >> 6, d = c.tid & 63, cc = c0 + cl;
        const float* w = kv ? wv : wk;
        float a0 = 0.f, a1 = 0.f;
#pragma unroll 4
        for (int l = 0; l < 32; ++l) {
            const LAS float* kr = kl + (cl * 16 + l) * 64;
            const LAS float* pr = pl + l * 64;
            const float* wr = w + (size_t)l * 64 * 64 + d;
#pragma unroll 8
            for (int dp = 0; dp < 64; dp += 2) {
                a0 += (kr[dp] + pr[dp]) * wr[(size_t)dp * 64];
                a1 += (kr[dp + 1] + pr[dp + 1]) * wr[(size_t)(dp + 1) * 64];
            }
        }
        bf16_t* dst = kv ? VC : KC;
        dst[((size_t)b * 512 + cc) * 64 + d] = (cc < 511) ? f2bf(a0 + a1) : (bf16_t)0;
        __syncthreads();
    }
}

__device__ __forceinline__ void phase_compress2(const Ctx& c, const bf16_t* Y, const bf16_t* WC, float* RC) {
    const int wm = c.wave >> 1, wn = c.wave & 1, r = c.lane & 31, h = c.lane >> 5;
    for (int u = c.blk; u < 16; u += c.nblk) {
        const int rt = u & 3, kv = (u >> 2) & 1, b = u >> 3;
        f32x16 acc[1][2]; acc_zero<1, 2>(acc);
        gemm_kloop<1, 2>(c, acc, Y + ((size_t)b * SEQ + (size_t)rt * 128 * 16) * NY + (kv ? C_NVC : C_NKC), 16 * NY, WC + (size_t)kv * 128 * 1024, 1024, 1024, NY);
        EPI_LOOP(1, 2) {
            const int m = rt * 128 + (wm + i) * 32 + r, n = (wn * 2 + j) * 32 + 8 * g + 4 * h;
            f32x4 o; o[0] = acc[i][j][4 * g]; o[1] = acc[i][j][4 * g + 1]; o[2] = acc[i][j][4 * g + 2]; o[3] = acc[i][j][4 * g + 3];
            *(f32x4*)(RC + ((size_t)(b * 2 + kv) * 512 + m) * 128 + n) = o;
        }
    }
}
__device__ __forceinline__ void phase_compress_combine(const Ctx& c, const float* RC, const float* CB, bf16_t* KC, bf16_t* VC) {
    for (int i = c.blk * NTHREADS + c.tid; i < 2 * 2 * 512 * 64; i += c.nblk * NTHREADS) {
        const int d = i & 63, cc = (i >> 6) & 511, kv = (i >> 15) & 1, b = i >> 16;
        const float* R = RC + (size_t)(b * 2 + kv) * 512 * 128;
        const float v = (cc < 511) ? R[cc * 128 + d] + R[(cc + 1) * 128 + 64 + d] + CB[kv * 64 + d] : 0.f;
        (kv ? VC : KC)[((size_t)b * 512 + cc) * 64 + d] = f2bf(v);
    }
}

__device__ __forceinline__ float ret_logg(int h) { return log1pf(-exp2f(-5.0f - (float)h)); }
__device__ __forceinline__ void phase_ret_local(const Ctx& c, const bf16_t* Y, float* UST) {
    const lptr Kt = c.lds, Vt = c.lds + 64 * 272;
    for (int u = c.blk; u < 512; u += c.nblk) {
        const int i = u & 63, hh = (u >> 6) & 3, b = u >> 8;
        const float lg = ret_logg(hh);
        {
            const int j = c.tid >> 2, dc = (c.tid & 3) * 16;
            const size_t row = (size_t)b * SEQ + i * 128 + j;
            const float kd = __expf(lg * (float)(127 - j)) * 0.125f;
            const u32x4* kp = (const u32x4*)(Y + row * NY + C_RK + hh * 64 + dc);
            const u32x4* vp = (const u32x4*)(Y + row * NY + C_RV + hh * 64 + dc);
            const u32x4 k0 = kp[0], k1 = kp[1], v0 = vp[0], v1 = vp[1];
            const unsigned kk[8] = {k0.x, k0.y, k0.z, k0.w, k1.x, k1.y, k1.z, k1.w};
            const unsigned vv[8] = {v0.x, v0.y, v0.z, v0.w, v1.x, v1.y, v1.z, v1.w};
#pragma unroll
            for (int e = 0; e < 8; ++e) {
                *(LAS bf16_t*)(Kt + (dc + 2 * e) * 272 + j * 2) = f2bf(bf_lo(kk[e]) * kd);
                *(LAS bf16_t*)(Kt + (dc + 2 * e + 1) * 272 + j * 2) = f2bf(bf_hi(kk[e]) * kd);
                *(LAS bf16_t*)(Vt + (dc + 2 * e) * 272 + j * 2) = (bf16_t)(vv[e] & 0xffffu);
                *(LAS bf16_t*)(Vt + (dc + 2 * e + 1) * 272 + j * 2) = (bf16_t)(vv[e] >> 16);
            }
        }
        __syncthreads();
        if (c.wave < 4) {
            const int wm = c.wave >> 1, wn = c.wave & 1, r = c.lane & 31, h = c.lane >> 5;
            f32x16 acc = mma_lds(zero16(), Kt + wm * 32 * 272, 272, Vt + wn * 32 * 272, 272, 128, c.lane);
            float* dst = UST + (((size_t)(b * 4 + hh) * 64 + i) * 64 + wm * 32 + r) * 64 + wn * 32 + 4 * h;
#pragma unroll
            for (int g = 0; g < 4; ++g) { f32x4 o; o[0] = acc[4 * g]; o[1] = acc[4 * g + 1]; o[2] = acc[4 * g + 2]; o[3] = acc[4 * g + 3]; *(f32x4*)(dst + 8 * g) = o; }
        }
        __syncthreads();
    }
}
__device__ __forceinline__ void phase_scans(const Ctx& c, const float* UST, float* RST, const float* UGLA, float* SGLA, const float* BL) {
    for (int u = c.blk; u < 96; u += c.nblk) {
        if (u < 64) {
            const int ch = u * NTHREADS + c.tid;
            const int bh = ch >> 12, de = ch & 4095;
            const float cd = __expf(ret_logg(bh & 3) * 128.0f);
            const float* up = UST + (size_t)bh * 64 * 4096 + de; float* rp = RST + (size_t)bh * 64 * 4096 + de;
            float R = 0.f;
            for (int i0 = 0; i0 < 64; i0 += 16) {
                float uv[16];
#pragma unroll
                for (int j = 0; j < 16; ++j) uv[j] = up[(size_t)(i0 + j) * 4096];
#pragma unroll
                for (int j = 0; j < 16; ++j) { rp[(size_t)(i0 + j) * 4096] = R; R = cd * R + uv[j]; }
            }
        } else {
            const int ch = (u - 64) * NTHREADS + c.tid;
            const int bh = ch >> 11, ke = ch & 2047, k = ke >> 6;
            const float* up = UGLA + (size_t)bh * 128 * 2048 + ke; float* sp = SGLA + (size_t)bh * 128 * 2048 + ke;
            const float* bl = BL + (size_t)bh * 128 * 32 + k;
            float S = 0.f;
            for (int i0 = 0; i0 < 128; i0 += 16) {
                float uv[16], dv[16];
#pragma unroll
                for (int j = 0; j < 16; ++j) { uv[j] = up[(size_t)(i0 + j) * 2048]; dv[j] = bl[(i0 + j) * 32]; }
#pragma unroll
                for (int j = 0; j < 16; ++j) { sp[(size_t)(i0 + j) * 2048] = S; S = __expf(dv[j]) * S + uv[j]; }
            }
        }
    }
}
__device__ __forceinline__ void phase_ret_out(const Ctx& c, const bf16_t* Y, const float* RST, const float* gn_g, const float* gn_b, bf16_t* O) {
    const lptr Qs = c.lds, Ks = c.lds + 18432, Vt = c.lds + 36864, Rt = c.lds + 54272, Att = c.lds + 63488;
    LAS float* Of = (LAS float*)(c.lds + 98304);
    for (int u = c.blk; u < 512; u += c.nblk) {
        const int i = u & 63, hh = (u >> 6) & 3, b = u >> 8;
        const float lg = ret_logg(hh);
        const size_t row0 = (size_t)b * SEQ + i * 128;
        {
            const int j = c.tid >> 2, dc = (c.tid & 3) * 16;
            const size_t row = row0 + j;
            const u32x4* qp = (const u32x4*)(Y + row * NY + C_RQ + hh * 64 + dc);
            const u32x4* kp = (const u32x4*)(Y + row * NY + C_RK + hh * 64 + dc);
            const u32x4* vp = (const u32x4*)(Y + row * NY + C_RV + hh * 64 + dc);
            const u32x4 q0 = qp[0], q1 = qp[1], k0 = kp[0], k1 = kp[1], v0 = vp[0], v1 = vp[1];
            *(LAS u32x4*)(Qs + j * 144 + dc * 2) = q0; *(LAS u32x4*)(Qs + j * 144 + dc * 2 + 16) = q1;
            *(LAS u32x4*)(Ks + j * 144 + dc * 2) = k0; *(LAS u32x4*)(Ks + j * 144 + dc * 2 + 16) = k1;
            const unsigned vv[8] = {v0.x, v0.y, v0.z, v0.w, v1.x, v1.y, v1.z, v1.w};
#pragma unroll
            for (int e = 0; e < 8; ++e) {
                *(LAS bf16_t*)(Vt + (dc + 2 * e) * 272 + j * 2) = (bf16_t)(vv[e] & 0xffffu);
                *(LAS bf16_t*)(Vt + (dc + 2 * e + 1) * 272 + j * 2) = (bf16_t)(vv[e] >> 16);
            }
            const int d = c.tid >> 3, ec = (c.tid & 7) * 8;
            const float* rp = RST + (((size_t)(b * 4 + hh) * 64 + i) * 64 + d) * 64 + ec;
            const f32x4 r0 = *(const f32x4*)rp, r1 = *(const f32x4*)(rp + 4);
            const float rv[8] = {r0[0], r0[1], r0[2], r0[3], r1[0], r1[1], r1[2], r1[3]};
#pragma unroll
            for (int e = 0; e < 8; ++e) *(LAS bf16_t*)(Rt + (ec + e) * 144 + d * 2) = f2bf(rv[e]);
        }
        __syncthreads();
        const int r = c.lane & 31, h = c.lane >> 5;
        {
            const int mi = c.wave >> 1;
#pragma unroll
            for (int jj = 0; jj < 2; ++jj) {
                const int nj = (c.wave & 1) * 2 + jj;
                if (nj <= mi) {
                    f32x16 s = mma_lds(zero16(), Qs + mi * 32 * 144, 144, Ks + nj * 32 * 144, 144, 64, c.lane);
                    const int ii = mi * 32 + r;
#pragma unroll
                    for (int g = 0; g < 4; ++g) {
                        float p[4];
#pragma unroll
                        for (int e = 0; e < 4; ++e) { const int jx = nj * 32 + 8 * g + 4 * h + e; const int df = ii - jx; p[e] = (df >= 0) ? s[4 * g + e] * 0.125f * __expf(lg * (float)df) : 0.f; }
                        u32x2 w; w.x = pk_bf16(p[0], p[1]); w.y = pk_bf16(p[2], p[3]);
                        *(LAS u32x2*)(Att + ii * 272 + (nj * 32 + 8 * g + 4 * h) * 2) = w;
                    }
                }
            }
        }
        __syncthreads();
        {
            const int wm = c.wave >> 1, wn = c.wave & 1;
            f32x16 acc = mma_lds(zero16(), Qs + wm * 32 * 144, 144, Rt + wn * 32 * 144, 144, 64, c.lane);
            const int ii = wm * 32 + r;
            const float qd = __expf(lg * (float)(ii + 1));
#pragma unroll
            for (int e = 0; e < 16; ++e) acc[e] *= qd;
            acc = mma_lds(acc, Att + wm * 32 * 272, 272, Vt + wn * 32 * 272, 272, (wm + 1) * 32, c.lane);
#pragma unroll
            for (int g = 0; g < 4; ++g) { f32x4 o; o[0] = acc[4 * g]; o[1] = acc[4 * g + 1]; o[2] = acc[4 * g + 2]; o[3] = acc[4 * g + 3]; *(LAS f32x4*)(Of + ii * 68 + wn * 32 + 8 * g + 4 * h) = o; }
        }
        __syncthreads();
        {
            const int rw = c.tid >> 2, part = c.tid & 3;
            float v[16]; float s = 0.f;
#pragma unroll
            for (int e = 0; e < 16; ++e) { v[e] = Of[rw * 68 + part * 16 + e]; s += v[e]; }
            s += __shfl_xor(s, 1); s += __shfl_xor(s, 2);
            const float mu = s * (1.0f / 64.0f);
            float q = 0.f;
#pragma unroll
            for (int e = 0; e < 16; ++e) { const float d = v[e] - mu; q += d * d; }
            q += __shfl_xor(q, 1); q += __shfl_xor(q, 2);
            const float rstd = rsqrtf(q * (1.0f / 64.0f) + LN_EPS);
            const size_t row = row0 + rw;
            const int ch = hh * 64 + part * 16;
            const u32x4* gp = (const u32x4*)(Y + row * NY + C_RG + ch);
            const u32x4 g0 = gp[0], g1 = gp[1];
            const unsigned gg[8] = {g0.x, g0.y, g0.z, g0.w, g1.x, g1.y, g1.z, g1.w};
            unsigned ow[8];
#pragma unroll
            for (int e = 0; e < 8; ++e) {
                const float y0 = ((v[2 * e] - mu) * rstd * gn_g[ch + 2 * e] + gn_b[ch + 2 * e]) * siluf_(bf_lo(gg[e]));
                const float y1 = ((v[2 * e + 1] - mu) * rstd * gn_g[ch + 2 * e + 1] + gn_b[ch + 2 * e + 1]) * siluf_(bf_hi(gg[e]));
                ow[e] = pk_bf16(y0, y1);
            }
            u32x4* op = (u32x4*)(O + row * DM + 2 * 256 + ch);
            u32x4 w0, w1; w0.x = ow[0]; w0.y = ow[1]; w0.z = ow[2]; w0.w = ow[3]; w1.x = ow[4]; w1.y = ow[5]; w1.z = ow[6]; w1.w = ow[7];
            op[0] = w0; op[1] = w1;
        }
        __syncthreads();
    }
}

template <int NH>
__device__ __forceinline__ void gla_decays(const Ctx& c, const bf16_t* Y, size_t row0, int h0, const float* w_alpha, const float* b_alpha, LAS float* Ab, LAS float* lrs) {
    for (int i = c.tid; i < 64 * 16; i += NTHREADS) lrs[i] = bf2f(Y[(row0 + (i >> 4)) * NY + C_GLR + (i & 15)]);
    __syncthreads();
    for (int i = c.tid; i < NH * 64 * 32; i += NTHREADS) {
        const int k = i & 31, t = (i >> 5) & 63, hl = i >> 11;
        const int col = (h0 + hl) * 32 + k;
        float x = b_alpha[col];
#pragma unroll
        for (int rr = 0; rr < 16; ++rr) x += lrs[t * 16 + rr] * w_alpha[rr * 128 + col];
        Ab[i] = -softplusf_(-x) * (1.0f / 16.0f);
    }
    __syncthreads();
    if (c.tid < NH * 32) {
        const int k = c.tid & 31, hl = c.tid >> 5;
        float s = 0.f;
        for (int t = 0; t < 64; ++t) { s += Ab[(hl * 64 + t) * 32 + k]; Ab[(hl * 64 + t) * 32 + k] = s; }
    }
    __syncthreads();
}
__device__ __forceinline__ void phase_gla_local(const Ctx& c, const bf16_t* Y, const float* w_alpha, const float* b_alpha, float* UGLA, float* BL) {
    LAS float* Ab = (LAS float*)c.lds;
    LAS float* lrs = (LAS float*)(c.lds + 32768);
    const lptr Kt = c.lds + 36864;
    const lptr Vt = c.lds + 36864 + 18432;
    for (int u = c.blk; u < 256; u += c.nblk) {
        const int i = u & 127, b = u >> 7;
        const size_t row0 = (size_t)b * SEQ + i * 64;
        gla_decays<4>(c, Y, row0, 0, w_alpha, b_alpha, Ab, lrs);
        {
            const int s = c.tid >> 3, cc = (c.tid & 7) * 16;
            const u32x4* kp = (const u32x4*)(Y + (row0 + s) * NY + C_GK + cc);
            const u32x4 k0 = kp[0], k1 = kp[1];
            const unsigned kk[8] = {k0.x, k0.y, k0.z, k0.w, k1.x, k1.y, k1.z, k1.w};
#pragma unroll
            for (int e = 0; e < 16; ++e) {
                const int col = cc + e, hl = col >> 5, k = col & 31;
                const float kvf = (e & 1) ? bf_hi(kk[e >> 1]) : bf_lo(kk[e >> 1]);
                const float dec = __expf(Ab[(hl * 64 + 63) * 32 + k] - Ab[(hl * 64 + s) * 32 + k]);
                *(LAS bf16_t*)(Kt + hl * 4608 + k * 144 + s * 2) = f2bf(kvf * dec);
            }
            const int vc = (c.tid & 7) * 32;
            const u32x4* vp = (const u32x4*)(Y + (row0 + s) * NY + C_GV + vc);
#pragma unroll
            for (int q4 = 0; q4 < 4; ++q4) {
                const u32x4 v = vp[q4];
                const unsigned vv[4] = {v.x, v.y, v.z, v.w};
#pragma unroll
                for (int e = 0; e < 4; ++e) {
                    const int col = vc + q4 * 8 + 2 * e, hl = col >> 6, ee = col & 63;
                    *(LAS bf16_t*)(Vt + hl * 9216 + ee * 144 + s * 2) = (bf16_t)(vv[e] & 0xffffu);
                    *(LAS bf16_t*)(Vt + hl * 9216 + (ee + 1) * 144 + s * 2) = (bf16_t)(vv[e] >> 16);
                }
            }
        }
        __syncthreads();
        {
            const int hl = c.wave >> 1, wn = c.wave & 1, r = c.lane & 31, h = c.lane >> 5;
            f32x16 acc = mma_lds(zero16(), Kt + hl * 4608, 144, Vt + hl * 9216 + wn * 32 * 144, 144, 64, c.lane);
            float* dst = UGLA + (((size_t)(b * 4 + hl) * 128 + i) * 32 + r) * 64 + wn * 32 + 4 * h;
#pragma unroll
            for (int g = 0; g < 4; ++g) { f32x4 o; o[0] = acc[4 * g]; o[1] = acc[4 * g + 1]; o[2] = acc[4 * g + 2]; o[3] = acc[4 * g + 3]; *(f32x4*)(dst + 8 * g) = o; }
            if (c.tid < 128) { const int hl2 = c.tid >> 5, k = c.tid & 31; BL[((size_t)(b * 4 + hl2) * 128 + i) * 32 + k] = Ab[(hl2 * 64 + 63) * 32 + k]; }
        }
        __syncthreads();
    }
}
__device__ __forceinline__ void phase_gla_out(const Ctx& c, const bf16_t* Y, const float* w_alpha, const float* b_alpha, const float* SGLA, const float* norm_g, bf16_t* O) {
    LAS float* Ab = (LAS float*)c.lds;
    LAS float* lrs = (LAS float*)(c.lds + 16384);
    const lptr Qp = c.lds + 20480;
    const lptr Kp = Qp + 10240;
    const lptr Vt = Kp + 10240;
    const lptr St = Vt + 18432;
    const lptr Att = St + 10240;
    LAS float* Of = (LAS float*)(Att + 18432);
    for (int u = c.blk; u < 512; u += c.nblk) {
        const int hp = u & 1, i = (u >> 1) & 127, b = u >> 8;
        const size_t row0 = (size_t)b * SEQ + i * 64;
        gla_decays<2>(c, Y, row0, hp * 2, w_alpha, b_alpha, Ab, lrs);
        {
            const int s = c.tid >> 3, cc = (c.tid & 7) * 8;
            const int hl = cc >> 5, k0 = cc & 31;
            const u32x4 qv = *(const u32x4*)(Y + (row0 + s) * NY + C_GQ + hp * 64 + cc);
            const u32x4 kv = *(const u32x4*)(Y + (row0 + s) * NY + C_GK + hp * 64 + cc);
            const unsigned qq[4] = {qv.x, qv.y, qv.z, qv.w}, kk[4] = {kv.x, kv.y, kv.z, kv.w};
            unsigned qo[4], ko[4];
#pragma unroll
            for (int e = 0; e < 4; ++e) {
                const float b0 = Ab[(hl * 64 + s) * 32 + k0 + 2 * e], b1 = Ab[(hl * 64 + s) * 32 + k0 + 2 * e + 1];
                const float e0 = __expf(b0), e1 = __expf(b1);
                qo[e] = pk_bf16(bf_lo(qq[e]) * 0.17677669529663687f * e0, bf_hi(qq[e]) * 0.17677669529663687f * e1);
                ko[e] = pk_bf16(bf_lo(kk[e]) / e0, bf_hi(kk[e]) / e1);
            }
            u32x4 w; w.x = qo[0]; w.y = qo[1]; w.z = qo[2]; w.w = qo[3];
            *(LAS u32x4*)(Qp + hl * 5120 + s * 80 + k0 * 2) = w;
            w.x = ko[0]; w.y = ko[1]; w.z = ko[2]; w.w = ko[3];
            *(LAS u32x4*)(Kp + hl * 5120 + s * 80 + k0 * 2) = w;
            const int vc = (c.tid & 7) * 16;
            const u32x4* vp = (const u32x4*)(Y + (row0 + s) * NY + C_GV + hp * 128 + vc);
#pragma unroll
            for (int q4 = 0; q4 < 2; ++q4) {
                const u32x4 v = vp[q4];
                const unsigned vv[4] = {v.x, v.y, v.z, v.w};
#pragma unroll
                for (int e = 0; e < 4; ++e) {
                    const int col = vc + q4 * 8 + 2 * e, hl2 = col >> 6, ee = col & 63;
                    *(LAS bf16_t*)(Vt + hl2 * 9216 + ee * 144 + s * 2) = (bf16_t)(vv[e] & 0xffffu);
                    *(LAS bf16_t*)(Vt + hl2 * 9216 + (ee + 1) * 144 + s * 2) = (bf16_t)(vv[e] >> 16);
                }
            }
            const int sh = c.tid >> 8, sk = (c.tid >> 3) & 31, se = (c.tid & 7) * 8;
            const float* spp = SGLA + (((size_t)(b * 4 + hp * 2 + sh) * 128 + i) * 32 + sk) * 64 + se;
            const f32x4 s0 = *(const f32x4*)spp, s1 = *(const f32x4*)(spp + 4);
            const float sv[8] = {s0[0], s0[1], s0[2], s0[3], s1[0], s1[1], s1[2], s1[3]};
#pragma unroll
            for (int e = 0; e < 8; ++e) *(LAS bf16_t*)(St + sh * 5120 + (se + e) * 80 + sk * 2) = f2bf(sv[e]);
        }
        __syncthreads();
        const int hl = c.wave >> 2, mi = (c.wave >> 1) & 1, nj = c.wave & 1, r = c.lane & 31, h = c.lane >> 5;
        if (nj <= mi) {
            f32x16 s = mma_lds(zero16(), Qp + hl * 5120 + mi * 32 * 80, 80, Kp + hl * 5120 + nj * 32 * 80, 80, 32, c.lane);
            const int tt = mi * 32 + r;
#pragma unroll
            for (int g = 0; g < 4; ++g) {
                float p[4];
#pragma unroll
                for (int e = 0; e < 4; ++e) { const int sx = nj * 32 + 8 * g + 4 * h + e; p[e] = (sx <= tt) ? s[4 * g + e] : 0.f; }
                u32x2 w; w.x = pk_bf16(p[0], p[1]); w.y = pk_bf16(p[2], p[3]);
                *(LAS u32x2*)(Att + hl * 9216 + tt * 144 + (nj * 32 + 8 * g + 4 * h) * 2) = w;
            }
        }
        __syncthreads();
        {
            f32x16 acc = mma_lds(zero16(), Qp + hl * 5120 + mi * 32 * 80, 80, St + hl * 5120 + nj * 32 * 80, 80, 32, c.lane);
            acc = mma_lds(acc, Att + hl * 9216 + mi * 32 * 144, 144, Vt + hl * 9216 + nj * 32 * 144, 144, (mi + 1) * 32, c.lane);
            const int tt = mi * 32 + r;
#pragma unroll
            for (int g = 0; g < 4; ++g) { f32x4 o; o[0] = acc[4 * g]; o[1] = acc[4 * g + 1]; o[2] = acc[4 * g + 2]; o[3] = acc[4 * g + 3]; *(LAS f32x4*)(Of + (hl * 64 + tt) * 68 + nj * 32 + 8 * g + 4 * h) = o; }
        }
        __syncthreads();
        {
            const int rw = c.tid >> 2, part = c.tid & 3;
            const int hl2 = rw >> 6, tt = rw & 63, hh = hp * 2 + hl2;
            float v[16]; float q = 0.f;
#pragma unroll
            for (int e = 0; e < 16; ++e) { v[e] = Of[rw * 68 + part * 16 + e]; q += v[e] * v[e]; }
            q += __shfl_xor(q, 1); q += __shfl_xor(q, 2);
            const float rstd = rsqrtf(q * (1.0f / 64.0f) + LN_EPS);
            const size_t row = row0 + tt;
            const int ch = hh * 64 + part * 16;
            const u32x4* gp = (const u32x4*)(Y + row * NY + C_GR + ch);
            const u32x4 g0 = gp[0], g1 = gp[1];
            const unsigned gg[8] = {g0.x, g0.y, g0.z, g0.w, g1.x, g1.y, g1.z, g1.w};
            unsigned ow[8];
#pragma unroll
            for (int e = 0; e < 8; ++e) {
                const float y0 = v[2 * e] * rstd * norm_g[ch + 2 * e] * siluf_(bf_lo(gg[e]));
                const float y1 = v[2 * e + 1] * rstd * norm_g[ch + 2 * e + 1] * siluf_(bf_hi(gg[e]));
                ow[e] = pk_bf16(y0, y1);
            }
            u32x4* op = (u32x4*)(O + row * DM + 3 * 256 + ch);
            u32x4 w0, w1; w0.x = ow[0]; w0.y = ow[1]; w0.z = ow[2]; w0.w = ow[3]; w1.x = ow[4]; w1.y = ow[5]; w1.z = ow[6]; w1.w = ow[7];
            op[0] = w0; op[1] = w1;
        }
        __syncthreads();
    }
}

constexpr int NS_Q = 0;
constexpr int NS_K = 18432;
constexpr int NS_VT = 27648;
constexpr int NS_S = 36864;
constexpr int NS_P = 71680;
constexpr int NS_M = 90112;
constexpr int NS_L = NS_M + 512;
constexpr int NS_A = NS_L + 512;
constexpr int NS_G = NS_A + 512;
constexpr int NS_IMP = NS_G + 2048;
constexpr int NS_SEL = NS_IMP + 16384;
constexpr int NS_UM = NS_SEL + 512;
constexpr int NS_CARRY = NS_UM + 64;
constexpr int NS_BLIST = NS_CARRY + 256;
constexpr int NS_END = NS_BLIST + 512;

__device__ __forceinline__ void ns_stage_rows(const Ctx& c, lptr dst, const bf16_t* src, size_t ld) {
    const int rr = c.tid >> 3, cc = (c.tid & 7) * 8;
    *(LAS u32x4*)(dst + rr * 144 + cc * 2) = *(const u32x4*)(src + (size_t)rr * ld + cc);
}
__device__ __forceinline__ void ns_stage_T(const Ctx& c, lptr dst, const bf16_t* src, size_t ld) {
    const int rr = c.tid >> 3, cc = (c.tid & 7) * 8;
    const u32x4 v = *(const u32x4*)(src + (size_t)rr * ld + cc);
    const unsigned vv[4] = {v.x, v.y, v.z, v.w};
#pragma unroll
    for (int e = 0; e < 4; ++e) {
        *(LAS bf16_t*)(dst + (cc + 2 * e) * 144 + rr * 2) = (bf16_t)(vv[e] & 0xffffu);
        *(LAS bf16_t*)(dst + (cc + 2 * e + 1) * 144 + rr * 2) = (bf16_t)(vv[e] >> 16);
    }
}
__device__ __forceinline__ void ns_scores(const Ctx& c) {
    const int wm = c.wave >> 1, wn = c.wave & 1, r = c.lane & 31, h = c.lane >> 5;
    const f32x16 s = mma_lds(zero16(), c.lds + NS_Q + wm * 32 * 144, 144, c.lds + NS_K + wn * 32 * 144, 144, 64, c.lane);
    LAS float* Sf = (LAS float*)(c.lds + NS_S);
#pragma unroll
    for (int g = 0; g < 4; ++g) { f32x4 o; o[0] = s[4 * g]; o[1] = s[4 * g + 1]; o[2] = s[4 * g + 2]; o[3] = s[4 * g + 3]; *(LAS f32x4*)(Sf + (wm * 32 + r) * 68 + wn * 32 + 8 * g + 4 * h) = o; }
}
template <int MODE>
__device__ __forceinline__ bool ns_valid(int t, int kidx, int tok, const Ctx& c, float& dist) {
    if (MODE == 0) { const int d = t - 16 * kidx - 31; dist = (float)d; return d >= 0 && kidx < 511; }
    if (MODE == 1) { const int nb = kidx >> 6; const unsigned m = ((LAS const unsigned*)(c.lds + NS_SEL))[tok * 4 + (nb >> 5)]; const int d = t - kidx; dist = (float)d; return ((m >> (nb & 31)) & 1u) && d >= 0; }
    const int d = t - kidx; dist = (float)d; return d >= 0 && d < 512;
}
template <int MODE, int PASS>
__device__ __forceinline__ void ns_softmax(const Ctx& c, int t0, int k0) {
    LAS float* Sf = (LAS float*)(c.lds + NS_S);
    LAS float* Mr = (LAS float*)(c.lds + NS_M); LAS float* Lr = (LAS float*)(c.lds + NS_L); LAS float* Ar = (LAS float*)(c.lds + NS_A);
    const int row = c.tid >> 2, part = c.tid & 3, tok = row & 31, hh = row >> 5, t = t0 + tok;
    const float slope = exp2f(-2.0f * (float)(hh + 1));
    float s[16]; bool ok[16]; float mloc = NEGF;
#pragma unroll
    for (int e = 0; e < 16; ++e) {
        const int j = part * 16 + e; float dist;
        ok[e] = ns_valid<MODE>(t, k0 + j, tok, c, dist);
        s[e] = Sf[row * 68 + j] * 0.125f - slope * dist;
        if (ok[e]) mloc = fmaxf(mloc, s[e]);
    }
    mloc = fmaxf(mloc, __shfl_xor(mloc, 1)); mloc = fmaxf(mloc, __shfl_xor(mloc, 2));
    const float mold = Mr[row], lold = Lr[row];
    if (PASS == 2) {
        const float inv = lold > 0.f ? 1.0f / lold : 0.f;
        unsigned pw[8];
#pragma unroll
        for (int e = 0; e < 16; e += 2) {
            const float p0 = ok[e] ? __expf(s[e] - mold) * inv : 0.f, p1 = ok[e + 1] ? __expf(s[e + 1] - mold) * inv : 0.f;
            Sf[row * 68 + part * 16 + e] = p0; Sf[row * 68 + part * 16 + e + 1] = p1;
            pw[e >> 1] = pk_bf16(p0, p1);
        }
        u32x4 w0, w1; w0.x = pw[0]; w0.y = pw[1]; w0.z = pw[2]; w0.w = pw[3]; w1.x = pw[4]; w1.y = pw[5]; w1.z = pw[6]; w1.w = pw[7];
        *(LAS u32x4*)(c.lds + NS_P + row * 144 + part * 32) = w0; *(LAS u32x4*)(c.lds + NS_P + row * 144 + part * 32 + 16) = w1;
        return;
    }
    const float mnew = fmaxf(mold, mloc);
    float sum = 0.f; unsigned pw[8];
#pragma unroll
    for (int e = 0; e < 16; e += 2) {
        const float p0 = ok[e] ? __expf(s[e] - mnew) : 0.f, p1 = ok[e + 1] ? __expf(s[e + 1] - mnew) : 0.f;
        sum += p0 + p1; pw[e >> 1] = pk_bf16(p0, p1);
    }
    sum += __shfl_xor(sum, 1); sum += __shfl_xor(sum, 2);
    const float alpha = __expf(mold - mnew);
    if (PASS == 1) {
        u32x4 w0, w1; w0.x = pw[0]; w0.y = pw[1]; w0.z = pw[2]; w0.w = pw[3]; w1.x = pw[4]; w1.y = pw[5]; w1.z = pw[6]; w1.w = pw[7];
        *(LAS u32x4*)(c.lds + NS_P + row * 144 + part * 32) = w0; *(LAS u32x4*)(c.lds + NS_P + row * 144 + part * 32 + 16) = w1;
    }
    if (part == 0) { Mr[row] = mnew; Lr[row] = lold * alpha + sum; Ar[row] = alpha; }
}
__device__ __forceinline__ f32x16 ns_pv(const Ctx& c, f32x16 acc, bool rescale) {
    const int wm = c.wave >> 1, wn = c.wave & 1, r = c.lane & 31;
    if (rescale) { const float a = ((LAS const float*)(c.lds + NS_A))[wm * 32 + r];
#pragma unroll
        for (int e = 0; e < 16; ++e) acc[e] *= a; }
    return mma_lds(acc, c.lds + NS_P + wm * 32 * 144, 144, c.lds + NS_VT + wn * 32 * 144, 144, 64, c.lane);
}
__device__ __forceinline__ void ns_reset_stats(const Ctx& c) {
    if (c.tid < 128) { ((LAS float*)(c.lds + NS_M))[c.tid] = NEGF; ((LAS float*)(c.lds + NS_L))[c.tid] = 0.f; ((LAS float*)(c.lds + NS_A))[c.tid] = 1.f; }
}

__device__ __forceinline__ void phase_nsa(const Ctx& c, const bf16_t* Y, const bf16_t* KC, const bf16_t* VC, bf16_t* O) {
    LAS float* Sf = (LAS float*)(c.lds + NS_S);
    LAS float* Gt = (LAS float*)(c.lds + NS_G);
    LAS float* Imp = (LAS float*)(c.lds + NS_IMP);
    LAS unsigned* Sel = (LAS unsigned*)(c.lds + NS_SEL);
    LAS unsigned* Um = (LAS unsigned*)(c.lds + NS_UM);
    LAS float* Carry = (LAS float*)(c.lds + NS_CARRY);
    const int wm = c.wave >> 1, wn = c.wave & 1, r = c.lane & 31, h = c.lane >> 5;
    for (int u = c.blk; u < 512; u += c.nblk) {
        const int tq = u & 255, b = u >> 8;
        const int t0 = tq * 32;
        const size_t row0 = (size_t)b * SEQ + t0;
        {
            const int row = c.tid >> 2, dc = (c.tid & 3) * 16, tok = row & 31, hh = row >> 5;
            const u32x4* qp = (const u32x4*)(Y + (row0 + tok) * NY + C_NQ + hh * 64 + dc);
            *(LAS u32x4*)(c.lds + NS_Q + row * 144 + dc * 2) = qp[0]; *(LAS u32x4*)(c.lds + NS_Q + row * 144 + dc * 2 + 16) = qp[1];
            if (c.tid < 384) { const int rw = c.tid / 3, gi = c.tid % 3; Gt[rw * 4 + gi] = sigmoidf_(bf2f(Y[(row0 + (rw & 31)) * NY + C_NG + (rw >> 5) * 3 + gi])); }
            for (int i = c.tid; i < 32 * 128; i += NTHREADS) Imp[i] = 0.f;
            if (c.tid < 32) Carry[c.tid] = 0.f;
            if (c.tid < 4) Um[c.tid] = 0u;
            ns_reset_stats(c);
        }
        __syncthreads();
        f32x16 outacc = zero16();
        const int ncmp = min(t0 / 16 + 1, 511);
        const int nct = (ncmp + 63) / 64;
        const bf16_t* kcb = KC + (size_t)b * 512 * 64; const bf16_t* vcb = VC + (size_t)b * 512 * 64;
        for (int ct = 0; ct < nct; ++ct) {
            ns_stage_rows(c, c.lds + NS_K, kcb + (size_t)ct * 64 * 64, 64);
            __syncthreads();
            ns_scores(c);
            __syncthreads();
            ns_softmax<0, 0>(c, t0, ct * 64);
            __syncthreads();
        }
        {
            f32x16 acc = zero16();
            for (int ct = 0; ct < nct; ++ct) {
                ns_stage_rows(c, c.lds + NS_K, kcb + (size_t)ct * 64 * 64, 64);
                ns_stage_T(c, c.lds + NS_VT, vcb + (size_t)ct * 64 * 64, 64);
                __syncthreads();
                ns_scores(c);
                __syncthreads();
                ns_softmax<0, 2>(c, t0, ct * 64);
                __syncthreads();
                acc = ns_pv(c, acc, false);
                {
                    const int tok = c.tid >> 4, g = c.tid & 15;
                    float a = 0.f, last = 0.f, prev = 0.f;
#pragma unroll
                    for (int hh = 0; hh < 4; ++hh) {
                        const LAS float* pr = Sf + (hh * 32 + tok) * 68 + 4 * g;
                        a += (pr[0] + pr[1]) + (pr[2] + pr[3]);
                        last += pr[3];
                        if (g > 0) prev += pr[-1];
                    }
                    if (g == 0) prev = Carry[tok];
                    Imp[tok * 128 + ct * 16 + g] += a + prev;
                    __syncthreads();
                    if (g == 15) Carry[tok] = last;
                }
                __syncthreads();
            }
            const float g0 = Gt[(wm * 32 + r) * 4 + 0];
#pragma unroll
            for (int e = 0; e < 16; ++e) outacc[e] += g0 * acc[e];
        }
        for (int tk = 0; tk < 4; ++tk) {
            const int tok = c.wave * 4 + tk, t = t0 + tok, cur = t >> 6;
            float v0 = Imp[tok * 128 + c.lane], v1 = Imp[tok * 128 + 64 + c.lane];
            const int n0 = c.lane, n1 = c.lane + 64;
            if (n0 > cur) v0 = NEGF; if (n1 > cur) v1 = NEGF;
            if (n0 == cur) v0 = 1e30f; if (n1 == cur) v1 = 1e30f;
            unsigned m0 = 0u, m1 = 0u, m2 = 0u, m3 = 0u;
            for (int it = 0; it < 16; ++it) {
                const float mx = wave_max(fmaxf(v0, v1));
                if (mx <= NEGF) break;
                const unsigned long long b0 = __ballot(v0 == mx);
                int nsel;
                if (b0) { nsel = __ffsll((long long)b0) - 1; if (c.lane == nsel) v0 = -3e38f; }
                else { const unsigned long long b1 = __ballot(v1 == mx); const int l1 = __ffsll((long long)b1) - 1; nsel = 64 + l1; if (c.lane == l1) v1 = -3e38f; }
                if (nsel < 32) m0 |= 1u << nsel; else if (nsel < 64) m1 |= 1u << (nsel - 32); else if (nsel < 96) m2 |= 1u << (nsel - 64); else m3 |= 1u << (nsel - 96);
            }
            if (c.lane == 0) {
                Sel[tok * 4 + 0] = m0; Sel[tok * 4 + 1] = m1; Sel[tok * 4 + 2] = m2; Sel[tok * 4 + 3] = m3;
                atomicOr((unsigned*)&Um[0], m0); atomicOr((unsigned*)&Um[1], m1); atomicOr((unsigned*)&Um[2], m2); atomicOr((unsigned*)&Um[3], m3);
            }
        }
        ns_reset_stats(c);
        __syncthreads();
        {
            f32x16 acc = zero16();
            const bf16_t* ksb = Y + (size_t)b * SEQ * NY + C_NKS; const bf16_t* vsb = Y + (size_t)b * SEQ * NY + C_NVS;
            for (int wd = 0; wd < 4; ++wd) {
                unsigned bits = Um[wd];
                while (bits) {
                    const int nb = wd * 32 + __ffs((int)bits) - 1; bits &= bits - 1;
                    ns_stage_rows(c, c.lds + NS_K, ksb + (size_t)nb * 64 * NY, NY);
                    ns_stage_T(c, c.lds + NS_VT, vsb + (size_t)nb * 64 * NY, NY);
                    __syncthreads();
                    ns_scores(c);
                    __syncthreads();
                    ns_softmax<1, 1>(c, t0, nb * 64);
                    __syncthreads();
                    acc = ns_pv(c, acc, true);
                    __syncthreads();
                }
            }
            const float l = ((LAS const float*)(c.lds + NS_L))[wm * 32 + r];
            const float g1 = Gt[(wm * 32 + r) * 4 + 1] * (l > 0.f ? 1.0f / l : 0.f);
#pragma unroll
            for (int e = 0; e < 16; ++e) outacc[e] += g1 * acc[e];
        }
        __syncthreads();
        ns_reset_stats(c);
        __syncthreads();
        {
            f32x16 acc = zero16();
            const bf16_t* kwb = Y + (size_t)b * SEQ * NY + C_NKW; const bf16_t* vwb = Y + (size_t)b * SEQ * NY + C_NVW;
            const int kt1 = t0 >> 6, kt0 = max(0, kt1 - 8);
            for (int kt = kt0; kt <= kt1; ++kt) {
                ns_stage_rows(c, c.lds + NS_K, kwb + (size_t)kt * 64 * NY, NY);
                ns_stage_T(c, c.lds + NS_VT, vwb + (size_t)kt * 64 * NY, NY);
                __syncthreads();
                ns_scores(c);
                __syncthreads();
                ns_softmax<2, 1>(c, t0, kt * 64);
                __syncthreads();
                acc = ns_pv(c, acc, true);
                __syncthreads();
            }
            const float l = ((LAS const float*)(c.lds + NS_L))[wm * 32 + r];
            const float g2 = Gt[(wm * 32 + r) * 4 + 2] * (l > 0.f ? 1.0f / l : 0.f);
#pragma unroll
            for (int e = 0; e < 16; ++e) outacc[e] += g2 * acc[e];
        }
        {
            bf16_t* op = O + (row0 + r) * DM + 256 + wm * 64 + wn * 32 + 4 * h;
#pragma unroll
            for (int g = 0; g < 4; ++g) { u32x2 w; w.x = pk_bf16(outacc[4 * g], outacc[4 * g + 1]); w.y = pk_bf16(outacc[4 * g + 2], outacc[4 * g + 3]); *(u32x2*)(op + 8 * g) = w; }
        }
        __syncthreads();
    }
}

__device__ __forceinline__ void phase_sb2(const Ctx& c, const bf16_t* Y, bf16_t* O) {
    LAS float* Sf = (LAS float*)(c.lds + NS_S);
    LAS float* Cr = (LAS float*)(c.lds + NS_M);
    const int wm = c.wave >> 1, wn = c.wave & 1, r = c.lane & 31, h = c.lane >> 5;
    for (int u = c.blk; u < 512; u += c.nblk) {
        const int b = u >> 8, hh = (u >> 6) & 3, qt = b ? 63 - (u & 63) : (u & 63);
        const int t0 = qt * 128;
        const size_t row0 = (size_t)b * SEQ + t0;
        {
            const int row = c.tid >> 2, dc = (c.tid & 3) * 16;
            const u32x4* qp = (const u32x4*)(Y + (row0 + row) * NY + C_SBQ + hh * 64 + dc);
            *(LAS u32x4*)(c.lds + NS_Q + row * 144 + dc * 2) = qp[0]; *(LAS u32x4*)(c.lds + NS_Q + row * 144 + dc * 2 + 16) = qp[1];
            if (c.tid < 128) Cr[c.tid] = 0.f;
        }
        LAS volatile unsigned* NotDone = (LAS volatile unsigned*)(c.lds + NS_L);
        f32x16 acc = zero16();
        const bf16_t* kb = Y + (size_t)b * SEQ * NY + C_SBK + hh * 64; const bf16_t* vb = Y + (size_t)b * SEQ * NY + C_SBV + hh * 64;
        for (int kt = 2 * qt + 1; kt >= 0; --kt) {
            ns_stage_rows(c, c.lds + NS_K, kb + (size_t)kt * 64 * NY, NY);
            ns_stage_T(c, c.lds + NS_VT, vb + (size_t)kt * 64 * NY, NY);
            if (c.tid == 0) NotDone[0] = 0u;
            __syncthreads();
            ns_scores(c);
            __syncthreads();
            {
                const int row = c.tid >> 2, part = c.tid & 3, t = t0 + row;
                float z[16], suf[16]; bool ok[16];
                float run = 0.f;
#pragma unroll
                for (int e = 15; e >= 0; --e) {
                    const int pos = kt * 64 + part * 16 + e;
                    z[e] = Sf[row * 68 + part * 16 + e] * 0.125f;
                    ok[e] = pos < t;
                    run += ok[e] ? -softplusf_(z[e]) : 0.f;
                    suf[e] = run;
                }
                const float tot = run;
                const float t1 = __shfl_down(tot, 1), t2 = __shfl_down(tot, 2), t3 = __shfl_down(tot, 3);
                const float thigh = (part < 3 ? t1 : 0.f) + (part < 2 ? t2 : 0.f) + (part < 1 ? t3 : 0.f);
                const float carry = Cr[row];
                unsigned pw[8];
#pragma unroll
                for (int e = 0; e < 16; e += 2) {
                    const float w0 = ok[e] ? __expf(z[e] + carry + thigh + suf[e]) : 0.f, w1 = ok[e + 1] ? __expf(z[e + 1] + carry + thigh + suf[e + 1]) : 0.f;
                    pw[e >> 1] = pk_bf16(w0, w1);
                }
                u32x4 w0, w1; w0.x = pw[0]; w0.y = pw[1]; w0.z = pw[2]; w0.w = pw[3]; w1.x = pw[4]; w1.y = pw[5]; w1.z = pw[6]; w1.w = pw[7];
                *(LAS u32x4*)(c.lds + NS_P + row * 144 + part * 32) = w0; *(LAS u32x4*)(c.lds + NS_P + row * 144 + part * 32 + 16) = w1;
                const float cn = carry + thigh + tot;
                if (part == 0) { Cr[row] = cn; if (!(cn < -104.0f)) NotDone[0] = 1u; }
            }
            __syncthreads();
            const bool alldone = (NotDone[0] == 0u);
            acc = ns_pv(c, acc, false);
            __syncthreads();
            if (alldone) break;
        }
        {
            bf16_t* op = O + (row0 + wm * 32 + r) * DM + hh * 64 + wn * 32 + 4 * h;
#pragma unroll
            for (int g = 0; g < 4; ++g) { u32x2 w; w.x = pk_bf16(acc[4 * g], acc[4 * g + 1]); w.y = pk_bf16(acc[4 * g + 2], acc[4 * g + 3]); *(u32x2*)(op + 8 * g) = w; }
        }
        __syncthreads();
    }
}

struct TileSeq { const bf16_t* kbase; const bf16_t* vbase; size_t ld; int first, step; LAS const int* list; };
__device__ __forceinline__ int seq_idx(const TileSeq& s, int i) { return s.list ? s.list[i] : s.first + s.step * i; }
__device__ __forceinline__ u32x4 ns_ldK(const Ctx& c, const bf16_t* src, size_t ld) { return *(const u32x4*)(src + (size_t)(c.tid >> 3) * ld + (c.tid & 7) * 8); }
__device__ __forceinline__ u32x4 ns_ldV(const Ctx& c, const bf16_t* src, size_t ld) { return *(const u32x4*)(src + (size_t)(c.tid & 63) * ld + (c.tid >> 6) * 8); }
__device__ __forceinline__ void ns_stK(const Ctx& c, u32x4 v) { *(LAS u32x4*)(c.lds + NS_K + (c.tid >> 3) * 144 + (c.tid & 7) * 16) = v; }
__device__ __forceinline__ void ns_stVT(const Ctx& c, u32x4 v) {
    const int key = c.tid & 63, e0 = (c.tid >> 6) * 8;
    const unsigned vv[4] = {v.x, v.y, v.z, v.w};
#pragma unroll
    for (int e = 0; e < 4; ++e) {
        *(LAS bf16_t*)(c.lds + NS_VT + (e0 + 2 * e) * 144 + key * 2) = (bf16_t)(vv[e] & 0xffffu);
        *(LAS bf16_t*)(c.lds + NS_VT + (e0 + 2 * e + 1) * 144 + key * 2) = (bf16_t)(vv[e] >> 16);
    }
}
__device__ __forceinline__ void sb_scan(const Ctx& c, int t0, int k0) {
    LAS float* Sf = (LAS float*)(c.lds + NS_S);
    LAS float* Cr = (LAS float*)(c.lds + NS_M);
    LAS volatile unsigned* NotDone = (LAS volatile unsigned*)(c.lds + NS_L);
    const int row = c.tid >> 2, part = c.tid & 3, t = t0 + row;
    float z[16], suf[16]; bool ok[16];
    float run = 0.f;
#pragma unroll
    for (int e = 15; e >= 0; --e) {
        const int pos = k0 + part * 16 + e;
        z[e] = Sf[row * 68 + part * 16 + e] * 0.125f;
        ok[e] = pos < t;
        run += ok[e] ? -softplusf_(z[e]) : 0.f;
        suf[e] = run;
    }
    const float tot = run;
    const float t1 = __shfl_down(tot, 1), t2 = __shfl_down(tot, 2), t3 = __shfl_down(tot, 3);
    const float thigh = (part < 3 ? t1 : 0.f) + (part < 2 ? t2 : 0.f) + (part < 1 ? t3 : 0.f);
    const float carry = Cr[row];
    unsigned pw[8];
#pragma unroll
    for (int e = 0; e < 16; e += 2) {
        const float w0 = ok[e] ? __expf(z[e] + carry + thigh + suf[e]) : 0.f, w1 = ok[e + 1] ? __expf(z[e + 1] + carry + thigh + suf[e + 1]) : 0.f;
        pw[e >> 1] = pk_bf16(w0, w1);
    }
    u32x4 w0, w1; w0.x = pw[0]; w0.y = pw[1]; w0.z = pw[2]; w0.w = pw[3]; w1.x = pw[4]; w1.y = pw[5]; w1.z = pw[6]; w1.w = pw[7];
    *(LAS u32x4*)(c.lds + NS_P + row * 144 + part * 32) = w0; *(LAS u32x4*)(c.lds + NS_P + row * 144 + part * 32 + 16) = w1;
    const float cn = carry + thigh + tot;
    if (part == 0) { Cr[row] = cn; if (!(cn < -104.0f)) NotDone[0] = 1u; }
}
__device__ __forceinline__ void ns_importance(const Ctx& c, int ct) {
    LAS float* Sf = (LAS float*)(c.lds + NS_S);
    LAS float* Imp = (LAS float*)(c.lds + NS_IMP);
    LAS float* Carry = (LAS float*)(c.lds + NS_CARRY);
    const int tok = c.tid >> 4, g = c.tid & 15;
    float a = 0.f, last = 0.f, prev = 0.f;
#pragma unroll
    for (int hh = 0; hh < 4; ++hh) {
        const LAS float* pr = Sf + (hh * 32 + tok) * 68 + 4 * g;
        a += (pr[0] + pr[1]) + (pr[2] + pr[3]);
        last += pr[3];
        if (g > 0) prev += pr[-1];
    }
    if (g == 0) prev = Carry[(ct & 1) * 32 + tok];
    Imp[tok * 128 + ct * 16 + g] += a + prev;
    if (g == 15) Carry[((ct + 1) & 1) * 32 + tok] = last;
}
template <int MODE, int PASS, bool HASV>
__device__ __forceinline__ f32x16 ns_loop(const Ctx& c, f32x16 acc, int t0, int ntiles, const TileSeq sq) {
    if (ntiles <= 0) return acc;
    int idx = seq_idx(sq, 0);
    u32x4 rk = ns_ldK(c, sq.kbase + (size_t)idx * 64 * sq.ld, sq.ld), rv = rk;
    if (HASV) rv = ns_ldV(c, sq.vbase + (size_t)idx * 64 * sq.ld, sq.ld);
    ns_stK(c, rk); if (HASV) ns_stVT(c, rv);
    __syncthreads();
    for (int i = 0; i < ntiles; ++i) {
        const int k0 = idx * 64;
        const bool more = (i + 1 < ntiles);
        int nidx = idx;
        if (more) {
            nidx = seq_idx(sq, i + 1);
            rk = ns_ldK(c, sq.kbase + (size_t)nidx * 64 * sq.ld, sq.ld);
            if (HASV) rv = ns_ldV(c, sq.vbase + (size_t)nidx * 64 * sq.ld, sq.ld);
        }
        if (MODE == 3 && c.tid == 0) ((LAS volatile unsigned*)(c.lds + NS_L))[0] = 0u;
        ns_scores(c);
        __syncthreads();
        if (MODE == 3) sb_scan(c, t0, k0); else ns_softmax<(MODE == 3 ? 0 : MODE), PASS>(c, t0, k0);
        if (more) ns_stK(c, rk);
        __syncthreads();
        bool stop = false;
        if (MODE == 3) stop = (((LAS volatile unsigned*)(c.lds + NS_L))[0] == 0u);
        if (HASV) {
            acc = ns_pv(c, acc, MODE != 3 && PASS == 1);
            if (MODE == 0 && PASS == 2) ns_importance(c, idx);
            __syncthreads();
            if (more && !stop) ns_stVT(c, rv);
        }
        if (stop) break;
        idx = nidx;
    }
    __syncthreads();
    return acc;
}

__device__ __forceinline__ void phase_nsa2(const Ctx& c, const bf16_t* Y, const bf16_t* KCp, const bf16_t* VCp, bf16_t* Op) {
    LAS float* Gt = (LAS float*)(c.lds + NS_G);
    LAS float* Imp = (LAS float*)(c.lds + NS_IMP);
    LAS unsigned* Sel = (LAS unsigned*)(c.lds + NS_SEL);
    LAS unsigned* Um = (LAS unsigned*)(c.lds + NS_UM);
    LAS float* Carry = (LAS float*)(c.lds + NS_CARRY);
    LAS int* Blist = (LAS int*)(c.lds + NS_BLIST);
    const int wm = c.wave >> 1, wn = c.wave & 1, r = c.lane & 31, h = c.lane >> 5;
    for (int u = c.blk; u < 512; u += c.nblk) {
        const int b = u >> 8, tq = b ? 255 - (u & 255) : (u & 255);
        const int t0 = tq * 32;
        const size_t row0 = (size_t)b * SEQ + t0;
        {
            const int row = c.tid >> 2, dc = (c.tid & 3) * 16, tok = row & 31, hh = row >> 5;
            const u32x4* qp = (const u32x4*)(Y + (row0 + tok) * NY + C_NQ + hh * 64 + dc);
            *(LAS u32x4*)(c.lds + NS_Q + row * 144 + dc * 2) = qp[0]; *(LAS u32x4*)(c.lds + NS_Q + row * 144 + dc * 2 + 16) = qp[1];
            if (c.tid < 384) { const int rw = c.tid / 3, gi = c.tid % 3; Gt[rw * 4 + gi] = sigmoidf_(bf2f(Y[(row0 + (rw & 31)) * NY + C_NG + (rw >> 5) * 3 + gi])); }
            for (int i = c.tid; i < 32 * 128; i += NTHREADS) Imp[i] = 0.f;
            if (c.tid < 64) Carry[c.tid] = 0.f;
            if (c.tid < 4) Um[c.tid] = 0u;
            ns_reset_stats(c);
        }
        __syncthreads();
        f32x16 outacc = zero16();
        const int ncmp = min(t0 / 16 + 1, 511);
        const int nct = (ncmp + 63) / 64;
        {
            const TileSeq sq{KCp + (size_t)b * 512 * 64, VCp + (size_t)b * 512 * 64, 64, 0, 1, nullptr};
            (void)ns_loop<0, 0, false>(c, zero16(), t0, nct, sq);
            const f32x16 acc = ns_loop<0, 2, true>(c, zero16(), t0, nct, sq);
            const float g0 = Gt[(wm * 32 + r) * 4 + 0];
#pragma unroll
            for (int e = 0; e < 16; ++e) outacc[e] += g0 * acc[e];
        }
        for (int tk = 0; tk < 4; ++tk) {
            const int tok = c.wave * 4 + tk, t = t0 + tok, cur = t >> 6;
            float v0 = Imp[tok * 128 + c.lane], v1 = Imp[tok * 128 + 64 + c.lane];
            const int n0 = c.lane, n1 = c.lane + 64;
            if (n0 > cur) v0 = NEGF; if (n1 > cur) v1 = NEGF;
            if (n0 == cur) v0 = 1e30f; if (n1 == cur) v1 = 1e30f;
            unsigned m0 = 0u, m1 = 0u, m2 = 0u, m3 = 0u;
            for (int it = 0; it < 16; ++it) {
                const float mx = wave_max(fmaxf(v0, v1));
                if (mx <= NEGF) break;
                const unsigned long long b0 = __ballot(v0 == mx);
                int nsel;
                if (b0) { nsel = __ffsll((long long)b0) - 1; if (c.lane == nsel) v0 = -3e38f; }
                else { const unsigned long long b1 = __ballot(v1 == mx); const int l1 = __ffsll((long long)b1) - 1; nsel = 64 + l1; if (c.lane == l1) v1 = -3e38f; }
                if (nsel < 32) m0 |= 1u << nsel; else if (nsel < 64) m1 |= 1u << (nsel - 32); else if (nsel < 96) m2 |= 1u << (nsel - 64); else m3 |= 1u << (nsel - 96);
            }
            if (c.lane == 0) {
                Sel[tok * 4 + 0] = m0; Sel[tok * 4 + 1] = m1; Sel[tok * 4 + 2] = m2; Sel[tok * 4 + 3] = m3;
                atomicOr((unsigned*)&Um[0], m0); atomicOr((unsigned*)&Um[1], m1); atomicOr((unsigned*)&Um[2], m2); atomicOr((unsigned*)&Um[3], m3);
            }
        }
        ns_reset_stats(c);
        __syncthreads();
        int nsel_blocks;
        {
            const unsigned u0 = Um[0], u1 = Um[1], u2 = Um[2], u3 = Um[3];
            nsel_blocks = __popc(u0) + __popc(u1) + __popc(u2) + __popc(u3);
            if (c.tid < 128) {
                const unsigned wd = c.tid >> 5, bt = c.tid & 31;
                const unsigned mine = wd == 0 ? u0 : wd == 1 ? u1 : wd == 2 ? u2 : u3;
                if ((mine >> bt) & 1u) {
                    int pos = __popc(mine & ((1u << bt) - 1u));
                    if (wd > 0) pos += __popc(u0); if (wd > 1) pos += __popc(u1); if (wd > 2) pos += __popc(u2);
                    Blist[pos] = (int)c.tid;
                }
            }
        }
        __syncthreads();
        {
            const TileSeq sq{Y + (size_t)b * SEQ * NY + C_NKS, Y + (size_t)b * SEQ * NY + C_NVS, (size_t)NY, 0, 0, Blist};
            const f32x16 acc = ns_loop<1, 1, true>(c, zero16(), t0, nsel_blocks, sq);
            const float l = ((LAS const float*)(c.lds + NS_L))[wm * 32 + r];
            const float g1 = Gt[(wm * 32 + r) * 4 + 1] * (l > 0.f ? 1.0f / l : 0.f);
#pragma unroll
            for (int e = 0; e < 16; ++e) outacc[e] += g1 * acc[e];
        }
        __syncthreads();
        ns_reset_stats(c);
        __syncthreads();
        {
            const int kt1 = t0 >> 6, kt0 = max(0, kt1 - 8);
            const TileSeq sq{Y + (size_t)b * SEQ * NY + C_NKW, Y + (size_t)b * SEQ * NY + C_NVW, (size_t)NY, kt0, 1, nullptr};
            const f32x16 acc = ns_loop<2, 1, true>(c, zero16(), t0, kt1 - kt0 + 1, sq);
            const float l = ((LAS const float*)(c.lds + NS_L))[wm * 32 + r];
            const float g2 = Gt[(wm * 32 + r) * 4 + 2] * (l > 0.f ? 1.0f / l : 0.f);
#pragma unroll
            for (int e = 0; e < 16; ++e) outacc[e] += g2 * acc[e];
        }
        {
            bf16_t* op = Op + (row0 + r) * DM + 256 + wm * 64 + wn * 32 + 4 * h;
#pragma unroll
            for (int g = 0; g < 4; ++g) { u32x2 w; w.x = pk_bf16(outacc[4 * g], outacc[4 * g + 1]); w.y = pk_bf16(outacc[4 * g + 2], outacc[4 * g + 3]); *(u32x2*)(op + 8 * g) = w; }
        }
        __syncthreads();
    }
}
__device__ __forceinline__ void phase_sb3(const Ctx& c, const bf16_t* Y, bf16_t* Op) {
    LAS float* Cr = (LAS float*)(c.lds + NS_M);
    const int wm = c.wave >> 1, wn = c.wave & 1, r = c.lane & 31, h = c.lane >> 5;
    for (int u = c.blk; u < 512; u += c.nblk) {
        const int b = u >> 8, hh = (u >> 6) & 3, qt = b ? 63 - (u & 63) : (u & 63);
        const int t0 = qt * 128;
        const size_t row0 = (size_t)b * SEQ + t0;
        {
            const int row = c.tid >> 2, dc = (c.tid & 3) * 16;
            const u32x4* qp = (const u32x4*)(Y + (row0 + row) * NY + C_SBQ + hh * 64 + dc);
            *(LAS u32x4*)(c.lds + NS_Q + row * 144 + dc * 2) = qp[0]; *(LAS u32x4*)(c.lds + NS_Q + row * 144 + dc * 2 + 16) = qp[1];
            if (c.tid < 128) Cr[c.tid] = 0.f;
        }
        const TileSeq sq{Y + (size_t)b * SEQ * NY + C_SBK + hh * 64, Y + (size_t)b * SEQ * NY + C_SBV + hh * 64, (size_t)NY, 2 * qt + 1, -1, nullptr};
        const f32x16 acc = ns_loop<3, 1, true>(c, zero16(), t0, 2 * qt + 2, sq);
        {
            bf16_t* op = Op + (row0 + wm * 32 + r) * DM + hh * 64 + wn * 32 + 4 * h;
#pragma unroll
            for (int g = 0; g < 4; ++g) { u32x2 w; w.x = pk_bf16(acc[4 * g], acc[4 * g + 1]); w.y = pk_bf16(acc[4 * g + 2], acc[4 * g + 3]); *(u32x2*)(op + 8 * g) = w; }
        }
        __syncthreads();
    }
}

__device__ __forceinline__ void phase_subkey(const Ctx& c, const bf16_t* QV, const bf16_t* KEYS, float* TOPS, int* TOPI) {
    constexpr int SC_OFF = 73728;
    LAS float* Sc = (LAS float*)(c.lds + SC_OFF);
    const int wm = c.wave >> 1, wn = c.wave & 1, r = c.lane & 31, h = c.lane >> 5;
    for (int u = c.blk; u < 128 * 16; u += c.nblk) {
        const int hp = u & 15, pm = u >> 4;
        f32x16 acc[1][2]; acc_zero<1, 2>(acc);
        gemm_kloop<1, 2>(c, acc, QV + (size_t)pm * 128 * 2048 + hp * 128, 2048, KEYS + (size_t)hp * 128 * 128, 128, 128);
        EPI_LOOP(1, 2) {
            const int m = (wm + i) * 32 + r, n = (wn * 2 + j) * 32 + 8 * g + 4 * h;
            f32x4 o; o[0] = acc[i][j][4 * g]; o[1] = acc[i][j][4 * g + 1]; o[2] = acc[i][j][4 * g + 2]; o[3] = acc[i][j][4 * g + 3];
            *(LAS f32x4*)(Sc + m * 132 + n) = o;
        }
        __syncthreads();
        for (int rr = 0; rr < 16; ++rr) {
            const int row = c.wave * 16 + rr;
            float v0 = Sc[row * 132 + c.lane], v1 = Sc[row * 132 + 64 + c.lane];
            float ks = 0.f; int ki = 0;
            for (int it = 0; it < 16; ++it) {
                const float mx = wave_max(fmaxf(v0, v1));
                const unsigned long long b0 = __ballot(v0 == mx);
                int nsel;
                if (b0) { nsel = __ffsll((long long)b0) - 1; if (c.lane == nsel) v0 = -3e38f; }
                else { const unsigned long long b1 = __ballot(v1 == mx); const int l1 = __ffsll((long long)b1) - 1; nsel = 64 + l1; if (c.lane == l1) v1 = -3e38f; }
                if (c.lane == it) { ks = mx; ki = nsel; }
            }
            if (c.lane < 16) {
                const size_t o = ((size_t)(pm * 128 + row) * 16 + hp) * 16 + c.lane;
                TOPS[o] = ks; TOPI[o] = ki;
            }
        }
        __syncthreads();
    }
}


__device__ __forceinline__ unsigned ord_key(float s) { const unsigned u = __float_as_uint(s); return u ^ ((unsigned)((int)u >> 31) | 0x80000000u); }
__device__ __forceinline__ float unord_key(unsigned k) { const unsigned u = (k & 0x80000000u) ? (k ^ 0x80000000u) : ~k; return __uint_as_float(u); }
#define CE_DESC(a, b) do { const unsigned _hi = max((a), (b)), _lo = min((a), (b)); (a) = _hi; (b) = _lo; } while (0)
__device__ __forceinline__ void sort16_desc(unsigned (&k)[16]) {
#pragma unroll
    for (int size = 2; size <= 16; size <<= 1)
#pragma unroll
        for (int stride = size >> 1; stride > 0; stride >>= 1)
#pragma unroll
            for (int i = 0; i < 16; ++i) {
                const int j = i ^ stride;
                if (j > i) { if ((i & size) == 0) CE_DESC(k[i], k[j]); else CE_DESC(k[j], k[i]); }
            }
}
__device__ __forceinline__ void bitonic_merge16_desc(unsigned (&k)[16]) {
#pragma unroll
    for (int stride = 8; stride > 0; stride >>= 1)
#pragma unroll
        for (int i = 0; i < 16; ++i) { const int j = i ^ stride; if (j > i) CE_DESC(k[i], k[j]); }
}
__device__ __forceinline__ void top16_merge(unsigned (&a)[16], const unsigned (&b)[16]) {
#pragma unroll
    for (int i = 0; i < 16; ++i) a[i] = max(a[i], b[15 - i]);
    bitonic_merge16_desc(a);
}

__device__ __forceinline__ void phase_subkey2(const Ctx& c, const bf16_t* QV, const bf16_t* KEYS, float* TOPS, int* TOPI) {
    const lptr Ab = c.lds, Bb = c.lds + 256 * 272;
    const int r = c.lane & 31, h = c.lane >> 5;
    int cur_hp = -1;
    for (int u = c.blk; u < 64 * 16; u += c.nblk) {
        const int hp = u & 15, pm = u >> 4;
        if (hp != cur_hp) {
            cur_hp = hp;
#pragma unroll
            for (int i = 0; i < 4; ++i) { const int id = c.tid + i * NTHREADS; *(LAS u32x4*)(Bb + (id >> 4) * 272 + (id & 15) * 16) = *(const u32x4*)(KEYS + (size_t)hp * 128 * 128 + (size_t)(id >> 4) * 128 + (id & 15) * 8); }
        }
#pragma unroll
        for (int i = 0; i < 8; ++i) { const int id = c.tid + i * NTHREADS; *(LAS u32x4*)(Ab + (id >> 4) * 272 + (id & 15) * 16) = *(const u32x4*)(QV + (size_t)(pm * 256 + (id >> 4)) * 2048 + hp * 128 + (id & 15) * 8); }
        __syncthreads();
        f32x16 acc[4];
#pragma unroll
        for (int j = 0; j < 4; ++j) acc[j] = zero16();
#pragma unroll
        for (int s = 0; s < 8; ++s) {
            const bf16x8 fa = *(LAS const bf16x8*)(Ab + (c.wave * 32 + r) * 272 + s * 32 + h * 16);
#pragma unroll
            for (int j = 0; j < 4; ++j) {
                const bf16x8 fb = *(LAS const bf16x8*)(Bb + (j * 32 + r) * 272 + s * 32 + h * 16);
                acc[j] = __builtin_amdgcn_mfma_f32_32x32x16_bf16(fb, fa, acc[j], 0, 0, 0);
            }
        }
        unsigned best[16];
#pragma unroll
        for (int j = 0; j < 4; ++j) {
            unsigned k[16];
#pragma unroll
            for (int g = 0; g < 4; ++g)
#pragma unroll
                for (int e = 0; e < 4; ++e) { const int n = j * 32 + 8 * g + 4 * h + e; k[4 * g + e] = (ord_key(acc[j][4 * g + e]) & ~127u) | (unsigned)(127 - n); }
            sort16_desc(k);
            if (j == 0) {
#pragma unroll
                for (int i = 0; i < 16; ++i) best[i] = k[i];
            } else top16_merge(best, k);
        }
        {
            unsigned other[16];
#pragma unroll
            for (int i = 0; i < 16; ++i) other[i] = (unsigned)__shfl_xor((int)best[i], 32);
            top16_merge(best, other);
        }
        {
            const size_t o = ((size_t)(pm * 256 + c.wave * 32 + r) * 16 + hp) * 16 + 8 * h;
            f32x4 s0, s1; int i0[4], i1[4];
#pragma unroll
            for (int i = 0; i < 4; ++i) {
                const unsigned ka = h ? best[8 + i] : best[i], kb = h ? best[12 + i] : best[4 + i];
                s0[i] = unord_key((ka & ~127u) | 64u); s1[i] = unord_key((kb & ~127u) | 64u);
                i0[i] = 127 - (int)(ka & 127u); i1[i] = 127 - (int)(kb & 127u);
            }
            *(f32x4*)(TOPS + o) = s0; *(f32x4*)(TOPS + o + 4) = s1;
            int4 w0 = make_int4(i0[0], i0[1], i0[2], i0[3]), w1 = make_int4(i1[0], i1[1], i1[2], i1[3]);
            *(int4*)(TOPI + o) = w0; *(int4*)(TOPI + o + 4) = w1;
        }
        __syncthreads();
    }
}

__device__ __forceinline__ float gelu_erf(float x) { return 0.5f * x * (1.0f + erff(x * 0.70710678118654752f)); }
__device__ __forceinline__ void phase_peer(const Ctx& c, const float* XF, const bf16_t* XB, const float* TOPS, const int* TOPI, const bf16_t* UB, const bf16_t* VB,
                                           const float* ln_g, const float* ln_b, float* outf, bf16_t* outb, bool store) {
    LAS int* eidx = (LAS int*)(c.lds + c.wave * 1024);
    LAS float* ewt = (LAS float*)(c.lds + c.wave * 1024 + 512);
    const int lane = c.lane;
    for (int tok = c.blk * 8 + c.wave; tok < NTOK; tok += c.nblk * 8) {
        for (int hh = 0; hh < 8; ++hh) {
            const float* ts = TOPS + ((size_t)tok * 16 + hh * 2) * 16; const int* ti = TOPI + ((size_t)tok * 16 + hh * 2) * 16;
            const int a = lane >> 2, bq = (lane & 3) * 4;
            const float sa = ts[a];
            const f32x4 sb = *(const f32x4*)(ts + 16 + bq);
            float v[4] = {sa + sb[0], sa + sb[1], sa + sb[2], sa + sb[3]};
            float ks = 0.f; int kf = 0;
            for (int it = 0; it < 16; ++it) {
                const float lm = fmaxf(fmaxf(v[0], v[1]), fmaxf(v[2], v[3]));
                const float mx = wave_max(lm);
                const unsigned long long bl = __ballot(lm == mx);
                const int wl = (__ffsll((long long)bl) - 1) & 63;
                int li = (v[0] == mx) ? 0 : (v[1] == mx) ? 1 : (v[2] == mx) ? 2 : 3;
                li = __builtin_amdgcn_readlane(li, wl);
                if (lane == wl) { if (li == 0) v[0] = -3e38f; else if (li == 1) v[1] = -3e38f; else if (li == 2) v[2] = -3e38f; else v[3] = -3e38f; }
                if (lane == it) { ks = mx; kf = wl * 4 + li; }
            }
            float mx16 = (lane < 16) ? ks : -3e38f;
            mx16 = wave_max(mx16);
            const float ex = (lane < 16) ? __expf(ks - mx16) : 0.f;
            const float den = wave_sum(ex);
            if (lane < 16) {
                const int ia = ti[kf >> 4], ib = ti[16 + (kf & 15)];
                eidx[hh * 16 + lane] = (ia * 128 + ib) & 16383;
                ewt[hh * 16 + lane] = ex / den;
            }
        }
        asm volatile("s_waitcnt lgkmcnt(0)" ::: "memory");
        unsigned xb[8];
        {
            const u32x4 x0 = *(const u32x4*)(XB + (size_t)tok * DM + lane * 8), x1 = *(const u32x4*)(XB + (size_t)tok * DM + 512 + lane * 8);
            xb[0] = x0.x; xb[1] = x0.y; xb[2] = x0.z; xb[3] = x0.w; xb[4] = x1.x; xb[5] = x1.y; xb[6] = x1.z; xb[7] = x1.w;
        }
        for (int e0 = 0; e0 < 128; e0 += 8) {
            u32x4 ua[8], ub2[8];
#pragma unroll
            for (int j = 0; j < 8; ++j) {
                const int ex = __builtin_amdgcn_readfirstlane(eidx[e0 + j]);
                const bf16_t* up = UB + (size_t)ex * DM;
                ua[j] = *(const u32x4*)(up + lane * 8); ub2[j] = *(const u32x4*)(up + 512 + lane * 8);
            }
            float p[8];
#pragma unroll
            for (int j = 0; j < 8; ++j) {
                float s0 = dot2bf(xb[0], ua[j].x, 0.f), s1 = dot2bf(xb[1], ua[j].y, 0.f);
                s0 = dot2bf(xb[2], ua[j].z, s0); s1 = dot2bf(xb[3], ua[j].w, s1);
                s0 = dot2bf(xb[4], ub2[j].x, s0); s1 = dot2bf(xb[5], ub2[j].y, s1);
                s0 = dot2bf(xb[6], ub2[j].z, s0); s1 = dot2bf(xb[7], ub2[j].w, s1);
                p[j] = s0 + s1;
            }
            const bool b5 = lane & 32, b4 = lane & 16, b3 = lane & 8;
            float q4[4], q2[2], q1;
#pragma unroll
            for (int j = 0; j < 4; ++j) { const float send = b5 ? p[j] : p[j + 4], keep = b5 ? p[j + 4] : p[j]; q4[j] = keep + __shfl_xor(send, 32); }
#pragma unroll
            for (int j = 0; j < 2; ++j) { const float send = b4 ? q4[j] : q4[j + 2], keep = b4 ? q4[j + 2] : q4[j]; q2[j] = keep + __shfl_xor(send, 16); }
            { const float send = b3 ? q2[0] : q2[1], keep = b3 ? q2[1] : q2[0]; q1 = keep + __shfl_xor(send, 8); }
            q1 += __shfl_xor(q1, 4); q1 += __shfl_xor(q1, 2); q1 += __shfl_xor(q1, 1);
            const int jx = (b5 ? 4 : 0) + (b4 ? 2 : 0) + (b3 ? 1 : 0);
            if ((lane & 7) == 0) ewt[e0 + jx] = ewt[e0 + jx] * gelu_erf(q1);
        }
        asm volatile("s_waitcnt lgkmcnt(0)" ::: "memory");
        float y[16];
#pragma unroll
        for (int i = 0; i < 16; ++i) y[i] = 0.f;
        for (int e0 = 0; e0 < 128; e0 += 8) {
            u32x4 va[8], vb2[8];
#pragma unroll
            for (int j = 0; j < 8; ++j) {
                const int ex = __builtin_amdgcn_readfirstlane(eidx[e0 + j]);
                const bf16_t* vp = VB + (size_t)ex * DM;
                va[j] = *(const u32x4*)(vp + lane * 8); vb2[j] = *(const u32x4*)(vp + 512 + lane * 8);
            }
#pragma unroll
            for (int j = 0; j < 8; ++j) {
                const float w = ewt[e0 + j];
                y[0] += w * bf_lo(va[j].x); y[1] += w * bf_hi(va[j].x); y[2] += w * bf_lo(va[j].y); y[3] += w * bf_hi(va[j].y);
                y[4] += w * bf_lo(va[j].z); y[5] += w * bf_hi(va[j].z); y[6] += w * bf_lo(va[j].w); y[7] += w * bf_hi(va[j].w);
                y[8] += w * bf_lo(vb2[j].x); y[9] += w * bf_hi(vb2[j].x); y[10] += w * bf_lo(vb2[j].y); y[11] += w * bf_hi(vb2[j].y);
                y[12] += w * bf_lo(vb2[j].z); y[13] += w * bf_hi(vb2[j].z); y[14] += w * bf_lo(vb2[j].w); y[15] += w * bf_hi(vb2[j].w);
            }
        }
        {
            const float* xr = XF + (size_t)tok * DM;
            const f32x4 a0 = *(const f32x4*)(xr + lane * 8), a1 = *(const f32x4*)(xr + lane * 8 + 4), a2 = *(const f32x4*)(xr + 512 + lane * 8), a3 = *(const f32x4*)(xr + 512 + lane * 8 + 4);
            const float xs[16] = {a0[0], a0[1], a0[2], a0[3], a1[0], a1[1], a1[2], a1[3], a2[0], a2[1], a2[2], a2[3], a3[0], a3[1], a3[2], a3[3]};
            float s = 0.f;
#pragma unroll
            for (int i = 0; i < 16; ++i) { y[i] = DN_ALPHA * xs[i] + y[i]; s += y[i]; }
            const float mean = wave_sum(s) * (1.0f / 1024.0f);
            float q = 0.f;
#pragma unroll
            for (int i = 0; i < 16; ++i) { const float d = y[i] - mean; q += d * d; }
            const float rstd = rsqrtf(wave_sum(q) * (1.0f / 1024.0f) + LN_EPS);
            float o[16];
#pragma unroll
            for (int i = 0; i < 16; ++i) { const int ch = (i < 8) ? lane * 8 + i : 512 + lane * 8 + (i - 8); o[i] = (y[i] - mean) * rstd * ln_g[ch] + ln_b[ch]; }
            if (store) {
            float* of = outf + (size_t)tok * DM;
            f32x4 w;
            w[0] = o[0]; w[1] = o[1]; w[2] = o[2]; w[3] = o[3]; *(f32x4*)(of + lane * 8) = w;
            w[0] = o[4]; w[1] = o[5]; w[2] = o[6]; w[3] = o[7]; *(f32x4*)(of + lane * 8 + 4) = w;
            w[0] = o[8]; w[1] = o[9]; w[2] = o[10]; w[3] = o[11]; *(f32x4*)(of + 512 + lane * 8) = w;
            w[0] = o[12]; w[1] = o[13]; w[2] = o[14]; w[3] = o[15]; *(f32x4*)(of + 512 + lane * 8 + 4) = w;
            if (outb) {
                u32x4 pb; pb.x = pk_bf16(o[0], o[1]); pb.y = pk_bf16(o[2], o[3]); pb.z = pk_bf16(o[4], o[5]); pb.w = pk_bf16(o[6], o[7]);
                *(u32x4*)(outb + (size_t)tok * DM + lane * 8) = pb;
                pb.x = pk_bf16(o[8], o[9]); pb.y = pk_bf16(o[10], o[11]); pb.z = pk_bf16(o[12], o[13]); pb.w = pk_bf16(o[14], o[15]);
                *(u32x4*)(outb + (size_t)tok * DM + 512 + lane * 8) = pb;
            }
            }
        }
        asm volatile("s_waitcnt lgkmcnt(0)" ::: "memory");
    }
}


__device__ __forceinline__ void phase_peer2(const Ctx& c, const float* XF, const bf16_t* XB, const float* TOPS, const int* TOPI, const unsigned char* U8, const unsigned char* V8,
                                            const float* SU, const float* SV, const float* ln_g, const float* ln_b, float* outf, bf16_t* outb, bool store) {
    LAS int* ent_e = (LAS int*)(c.lds + c.wave * 16384);
    LAS float* ent_g = (LAS float*)(c.lds + c.wave * 16384 + 4096);
    LAS float* ent_su = (LAS float*)(c.lds + c.wave * 16384 + 8192);
    LAS float* ent_sv = (LAS float*)(c.lds + c.wave * 16384 + 12288);
    const int lane = c.lane;
    for (int base = (c.blk * 8 + c.wave) * 8; base < NTOK; base += c.nblk * 64) {
        {
            const int ti_ = lane >> 3, hh = lane & 7, t = base + ti_;
            const float* ts = TOPS + ((size_t)t * 16 + hh * 2) * 16; const int* tix = TOPI + ((size_t)t * 16 + hh * 2) * 16;
            float s0[16], s1[16];
#pragma unroll
            for (int i = 0; i < 4; ++i) { const f32x4 a = *(const f32x4*)(ts + 4 * i), b = *(const f32x4*)(ts + 16 + 4 * i);
                s0[4 * i] = a[0]; s0[4 * i + 1] = a[1]; s0[4 * i + 2] = a[2]; s0[4 * i + 3] = a[3]; s1[4 * i] = b[0]; s1[4 * i + 1] = b[1]; s1[4 * i + 2] = b[2]; s1[4 * i + 3] = b[3]; }
            unsigned best[16];
#pragma unroll
            for (int g = 0; g < 4; ++g) {
                unsigned k[16];
#pragma unroll
                for (int j = 0; j < 16; ++j) {
                    constexpr int cnt[16] = {16, 8, 5, 4, 3, 2, 2, 2, 1, 1, 1, 1, 1, 1, 1, 1};
                    int idx = 16 * g + j, a = -1, b = 0;
#pragma unroll
                    for (int aa = 0; aa < 16; ++aa) { if (a < 0) { if (idx < cnt[aa]) { a = aa; b = idx; } else idx -= cnt[aa]; } }
                    if (a >= 0) k[j] = (ord_key(s0[a] + s1[b]) & ~255u) | (unsigned)(255 - (a * 16 + b)); else k[j] = 0u;
                }
                sort16_desc(k);
                if (g == 0) {
#pragma unroll
                    for (int i = 0; i < 16; ++i) best[i] = k[i];
                } else top16_merge(best, k);
            }
            float sc[16]; int ee[16]; float mx = -3e38f;
#pragma unroll
            for (int k = 0; k < 16; ++k) {
                const int f = 255 - (int)(best[k] & 255u), a = f >> 4, b = f & 15;
                sc[k] = ts[a] + ts[16 + b]; ee[k] = tix[a] * 128 + tix[16 + b];
                mx = fmaxf(mx, sc[k]);
            }
            float den = 0.f;
#pragma unroll
            for (int k = 0; k < 16; ++k) { sc[k] = __expf(sc[k] - mx); den += sc[k]; }
            const float rden = 1.0f / den;
#pragma unroll
            for (int k = 0; k < 16; ++k) {
                const int e = ee[k] & 16383, slot = ti_ * 128 + hh * 16 + k;
                ent_e[slot] = e; ent_g[slot] = sc[k] * rden; ent_su[slot] = SU[e]; ent_sv[slot] = SV[e];
            }
        }
        asm volatile("s_waitcnt lgkmcnt(0)" ::: "memory");
#pragma unroll 1
        for (int ti_ = 0; ti_ < 8; ++ti_) {
            const int tok = base + ti_;
            LAS const int* ee = ent_e + ti_ * 128; LAS float* eg = ent_g + ti_ * 128; LAS const float* esu = ent_su + ti_ * 128; LAS const float* esv = ent_sv + ti_ * 128;
            int xq[4]; float sx;
            {
                const u32x4 x0 = *(const u32x4*)(XB + (size_t)tok * DM + lane * 16), x1 = *(const u32x4*)(XB + (size_t)tok * DM + lane * 16 + 8);
                const unsigned xw[8] = {x0.x, x0.y, x0.z, x0.w, x1.x, x1.y, x1.z, x1.w};
                float xv[16]; float am = 0.f;
#pragma unroll
                for (int i = 0; i < 8; ++i) { xv[2 * i] = bf_lo(xw[i]); xv[2 * i + 1] = bf_hi(xw[i]); am = fmaxf(am, fmaxf(fabsf(xv[2 * i]), fabsf(xv[2 * i + 1]))); }
                am = wave_max(am);
                const float inv = am > 0.f ? 127.0f / am : 0.f; sx = am * (1.0f / 127.0f);
#pragma unroll
                for (int i = 0; i < 4; ++i) {
                    unsigned pk = 0u;
#pragma unroll
                    for (int e = 0; e < 4; ++e) { const int q = (int)__builtin_rintf(xv[4 * i + e] * inv); pk |= ((unsigned)q & 0xffu) << (8 * e); }
                    xq[i] = (int)pk;
                }
            }
#pragma unroll 1
            for (int e0 = 0; e0 < 128; e0 += 16) {
                u32x4 ur[16];
#pragma unroll
                for (int j = 0; j < 16; ++j) { const int ex = __builtin_amdgcn_readfirstlane(ee[e0 + j]); ur[j] = *(const u32x4*)(U8 + (size_t)ex * 1024 + lane * 16); }
                int p[16];
#pragma unroll
                for (int j = 0; j < 16; ++j) {
                    int a = __builtin_amdgcn_sdot4(xq[0], (int)ur[j].x, 0, false);
                    a = __builtin_amdgcn_sdot4(xq[1], (int)ur[j].y, a, false);
                    a = __builtin_amdgcn_sdot4(xq[2], (int)ur[j].z, a, false);
                    p[j] = __builtin_amdgcn_sdot4(xq[3], (int)ur[j].w, a, false);
                }
                const bool b5 = lane & 32, b4 = lane & 16, b3 = lane & 8, b2 = lane & 4;
                int q8[8], q4[4], q2[2], q1;
#pragma unroll
                for (int j = 0; j < 8; ++j) { const int send = b5 ? p[j] : p[j + 8], keep = b5 ? p[j + 8] : p[j]; q8[j] = keep + __shfl_xor(send, 32); }
#pragma unroll
                for (int j = 0; j < 4; ++j) { const int send = b4 ? q8[j] : q8[j + 4], keep = b4 ? q8[j + 4] : q8[j]; q4[j] = keep + __shfl_xor(send, 16); }
#pragma unroll
                for (int j = 0; j < 2; ++j) { const int send = b3 ? q4[j] : q4[j + 2], keep = b3 ? q4[j + 2] : q4[j]; q2[j] = keep + __shfl_xor(send, 8); }
                { const int send = b2 ? q2[0] : q2[1], keep = b2 ? q2[1] : q2[0]; q1 = keep + __shfl_xor(send, 4); }
                q1 += __shfl_xor(q1, 2); q1 += __shfl_xor(q1, 1);
                if ((lane & 3) == 0) {
                    const int jx = e0 + (lane >> 2);
                    const float dot = esu[jx] * sx * (float)q1;
                    eg[jx] = eg[jx] * gelu_erf(dot) * esv[jx];
                }
            }
            asm volatile("s_waitcnt lgkmcnt(0)" ::: "memory");
            float y[16]; float sw = 0.f;
#pragma unroll
            for (int i = 0; i < 16; ++i) y[i] = 0.f;
#pragma unroll 1
            for (int e0 = 0; e0 < 128; e0 += 16) {
                u32x4 vr[16];
#pragma unroll
                for (int j = 0; j < 16; ++j) { const int ex = __builtin_amdgcn_readfirstlane(ee[e0 + j]); vr[j] = *(const u32x4*)(V8 + (size_t)ex * 1024 + lane * 16); }
#pragma unroll
                for (int j = 0; j < 16; ++j) {
                    const float w = eg[e0 + j]; sw += w;
                    const unsigned vw[4] = {vr[j].x, vr[j].y, vr[j].z, vr[j].w};
#pragma unroll
                    for (int i = 0; i < 4; ++i) {
                        y[4 * i + 0] += w * (float)(vw[i] & 0xffu); y[4 * i + 1] += w * (float)((vw[i] >> 8) & 0xffu);
                        y[4 * i + 2] += w * (float)((vw[i] >> 16) & 0xffu); y[4 * i + 3] += w * (float)(vw[i] >> 24);
                    }
                }
            }
            {
                const float* xr = XF + (size_t)tok * DM + lane * 16;
                const f32x4 a0 = *(const f32x4*)(xr), a1 = *(const f32x4*)(xr + 4), a2 = *(const f32x4*)(xr + 8), a3 = *(const f32x4*)(xr + 12);
                const float xs[16] = {a0[0], a0[1], a0[2], a0[3], a1[0], a1[1], a1[2], a1[3], a2[0], a2[1], a2[2], a2[3], a3[0], a3[1], a3[2], a3[3]};
                float s = 0.f;
#pragma unroll
                for (int i = 0; i < 16; ++i) { y[i] = DN_ALPHA * xs[i] + (y[i] - 128.0f * sw); s += y[i]; }
                const float mean = wave_sum(s) * (1.0f / 1024.0f);
                float q = 0.f;
#pragma unroll
                for (int i = 0; i < 16; ++i) { const float d = y[i] - mean; q += d * d; }
                const float rstd = rsqrtf(wave_sum(q) * (1.0f / 1024.0f) + LN_EPS);
                float o[16];
#pragma unroll
                for (int i = 0; i < 4; ++i) {
                    const f32x4 gg = *(const f32x4*)(ln_g + lane * 16 + 4 * i), bb = *(const f32x4*)(ln_b + lane * 16 + 4 * i);
#pragma unroll
                    for (int e = 0; e < 4; ++e) o[4 * i + e] = (y[4 * i + e] - mean) * rstd * gg[e] + bb[e];
                }
                if (store) {
                    float* of = outf + (size_t)tok * DM + lane * 16;
#pragma unroll
                    for (int i = 0; i < 4; ++i) { f32x4 w; w[0] = o[4 * i]; w[1] = o[4 * i + 1]; w[2] = o[4 * i + 2]; w[3] = o[4 * i + 3]; *(f32x4*)(of + 4 * i) = w; }
                    if (outb) {
                        u32x4 pb; pb.x = pk_bf16(o[0], o[1]); pb.y = pk_bf16(o[2], o[3]); pb.z = pk_bf16(o[4], o[5]); pb.w = pk_bf16(o[6], o[7]);
                        *(u32x4*)(outb + (size_t)tok * DM + lane * 16) = pb;
                        pb.x = pk_bf16(o[8], o[9]); pb.y = pk_bf16(o[10], o[11]); pb.z = pk_bf16(o[12], o[13]); pb.w = pk_bf16(o[14], o[15]);
                        *(u32x4*)(outb + (size_t)tok * DM + lane * 16 + 8) = pb;
                    }
                }
            }
        }
        asm volatile("s_waitcnt lgkmcnt(0)" ::: "memory");
    }
}

template <int NT>
__device__ __forceinline__ void peer_row_quant(const bf16_t* XB, int tok, int lane, int (&xq)[4], float& sx) {
    const u32x4 x0 = *(const u32x4*)(XB + (size_t)tok * DM + lane * 16), x1 = *(const u32x4*)(XB + (size_t)tok * DM + lane * 16 + 8);
    const unsigned xw[8] = {x0.x, x0.y, x0.z, x0.w, x1.x, x1.y, x1.z, x1.w};
    float xv[16]; float am = 0.f;
#pragma unroll
    for (int i = 0; i < 8; ++i) { xv[2 * i] = bf_lo(xw[i]); xv[2 * i + 1] = bf_hi(xw[i]); am = fmaxf(am, fmaxf(fabsf(xv[2 * i]), fabsf(xv[2 * i + 1]))); }
    am = wave_max(am);
    const float inv = am > 0.f ? 127.0f / am : 0.f; sx = am * (1.0f / 127.0f);
#pragma unroll
    for (int i = 0; i < 4; ++i) {
        unsigned pk = 0u;
#pragma unroll
        for (int e = 0; e < 4; ++e) { const int q = (int)__builtin_rintf(xv[4 * i + e] * inv); pk |= ((unsigned)q & 0xffu) << (8 * e); }
        xq[i] = (int)pk;
    }
}
__device__ __forceinline__ void phase_peer3(const Ctx& c, const float* XF, const bf16_t* XB, const float* TOPS, const int* TOPI, const unsigned char* U8, const unsigned char* V8,
                                            const float* SU, const float* SV, const float* ln_g, const float* ln_b, float* outf, bf16_t* outb, bool store) {
    constexpr int NT = 4;
    const lptr wb = c.lds + c.wave * 16640;
    LAS int* a_e = (LAS int*)(wb);
    LAS float* a_g = (LAS float*)(wb + 2048);
    LAS float* a_su = (LAS float*)(wb + 4096);
    LAS float* a_sv = (LAS float*)(wb + 6144);
    LAS int* s_e = (LAS int*)(wb + 8192);
    LAS float* s_w = (LAS float*)(wb + 10240);
    LAS float* s_su = (LAS float*)(wb + 12288);
    LAS float* s_sv = (LAS float*)(wb + 14336);
    LAS int* offs = (LAS int*)(wb + 16384);
    const int lane = c.lane;
    for (int base = (c.blk * 8 + c.wave) * NT; base < NTOK; base += c.nblk * 8 * NT) {
        if (lane < 32) {
            const int ti_ = lane >> 3, hh = lane & 7, t = base + ti_;
            const float* ts = TOPS + ((size_t)t * 16 + hh * 2) * 16; const int* tix = TOPI + ((size_t)t * 16 + hh * 2) * 16;
            float s0[16], s1[16];
#pragma unroll
            for (int i = 0; i < 4; ++i) { const f32x4 a = *(const f32x4*)(ts + 4 * i), b = *(const f32x4*)(ts + 16 + 4 * i);
                s0[4 * i] = a[0]; s0[4 * i + 1] = a[1]; s0[4 * i + 2] = a[2]; s0[4 * i + 3] = a[3]; s1[4 * i] = b[0]; s1[4 * i + 1] = b[1]; s1[4 * i + 2] = b[2]; s1[4 * i + 3] = b[3]; }
            unsigned best[16];
#pragma unroll
            for (int g = 0; g < 4; ++g) {
                unsigned k[16];
#pragma unroll
                for (int j = 0; j < 16; ++j) {
                    constexpr int cnt[16] = {16, 8, 5, 4, 3, 2, 2, 2, 1, 1, 1, 1, 1, 1, 1, 1};
                    int idx = 16 * g + j, a = -1, b = 0;
#pragma unroll
                    for (int aa = 0; aa < 16; ++aa) { if (a < 0) { if (idx < cnt[aa]) { a = aa; b = idx; } else idx -= cnt[aa]; } }
                    if (a >= 0) k[j] = (ord_key(s0[a] + s1[b]) & ~255u) | (unsigned)(255 - (a * 16 + b)); else k[j] = 0u;
                }
                sort16_desc(k);
                if (g == 0) {
#pragma unroll
                    for (int i = 0; i < 16; ++i) best[i] = k[i];
                } else top16_merge(best, k);
            }
            float sc[16]; int ee[16]; float mx = -3e38f;
#pragma unroll
            for (int k = 0; k < 16; ++k) {
                const int f = 255 - (int)(best[k] & 255u), a = f >> 4, b = f & 15;
                sc[k] = ts[a] + ts[16 + b]; ee[k] = tix[a] * 128 + tix[16 + b];
                mx = fmaxf(mx, sc[k]);
            }
            float den = 0.f;
#pragma unroll
            for (int k = 0; k < 16; ++k) { sc[k] = __expf(sc[k] - mx); den += sc[k]; }
            const float rden = 1.0f / den;
#pragma unroll
            for (int k = 0; k < 16; ++k) {
                const int e = ee[k] & 16383, slot = ti_ * 128 + hh * 16 + k;
                a_e[slot] = e; a_g[slot] = sc[k] * rden; a_su[slot] = SU[e]; a_sv[slot] = SV[e];
            }
        }
        asm volatile("s_waitcnt lgkmcnt(0)" ::: "memory");
#pragma unroll
        for (int i = 0; i < NT; ++i) {
            const int e0 = a_e[i * 128 + lane], e1 = a_e[i * 128 + 64 + lane];
            const int r0 = e0 >> 11, r1 = e1 >> 11;
            const unsigned long long lt = (1ull << lane) - 1ull;
            int bs = 0, p0 = 0, p1 = 0;
#pragma unroll
            for (int rho = 0; rho < 8; ++rho) {
                const unsigned long long m0 = __ballot(r0 == rho), m1 = __ballot(r1 == rho);
                if (lane == 0) offs[i * 16 + rho] = bs;
                if (r0 == rho) p0 = bs + __popcll(m0 & lt);
                if (r1 == rho) p1 = bs + __popcll(m0) + __popcll(m1 & lt);
                bs += __popcll(m0) + __popcll(m1);
            }
            if (lane == 0) offs[i * 16 + 8] = bs;
            s_e[i * 128 + p0] = e0; s_w[i * 128 + p0] = a_g[i * 128 + lane]; s_su[i * 128 + p0] = a_su[i * 128 + lane]; s_sv[i * 128 + p0] = a_sv[i * 128 + lane];
            s_e[i * 128 + p1] = e1; s_w[i * 128 + p1] = a_g[i * 128 + 64 + lane]; s_su[i * 128 + p1] = a_su[i * 128 + 64 + lane]; s_sv[i * 128 + p1] = a_sv[i * 128 + 64 + lane];
        }
        asm volatile("s_waitcnt lgkmcnt(0)" ::: "memory");
        int xq[NT][4]; float sx[NT];
#pragma unroll
        for (int i = 0; i < NT; ++i) peer_row_quant<NT>(XB, base + i, lane, xq[i], sx[i]);
#pragma unroll 1
        for (int rho = 0; rho < 8; ++rho) {
#pragma unroll
            for (int i = 0; i < NT; ++i) {
                const int beg = __builtin_amdgcn_readfirstlane(offs[i * 16 + rho]), end = __builtin_amdgcn_readfirstlane(offs[i * 16 + rho + 1]);
#pragma unroll 1
                for (int e0 = beg; e0 < end; e0 += 8) {
                    u32x4 ur[8];
#pragma unroll
                    for (int j = 0; j < 8; ++j) { const int sl = min(e0 + j, end - 1); const int ex = __builtin_amdgcn_readfirstlane(s_e[i * 128 + sl]); ur[j] = *(const u32x4*)(U8 + (size_t)ex * 1024 + lane * 16); }
                    int p[8];
#pragma unroll
                    for (int j = 0; j < 8; ++j) {
                        int a = __builtin_amdgcn_sdot4(xq[i][0], (int)ur[j].x, 0, false);
                        a = __builtin_amdgcn_sdot4(xq[i][1], (int)ur[j].y, a, false);
                        a = __builtin_amdgcn_sdot4(xq[i][2], (int)ur[j].z, a, false);
                        p[j] = __builtin_amdgcn_sdot4(xq[i][3], (int)ur[j].w, a, false);
                    }
                    const bool b5 = lane & 32, b4 = lane & 16, b3 = lane & 8;
                    int q4[4], q2[2], q1;
#pragma unroll
                    for (int j = 0; j < 4; ++j) { const int send = b5 ? p[j] : p[j + 4], keep = b5 ? p[j + 4] : p[j]; q4[j] = keep + __shfl_xor(send, 32); }
#pragma unroll
                    for (int j = 0; j < 2; ++j) { const int send = b4 ? q4[j] : q4[j + 2], keep = b4 ? q4[j + 2] : q4[j]; q2[j] = keep + __shfl_xor(send, 16); }
                    { const int send = b3 ? q2[0] : q2[1], keep = b3 ? q2[1] : q2[0]; q1 = keep + __shfl_xor(send, 8); }
                    q1 += __shfl_xor(q1, 4); q1 += __shfl_xor(q1, 2); q1 += __shfl_xor(q1, 1);
                    const int sl = e0 + (lane >> 3);
                    if ((lane & 7) == 0 && sl < end) {
                        const float dot = s_su[i * 128 + sl] * sx[i] * (float)q1;
                        s_w[i * 128 + sl] = s_w[i * 128 + sl] * gelu_erf(dot) * s_sv[i * 128 + sl];
                    }
                }
            }
        }
        asm volatile("s_waitcnt lgkmcnt(0)" ::: "memory");
        float y[NT][16]; float sw[NT];
#pragma unroll
        for (int i = 0; i < NT; ++i) { sw[i] = 0.f;
#pragma unroll
            for (int e = 0; e < 16; ++e) y[i][e] = 0.f; }
#pragma unroll 1
        for (int rho = 0; rho < 8; ++rho) {
#pragma unroll
            for (int i = 0; i < NT; ++i) {
                const int beg = __builtin_amdgcn_readfirstlane(offs[i * 16 + rho]), end = __builtin_amdgcn_readfirstlane(offs[i * 16 + rho + 1]);
#pragma unroll 1
                for (int e0 = beg; e0 < end; e0 += 8) {
                    u32x4 vr[8];
#pragma unroll
                    for (int j = 0; j < 8; ++j) { const int sl = min(e0 + j, end - 1); const int ex = __builtin_amdgcn_readfirstlane(s_e[i * 128 + sl]); vr[j] = *(const u32x4*)(V8 + (size_t)ex * 1024 + lane * 16); }
#pragma unroll
                    for (int j = 0; j < 8; ++j) {
                        const float w = (e0 + j < end) ? s_w[i * 128 + min(e0 + j, end - 1)] : 0.f; sw[i] += w;
                        const unsigned vw[4] = {vr[j].x, vr[j].y, vr[j].z, vr[j].w};
#pragma unroll
                        for (int q = 0; q < 4; ++q) {
                            y[i][4 * q + 0] += w * (float)(vw[q] & 0xffu); y[i][4 * q + 1] += w * (float)((vw[q] >> 8) & 0xffu);
                            y[i][4 * q + 2] += w * (float)((vw[q] >> 16) & 0xffu); y[i][4 * q + 3] += w * (float)(vw[q] >> 24);
                        }
                    }
                }
            }
        }
#pragma unroll
        for (int i = 0; i < NT; ++i) {
            const int tok = base + i;
            const float* xr = XF + (size_t)tok * DM + lane * 16;
            const f32x4 a0 = *(const f32x4*)(xr), a1 = *(const f32x4*)(xr + 4), a2 = *(const f32x4*)(xr + 8), a3 = *(const f32x4*)(xr + 12);
            const float xs[16] = {a0[0], a0[1], a0[2], a0[3], a1[0], a1[1], a1[2], a1[3], a2[0], a2[1], a2[2], a2[3], a3[0], a3[1], a3[2], a3[3]};
            float yy[16]; float s = 0.f;
#pragma unroll
            for (int e = 0; e < 16; ++e) { yy[e] = DN_ALPHA * xs[e] + (y[i][e] - 128.0f * sw[i]); s += yy[e]; }
            const float mean = wave_sum(s) * (1.0f / 1024.0f);
            float q = 0.f;
#pragma unroll
            for (int e = 0; e < 16; ++e) { const float d = yy[e] - mean; q += d * d; }
            const float rstd = rsqrtf(wave_sum(q) * (1.0f / 1024.0f) + LN_EPS);
            float o[16];
#pragma unroll
            for (int g4 = 0; g4 < 4; ++g4) {
                const f32x4 gg = *(const f32x4*)(ln_g + lane * 16 + 4 * g4), bb = *(const f32x4*)(ln_b + lane * 16 + 4 * g4);
#pragma unroll
                for (int e = 0; e < 4; ++e) o[4 * g4 + e] = (yy[4 * g4 + e] - mean) * rstd * gg[e] + bb[e];
            }
            if (store) {
                float* of = outf + (size_t)tok * DM + lane * 16;
#pragma unroll
                for (int g4 = 0; g4 < 4; ++g4) { f32x4 w; w[0] = o[4 * g4]; w[1] = o[4 * g4 + 1]; w[2] = o[4 * g4 + 2]; w[3] = o[4 * g4 + 3]; *(f32x4*)(of + 4 * g4) = w; }
                if (outb) {
                    u32x4 pb; pb.x = pk_bf16(o[0], o[1]); pb.y = pk_bf16(o[2], o[3]); pb.z = pk_bf16(o[4], o[5]); pb.w = pk_bf16(o[6], o[7]);
                    *(u32x4*)(outb + (size_t)tok * DM + lane * 16) = pb;
                    pb.x = pk_bf16(o[8], o[9]); pb.y = pk_bf16(o[10], o[11]); pb.z = pk_bf16(o[12], o[13]); pb.w = pk_bf16(o[14], o[15]);
                    *(u32x4*)(outb + (size_t)tok * DM + lane * 16 + 8) = pb;
                }
            }
        }
        asm volatile("s_waitcnt lgkmcnt(0)" ::: "memory");
    }
}

__device__ __forceinline__ void quant_rows(const Ctx& c, const float* src, unsigned char* dst, float* scale, int R, int bias) {
    const int gw = c.blk * 8 + c.wave, nw = c.nblk * 8;
    for (int row0 = gw * 4; row0 < R; row0 += nw * 4) {
        f32x4 v[4][4]; float am[4];
#pragma unroll
        for (int rr = 0; rr < 4; ++rr) {
            const f32x4* p = (const f32x4*)(src + (size_t)(row0 + rr) * 1024 + c.lane * 16);
#pragma unroll
            for (int i = 0; i < 4; ++i) v[rr][i] = p[i];
        }
#pragma unroll
        for (int rr = 0; rr < 4; ++rr) {
            float a = 0.f;
#pragma unroll
            for (int i = 0; i < 4; ++i) a = fmaxf(a, fmaxf(fmaxf(fabsf(v[rr][i][0]), fabsf(v[rr][i][1])), fmaxf(fabsf(v[rr][i][2]), fabsf(v[rr][i][3]))));
            am[rr] = wave_max(a);
        }
#pragma unroll
        for (int rr = 0; rr < 4; ++rr) {
            const float inv = am[rr] > 0.f ? 127.0f / am[rr] : 0.f;
            unsigned w[4];
#pragma unroll
            for (int i = 0; i < 4; ++i) {
                unsigned pk = 0u;
#pragma unroll
                for (int e = 0; e < 4; ++e) { const int q = (int)__builtin_rintf(v[rr][i][e] * inv) + bias; pk |= ((unsigned)q & 0xffu) << (8 * e); }
                w[i] = pk;
            }
            u32x4 o; o.x = w[0]; o.y = w[1]; o.z = w[2]; o.w = w[3];
            *(u32x4*)(dst + (size_t)(row0 + rr) * 1024 + c.lane * 16) = o;
            if (c.lane == 0) scale[row0 + rr] = am[rr] > 0.f ? am[rr] * (1.0f / 127.0f) : 1.0f;
        }
    }
}

__device__ __forceinline__ void phase_prologue(const Ctx& c, const Args& a, float* SUp, float* SVp, bf16_t* WC, float* CB, bf16_t* WIN, bf16_t* WG, bf16_t* WB, bf16_t* WO, bf16_t* WQ, bf16_t* KEYS, bf16_t* UB, bf16_t* VB, float* HF, bf16_t* HB) {
#pragma unroll 1
    for (int l = 0; l < 2; ++l) {
        transpose_cvt(c, a.in[3] + (size_t)l * 1024 * W_IN_LD, W_IN_LD, 1024, 0, 3228, NY, 1, WIN + (size_t)l * NIN * 1024, 1024);
        transpose_cvt(c, a.in[3] + (size_t)l * 1024 * W_IN_LD, W_IN_LD, 1024, W_MG, 4096, 4096, 0, WIN + ((size_t)l * NIN + NY) * 1024, 1024);
#pragma unroll 1
        for (int nb = 0; nb < 4; ++nb)
            transpose_cvt(c, a.in[12] + (size_t)(l * 4 + nb) * 256 * 1024, 1024, 256, 0, 1024, 1024, 0, WB + (size_t)(l * 4 + nb) * 1024 * 256, 256);
        transpose_cvt(c, a.in[13] + (size_t)l * 1024 * 1024, 1024, 1024, 0, 1024, 1024, 0, WO + (size_t)l * 1024 * 1024, 1024);
        transpose_cvt(c, a.in[16] + (size_t)l * 1024 * 2048, 2048, 1024, 0, 2048, 2048, 0, WQ + (size_t)l * 2048 * 1024, 1024);
#pragma unroll 1
        for (int kv = 0; kv < 2; ++kv) {
            const float* w = a.in[5 + kv] + (size_t)l * 2048 * 64;
            transpose_cvt(c, w, 64, 1024, 0, 64, 64, 0, WC + (size_t)(l * 2 + kv) * 128 * 1024, 1024);
            transpose_cvt(c, w + 1024 * 64, 64, 1024, 0, 64, 64, 0, WC + (size_t)(l * 2 + kv) * 128 * 1024 + 64 * 1024, 1024);
        }
    }
    {
        const int gw = c.blk * 8 + c.wave;
        if (gw < 256) {
            const int d = gw & 63, kv = (gw >> 6) & 1, l = gw >> 7;
            const float* w = a.in[5 + kv] + (size_t)l * 2048 * 64; const float* pos = a.in[4] + (size_t)l * 2048;
            float sacc = 0.f;
            for (int k = c.lane; k < 2048; k += 64) sacc += pos[k] * w[(size_t)k * 64 + d];
            sacc = wave_sum(sacc);
            if (c.lane == 0) CB[gw] = sacc;
        }
    }
    convert_flat(c, a.in[17], KEYS, (size_t)2 * 16 * 128 * 128);
    quant_rows(c, a.in[18], (unsigned char*)UB, SUp, 2 * 16384, 0);
    quant_rows(c, a.in[19], (unsigned char*)VB, SVp, 2 * 16384, 128);
    ln_rows(c, a.in[0], a.in[1], a.in[2], HF, HB);
}

constexpr int PH_PER_LAYER = 10, N_PHASES = 1 + 2 * PH_PER_LAYER;

__global__ void __launch_bounds__(NTHREADS, 2) mk_fwd(Args a) {
    extern __shared__ __attribute__((aligned(16))) unsigned char lds_raw[];
    volatile LAS unsigned* st = (volatile LAS unsigned*)((lptr)lds_raw + LDS_BYTES - 16);
    if (threadIdx.x == 0) { st[0] = 0u; st[1] = 0u; st[2] = 0u; st[3] = 0u; }
    __syncthreads();
#if ONE_LAUNCH
    constexpr int lo = 0, hi = N_PHASES;
#else
    const int lo = a.ph_lo, hi = a.ph_hi;
#endif
    XcdBarrier bar; bar.bar = (unsigned*)(a.ws + WS_CTL); bar.x = 0; bar.st = st;
    if (hi - lo > 1) bar = xcd_barrier_post((unsigned*)(a.ws + WS_CTL), st);
#define IN(k) (lo <= (k) && (k) < hi)
#ifndef ONLY_PHASE
#define ONLY_PHASE -1
#endif
#define EN(j) (ONLY_PHASE < 0 || ONLY_PHASE == (j))
#define SEAM(k) do { if (IN(k) && IN((k) + 1)) xcd_barrier(bar); } while (0)
#define FRESH() Ctx c; c.lds = (lptr)lds_raw; c.tid = threadIdx.x; asm volatile("" : "+v"(c.tid)); c.lane = c.tid & 63; c.wave = __builtin_amdgcn_readfirstlane(c.tid >> 6); c.blk = blockIdx.x; c.nblk = gridDim.x; \
    unsigned char* ws = a.ws + (unsigned)__builtin_amdgcn_readfirstlane((int)st[2]); c.ws = ws

#define HF ((float*)(ws + WS_HF))
#define HB ((bf16_t*)(ws + WS_HB))
#define Y ((bf16_t*)(ws + WS_Y))
#define Z ((float*)(ws + WS_Z))
#define TOPS ((float*)(ws + WS_TOPS))
#define TOPI ((int*)(ws + WS_TOPI))
#define O ((bf16_t*)(ws + WS_O))
#define MIX ((bf16_t*)(ws + WS_MIX))
#define QV ((bf16_t*)(ws + WS_QV))
#define UST ((float*)(ws + WS_UST))
#define RST ((float*)(ws + WS_RST))
#define UGLA ((float*)(ws + WS_UGLA))
#define SGLA ((float*)(ws + WS_SGLA))
#define BL ((float*)(ws + WS_BL))
#define KC ((bf16_t*)(ws + WS_KC))
#define VC ((bf16_t*)(ws + WS_VC))
#define WIN ((bf16_t*)(ws + WS_WIN))
#define WG ((bf16_t*)(ws + WS_WG))
#define WB ((bf16_t*)(ws + WS_WB))
#define WO ((bf16_t*)(ws + WS_WO))
#define WQ ((bf16_t*)(ws + WS_WQ))
#define KEYS ((bf16_t*)(ws + WS_KEYS))
#define UB ((bf16_t*)(ws + WS_UB))
#define VB ((bf16_t*)(ws + WS_VB))
#ifndef REP_MASK
#define REP_MASK 0
#endif
#define NREP(j) (((REP_MASK >> (j)) & 1) ? 2 : 1)
#define RUN(j, k, body) do { if (IN(k) && EN(j)) { _Pragma("unroll 1") for (int rr = 0; rr < NREP(j); ++rr) { if (rr) xcd_barrier(bar); FRESH(); body; } } } while (0)
    RUN(10, 0, phase_prologue(c, a, (float*)(ws + WS_SU), (float*)(ws + WS_SV), (bf16_t*)(ws + WS_WC), (float*)(ws + WS_CB), WIN, WG, WB, WO, WQ, KEYS, UB, VB, HF, HB));
    SEAM(0);
#ifndef SUB1
#define SUB1 15
#endif
#ifndef SUB
#define SUB 7
#endif
#define LAYER(l, pb) \
        RUN(0, pb + 0, phase_inproj_gates_pg8(c, HB, WIN + (size_t)l * NIN * 1024, Y, (unsigned char*)(ws + WS_G))); \
        SEAM(pb + 0); \
        RUN(1, pb + 1, { \
            if (SUB1 & 1) phase_sb3(c, Y, O); \
            if (SUB1 & 2) phase_compress2(c, Y, (const bf16_t*)(ws + WS_WC) + (size_t)l * 2 * 128 * 1024, (float*)(ws + WS_RC)); \
            if (SUB1 & 4) phase_ret_local(c, Y, UST); \
            if (SUB1 & 8) phase_gla_local(c, Y, a.in[9] + (size_t)l * 16 * 128, a.in[10] + (size_t)l * 128, UGLA, BL); \
        }); \
        SEAM(pb + 1); \
        RUN(2, pb + 2, { phase_scans(c, UST, RST, UGLA, SGLA, BL); phase_compress_combine(c, (const float*)(ws + WS_RC), (const float*)(ws + WS_CB) + l * 128, KC, VC); }); \
        SEAM(pb + 2); \
        RUN(3, pb + 3, { \
            if (SUB & 1) phase_nsa2(c, Y, KC, VC, O); \
            if (SUB & 2) phase_ret_out(c, Y, RST, a.in[7] + (size_t)l * 256, a.in[8] + (size_t)l * 256, O); \
            if (SUB & 4) phase_gla_out(c, Y, a.in[9] + (size_t)l * 16 * 128, a.in[10] + (size_t)l * 128, SGLA, a.in[11] + (size_t)l * 256, O); \
        }); \
        SEAM(pb + 3); \
        RUN(4, pb + 4, phase_merge2(c, (const unsigned char*)(ws + WS_G), O, WB + (size_t)l * 4 * 1024 * 256, MIX)); \
        SEAM(pb + 4); \
        RUN(5, pb + 5, phase_outproj_pg8(c, MIX, WO + (size_t)l * 1024 * 1024, HF, Z)); \
        SEAM(pb + 5); \
        RUN(6, pb + 6, ln_rows(c, Z, a.in[14] + (size_t)l * 1024, a.in[15] + (size_t)l * 1024, HF, HB)); \
        SEAM(pb + 6); \
        RUN(7, pb + 7, phase_wq_pg8(c, HB, WQ + (size_t)l * 2048 * 1024, QV)); \
        SEAM(pb + 7); \
        RUN(8, pb + 8, phase_subkey2(c, QV, KEYS + (size_t)l * 16 * 128 * 128, TOPS, TOPI)); \
        SEAM(pb + 8); \
        RUN(9, pb + 9, phase_peer3(c, HF, HB, TOPS, TOPI, (const unsigned char*)UB + (size_t)l * 16384 * 1024, (const unsigned char*)VB + (size_t)l * 16384 * 1024, \
                                   (const float*)(ws + WS_SU) + (size_t)l * 16384, (const float*)(ws + WS_SV) + (size_t)l * 16384, \
                                   a.in[20] + (size_t)l * 1024, a.in[21] + (size_t)l * 1024, (l == 1) ? a.out : HF, (l == 1) ? (bf16_t*)nullptr : HB, \
                                   (rr == NREP(9) - 1) || (lo > 1000))); \
        SEAM(pb + 9);
    LAYER(0, 1)
    LAYER(1, 1 + PH_PER_LAYER)
#undef LAYER
#undef RUN
#undef HF
#undef HB
#undef Y
#undef Z
#undef TOPS
#undef TOPI
#undef O
#undef MIX
#undef QV
#undef UST
#undef RST
#undef UGLA
#undef SGLA
#undef BL
#undef KC
#undef VC
#undef WIN
#undef WG
#undef WB
#undef WO
#undef WQ
#undef KEYS
#undef UB
#undef VB
#undef IN
#undef SEAM
#undef FRESH
}


#ifndef DBG_DUMP
#define DBG_DUMP 0
#endif
#ifndef DBG_C0
#define DBG_C0 0
#endif
#ifndef DBG_C1
#define DBG_C1 1024
#endif
__global__ void dbg_dump(const unsigned char* ws, float* out, int sel) {
    const size_t n = (size_t)NTOK * DM;
    for (size_t i = (size_t)blockIdx.x * blockDim.x + threadIdx.x; i < n; i += (size_t)gridDim.x * blockDim.x) {
        const int col = (int)(i & 1023);
        float v = 0.f;
        if (col >= DBG_C0 && col < DBG_C1) {
            if (sel == 1) v = bf2f(((const bf16_t*)(ws + WS_O))[i]);
            else if (sel == 2) v = ((const float*)(ws + WS_HF))[i];
            else if (sel == 3) v = bf2f(((const bf16_t*)(ws + WS_Y))[(i >> 10) * NY + col]);
            else if (sel == 4) v = bf2f(((const bf16_t*)(ws + WS_Y))[(i >> 10) * NY + 1024 + col]);
            else if (sel == 5) v = bf2f(((const bf16_t*)(ws + WS_Y))[(i >> 10) * NY + 2048 + col]);
            else if (sel == 6) v = bf2f(((const bf16_t*)(ws + WS_MIX))[i]);
            else if (sel == 7) v = ((const float*)(ws + WS_Z))[i];
        }
        out[i] = v;
    }
}

extern "C" void kernel_launch(void* const* d_in, const int* in_sizes, int n_in, void* d_out, int out_size, void* d_ws, size_t ws_size, hipStream_t stream) {
    static int grid = 0;
    if (grid == 0) {
        if (n_in != 22 || out_size != NTOK * DM || ws_size < WS_END) { fprintf(stderr, "kernel_launch: unexpected shapes (n_in %d out %d ws %zu need %zu)\n", n_in, out_size, ws_size, (size_t)WS_END); grid = -1; return; }
        int dev = 0, cus = 0, per_cu = 0;
        if (hipGetDevice(&dev) != hipSuccess || hipDeviceGetAttribute(&cus, hipDeviceAttributeMultiprocessorCount, dev) != hipSuccess) { grid = -1; return; }
        if (hipFuncSetAttribute((const void*)mk_fwd, hipFuncAttributeMaxDynamicSharedMemorySize, LDS_BYTES) != hipSuccess) { fprintf(stderr, "kernel_launch: hipFuncSetAttribute failed\n"); grid = -1; return; }
        if (hipOccupancyMaxActiveBlocksPerMultiprocessor(&per_cu, (const void*)mk_fwd, NTHREADS, LDS_BYTES) != hipSuccess || per_cu < 1) { fprintf(stderr, "kernel_launch: occupancy query says %d\n", per_cu); }
        (void)hipGetLastError();
        grid = cus;
    }
    if (grid < 0) return;
    (void)hipMemsetAsync((char*)d_ws + WS_CTL, 0, XCD_BAR_WORDS * sizeof(unsigned), stream);
    Args a{};
    for (int i = 0; i < 22; ++i) a.in[i] = (const float*)d_in[i];
    a.out = (float*)d_out; a.ws = (unsigned char*)d_ws;
#if ONE_LAUNCH
    a.ph_lo = 0; a.ph_hi = N_PHASES;
    hipLaunchKernelGGL(mk_fwd, dim3(grid), dim3(NTHREADS), LDS_BYTES, stream, a);
#else
#ifndef DBG_PH_HI
#define DBG_PH_HI N_PHASES
#endif
#ifndef DBG_PH_LO
#define DBG_PH_LO 0
#endif
    for (int p = DBG_PH_LO; p < DBG_PH_HI; ++p) {
        a.ph_lo = p; a.ph_hi = p + 1;
        hipLaunchKernelGGL(mk_fwd, dim3(grid), dim3(NTHREADS), LDS_BYTES, stream, a);
    }
    if (DBG_DUMP) hipLaunchKernelGGL(dbg_dump, dim3(1024), dim3(256), 0, stream, (const unsigned char*)d_ws, (float*)d_out, (int)DBG_DUMP);
#endif
}
```

```cpp
#include <hip/hip_runtime.h>
#include <stdint.h>
#include <stdio.h>

#ifndef ONE_LAUNCH
#define ONE_LAUNCH 1
#endif

#define LAS __attribute__((address_space(3)))
typedef unsigned short bf16_t;
typedef short bf16x8 __attribute__((ext_vector_type(8)));
typedef float f32x4 __attribute__((ext_vector_type(4)));
typedef float f32x16 __attribute__((ext_vector_type(16)));
typedef unsigned u32x4 __attribute__((ext_vector_type(4)));
typedef unsigned u32x2 __attribute__((ext_vector_type(2)));
typedef __bf16 bf2_t __attribute__((ext_vector_type(2)));
typedef LAS unsigned char* lptr;

constexpr int NTOK = 16384, SEQ = 8192, DM = 1024, NB = 2;
constexpr int NY = 3328;
constexpr int W_IN_LD = 7324;
constexpr int NIN = NY + 4096;
constexpr int C_SBQ = 0, C_SBK = 256, C_SBV = 512, C_NQ = 768, C_NKC = 1024, C_NVC = 1088, C_NKS = 1152, C_NVS = 1216, C_NKW = 1280, C_NVW = 1344;
constexpr int C_RQ = 1408, C_RK = 1664, C_RV = 1920, C_RG = 2176, C_GQ = 2432, C_GK = 2560, C_GV = 2688, C_GR = 2944, C_NG = 3200, C_GLR = 3216;
constexpr int W_MG = 3228;
constexpr float NEGF = -1e30f;
constexpr float LN_EPS = 1e-5f;
constexpr float DN_ALPHA = 1.41421356237f;

constexpr int NTHREADS = 512;
constexpr int LDS_BYTES = 147456;

constexpr size_t MB = 1024 * 1024;
constexpr size_t WS_CTL   = 0;
constexpr size_t WS_HF    = 1 * MB;
constexpr size_t WS_HB    = WS_HF + 64 * MB;
constexpr size_t WS_Y     = WS_HB + 32 * MB;
constexpr size_t WS_Z     = WS_Y;
constexpr size_t WS_TOPS  = WS_Y + 64 * MB;
constexpr size_t WS_TOPI  = WS_TOPS + 16 * MB;
constexpr size_t WS_O     = WS_Y + 104 * MB;
constexpr size_t WS_MIX   = WS_O + 32 * MB;
constexpr size_t WS_QV    = WS_O;
constexpr size_t WS_UST   = WS_MIX + 32 * MB;
constexpr size_t WS_RST   = WS_UST + 8 * MB;
constexpr size_t WS_UGLA  = WS_RST + 8 * MB;
constexpr size_t WS_SGLA  = WS_UGLA + 8 * MB;
constexpr size_t WS_BL    = WS_SGLA + 8 * MB;
constexpr size_t WS_KC    = WS_BL + 1 * MB;
constexpr size_t WS_VC    = WS_KC + 1 * MB;
constexpr size_t WS_WIN   = WS_VC + 1 * MB;
constexpr size_t WS_WG    = WS_WIN + 14 * MB;
constexpr size_t WS_WB    = WS_WG + 16 * MB;
constexpr size_t WS_WO    = WS_WB + 4 * MB;
constexpr size_t WS_WQ    = WS_WO + 4 * MB;
constexpr size_t WS_KEYS  = WS_WQ + 8 * MB;
constexpr size_t WS_UB    = WS_KEYS + 1 * MB;
constexpr size_t WS_VB    = WS_UB + 32 * MB;
constexpr size_t WS_SU    = WS_UB + 64 * MB;
constexpr size_t WS_SV    = WS_SU + 256 * 1024;
constexpr size_t WS_G     = WS_UB + 65 * MB;
constexpr size_t WS_WC    = WS_G + 64 * MB;
constexpr size_t WS_RC    = WS_WC + 1 * MB;
constexpr size_t WS_CB    = WS_RC + 1 * MB;
constexpr size_t WS_END   = WS_CB + 1 * MB;

typedef float f32x2_t __attribute__((ext_vector_type(2)));
__device__ __forceinline__ unsigned pk_bf16(float lo, float hi) { f32x2_t v = {lo, hi}; bf2_t b = __builtin_convertvector(v, bf2_t); return __builtin_bit_cast(unsigned, b); }
__device__ __forceinline__ float bf_lo(unsigned u) { return __uint_as_float(u << 16); }
__device__ __forceinline__ float bf_hi(unsigned u) { return __uint_as_float(u & 0xffff0000u); }
__device__ __forceinline__ bf16_t f2bf(float f) { return (bf16_t)(pk_bf16(f, f) & 0xffffu); }
__device__ __forceinline__ float bf2f(bf16_t b) { return __uint_as_float(((unsigned)b) << 16); }
__device__ __forceinline__ float wave_sum(float v) {
#pragma unroll
    for (int o = 32; o; o >>= 1) v += __shfl_xor(v, o);
    return v;
}
__device__ __forceinline__ float wave_max(float v) {
#pragma unroll
    for (int o = 32; o; o >>= 1) v = fmaxf(v, __shfl_xor(v, o));
    return v;
}
__device__ __forceinline__ float sigmoidf_(float x) { return 1.0f / (1.0f + __expf(-x)); }
__device__ __forceinline__ float softplusf_(float x) { return fmaxf(x, 0.f) + __logf(1.0f + __expf(-fabsf(x))); }
__device__ __forceinline__ float siluf_(float x) { return x * sigmoidf_(x); }
__device__ __forceinline__ float dot2bf(unsigned a, unsigned b, float c) {
    return __builtin_amdgcn_fdot2_f32_bf16(__builtin_bit_cast(bf2_t, a), __builtin_bit_cast(bf2_t, b), c, false);
}

#define XB_TMO      128
#define XB_XCNT(j)  (256  + 64 * (j))
#define XB_XSUB(j)  (1280 + 64 * (j))
#define XB_XGEN(j)  (2304 + 64 * (j))
#define XB_TOP      3328
#define XB_TOPGEN   3392
#define XCD_BAR_WORDS 3456
#define XB_SPIN_CAP (1u << 22)

__device__ __forceinline__ unsigned xb_ld(unsigned* p)              { return __hip_atomic_load(p, __ATOMIC_RELAXED, __HIP_MEMORY_SCOPE_AGENT); }
__device__ __forceinline__ unsigned xb_add(unsigned* p, unsigned v) { return __hip_atomic_fetch_add(p, v, __ATOMIC_RELAXED, __HIP_MEMORY_SCOPE_AGENT); }
__device__ __forceinline__ unsigned xb_xcc_id() { return (unsigned)__builtin_amdgcn_s_getreg((3 << 11) | 20) & 0xFu; }
#define XB_SPIN(cond, bar) do { unsigned _sp = 0; while (cond) { __builtin_amdgcn_s_sleep(1); \
    if ((++_sp & 255u) == 0u) { if (xb_ld(&(bar)[XB_TMO])) break; if (_sp > XB_SPIN_CAP) { atomicAdd(&(bar)[XB_TMO], 1u); break; } } } } while (0)

struct XcdBarrier { unsigned* bar; unsigned x; volatile LAS unsigned* st; };

__device__ __forceinline__ XcdBarrier xcd_barrier_post(unsigned* bar, volatile LAS unsigned* st) {
    XcdBarrier b; b.bar = bar; b.x = xb_xcc_id(); b.st = st;
    if (threadIdx.x == 0) (void)xb_add(&bar[XB_XCNT(b.x)], 1u);
    return b;
}
__device__ __forceinline__ void xcd_barrier_complete(unsigned* bar, unsigned x, unsigned& nloc, unsigned& nx) {
    const unsigned G = gridDim.x * gridDim.y * gridDim.z;
    unsigned sum, cnt, mine, sp = 0u;
    for (;;) {
        sum = 0u; cnt = 0u; mine = 0u;
#pragma unroll
        for (unsigned j = 0; j < 16; ++j) { const unsigned c = xb_ld(&bar[XB_XCNT(j)]); sum += c; cnt += (c > 0u) ? 1u : 0u; mine = (j == x) ? c : mine; }
        if (sum == G) break;
        __builtin_amdgcn_s_sleep(1);
        if ((++sp & 255u) == 0u) { if (xb_ld(&bar[XB_TMO])) break; if (sp > XB_SPIN_CAP) { atomicAdd(&bar[XB_TMO], 1u); break; } }
    }
    nloc = mine > 0u ? mine : 1u; nx = cnt > 0u ? cnt : 1u;
}
__device__ __forceinline__ void xcd_barrier(const XcdBarrier& b) {
    asm volatile("s_waitcnt vmcnt(0)" ::: "memory");
    __syncthreads();
    if (threadIdx.x == 0) {
        unsigned* bar = b.bar;
        __builtin_amdgcn_s_waitcnt(0);
        unsigned nloc = b.st[0], nx = b.st[1];
        if (nloc == 0u) { xcd_barrier_complete(bar, b.x, nloc, nx); b.st[0] = nloc; b.st[1] = nx; }
        const unsigned old = xb_add(&bar[XB_XSUB(b.x)], 1u);
        const unsigned gen = old / nloc;
        if (old + 1u == (gen + 1u) * nloc) {
            __builtin_amdgcn_fence(__ATOMIC_RELEASE, "agent");
            asm volatile("s_waitcnt vmcnt(0)" ::: "memory");
            const unsigned og = xb_add(&bar[XB_TOP], 1u);
            const unsigned tg = og / nx;
            if (og + 1u == (tg + 1u) * nx) xb_add(&bar[XB_TOPGEN], 1u);
            else XB_SPIN(xb_ld(&bar[XB_TOPGEN]) == tg, bar);
            __builtin_amdgcn_fence(__ATOMIC_ACQUIRE, "agent");
            xb_add(&bar[XB_XGEN(b.x)], 1u);
            asm volatile("s_waitcnt vmcnt(0)" ::: "memory");
        } else {
            XB_SPIN(xb_ld(&bar[XB_XGEN(b.x)]) == gen, bar);
            __builtin_amdgcn_fence(__ATOMIC_ACQUIRE, "agent");
            asm volatile("s_waitcnt vmcnt(0)" ::: "memory");
        }
    }
    __syncthreads();
}

struct Args { const float* in[22]; float* out; unsigned char* ws; int ph_lo, ph_hi; };
struct Ctx {
    lptr lds; int tid, lane, wave, nblk, blk;
    unsigned char* ws;
};

__device__ __forceinline__ void ln_rows(const Ctx& c, const float* src, const float* g, const float* b, float* outf, bf16_t* outb) {
    const int gw = c.blk * 8 + c.wave, nw = c.nblk * 8;
    for (int row0 = gw * 2; row0 < NTOK; row0 += nw * 2) {
        f32x4 v[2][4]; float mean[2], rstd[2];
#pragma unroll
        for (int rr = 0; rr < 2; ++rr) {
            const f32x4* p = (const f32x4*)(src + (size_t)(row0 + rr) * DM);
#pragma unroll
            for (int i = 0; i < 4; ++i) v[rr][i] = p[i * 64 + c.lane];
        }
#pragma unroll
        for (int rr = 0; rr < 2; ++rr) {
            float s = 0.f;
#pragma unroll
            for (int i = 0; i < 4; ++i) s += (v[rr][i][0] + v[rr][i][1]) + (v[rr][i][2] + v[rr][i][3]);
            mean[rr] = wave_sum(s) * (1.0f / 1024.0f);
            float q = 0.f;
#pragma unroll
            for (int i = 0; i < 4; ++i) { const f32x4 d = v[rr][i] - mean[rr]; q += (d[0] * d[0] + d[1] * d[1]) + (d[2] * d[2] + d[3] * d[3]); }
            rstd[rr] = rsqrtf(wave_sum(q) * (1.0f / 1024.0f) + LN_EPS);
        }
#pragma unroll
        for (int i = 0; i < 4; ++i) {
            const int idx = i * 64 + c.lane;
            const f32x4 gg = ((const f32x4*)g)[idx], bb = ((const f32x4*)b)[idx];
#pragma unroll
            for (int rr = 0; rr < 2; ++rr) {
                const f32x4 y = (v[rr][i] - mean[rr]) * rstd[rr] * gg + bb;
                if (outf) ((f32x4*)(outf + (size_t)(row0 + rr) * DM))[idx] = y;
                if (outb) { u32x2 w; w.x = pk_bf16(y[0], y[1]); w.y = pk_bf16(y[2], y[3]); ((u32x2*)(outb + (size_t)(row0 + rr) * DM))[idx] = w; }
            }
        }
    }
}

__device__ __forceinline__ int ycol_to_wcol(int j) {
    if (j < 1408) return j;
    if (j < 3200) return j + 12;
    if (j < 3212) return 1408 + (j - 3200);
    if (j < 3216) return -1;
    if (j < 3232) return 3212 + (j - 3216);
    return -1;
}
__device__ __forceinline__ void transpose_cvt(const Ctx& c, const float* src, int ld_src, int R, int c_off, int C, int Cpad, int mode, bf16_t* dst, int ld_dst) {
    LAS float* buf = (LAS float*)c.lds;
    const int nRt = R / 64, nCt = Cpad / 64;
    for (int tile = c.blk; tile < nRt * nCt; tile += c.nblk) {
        const int rt = tile % nRt, ct = tile / nRt;
        const int r0 = rt * 64, c0 = ct * 64;
        {
            const int row = c.tid >> 3, cc = (c.tid & 7) * 8;
            const float* sp = src + (size_t)(r0 + row) * ld_src;
            float v[8];
            bool fast = false; int sc0 = 0;
            if (mode == 0) { fast = (c0 + 64 <= C); sc0 = c_off + c0 + cc; }
            else { if (c0 + 64 <= 1408) { fast = true; sc0 = c0 + cc; } else if (c0 >= 1408 && c0 + 64 <= 3200) { fast = true; sc0 = c0 + cc + 12; } }
            if (fast) {
                const f32x4 a = *(const f32x4*)(sp + sc0), b = *(const f32x4*)(sp + sc0 + 4);
                v[0] = a[0]; v[1] = a[1]; v[2] = a[2]; v[3] = a[3]; v[4] = b[0]; v[5] = b[1]; v[6] = b[2]; v[7] = b[3];
            } else {
#pragma unroll
                for (int i = 0; i < 8; ++i) {
                    const int n = c0 + cc + i; int sc;
                    if (mode == 0) sc = (n < C) ? c_off + n : -1; else sc = ycol_to_wcol(n);
                    v[i] = (sc >= 0) ? sp[sc] : 0.f;
                }
            }
#pragma unroll
            for (int i = 0; i < 8; ++i) buf[row * 65 + cc + i] = v[i];
        }
        __syncthreads();
        {
            const int n = c.tid >> 3, kc = (c.tid & 7) * 8;
            float v[8];
#pragma unroll
            for (int i = 0; i < 8; ++i) v[i] = buf[(kc + i) * 65 + n];
            u32x4 w; w.x = pk_bf16(v[0], v[1]); w.y = pk_bf16(v[2], v[3]); w.z = pk_bf16(v[4], v[5]); w.w = pk_bf16(v[6], v[7]);
            *(u32x4*)(dst + (size_t)(c0 + n) * ld_dst + r0 + kc) = w;
        }
        __syncthreads();
    }
}
__device__ __forceinline__ void convert_flat(const Ctx& c, const float* src, bf16_t* dst, size_t n) {
    const size_t stride = (size_t)c.nblk * NTHREADS;
    for (size_t i = (size_t)c.blk * NTHREADS + c.tid; i < n / 8; i += stride) {
        const f32x4 a = ((const f32x4*)src)[2 * i], b = ((const f32x4*)src)[2 * i + 1];
        u32x4 w; w.x = pk_bf16(a[0], a[1]); w.y = pk_bf16(a[2], a[3]); w.z = pk_bf16(b[0], b[1]); w.w = pk_bf16(b[2], b[3]);
        ((u32x4*)dst)[i] = w;
    }
}

template <int WM, int WN>
__device__ __forceinline__ void gemm_kloop(const Ctx& c, f32x16 (&acc)[WM][WN], const bf16_t* A, int lda, const bf16_t* Bt, int ldb, int K, int kstepA = 64) {
    constexpr int BMt = 128 * WM, BNt = 64 * WN, STAGE = (BMt + BNt) * 144;
    constexpr int NA = BMt * 8 / NTHREADS, NBc = BNt * 8 / NTHREADS;
    static_assert(NBc >= 1, "tile too small");
    const lptr lds = c.lds;
    const int wm = c.wave >> 1, wn = c.wave & 1, r = c.lane & 31, h = c.lane >> 5;
    u32x4 ra[NA], rb[NBc];
    const int nk = K / 64;
#pragma unroll
    for (int i = 0; i < NA; ++i) { const int id = c.tid + i * NTHREADS; ra[i] = *(const u32x4*)(A + (size_t)(id >> 3) * lda + (id & 7) * 8); }
#pragma unroll
    for (int i = 0; i < NBc; ++i) { const int id = c.tid + i * NTHREADS; rb[i] = *(const u32x4*)(Bt + (size_t)(id >> 3) * ldb + (id & 7) * 8); }
#pragma unroll
    for (int i = 0; i < NA; ++i) { const int id = c.tid + i * NTHREADS; *(LAS u32x4*)(lds + (id >> 3) * 144 + (id & 7) * 16) = ra[i]; }
#pragma unroll
    for (int i = 0; i < NBc; ++i) { const int id = c.tid + i * NTHREADS; *(LAS u32x4*)(lds + BMt * 144 + (id >> 3) * 144 + (id & 7) * 16) = rb[i]; }
    __syncthreads();
    for (int kt = 0; kt < nk; ++kt) {
        const lptr cur = lds + (kt & 1) * STAGE, nxt = lds + ((kt + 1) & 1) * STAGE;
        const bool more = (kt + 1 < nk);
        if (more) {
            const int k0 = (kt + 1) * 64; const size_t k0a = (size_t)(kt + 1) * kstepA;
#pragma unroll
            for (int i = 0; i < NA; ++i) { const int id = c.tid + i * NTHREADS; ra[i] = *(const u32x4*)(A + (size_t)(id >> 3) * lda + k0a + (id & 7) * 8); }
#pragma unroll
            for (int i = 0; i < NBc; ++i) { const int id = c.tid + i * NTHREADS; rb[i] = *(const u32x4*)(Bt + (size_t)(id >> 3) * ldb + k0 + (id & 7) * 8); }
        }
        const lptr pa = cur + (wm * WM * 32 + r) * 144 + h * 16;
        const lptr pb = cur + BMt * 144 + (wn * WN * 32 + r) * 144 + h * 16;
#pragma unroll
        for (int s = 0; s < 4; ++s) {
            bf16x8 fa[WM], fb[WN];
#pragma unroll
            for (int i = 0; i < WM; ++i) fa[i] = *(LAS const bf16x8*)(pa + i * 32 * 144 + s * 32);
#pragma unroll
            for (int j = 0; j < WN; ++j) fb[j] = *(LAS const bf16x8*)(pb + j * 32 * 144 + s * 32);
#pragma unroll
            for (int i = 0; i < WM; ++i)
#pragma unroll
                for (int j = 0; j < WN; ++j) acc[i][j] = __builtin_amdgcn_mfma_f32_32x32x16_bf16(fb[j], fa[i], acc[i][j], 0, 0, 0);
        }
        if (more) {
#pragma unroll
            for (int i = 0; i < NA; ++i) { const int id = c.tid + i * NTHREADS; *(LAS u32x4*)(nxt + (id >> 3) * 144 + (id & 7) * 16) = ra[i]; }
#pragma unroll
            for (int i = 0; i < NBc; ++i) { const int id = c.tid + i * NTHREADS; *(LAS u32x4*)(nxt + BMt * 144 + (id >> 3) * 144 + (id & 7) * 16) = rb[i]; }
        }
        __syncthreads();
    }
}
template <int WM, int WN>
__device__ __forceinline__ void acc_zero(f32x16 (&acc)[WM][WN]) {
#pragma unroll
    for (int i = 0; i < WM; ++i)
#pragma unroll
        for (int j = 0; j < WN; ++j)
#pragma unroll
            for (int e = 0; e < 16; ++e) acc[i][j][e] = 0.f;
}

namespace pg8 {
#define PG8_LAS __attribute__((address_space(3)))
constexpr int BM = 256, BK = 64, HALF = 128, HTB = HALF * BK * 2  , STAGE_BYTES = 8 * HTB, NXCD = 8, WGM = 8;

__host__ __device__ __forceinline__ int lds_byte(int r, int c) { const int st = (r >> 4) * 2 + (c >> 5), rr = r & 15, cc = c & 31, ob = rr * 64 + cc * 2; return st * 1024 + (ob ^ (((ob >> 9) & 1) << 5)); }
__host__ __device__ __forceinline__ void stage_rc(int b, int& R, int& C) { const int st = b / 1024, sb = b % 1024, swz = sb ^ (((sb >> 9) & 1) << 5); R = (st >> 1) * 16 + swz / 64; C = (st & 1) * 32 + (swz % 64) / 2; }
__host__ __device__ __forceinline__ int perm32(int rho) { const int n = rho >> 4, i = rho & 15; return 8 * (i >> 2) + 4 * n + (i & 3); }
struct Unit { int pm, pn; };
struct Gemm { const bf16_t* A; const bf16_t* Bt; int M, N, K; };
struct StaticOrder {
    int nM, nN, nwg, G, c;
    __host__ __device__ void init(int M, int N, int G_, int c_) { nM = M / BM; nN = N / BM; nwg = nM * nN; G = G_; c = c_; }
    __host__ __device__ bool next(int i, Unit& u) const {
        const long L = (long)i * G + c; if (L >= nwg) return false;
        int wgid = (int)L; { const int q = nwg / NXCD, r = nwg % NXCD, xcd = wgid % NXCD, off = wgid / NXCD; wgid = (xcd < r ? xcd * (q + 1) : r * (q + 1) + (xcd - r) * q) + off; }
        const int nig = WGM * nN, gid = wgid / nig, fm = gid * WGM, gsz = (nM - fm) < WGM ? (nM - fm) : WGM;
        u.pm = fm + ((wgid % nig) % gsz); u.pn = (wgid % nig) / gsz; return true;
    }
    __device__ __forceinline__ void a_ready(const Unit&) const {}
    __device__ __forceinline__ void done(const Unit&) const {}
};
template <class Epi, class Sched>
__device__ __forceinline__ void gemm_phase(PG8_LAS unsigned char* lds, const Gemm g, const Sched& S, const Epi& E) {
    const int tid = threadIdx.x, wid = __builtin_amdgcn_readfirstlane(tid >> 6), lane = tid & 63, wr = wid >> 2, wc = wid & 3, fr = lane & 15, fq = lane >> 4;
    const int K = g.K, nt = K / BK;
    unsigned voffA[2], voffB[2];
#pragma unroll
    for (int i = 0; i < 2; ++i) { int R, C; stage_rc(tid * 16 + i * 8192, R, C); const int Rb = Epi::PERM ? ((R & ~31) + perm32(R & 31)) : R;
        voffA[i] = (unsigned)(R * K + C) * 2u; voffB[i] = (unsigned)(Rb * K + C) * 2u; }
    const size_t kstep = (size_t)(BK * 2);
    const size_t hstep = (size_t)HALF * K * 2;
    const size_t tstep = 2 * hstep;
    const unsigned ldsw = (unsigned)wid * 1024u;
    const int aoff = lds_byte(wr * 64 + fr, fq * 8), boff = lds_byte(wc * 32 + fr, fq * 8);
#define PG8_SA(b, h) (((b) * 2 + (h)) * HTB)
#define PG8_SB(b, h) ((4 + (b) * 2 + (h)) * HTB)
#define PG8_STAGE(bufoff, gbase, voff) do { _Pragma("unroll") for (int _i = 0; _i < 2; ++_i) \
        __builtin_amdgcn_global_load_lds((const unsigned*)((const char*)(gbase) + (voff)[_i]), (PG8_LAS unsigned*)(lds + (bufoff) + ldsw + _i * 8192), 16, 0, 0); } while (0)
#define PG8_LDA(dst, b, h) do { _Pragma("unroll") for (int m = 0; m < 4; ++m) _Pragma("unroll") for (int k = 0; k < 2; ++k) dst[m][k] = *(const PG8_LAS bf16x8*)(lds + PG8_SA(b, h) + aoff + m * 2048 + k * 1024); } while (0)
#define PG8_LDB(dst, b, h) do { _Pragma("unroll") for (int n = 0; n < 2; ++n) _Pragma("unroll") for (int k = 0; k < 2; ++k) dst[n][k] = *(const PG8_LAS bf16x8*)(lds + PG8_SB(b, h) + boff + n * 2048 + k * 1024); } while (0)
#define PG8_MMA(ai, bj, At, Bt) do { __builtin_amdgcn_s_setprio(1); _Pragma("unroll") for (int m = 0; m < 4; ++m) _Pragma("unroll") for (int n = 0; n < 2; ++n) _Pragma("unroll") for (int k = 0; k < 2; ++k) \
        acc[ai][bj][m][n] = __builtin_amdgcn_mfma_f32_16x16x32_bf16(Bt[n][k], At[m][k], acc[ai][bj][m][n], 0, 0, 0); __builtin_amdgcn_s_setprio(0); } while (0)
#define PG8_WAIT_V(n) asm volatile("s_waitcnt vmcnt(" #n ")" ::: "memory")
#define PG8_WAIT_L(n) asm volatile("s_waitcnt lgkmcnt(" #n ")" ::: "memory")
#define PG8_BAR __builtin_amdgcn_s_barrier()
#define PG8_SCHED __builtin_amdgcn_sched_barrier(0)
    Unit cur, nxt; int ui = 0;
    if (!S.next(0, cur)) return;
    f32x4 acc[2][2][4][2];
#pragma unroll
    for (int a = 0; a < 2; ++a)
#pragma unroll
        for (int b = 0; b < 2; ++b)
#pragma unroll
            for (int m = 0; m < 4; ++m)
#pragma unroll
                for (int n = 0; n < 2; ++n) acc[a][b][m][n] = (f32x4){0.f, 0.f, 0.f, 0.f};
    bf16x8 At[4][2], B0[2][2], B1[2][2];
    const char* cA = (const char*)g.A + (size_t)cur.pm * tstep; const char* cB = (const char*)g.Bt + (size_t)cur.pn * tstep;
    S.a_ready(cur);
    PG8_STAGE(PG8_SB(0, 0), cB, voffB); PG8_STAGE(PG8_SA(0, 0), cA, voffA); PG8_STAGE(PG8_SB(0, 1), cB + hstep, voffB); PG8_STAGE(PG8_SA(0, 1), cA + hstep, voffA);
    if (wr == 1) PG8_BAR;
    PG8_WAIT_V(4); PG8_BAR;
    PG8_STAGE(PG8_SB(1, 0), cB + kstep, voffB); PG8_STAGE(PG8_SA(1, 0), cA + kstep, voffA); PG8_STAGE(PG8_SB(1, 1), cB + hstep + kstep, voffB);
    PG8_WAIT_V(6); PG8_BAR;
    for (;;) {
        const bool has_next = S.next(ui + 1, nxt);
        const char* nA = has_next ? (const char*)g.A + (size_t)nxt.pm * tstep : cA; const char* nB = has_next ? (const char*)g.Bt + (size_t)nxt.pn * tstep : cB;
        for (int t = 0; t < nt; t += 2) {
            const bool last = (t == nt - 2);
            const char* a1 = cA + (size_t)(t + 1) * kstep;
            const char* a2 = last ? nA : cA + (size_t)(t + 2) * kstep; const char* b2 = last ? nB : cB + (size_t)(t + 2) * kstep;
            const char* a3 = a2 + kstep; const char* b3 = b2 + kstep;
            if (last && has_next) S.a_ready(nxt);
            PG8_LDB(B0, 0, 0); PG8_SCHED; PG8_LDA(At, 0, 0); PG8_STAGE(PG8_SA(1, 1), a1 + hstep, voffA);
            PG8_WAIT_L(8); PG8_BAR; PG8_WAIT_L(0); PG8_MMA(0, 0, At, B0); PG8_BAR; PG8_SCHED;
            PG8_LDB(B1, 0, 1); PG8_STAGE(PG8_SB(0, 0), b2, voffB);
            PG8_BAR; PG8_WAIT_L(0); PG8_MMA(0, 1, At, B1); PG8_BAR;
            PG8_LDA(At, 0, 1); PG8_STAGE(PG8_SA(0, 0), a2, voffA);
            PG8_BAR; PG8_WAIT_L(0); PG8_MMA(1, 0, At, B0); PG8_BAR; PG8_SCHED;
            PG8_STAGE(PG8_SB(0, 1), b2 + hstep, voffB);
            PG8_WAIT_V(6); PG8_BAR; PG8_MMA(1, 1, At, B1); PG8_BAR;
            PG8_LDB(B0, 1, 0); PG8_SCHED; PG8_LDA(At, 1, 0); PG8_STAGE(PG8_SA(0, 1), a2 + hstep, voffA);
            PG8_WAIT_L(8); PG8_BAR; PG8_WAIT_L(0); PG8_MMA(0, 0, At, B0); PG8_BAR; PG8_SCHED;
            PG8_LDB(B1, 1, 1); PG8_STAGE(PG8_SB(1, 0), b3, voffB);
            PG8_BAR; PG8_WAIT_L(0); PG8_MMA(0, 1, At, B1); PG8_BAR;
            PG8_LDA(At, 1, 1); PG8_STAGE(PG8_SA(1, 0), a3, voffA);
            PG8_BAR; PG8_WAIT_L(0); PG8_MMA(1, 0, At, B0); PG8_BAR; PG8_SCHED;
            PG8_STAGE(PG8_SB(1, 1), b3 + hstep, voffB);
            PG8_WAIT_V(6); PG8_BAR; PG8_MMA(1, 1, At, B1); PG8_BAR;
        }
        if constexpr (!Epi::AFTER_DRAIN) { E(acc, cur, wr, wc, fr, fq); S.done(cur); }
        if (!has_next) break;
#pragma unroll
        for (int a = 0; a < 2; ++a)
#pragma unroll
            for (int b = 0; b < 2; ++b)
#pragma unroll
                for (int m = 0; m < 4; ++m)
#pragma unroll
                    for (int n = 0; n < 2; ++n) acc[a][b][m][n] = (f32x4){0.f, 0.f, 0.f, 0.f};
        cur = nxt; cA = nA; cB = nB; ++ui;
    }
    PG8_WAIT_V(0);
    if (wr == 0) PG8_BAR;
    PG8_BAR;
    if constexpr (Epi::AFTER_DRAIN) { E.fused(acc, cur, wr, wc, fr, fq, lds, wid, lane); S.done(cur); }
#undef PG8_SA
#undef PG8_SB
#undef PG8_STAGE
#undef PG8_LDA
#undef PG8_LDB
#undef PG8_MMA
#undef PG8_WAIT_V
#undef PG8_WAIT_L
#undef PG8_BAR
#undef PG8_SCHED
}

struct EpiStoreBf16 {
    static constexpr bool PERM = true, AFTER_DRAIN = false;
    bf16_t* O; int ldc;
    __device__ __forceinline__ void operator()(const f32x4 (&acc)[2][2][4][2], const Unit& u, int wr, int wc, int fr, int fq) const {
        const int row0 = u.pm * BM + wr * 64 + fr, col0 = u.pn * BM + wc * 32 + 8 * fq;
#pragma unroll
        for (int ai = 0; ai < 2; ++ai)
#pragma unroll
            for (int m = 0; m < 4; ++m) { bf16_t* rowp = O + (size_t)(row0 + ai * HALF + m * 16) * ldc + col0;
#pragma unroll
                for (int bj = 0; bj < 2; ++bj) { const f32x4 v0 = acc[ai][bj][m][0], v1 = acc[ai][bj][m][1];
                    u32x4 w; w.x = pk_bf16(v0[0], v0[1]); w.y = pk_bf16(v0[2], v0[3]); w.z = pk_bf16(v1[0], v1[1]); w.w = pk_bf16(v1[2], v1[3]);
                    *(u32x4*)(rowp + bj * HALF) = w; } }
    }
};
struct EpiResidF32 {
    static constexpr bool PERM = false, AFTER_DRAIN = false;
    const float* R; float* C; int ldc; float alpha;
    __device__ __forceinline__ void operator()(const f32x4 (&acc)[2][2][4][2], const Unit& u, int wr, int wc, int fr, int fq) const {
        const int row0 = u.pm * BM + wr * 64 + fr, col0 = u.pn * BM + wc * 32 + 4 * fq;
#pragma unroll
        for (int ai = 0; ai < 2; ++ai)
#pragma unroll
            for (int m = 0; m < 4; ++m) { const size_t ro = (size_t)(row0 + ai * HALF + m * 16) * ldc + col0;
#pragma unroll
                for (int bj = 0; bj < 2; ++bj)
#pragma unroll
                    for (int n = 0; n < 2; ++n) { const f32x4 x = *(const f32x4*)(R + ro + bj * HALF + n * 16); *(f32x4*)(C + ro + bj * HALF + n * 16) = x * alpha + acc[ai][bj][m][n]; } }
    }
};

struct EpiYG {
    static constexpr bool PERM = true, AFTER_DRAIN = false;
    bf16_t* Yp; unsigned char* Gp;
    __device__ __forceinline__ void operator()(const f32x4 (&acc)[2][2][4][2], const Unit& u, int wr, int wc, int fr, int fq) const {
        const int row0 = u.pm * BM + wr * 64 + fr;
        if (u.pn < NY / 256) {
            const int col0 = u.pn * BM + wc * 32 + 8 * fq;
#pragma unroll
            for (int ai = 0; ai < 2; ++ai)
#pragma unroll
                for (int m = 0; m < 4; ++m) { bf16_t* rowp = Yp + (size_t)(row0 + ai * HALF + m * 16) * NY + col0;
#pragma unroll
                    for (int bj = 0; bj < 2; ++bj) { const f32x4 v0 = acc[ai][bj][m][0], v1 = acc[ai][bj][m][1];
                        u32x4 w; w.x = pk_bf16(v0[0], v0[1]); w.y = pk_bf16(v0[2], v0[3]); w.z = pk_bf16(v1[0], v1[1]); w.w = pk_bf16(v1[2], v1[3]);
                        *(u32x4*)(rowp + bj * HALF) = w; } }
        } else {
            const int col0 = (u.pn - NY / 256) * BM + wc * 32 + 8 * fq;
#pragma unroll
            for (int ai = 0; ai < 2; ++ai)
#pragma unroll
                for (int m = 0; m < 4; ++m) { unsigned char* rowp = Gp + (size_t)(row0 + ai * HALF + m * 16) * 4096 + col0;
#pragma unroll
                    for (int bj = 0; bj < 2; ++bj) { const f32x4 v0 = acc[ai][bj][m][0], v1 = acc[ai][bj][m][1];
                        unsigned lo = 0u, hi = 0u;
#pragma unroll
                        for (int e = 0; e < 4; ++e) {
                            lo |= (unsigned)(int)__builtin_rintf(255.0f * sigmoidf_(v0[e])) << (8 * e);
                            hi |= (unsigned)(int)__builtin_rintf(255.0f * sigmoidf_(v1[e])) << (8 * e);
                        }
                        u32x2 w; w.x = lo; w.y = hi;
                        *(u32x2*)(rowp + bj * HALF) = w; } }
        }
    }
};
}

#define EPI_LOOP(WM_, WN_)                                                                  \
    _Pragma("unroll") for (int i = 0; i < WM_; ++i)                                         \
    _Pragma("unroll") for (int j = 0; j < WN_; ++j)                                         \
    _Pragma("unroll") for (int g = 0; g < 4; ++g)

__device__ __forceinline__ void phase_inproj(const Ctx& c, const bf16_t* hb, const bf16_t* Wt, bf16_t* Y) {
    constexpr int NTN = NY / 128;
    const int wm = c.wave >> 1, wn = c.wave & 1, r = c.lane & 31, h = c.lane >> 5;
    for (int u = c.blk; u < 64 * NTN; u += c.nblk) {
        const int pm = u / NTN, pn = u % NTN;
        f32x16 acc[2][2]; acc_zero<2, 2>(acc);
        gemm_kloop<2, 2>(c, acc, hb + (size_t)pm * 256 * DM, DM, Wt + (size_t)pn * 128 * DM, DM, DM);
        EPI_LOOP(2, 2) {
            const int m = pm * 256 + (wm * 2 + i) * 32 + r, n = pn * 128 + (wn * 2 + j) * 32 + 8 * g + 4 * h;
            u32x2 w; w.x = pk_bf16(acc[i][j][4 * g], acc[i][j][4 * g + 1]); w.y = pk_bf16(acc[i][j][4 * g + 2], acc[i][j][4 * g + 3]);
            *(u32x2*)(Y + (size_t)m * NY + n) = w;
        }
    }
}
__device__ __forceinline__ void phase_merge(const Ctx& c, const bf16_t* hb, const bf16_t* Wg, const bf16_t* O, const bf16_t* Wb, bf16_t* MIX) {
    const int wm = c.wave >> 1, wn = c.wave & 1, r = c.lane & 31, h = c.lane >> 5;
    for (int u = c.blk; u < 128 * 8; u += c.nblk) {
        const int pm = u >> 3, pn = u & 7;
        f32x16 mix[1][2]; acc_zero<1, 2>(mix);
#pragma unroll 1
        for (int nb = 0; nb < 4; ++nb) {
            f32x16 ag[1][2]; acc_zero<1, 2>(ag);
            gemm_kloop<1, 2>(c, ag, hb + (size_t)pm * 128 * DM, DM, Wg + ((size_t)nb * 1024 + pn * 128) * DM, DM, DM);
            f32x16 ap[1][2]; acc_zero<1, 2>(ap);
            gemm_kloop<1, 2>(c, ap, O + (size_t)pm * 128 * DM + nb * 256, DM, Wb + ((size_t)nb * 1024 + pn * 128) * 256, 256, 256);
#pragma unroll
            for (int j = 0; j < 2; ++j)
#pragma unroll
                for (int e = 0; e < 16; ++e) mix[0][j][e] += sigmoidf_(ag[0][j][e]) * ap[0][j][e];
        }
        EPI_LOOP(1, 2) {
            const int m = pm * 128 + (wm + i) * 32 + r, n = pn * 128 + (wn * 2 + j) * 32 + 8 * g + 4 * h;
            u32x2 w; w.x = pk_bf16(mix[i][j][4 * g], mix[i][j][4 * g + 1]); w.y = pk_bf16(mix[i][j][4 * g + 2], mix[i][j][4 * g + 3]);
            *(u32x2*)(MIX + (size_t)m * DM + n) = w;
        }
    }
}
__device__ __forceinline__ void phase_outproj(const Ctx& c, const bf16_t* MIX, const bf16_t* Wo, const float* hf, float* Z) {
    const int wm = c.wave >> 1, wn = c.wave & 1, r = c.lane & 31, h = c.lane >> 5;
    for (int u = c.blk; u < 64 * 8; u += c.nblk) {
        const int pm = u >> 3, pn = u & 7;
        f32x16 acc[2][2]; acc_zero<2, 2>(acc);
        gemm_kloop<2, 2>(c, acc, MIX + (size_t)pm * 256 * DM, DM, Wo + (size_t)pn * 128 * DM, DM, DM);
        EPI_LOOP(2, 2) {
            const int m = pm * 256 + (wm * 2 + i) * 32 + r, n = pn * 128 + (wn * 2 + j) * 32 + 8 * g + 4 * h;
            const f32x4 x = *(const f32x4*)(hf + (size_t)m * DM + n);
            f32x4 y; y[0] = DN_ALPHA * x[0] + acc[i][j][4 * g]; y[1] = DN_ALPHA * x[1] + acc[i][j][4 * g + 1]; y[2] = DN_ALPHA * x[2] + acc[i][j][4 * g + 2]; y[3] = DN_ALPHA * x[3] + acc[i][j][4 * g + 3];
            *(f32x4*)(Z + (size_t)m * DM + n) = y;
        }
    }
}
__device__ __forceinline__ void phase_wq(const Ctx& c, const bf16_t* hb, const bf16_t* Wq, bf16_t* QV) {
    const int wm = c.wave >> 1, wn = c.wave & 1, r = c.lane & 31, h = c.lane >> 5;
    for (int u = c.blk; u < 64 * 16; u += c.nblk) {
        const int pm = u >> 4, pn = u & 15;
        f32x16 acc[2][2]; acc_zero<2, 2>(acc);
        gemm_kloop<2, 2>(c, acc, hb + (size_t)pm * 256 * DM, DM, Wq + (size_t)pn * 128 * DM, DM, DM);
        EPI_LOOP(2, 2) {
            const int m = pm * 256 + (wm * 2 + i) * 32 + r, n = pn * 128 + (wn * 2 + j) * 32 + 8 * g + 4 * h;
            u32x2 w; w.x = pk_bf16(acc[i][j][4 * g], acc[i][j][4 * g + 1]); w.y = pk_bf16(acc[i][j][4 * g + 2], acc[i][j][4 * g + 3]);
            *(u32x2*)(QV + (size_t)m * 2048 + n) = w;
        }
    }
}

__device__ __forceinline__ void phase_inproj_pg8(const Ctx& c, const bf16_t* hb, const bf16_t* Wt, bf16_t* Y) {
    pg8::Gemm g{hb, Wt, NTOK, NY, DM}; pg8::StaticOrder S; S.init(NTOK, NY, c.nblk, c.blk);
    pg8::EpiStoreBf16 E{Y, NY};
    pg8::gemm_phase<pg8::EpiStoreBf16, pg8::StaticOrder>(c.lds, g, S, E);
}
__device__ __forceinline__ void phase_wq_pg8(const Ctx& c, const bf16_t* hb, const bf16_t* Wq, bf16_t* QV) {
    pg8::Gemm g{hb, Wq, NTOK, 2048, DM}; pg8::StaticOrder S; S.init(NTOK, 2048, c.nblk, c.blk);
    pg8::EpiStoreBf16 E{QV, 2048};
    pg8::gemm_phase<pg8::EpiStoreBf16, pg8::StaticOrder>(c.lds, g, S, E);
}
__device__ __forceinline__ void phase_outproj_pg8(const Ctx& c, const bf16_t* MIX, const bf16_t* Wo, const float* hf, float* Z) {
    pg8::Gemm g{MIX, Wo, NTOK, DM, DM}; pg8::StaticOrder S; S.init(NTOK, DM, c.nblk, c.blk);
    pg8::EpiResidF32 E{hf, Z, DM, DN_ALPHA};
    pg8::gemm_phase<pg8::EpiResidF32, pg8::StaticOrder>(c.lds, g, S, E);
}

__device__ __forceinline__ void phase_inproj_gates_pg8(const Ctx& c, const bf16_t* hb, const bf16_t* Wt, bf16_t* Yp, unsigned char* Gp) {
    pg8::Gemm g{hb, Wt, NTOK, NIN, DM}; pg8::StaticOrder S; S.init(NTOK, NIN, c.nblk, c.blk);
    pg8::EpiYG E{Yp, Gp};
    pg8::gemm_phase<pg8::EpiYG, pg8::StaticOrder>(c.lds, g, S, E);
}
__device__ __forceinline__ void phase_merge2(const Ctx& c, const unsigned char* Gp, const bf16_t* Op, const bf16_t* Wb, bf16_t* MIXp) {
    const int wm = c.wave >> 1, wn = c.wave & 1, r = c.lane & 31, h = c.lane >> 5;
    for (int u = c.blk; u < 64 * 8; u += c.nblk) {
        const int pm = u >> 3, pn = u & 7;
        f32x16 mix[2][2]; acc_zero<2, 2>(mix);
#pragma unroll 1
        for (int nb = 0; nb < 4; ++nb) {
            f32x16 ap[2][2]; acc_zero<2, 2>(ap);
            gemm_kloop<2, 2>(c, ap, Op + (size_t)pm * 256 * DM + nb * 256, DM, Wb + ((size_t)nb * 1024 + pn * 128) * 256, 256, 256);
            EPI_LOOP(2, 2) {
                const int m = pm * 256 + (wm * 2 + i) * 32 + r, n = pn * 128 + (wn * 2 + j) * 32 + 8 * g + 4 * h;
                const unsigned gq = *(const unsigned*)(Gp + (size_t)m * 4096 + nb * 1024 + n);
                mix[i][j][4 * g + 0] += (float)(gq & 0xffu) * (1.0f / 255.0f) * ap[i][j][4 * g + 0];
                mix[i][j][4 * g + 1] += (float)((gq >> 8) & 0xffu) * (1.0f / 255.0f) * ap[i][j][4 * g + 1];
                mix[i][j][4 * g + 2] += (float)((gq >> 16) & 0xffu) * (1.0f / 255.0f) * ap[i][j][4 * g + 2];
                mix[i][j][4 * g + 3] += (float)(gq >> 24) * (1.0f / 255.0f) * ap[i][j][4 * g + 3];
            }
        }
        EPI_LOOP(2, 2) {
            const int m = pm * 256 + (wm * 2 + i) * 32 + r, n = pn * 128 + (wn * 2 + j) * 32 + 8 * g + 4 * h;
            u32x2 w; w.x = pk_bf16(mix[i][j][4 * g], mix[i][j][4 * g + 1]); w.y = pk_bf16(mix[i][j][4 * g + 2], mix[i][j][4 * g + 3]);
            *(u32x2*)(MIXp + (size_t)m * DM + n) = w;
        }
    }
}

__device__ __forceinline__ f32x16 mma_lds(f32x16 acc, lptr A, int sa, lptr B, int sb, int K, int lane) {
    const int r = lane & 31, h = lane >> 5;
    const lptr pa = A + r * sa + h * 16, pb = B + r * sb + h * 16;
    for (int k = 0; k < K; k += 16) {
        const bf16x8 a = *(LAS const bf16x8*)(pa + k * 2), b = *(LAS const bf16x8*)(pb + k * 2);
        acc = __builtin_amdgcn_mfma_f32_32x32x16_bf16(b, a, acc, 0, 0, 0);
    }
    return acc;
}
__device__ __forceinline__ f32x16 zero16() { f32x16 z;
#pragma unroll
    for (int e = 0; e < 16; ++e) z[e] = 0.f; return z; }

__device__ __forceinline__ void sb_wave_unit(const bf16_t* Y, bf16_t* O, int b, int hh, int qt, lptr wl, int lane) {
    const int t = qt * 64 + lane;
    const size_t row = (size_t)b * SEQ + t;
    unsigned q[32];
    {
        const u32x4* qp = (const u32x4*)(Y + row * NY + C_SBQ + hh * 64);
#pragma unroll
        for (int i = 0; i < 8; ++i) { const u32x4 v = qp[i]; q[4 * i] = v.x; q[4 * i + 1] = v.y; q[4 * i + 2] = v.z; q[4 * i + 3] = v.w; }
    }
    float acc[64];
#pragma unroll
    for (int e = 0; e < 64; ++e) acc[e] = 0.f;
    float C = 0.f;
    for (int kt = qt; kt >= 0; --kt) {
        {
            const size_t krow = (size_t)b * SEQ + kt * 64 + lane;
            const u32x4* kp = (const u32x4*)(Y + krow * NY + C_SBK + hh * 64);
            const u32x4* vp = (const u32x4*)(Y + krow * NY + C_SBV + hh * 64);
            u32x4 kr[8], vr[8];
#pragma unroll
            for (int i = 0; i < 8; ++i) { kr[i] = kp[i]; vr[i] = vp[i]; }
#pragma unroll
            for (int i = 0; i < 8; ++i) { *(LAS u32x4*)(wl + lane * 144 + i * 16) = kr[i]; *(LAS u32x4*)(wl + 9216 + lane * 144 + i * 16) = vr[i]; }
        }
        asm volatile("s_waitcnt lgkmcnt(0)" ::: "memory");
        const int s_hi = (kt == qt) ? 62 : 63;
#pragma unroll 1
        for (int s = s_hi; s >= 0; --s) {
            const int pos = kt * 64 + s;
            float z0 = 0.f, z1 = 0.f;
#pragma unroll
            for (int i = 0; i < 8; ++i) {
                const u32x4 kv = *(LAS const u32x4*)(wl + s * 144 + i * 16);
                z0 = dot2bf(q[4 * i], kv.x, z0); z1 = dot2bf(q[4 * i + 1], kv.y, z1); z0 = dot2bf(q[4 * i + 2], kv.z, z0); z1 = dot2bf(q[4 * i + 3], kv.w, z1);
            }
            const float z = (z0 + z1) * 0.125f;
            const bool valid = pos < t;
            const float Cn = C - softplusf_(z);
            const float w = valid ? __expf(z + Cn) : 0.f;
            C = valid ? Cn : C;
#pragma unroll
            for (int i = 0; i < 8; ++i) {
                const u32x4 vv = *(LAS const u32x4*)(wl + 9216 + s * 144 + i * 16);
                acc[8 * i + 0] += w * bf_lo(vv.x); acc[8 * i + 1] += w * bf_hi(vv.x); acc[8 * i + 2] += w * bf_lo(vv.y); acc[8 * i + 3] += w * bf_hi(vv.y);
                acc[8 * i + 4] += w * bf_lo(vv.z); acc[8 * i + 5] += w * bf_hi(vv.z); acc[8 * i + 6] += w * bf_lo(vv.w); acc[8 * i + 7] += w * bf_hi(vv.w);
            }
        }
        asm volatile("" ::: "memory");
        if (__all(C < -104.0f)) break;
    }
    u32x4* op = (u32x4*)(O + row * DM + 0 * 256 + hh * 64);
#pragma unroll
    for (int i = 0; i < 8; ++i) {
        u32x4 w; w.x = pk_bf16(acc[8 * i], acc[8 * i + 1]); w.y = pk_bf16(acc[8 * i + 2], acc[8 * i + 3]); w.z = pk_bf16(acc[8 * i + 4], acc[8 * i + 5]); w.w = pk_bf16(acc[8 * i + 6], acc[8 * i + 7]);
        op[i] = w;
    }
}
__device__ __forceinline__ void phase_sb(const Ctx& c, const bf16_t* Y, bf16_t* O) {
    const lptr wl = c.lds + c.wave * 18432;
    for (int u = c.blk * 8 + c.wave; u < 1024; u += c.nblk * 8) {
        const int qt = u & 127, hh = (u >> 7) & 3, b = u >> 9;
        sb_wave_unit(Y, O, b, hh, qt, wl, c.lane);
    }
    __syncthreads();
}

__device__ __forceinline__ void phase_compress(const Ctx& c, const bf16_t* Y, const float* pos, const float* wk, const float* wv, bf16_t* KC, bf16_t* VC) {
    LAS float* kl = (LAS float*)c.lds;
    LAS float* pl = (LAS float*)(c.lds + 144 * 64 * 4);
    for (int u = c.blk; u < 256; u += c.nblk) {
        const int cg = u & 63, kv = (u >> 6) & 1, b = u >> 7;
        const int c0 = cg * 8;
        const int col = kv ? C_NVC : C_NKC;
        for (int i = c.tid; i < 144 * 64; i += NTHREADS) {
            const int tr = i >> 6, d = i & 63, tok = c0 * 16 + tr;
            kl[i] = (tok < SEQ) ? bf2f(Y[((size_t)b * SEQ + tok) * NY + col + d]) : 0.f;
        }
        for (int i = c.tid; i < 32 * 64; i += NTHREADS) pl[i] = pos[i];
        __syncthreads();
        const int cl = c.tid >> 6, d = c.tid & 63, cc = c0 + cl;
        const float* w = kv ? wv : wk;
        float a0 = 0.f, a1 = 0.f;
#pragma unroll 4
        for (int l = 0; l < 32; ++l) {
            const LAS float* kr = kl + (cl * 16 + l) * 64;
            const LAS float* pr = pl + l * 64;
            const float* wr = w + (size_t)l * 64 * 64 + d;
#pragma unroll 8
            for (int dp = 0; dp < 64; dp += 2) {
                a0 += (kr[dp] + pr[dp]) * wr[(size_t)dp * 64];
                a1 += (kr[dp + 1] + pr[dp + 1]) * wr[(size_t)(dp + 1) * 64];
            }
        }
        bf16_t* dst = kv ? VC : KC;
        dst[((size_t)b * 512 + cc) * 64 + d] = (cc < 511) ? f2bf(a0 + a1) : (bf16_t)0;
        __syncthreads();
    }
}

__device__ __forceinline__ void phase_compress2(const Ctx& c, const bf16_t* Y, const bf16_t* WC, float* RC) {
    const int wm = c.wave >> 1, wn = c.wave & 1, r = c.lane & 31, h = c.lane >> 5;
    for (int u = c.blk; u < 16; u += c.nblk) {
        const int rt = u & 3, kv = (u >> 2) & 1, b = u >> 3;
        f32x16 acc[1][2]; acc_zero<1, 2>(acc);
        gemm_kloop<1, 2>(c, acc, Y + ((size_t)b * SEQ + (size_t)rt * 128 * 16) * NY + (kv ? C_NVC : C_NKC), 16 * NY, WC + (size_t)kv * 128 * 1024, 1024, 1024, NY);
        EPI_LOOP(1, 2) {
            const int m = rt * 128 + (wm + i) * 32 + r, n = (wn * 2 + j) * 32 + 8 * g + 4 * h;
            f32x4 o; o[0] = acc[i][j][4 * g]; o[1] = acc[i][j][4 * g + 1]; o[2] = acc[i][j][4 * g + 2]; o[3] = acc[i][j][4 * g + 3];
            *(f32x4*)(RC + ((size_t)(b * 2 + kv) * 512 + m) * 128 + n) = o;
        }
    }
}
__device__ __forceinline__ void phase_compress_combine(const Ctx& c, const float* RC, const float* CB, bf16_t* KC, bf16_t* VC) {
    for (int i = c.blk * NTHREADS + c.tid; i < 2 * 2 * 512 * 64; i += c.nblk * NTHREADS) {
        const int d = i & 63, cc = (i >> 6) & 511, kv = (i >> 15) & 1, b = i >> 16;
        const float* R = RC + (size_t)(b * 2 + kv) * 512 * 128;
        const float v = (cc < 511) ? R[cc * 128 + d] + R[(cc + 1) * 128 + 64 + d] + CB[kv * 64 + d] : 0.f;
        (kv ? VC : KC)[((size_t)b * 512 + cc) * 64 + d] = f2bf(v);
    }
}

__device__ __forceinline__ float ret_logg(int h) { return log1pf(-exp2f(-5.0f - (float)h)); }
__device__ __forceinline__ void phase_ret_local(const Ctx& c, const bf16_t* Y, float* UST) {
    const lptr Kt = c.lds, Vt = c.lds + 64 * 272;
    for (int u = c.blk; u < 512; u += c.nblk) {
        const int i = u & 63, hh = (u >> 6) & 3, b = u >> 8;
        const float lg = ret_logg(hh);
        {
            const int j = c.tid >> 2, dc = (c.tid & 3) * 16;
            const size_t row = (size_t)b * SEQ + i * 128 + j;
            const float kd = __expf(lg * (float)(127 - j)) * 0.125f;
            const u32x4* kp = (const u32x4*)(Y + row * NY + C_RK + hh * 64 + dc);
            const u32x4* vp = (const u32x4*)(Y + row * NY + C_RV + hh * 64 + dc);
            const u32x4 k0 = kp[0], k1 = kp[1], v0 = vp[0], v1 = vp[1];
            const unsigned kk[8] = {k0.x, k0.y, k0.z, k0.w, k1.x, k1.y, k1.z, k1.w};
            const unsigned vv[8] = {v0.x, v0.y, v0.z, v0.w, v1.x, v1.y, v1.z, v1.w};
#pragma unroll
            for (int e = 0; e < 8; ++e) {
                *(LAS bf16_t*)(Kt + (dc + 2 * e) * 272 + j * 2) = f2bf(bf_lo(kk[e]) * kd);
                *(LAS bf16_t*)(Kt + (dc + 2 * e + 1) * 272 + j * 2) = f2bf(bf_hi(kk[e]) * kd);
                *(LAS bf16_t*)(Vt + (dc + 2 * e) * 272 + j * 2) = (bf16_t)(vv[e] & 0xffffu);
                *(LAS bf16_t*)(Vt + (dc + 2 * e + 1) * 272 + j * 2) = (bf16_t)(vv[e] >> 16);
            }
        }
        __syncthreads();
        if (c.wave < 4) {
            const int wm = c.wave >> 1, wn = c.wave & 1, r = c.lane & 31, h = c.lane >> 5;
            f32x16 acc = mma_lds(zero16(), Kt + wm * 32 * 272, 272, Vt + wn * 32 * 272, 272, 128, c.lane);
            float* dst = UST + (((size_t)(b * 4 + hh) * 64 + i) * 64 + wm * 32 + r) * 64 + wn * 32 + 4 * h;
#pragma unroll
            for (int g = 0; g < 4; ++g) { f32x4 o; o[0] = acc[4 * g]; o[1] = acc[4 * g + 1]; o[2] = acc[4 * g + 2]; o[3] = acc[4 * g + 3]; *(f32x4*)(dst + 8 * g) = o; }
        }
        __syncthreads();
    }
}
__device__ __forceinline__ void phase_scans(const Ctx& c, const float* UST, float* RST, const float* UGLA, float* SGLA, const float* BL) {
    for (int u = c.blk; u < 96; u += c.nblk) {
        if (u < 64) {
            const int ch = u * NTHREADS + c.tid;
            const int bh = ch >> 12, de = ch & 4095;
            const float cd = __expf(ret_logg(bh & 3) * 128.0f);
            const float* up = UST + (size_t)bh * 64 * 4096 + de; float* rp = RST + (size_t)bh * 64 * 4096 + de;
            float R = 0.f;
            for (int i0 = 0; i0 < 64; i0 += 16) {
                float uv[16];
#pragma unroll
                for (int j = 0; j < 16; ++j) uv[j] = up[(size_t)(i0 + j) * 4096];
#pragma unroll
                for (int j = 0; j < 16; ++j) { rp[(size_t)(i0 + j) * 4096] = R; R = cd * R + uv[j]; }
            }
        } else {
            const int ch = (u - 64) * NTHREADS + c.tid;
            const int bh = ch >> 11, ke = ch & 2047, k = ke >> 6;
            const float* up = UGLA + (size_t)bh * 128 * 2048 + ke; float* sp = SGLA + (size_t)bh * 128 * 2048 + ke;
            const float* bl = BL + (size_t)bh * 128 * 32 + k;
            float S = 0.f;
            for (int i0 = 0; i0 < 128; i0 += 16) {
                float uv[16], dv[16];
#pragma unroll
                for (int j = 0; j < 16; ++j) { uv[j] = up[(size_t)(i0 + j) * 2048]; dv[j] = bl[(i0 + j) * 32]; }
#pragma unroll
                for (int j = 0; j < 16; ++j) { sp[(size_t)(i0 + j) * 2048] = S; S = __expf(dv[j]) * S + uv[j]; }
            }
        }
    }
}
__device__ __forceinline__ void phase_ret_out(const Ctx& c, const bf16_t* Y, const float* RST, const float* gn_g, const float* gn_b, bf16_t* O) {
    const lptr Qs = c.lds, Ks = c.lds + 18432, Vt = c.lds + 36864, Rt = c.lds + 54272, Att = c.lds + 63488;
    LAS float* Of = (LAS float*)(c.lds + 98304);
    for (int u = c.blk; u < 512; u += c.nblk) {
        const int i = u & 63, hh = (u >> 6) & 3, b = u >> 8;
        const float lg = ret_logg(hh);
        const size_t row0 = (size_t)b * SEQ + i * 128;
        {
            const int j = c.tid >> 2, dc = (c.tid & 3) * 16;
            const size_t row = row0 + j;
            const u32x4* qp = (const u32x4*)(Y + row * NY + C_RQ + hh * 64 + dc);
            const u32x4* kp = (const u32x4*)(Y + row * NY + C_RK + hh * 64 + dc);
            const u32x4* vp = (const u32x4*)(Y + row * NY + C_RV + hh * 64 + dc);
            const u32x4 q0 = qp[0], q1 = qp[1], k0 = kp[0], k1 = kp[1], v0 = vp[0], v1 = vp[1];
            *(LAS u32x4*)(Qs + j * 144 + dc * 2) = q0; *(LAS u32x4*)(Qs + j * 144 + dc * 2 + 16) = q1;
            *(LAS u32x4*)(Ks + j * 144 + dc * 2) = k0; *(LAS u32x4*)(Ks + j * 144 + dc * 2 + 16) = k1;
            const unsigned vv[8] = {v0.x, v0.y, v0.z, v0.w, v1.x, v1.y, v1.z, v1.w};
#pragma unroll
            for (int e = 0; e < 8; ++e) {
                *(LAS bf16_t*)(Vt + (dc + 2 * e) * 272 + j * 2) = (bf16_t)(vv[e] & 0xffffu);
                *(LAS bf16_t*)(Vt + (dc + 2 * e + 1) * 272 + j * 2) = (bf16_t)(vv[e] >> 16);
            }
            const int d = c.tid >> 3, ec = (c.tid & 7) * 8;
            const float* rp = RST + (((size_t)(b * 4 + hh) * 64 + i) * 64 + d) * 64 + ec;
            const f32x4 r0 = *(const f32x4*)rp, r1 = *(const f32x4*)(rp + 4);
            const float rv[8] = {r0[0], r0[1], r0[2], r0[3], r1[0], r1[1], r1[2], r1[3]};
#pragma unroll
            for (int e = 0; e < 8; ++e) *(LAS bf16_t*)(Rt + (ec + e) * 144 + d * 2) = f2bf(rv[e]);
        }
        __syncthreads();
        const int r = c.lane & 31, h = c.lane >> 5;
        {
            const int mi = c.wave >> 1;
#pragma unroll
            for (int jj = 0; jj < 2; ++jj) {
                const int nj = (c.wave & 1) * 2 + jj;
                if (nj <= mi) {
                    f32x16 s = mma_lds(zero16(), Qs + mi * 32 * 144, 144, Ks + nj * 32 * 144, 144, 64, c.lane);
                    const int ii = mi * 32 + r;
#pragma unroll
                    for (int g = 0; g < 4; ++g) {
                        float p[4];
#pragma unroll
                        for (int e = 0; e < 4; ++e) { const int jx = nj * 32 + 8 * g + 4 * h + e; const int df = ii - jx; p[e] = (df >= 0) ? s[4 * g + e] * 0.125f * __expf(lg * (float)df) : 0.f; }
                        u32x2 w; w.x = pk_bf16(p[0], p[1]); w.y = pk_bf16(p[2], p[3]);
                        *(LAS u32x2*)(Att + ii * 272 + (nj * 32 + 8 * g + 4 * h) * 2) = w;
                    }
                }
            }
        }
        __syncthreads();
        {
            const int wm = c.wave >> 1, wn = c.wave & 1;
            f32x16 acc = mma_lds(zero16(), Qs + wm * 32 * 144, 144, Rt + wn * 32 * 144, 144, 64, c.lane);
            const int ii = wm * 32 + r;
            const float qd = __expf(lg * (float)(ii + 1));
#pragma unroll
            for (int e = 0; e < 16; ++e) acc[e] *= qd;
            acc = mma_lds(acc, Att + wm * 32 * 272, 272, Vt + wn * 32 * 272, 272, (wm + 1) * 32, c.lane);
#pragma unroll
            for (int g = 0; g < 4; ++g) { f32x4 o; o[0] = acc[4 * g]; o[1] = acc[4 * g + 1]; o[2] = acc[4 * g + 2]; o[3] = acc[4 * g + 3]; *(LAS f32x4*)(Of + ii * 68 + wn * 32 + 8 * g + 4 * h) = o; }
        }
        __syncthreads();
        {
            const int rw = c.tid >> 2, part = c.tid & 3;
            float v[16]; float s = 0.f;
#pragma unroll
            for (int e = 0; e < 16; ++e) { v[e] = Of[rw * 68 + part * 16 + e]; s += v[e]; }
            s += __shfl_xor(s, 1); s += __shfl_xor(s, 2);
            const float mu = s * (1.0f / 64.0f);
            float q = 0.f;
#pragma unroll
            for (int e = 0; e < 16; ++e) { const float d = v[e] - mu; q += d * d; }
            q += __shfl_xor(q, 1); q += __shfl_xor(q, 2);
            const float rstd = rsqrtf(q * (1.0f / 64.0f) + LN_EPS);
            const size_t row = row0 + rw;
            const int ch = hh * 64 + part * 16;
            const u32x4* gp = (const u32x4*)(Y + row * NY + C_RG + ch);
            const u32x4 g0 = gp[0], g1 = gp[1];
            const unsigned gg[8] = {g0.x, g0.y, g0.z, g0.w, g1.x, g1.y, g1.z, g1.w};
            unsigned ow[8];
#pragma unroll
            for (int e = 0; e < 8; ++e) {
                const float y0 = ((v[2 * e] - mu) * rstd * gn_g[ch + 2 * e] + gn_b[ch + 2 * e]) * siluf_(bf_lo(gg[e]));
                const float y1 = ((v[2 * e + 1] - mu) * rstd * gn_g[ch + 2 * e + 1] + gn_b[ch + 2 * e + 1]) * siluf_(bf_hi(gg[e]));
                ow[e] = pk_bf16(y0, y1);
            }
            u32x4* op = (u32x4*)(O + row * DM + 2 * 256 + ch);
            u32x4 w0, w1; w0.x = ow[0]; w0.y = ow[1]; w0.z = ow[2]; w0.w = ow[3]; w1.x = ow[4]; w1.y = ow[5]; w1.z = ow[6]; w1.w = ow[7];
            op[0] = w0; op[1] = w1;
        }
        __syncthreads();
    }
}

template <int NH>
__device__ __forceinline__ void gla_decays(const Ctx& c, const bf16_t* Y, size_t row0, int h0, const float* w_alpha, const float* b_alpha, LAS float* Ab, LAS float* lrs) {
    for (int i = c.tid; i < 64 * 16; i += NTHREADS) lrs[i] = bf2f(Y[(row0 + (i >> 4)) * NY + C_GLR + (i & 15)]);
    __syncthreads();
    for (int i = c.tid; i < NH * 64 * 32; i += NTHREADS) {
        const int k = i & 31, t = (i >> 5) & 63, hl = i >> 11;
        const int col = (h0 + hl) * 32 + k;
        float x = b_alpha[col];
#pragma unroll
        for (int rr = 0; rr < 16; ++rr) x += lrs[t * 16 + rr] * w_alpha[rr * 128 + col];
        Ab[i] = -softplusf_(-x) * (1.0f / 16.0f);
    }
    __syncthreads();
    if (c.tid < NH * 32) {
        const int k = c.tid & 31, hl = c.tid >> 5;
        float s = 0.f;
        for (int t = 0; t < 64; ++t) { s += Ab[(hl * 64 + t) * 32 + k]; Ab[(hl * 64 + t) * 32 + k] = s; }
    }
    __syncthreads();
}
__device__ __forceinline__ void phase_gla_local(const Ctx& c, const bf16_t* Y, const float* w_alpha, const float* b_alpha, float* UGLA, float* BL) {
    LAS float* Ab = (LAS float*)c.lds;
    LAS float* lrs = (LAS float*)(c.lds + 32768);
    const lptr Kt = c.lds + 36864;
    const lptr Vt = c.lds + 36864 + 18432;
    for (int u = c.blk; u < 256; u += c.nblk) {
        const int i = u & 127, b = u >> 7;
        const size_t row0 = (size_t)b * SEQ + i * 64;
        gla_decays<4>(c, Y, row0, 0, w_alpha, b_alpha, Ab, lrs);
        {
            const int s = c.tid >> 3, cc = (c.tid & 7) * 16;
            const u32x4* kp = (const u32x4*)(Y + (row0 + s) * NY + C_GK + cc);
            const u32x4 k0 = kp[0], k1 = kp[1];
            const unsigned kk[8] = {k0.x, k0.y, k0.z, k0.w, k1.x, k1.y, k1.z, k1.w};
#pragma unroll
            for (int e = 0; e < 16; ++e) {
                const int col = cc + e, hl = col >> 5, k = col & 31;
                const float kvf = (e & 1) ? bf_hi(kk[e >> 1]) : bf_lo(kk[e >> 1]);
                const float dec = __expf(Ab[(hl * 64 + 63) * 32 + k] - Ab[(hl * 64 + s) * 32 + k]);
                *(LAS bf16_t*)(Kt + hl * 4608 + k * 144 + s * 2) = f2bf(kvf * dec);
            }
            const int vc = (c.tid & 7) * 32;
            const u32x4* vp = (const u32x4*)(Y + (row0 + s) * NY + C_GV + vc);
#pragma unroll
            for (int q4 = 0; q4 < 4; ++q4) {
                const u32x4 v = vp[q4];
                const unsigned vv[4] = {v.x, v.y, v.z, v.w};
#pragma unroll
                for (int e = 0; e < 4; ++e) {
                    const int col = vc + q4 * 8 + 2 * e, hl = col >> 6, ee = col & 63;
                    *(LAS bf16_t*)(Vt + hl * 9216 + ee * 144 + s * 2) = (bf16_t)(vv[e] & 0xffffu);
                    *(LAS bf16_t*)(Vt + hl * 9216 + (ee + 1) * 144 + s * 2) = (bf16_t)(vv[e] >> 16);
                }
            }
        }
        __syncthreads();
        {
            const int hl = c.wave >> 1, wn = c.wave & 1, r = c.lane & 31, h = c.lane >> 5;
            f32x16 acc = mma_lds(zero16(), Kt + hl * 4608, 144, Vt + hl * 9216 + wn * 32 * 144, 144, 64, c.lane);
            float* dst = UGLA + (((size_t)(b * 4 + hl) * 128 + i) * 32 + r) * 64 + wn * 32 + 4 * h;
#pragma unroll
            for (int g = 0; g < 4; ++g) { f32x4 o; o[0] = acc[4 * g]; o[1] = acc[4 * g + 1]; o[2] = acc[4 * g + 2]; o[3] = acc[4 * g + 3]; *(f32x4*)(dst + 8 * g) = o; }
            if (c.tid < 128) { const int hl2 = c.tid >> 5, k = c.tid & 31; BL[((size_t)(b * 4 + hl2) * 128 + i) * 32 + k] = Ab[(hl2 * 64 + 63) * 32 + k]; }
        }
        __syncthreads();
    }
}
__device__ __forceinline__ void phase_gla_out(const Ctx& c, const bf16_t* Y, const float* w_alpha, const float* b_alpha, const float* SGLA, const float* norm_g, bf16_t* O) {
    LAS float* Ab = (LAS float*)c.lds;
    LAS float* lrs = (LAS float*)(c.lds + 16384);
    const lptr Qp = c.lds + 20480;
    const lptr Kp = Qp + 10240;
    const lptr Vt = Kp + 10240;
    const lptr St = Vt + 18432;
    const lptr Att = St + 10240;
    LAS float* Of = (LAS float*)(Att + 18432);
    for (int u = c.blk; u < 512; u += c.nblk) {
        const int hp = u & 1, i = (u >> 1) & 127, b = u >> 8;
        const size_t row0 = (size_t)b * SEQ + i * 64;
        gla_decays<2>(c, Y, row0, hp * 2, w_alpha, b_alpha, Ab, lrs);
        {
            const int s = c.tid >> 3, cc = (c.tid & 7) * 8;
            const int hl = cc >> 5, k0 = cc & 31;
            const u32x4 qv = *(const u32x4*)(Y + (row0 + s) * NY + C_GQ + hp * 64 + cc);
            const u32x4 kv = *(const u32x4*)(Y + (row0 + s) * NY + C_GK + hp * 64 + cc);
            const unsigned qq[4] = {qv.x, qv.y, qv.z, qv.w}, kk[4] = {kv.x, kv.y, kv.z, kv.w};
            unsigned qo[4], ko[4];
#pragma unroll
            for (int e = 0; e < 4; ++e) {
                const float b0 = Ab[(hl * 64 + s) * 32 + k0 + 2 * e], b1 = Ab[(hl * 64 + s) * 32 + k0 + 2 * e + 1];
                const float e0 = __expf(b0), e1 = __expf(b1);
                qo[e] = pk_bf16(bf_lo(qq[e]) * 0.17677669529663687f * e0, bf_hi(qq[e]) * 0.17677669529663687f * e1);
                ko[e] = pk_bf16(bf_lo(kk[e]) / e0, bf_hi(kk[e]) / e1);
            }
            u32x4 w; w.x = qo[0]; w.y = qo[1]; w.z = qo[2]; w.w = qo[3];
            *(LAS u32x4*)(Qp + hl * 5120 + s * 80 + k0 * 2) = w;
            w.x = ko[0]; w.y = ko[1]; w.z = ko[2]; w.w = ko[3];
            *(LAS u32x4*)(Kp + hl * 5120 + s * 80 + k0 * 2) = w;
            const int vc = (c.tid & 7) * 16;
            const u32x4* vp = (const u32x4*)(Y + (row0 + s) * NY + C_GV + hp * 128 + vc);
#pragma unroll
            for (int q4 = 0; q4 < 2; ++q4) {
                const u32x4 v = vp[q4];
                const unsigned vv[4] = {v.x, v.y, v.z, v.w};
#pragma unroll
                for (int e = 0; e < 4; ++e) {
                    const int col = vc + q4 * 8 + 2 * e, hl2 = col >> 6, ee = col & 63;
                    *(LAS bf16_t*)(Vt + hl2 * 9216 + ee * 144 + s * 2) = (bf16_t)(vv[e] & 0xffffu);
                    *(LAS bf16_t*)(Vt + hl2 * 9216 + (ee + 1) * 144 + s * 2) = (bf16_t)(vv[e] >> 16);
                }
            }
            const int sh = c.tid >> 8, sk = (c.tid >> 3) & 31, se = (c.tid & 7) * 8;
            const float* spp = SGLA + (((size_t)(b * 4 + hp * 2 + sh) * 128 + i) * 32 + sk) * 64 + se;
            const f32x4 s0 = *(const f32x4*)spp, s1 = *(const f32x4*)(spp + 4);
            const float sv[8] = {s0[0], s0[1], s0[2], s0[3], s1[0], s1[1], s1[2], s1[3]};
#pragma unroll
            for (int e = 0; e < 8; ++e) *(LAS bf16_t*)(St + sh * 5120 + (se + e) * 80 + sk * 2) = f2bf(sv[e]);
        }
        __syncthreads();
        const int hl = c.wave >> 2, mi = (c.wave >> 1) & 1, nj = c.wave & 1, r = c.lane & 31, h = c.lane >> 5;
        if (nj <= mi) {
            f32x16 s = mma_lds(zero16(), Qp + hl * 5120 + mi * 32 * 80, 80, Kp + hl * 5120 + nj * 32 * 80, 80, 32, c.lane);
            const int tt = mi * 32 + r;
#pragma unroll
            for (int g = 0; g < 4; ++g) {
                float p[4];
#pragma unroll
                for (int e = 0; e < 4; ++e) { const int sx = nj * 32 + 8 * g + 4 * h + e; p[e] = (sx <= tt) ? s[4 * g + e] : 0.f; }
                u32x2 w; w.x = pk_bf16(p[0], p[1]); w.y = pk_bf16(p[2], p[3]);
                *(LAS u32x2*)(Att + hl * 9216 + tt * 144 + (nj * 32 + 8 * g + 4 * h) * 2) = w;
            }
        }
        __syncthreads();
        {
            f32x16 acc = mma_lds(zero16(), Qp + hl * 5120 + mi * 32 * 80, 80, St + hl * 5120 + nj * 32 * 80, 80, 32, c.lane);
            acc = mma_lds(acc, Att + hl * 9216 + mi * 32 * 144, 144, Vt + hl * 9216 + nj * 32 * 144, 144, (mi + 1) * 32, c.lane);
            const int tt = mi * 32 + r;
#pragma unroll
            for (int g = 0; g < 4; ++g) { f32x4 o; o[0] = acc[4 * g]; o[1] = acc[4 * g + 1]; o[2] = acc[4 * g + 2]; o[3] = acc[4 * g + 3]; *(LAS f32x4*)(Of + (hl * 64 + tt) * 68 + nj * 32 + 8 * g + 4 * h) = o; }
        }
        __syncthreads();
        {
            const int rw = c.tid >> 2, part = c.tid & 3;
            const int hl2 = rw >> 6, tt = rw & 63, hh = hp * 2 + hl2;
            float v[16]; float q = 0.f;
#pragma unroll
            for (int e = 0; e < 16; ++e) { v[e] = Of[rw * 68 + part * 16 + e]; q += v[e] * v[e]; }
            q += __shfl_xor(q, 1); q += __shfl_xor(q, 2);
            const float rstd = rsqrtf(q * (1.0f / 64.0f) + LN_EPS);
            const size_t row = row0 + tt;
            const int ch = hh * 64 + part * 16;
            const u32x4* gp = (const u32x4*)(Y + row * NY + C_GR + ch);
            const u32x4 g0 = gp[0], g1 = gp[1];
            const unsigned gg[8] = {g0.x, g0.y, g0.z, g0.w, g1.x, g1.y, g1.z, g1.w};
            unsigned ow[8];
#pragma unroll
            for (int e = 0; e < 8; ++e) {
                const float y0 = v[2 * e] * rstd * norm_g[ch + 2 * e] * siluf_(bf_lo(gg[e]));
                const float y1 = v[2 * e + 1] * rstd * norm_g[ch + 2 * e + 1] * siluf_(bf_hi(gg[e]));
                ow[e] = pk_bf16(y0, y1);
            }
            u32x4* op = (u32x4*)(O + row * DM + 3 * 256 + ch);
            u32x4 w0, w1; w0.x = ow[0]; w0.y = ow[1]; w0.z = ow[2]; w0.w = ow[3]; w1.x = ow[4]; w1.y = ow[5]; w1.z = ow[6]; w1.w = ow[7];
            op[0] = w0; op[1] = w1;
        }
        __syncthreads();
    }
}

constexpr int NS_Q = 0;
constexpr int NS_K = 18432;
constexpr int NS_VT = 27648;
constexpr int NS_S = 36864;
constexpr int NS_P = 71680;
constexpr int NS_M = 90112;
constexpr int NS_L = NS_M + 512;
constexpr int NS_A = NS_L + 512;
constexpr int NS_G = NS_A + 512;
constexpr int NS_IMP = NS_G + 2048;
constexpr int NS_SEL = NS_IMP + 16384;
constexpr int NS_UM = NS_SEL + 512;
constexpr int NS_CARRY = NS_UM + 64;
constexpr int NS_BLIST = NS_CARRY + 256;
constexpr int NS_END = NS_BLIST + 512;

__device__ __forceinline__ void ns_stage_rows(const Ctx& c, lptr dst, const bf16_t* src, size_t ld) {
    const int rr = c.tid >> 3, cc = (c.tid & 7) * 8;
    *(LAS u32x4*)(dst + rr * 144 + cc * 2) = *(const u32x4*)(src + (size_t)rr * ld + cc);
}
__device__ __forceinline__ void ns_stage_T(const Ctx& c, lptr dst, const bf16_t* src, size_t ld) {
    const int rr = c.tid >> 3, cc = (c.tid & 7) * 8;
    const u32x4 v = *(const u32x4*)(src + (size_t)rr * ld + cc);
    const unsigned vv[4] = {v.x, v.y, v.z, v.w};
#pragma unroll
    for (int e = 0; e < 4; ++e) {
        *(LAS bf16_t*)(dst + (cc + 2 * e) * 144 + rr * 2) = (bf16_t)(vv[e] & 0xffffu);
        *(LAS bf16_t*)(dst + (cc + 2 * e + 1) * 144 + rr * 2) = (bf16_t)(vv[e] >> 16);
    }
}
__device__ __forceinline__ void ns_scores(const Ctx& c) {
    const int wm = c.wave >> 1, wn = c.wave & 1, r = c.lane & 31, h = c.lane >> 5;
    const f32x16 s = mma_lds(zero16(), c.lds + NS_Q + wm * 32 * 144, 144, c.lds + NS_K + wn * 32 * 144, 144, 64, c.lane);
    LAS float* Sf = (LAS float*)(c.lds + NS_S);
#pragma unroll
    for (int g = 0; g < 4; ++g) { f32x4 o; o[0] = s[4 * g]; o[1] = s[4 * g + 1]; o[2] = s[4 * g + 2]; o[3] = s[4 * g + 3]; *(LAS f32x4*)(Sf + (wm * 32 + r) * 68 + wn * 32 + 8 * g + 4 * h) = o; }
}
template <int MODE>
__device__ __forceinline__ bool ns_valid(int t, int kidx, int tok, const Ctx& c, float& dist) {
    if (MODE == 0) { const int d = t - 16 * kidx - 31; dist = (float)d; return d >= 0 && kidx < 511; }
    if (MODE == 1) { const int nb = kidx >> 6; const unsigned m = ((LAS const unsigned*)(c.lds + NS_SEL))[tok * 4 + (nb >> 5)]; const int d = t - kidx; dist = (float)d; return ((m >> (nb & 31)) & 1u) && d >= 0; }
    const int d = t - kidx; dist = (float)d; return d >= 0 && d < 512;
}
template <int MODE, int PASS>
__device__ __forceinline__ void ns_softmax(const Ctx& c, int t0, int k0) {
    LAS float* Sf = (LAS float*)(c.lds + NS_S);
    LAS float* Mr = (LAS float*)(c.lds + NS_M); LAS float* Lr = (LAS float*)(c.lds + NS_L); LAS float* Ar = (LAS float*)(c.lds + NS_A);
    const int row = c.tid >> 2, part = c.tid & 3, tok = row & 31, hh = row >> 5, t = t0 + tok;
    const float slope = exp2f(-2.0f * (float)(hh + 1));
    float s[16]; bool ok[16]; float mloc = NEGF;
#pragma unroll
    for (int e = 0; e < 16; ++e) {
        const int j = part * 16 + e; float dist;
        ok[e] = ns_valid<MODE>(t, k0 + j, tok, c, dist);
        s[e] = Sf[row * 68 + j] * 0.125f - slope * dist;
        if (ok[e]) mloc = fmaxf(mloc, s[e]);
    }
    mloc = fmaxf(mloc, __shfl_xor(mloc, 1)); mloc = fmaxf(mloc, __shfl_xor(mloc, 2));
    const float mold = Mr[row], lold = Lr[row];
    if (PASS == 2) {
        const float inv = lold > 0.f ? 1.0f / lold : 0.f;
        unsigned pw[8];
#pragma unroll
        for (int e = 0; e < 16; e += 2) {
            const float p0 = ok[e] ? __expf(s[e] - mold) * inv : 0.f, p1 = ok[e + 1] ? __expf(s[e + 1] - mold) * inv : 0.f;
            Sf[row * 68 + part * 16 + e] = p0; Sf[row * 68 + part * 16 + e + 1] = p1;
            pw[e >> 1] = pk_bf16(p0, p1);
        }
        u32x4 w0, w1; w0.x = pw[0]; w0.y = pw[1]; w0.z = pw[2]; w0.w = pw[3]; w1.x = pw[4]; w1.y = pw[5]; w1.z = pw[6]; w1.w = pw[7];
        *(LAS u32x4*)(c.lds + NS_P + row * 144 + part * 32) = w0; *(LAS u32x4*)(c.lds + NS_P + row * 144 + part * 32 + 16) = w1;
        return;
    }
    const float mnew = fmaxf(mold, mloc);
    float sum = 0.f; unsigned pw[8];
#pragma unroll
    for (int e = 0; e < 16; e += 2) {
        const float p0 = ok[e] ? __expf(s[e] - mnew) : 0.f, p1 = ok[e + 1] ? __expf(s[e + 1] - mnew) : 0.f;
        sum += p0 + p1; pw[e >> 1] = pk_bf16(p0, p1);
    }
    sum += __shfl_xor(sum, 1); sum += __shfl_xor(sum, 2);
    const float alpha = __expf(mold - mnew);
    if (PASS == 1) {
        u32x4 w0, w1; w0.x = pw[0]; w0.y = pw[1]; w0.z = pw[2]; w0.w = pw[3]; w1.x = pw[4]; w1.y = pw[5]; w1.z = pw[6]; w1.w = pw[7];
        *(LAS u32x4*)(c.lds + NS_P + row * 144 + part * 32) = w0; *(LAS u32x4*)(c.lds + NS_P + row * 144 + part * 32 + 16) = w1;
    }
    if (part == 0) { Mr[row] = mnew; Lr[row] = lold * alpha + sum; Ar[row] = alpha; }
}
__device__ __forceinline__ f32x16 ns_pv(const Ctx& c, f32x16 acc, bool rescale) {
    const int wm = c.wave >> 1, wn = c.wave & 1, r = c.lane & 31;
    if (rescale) { const float a = ((LAS const float*)(c.lds + NS_A))[wm * 32 + r];
#pragma unroll
        for (int e = 0; e < 16; ++e) acc[e] *= a; }
    return mma_lds(acc, c.lds + NS_P + wm * 32 * 144, 144, c.lds + NS_VT + wn * 32 * 144, 144, 64, c.lane);
}
__device__ __forceinline__ void ns_reset_stats(const Ctx& c) {
    if (c.tid < 128) { ((LAS float*)(c.lds + NS_M))[c.tid] = NEGF; ((LAS float*)(c.lds + NS_L))[c.tid] = 0.f; ((LAS float*)(c.lds + NS_A))[c.tid] = 1.f; }
}

__device__ __forceinline__ void phase_nsa(const Ctx& c, const bf16_t* Y, const bf16_t* KC, const bf16_t* VC, bf16_t* O) {
    LAS float* Sf = (LAS float*)(c.lds + NS_S);
    LAS float* Gt = (LAS float*)(c.lds + NS_G);
    LAS float* Imp = (LAS float*)(c.lds + NS_IMP);
    LAS unsigned* Sel = (LAS unsigned*)(c.lds + NS_SEL);
    LAS unsigned* Um = (LAS unsigned*)(c.lds + NS_UM);
    LAS float* Carry = (LAS float*)(c.lds + NS_CARRY);
    const int wm = c.wave >> 1, wn = c.wave & 1, r = c.lane & 31, h = c.lane >> 5;
    for (int u = c.blk; u < 512; u += c.nblk) {
        const int tq = u & 255, b = u >> 8;
        const int t0 = tq * 32;
        const size_t row0 = (size_t)b * SEQ + t0;
        {
            const int row = c.tid >> 2, dc = (c.tid & 3) * 16, tok = row & 31, hh = row >> 5;
            const u32x4* qp = (const u32x4*)(Y + (row0 + tok) * NY + C_NQ + hh * 64 + dc);
            *(LAS u32x4*)(c.lds + NS_Q + row * 144 + dc * 2) = qp[0]; *(LAS u32x4*)(c.lds + NS_Q + row * 144 + dc * 2 + 16) = qp[1];
            if (c.tid < 384) { const int rw = c.tid / 3, gi = c.tid % 3; Gt[rw * 4 + gi] = sigmoidf_(bf2f(Y[(row0 + (rw & 31)) * NY + C_NG + (rw >> 5) * 3 + gi])); }
            for (int i = c.tid; i < 32 * 128; i += NTHREADS) Imp[i] = 0.f;
            if (c.tid < 32) Carry[c.tid] = 0.f;
            if (c.tid < 4) Um[c.tid] = 0u;
            ns_reset_stats(c);
        }
        __syncthreads();
        f32x16 outacc = zero16();
        const int ncmp = min(t0 / 16 + 1, 511);
        const int nct = (ncmp + 63) / 64;
        const bf16_t* kcb = KC + (size_t)b * 512 * 64; const bf16_t* vcb = VC + (size_t)b * 512 * 64;
        for (int ct = 0; ct < nct; ++ct) {
            ns_stage_rows(c, c.lds + NS_K, kcb + (size_t)ct * 64 * 64, 64);
            __syncthreads();
            ns_scores(c);
            __syncthreads();
            ns_softmax<0, 0>(c, t0, ct * 64);
            __syncthreads();
        }
        {
            f32x16 acc = zero16();
            for (int ct = 0; ct < nct; ++ct) {
                ns_stage_rows(c, c.lds + NS_K, kcb + (size_t)ct * 64 * 64, 64);
                ns_stage_T(c, c.lds + NS_VT, vcb + (size_t)ct * 64 * 64, 64);
                __syncthreads();
                ns_scores(c);
                __syncthreads();
                ns_softmax<0, 2>(c, t0, ct * 64);
                __syncthreads();
                acc = ns_pv(c, acc, false);
                {
                    const int tok = c.tid >> 4, g = c.tid & 15;
                    float a = 0.f, last = 0.f, prev = 0.f;
#pragma unroll
                    for (int hh = 0; hh < 4; ++hh) {
                        const LAS float* pr = Sf + (hh * 32 + tok) * 68 + 4 * g;
                        a += (pr[0] + pr[1]) + (pr[2] + pr[3]);
                        last += pr[3];
                        if (g > 0) prev += pr[-1];
                    }
                    if (g == 0) prev = Carry[tok];
                    Imp[tok * 128 + ct * 16 + g] += a + prev;
                    __syncthreads();
                    if (g == 15) Carry[tok] = last;
                }
                __syncthreads();
            }
            const float g0 = Gt[(wm * 32 + r) * 4 + 0];
#pragma unroll
            for (int e = 0; e < 16; ++e) outacc[e] += g0 * acc[e];
        }
        for (int tk = 0; tk < 4; ++tk) {
            const int tok = c.wave * 4 + tk, t = t0 + tok, cur = t >> 6;
            float v0 = Imp[tok * 128 + c.lane], v1 = Imp[tok * 128 + 64 + c.lane];
            const int n0 = c.lane, n1 = c.lane + 64;
            if (n0 > cur) v0 = NEGF; if (n1 > cur) v1 = NEGF;
            if (n0 == cur) v0 = 1e30f; if (n1 == cur) v1 = 1e30f;
            unsigned m0 = 0u, m1 = 0u, m2 = 0u, m3 = 0u;
            for (int it = 0; it < 16; ++it) {
                const float mx = wave_max(fmaxf(v0, v1));
                if (mx <= NEGF) break;
                const unsigned long long b0 = __ballot(v0 == mx);
                int nsel;
                if (b0) { nsel = __ffsll((long long)b0) - 1; if (c.lane == nsel) v0 = -3e38f; }
                else { const unsigned long long b1 = __ballot(v1 == mx); const int l1 = __ffsll((long long)b1) - 1; nsel = 64 + l1; if (c.lane == l1) v1 = -3e38f; }
                if (nsel < 32) m0 |= 1u << nsel; else if (nsel < 64) m1 |= 1u << (nsel - 32); else if (nsel < 96) m2 |= 1u << (nsel - 64); else m3 |= 1u << (nsel - 96);
            }
            if (c.lane == 0) {
                Sel[tok * 4 + 0] = m0; Sel[tok * 4 + 1] = m1; Sel[tok * 4 + 2] = m2; Sel[tok * 4 + 3] = m3;
                atomicOr((unsigned*)&Um[0], m0); atomicOr((unsigned*)&Um[1], m1); atomicOr((unsigned*)&Um[2], m2); atomicOr((unsigned*)&Um[3], m3);
            }
        }
        ns_reset_stats(c);
        __syncthreads();
        {
            f32x16 acc = zero16();
            const bf16_t* ksb = Y + (size_t)b * SEQ * NY + C_NKS; const bf16_t* vsb = Y + (size_t)b * SEQ * NY + C_NVS;
            for (int wd = 0; wd < 4; ++wd) {
                unsigned bits = Um[wd];
                while (bits) {
                    const int nb = wd * 32 + __ffs((int)bits) - 1; bits &= bits - 1;
                    ns_stage_rows(c, c.lds + NS_K, ksb + (size_t)nb * 64 * NY, NY);
                    ns_stage_T(c, c.lds + NS_VT, vsb + (size_t)nb * 64 * NY, NY);
                    __syncthreads();
                    ns_scores(c);
                    __syncthreads();
                    ns_softmax<1, 1>(c, t0, nb * 64);
                    __syncthreads();
                    acc = ns_pv(c, acc, true);
                    __syncthreads();
                }
            }
            const float l = ((LAS const float*)(c.lds + NS_L))[wm * 32 + r];
            const float g1 = Gt[(wm * 32 + r) * 4 + 1] * (l > 0.f ? 1.0f / l : 0.f);
#pragma unroll
            for (int e = 0; e < 16; ++e) outacc[e] += g1 * acc[e];
        }
        __syncthreads();
        ns_reset_stats(c);
        __syncthreads();
        {
            f32x16 acc = zero16();
            const bf16_t* kwb = Y + (size_t)b * SEQ * NY + C_NKW; const bf16_t* vwb = Y + (size_t)b * SEQ * NY + C_NVW;
            const int kt1 = t0 >> 6, kt0 = max(0, kt1 - 8);
            for (int kt = kt0; kt <= kt1; ++kt) {
                ns_stage_rows(c, c.lds + NS_K, kwb + (size_t)kt * 64 * NY, NY);
                ns_stage_T(c, c.lds + NS_VT, vwb + (size_t)kt * 64 * NY, NY);
                __syncthreads();
                ns_scores(c);
                __syncthreads();
                ns_softmax<2, 1>(c, t0, kt * 64);
                __syncthreads();
                acc = ns_pv(c, acc, true);
                __syncthreads();
            }
            const float l = ((LAS const float*)(c.lds + NS_L))[wm * 32 + r];
            const float g2 = Gt[(wm * 32 + r) * 4 + 2] * (l > 0.f ? 1.0f / l : 0.f);
#pragma unroll
            for (int e = 0; e < 16; ++e) outacc[e] += g2 * acc[e];
        }
        {
            bf16_t* op = O + (row0 + r) * DM + 256 + wm * 64 + wn * 32 + 4 * h;
#pragma unroll
            for (int g = 0; g < 4; ++g) { u32x2 w; w.x = pk_bf16(outacc[4 * g], outacc[4 * g + 1]); w.y = pk_bf16(outacc[4 * g + 2], outacc[4 * g + 3]); *(u32x2*)(op + 8 * g) = w; }
        }
        __syncthreads();
    }
}

__device__ __forceinline__ void phase_sb2(const Ctx& c, const bf16_t* Y, bf16_t* O) {
    LAS float* Sf = (LAS float*)(c.lds + NS_S);
    LAS float* Cr = (LAS float*)(c.lds + NS_M);
    const int wm = c.wave >> 1, wn = c.wave & 1, r = c.lane & 31, h = c.lane >> 5;
    for (int u = c.blk; u < 512; u += c.nblk) {
        const int b = u >> 8, hh = (u >> 6) & 3, qt = b ? 63 - (u & 63) : (u & 63);
        const int t0 = qt * 128;
        const size_t row0 = (size_t)b * SEQ + t0;
        {
            const int row = c.tid >> 2, dc = (c.tid & 3) * 16;
            const u32x4* qp = (const u32x4*)(Y + (row0 + row) * NY + C_SBQ + hh * 64 + dc);
            *(LAS u32x4*)(c.lds + NS_Q + row * 144 + dc * 2) = qp[0]; *(LAS u32x4*)(c.lds + NS_Q + row * 144 + dc * 2 + 16) = qp[1];
            if (c.tid < 128) Cr[c.tid] = 0.f;
        }
        LAS volatile unsigned* NotDone = (LAS volatile unsigned*)(c.lds + NS_L);
        f32x16 acc = zero16();
        const bf16_t* kb = Y + (size_t)b * SEQ * NY + C_SBK + hh * 64; const bf16_t* vb = Y + (size_t)b * SEQ * NY + C_SBV + hh * 64;
        for (int kt = 2 * qt + 1; kt >= 0; --kt) {
            ns_stage_rows(c, c.lds + NS_K, kb + (size_t)kt * 64 * NY, NY);
            ns_stage_T(c, c.lds + NS_VT, vb + (size_t)kt * 64 * NY, NY);
            if (c.tid == 0) NotDone[0] = 0u;
            __syncthreads();
            ns_scores(c);
            __syncthreads();
            {
                const int row = c.tid >> 2, part = c.tid & 3, t = t0 + row;
                float z[16], suf[16]; bool ok[16];
                float run = 0.f;
#pragma unroll
                for (int e = 15; e >= 0; --e) {
                    const int pos = kt * 64 + part * 16 + e;
                    z[e] = Sf[row * 68 + part * 16 + e] * 0.125f;
                    ok[e] = pos < t;
                    run += ok[e] ? -softplusf_(z[e]) : 0.f;
                    suf[e] = run;
                }
                const float tot = run;
                const float t1 = __shfl_down(tot, 1), t2 = __shfl_down(tot, 2), t3 = __shfl_down(tot, 3);
                const float thigh = (part < 3 ? t1 : 0.f) + (part < 2 ? t2 : 0.f) + (part < 1 ? t3 : 0.f);
                const float carry = Cr[row];
                unsigned pw[8];
#pragma unroll
                for (int e = 0; e < 16; e += 2) {
                    const float w0 = ok[e] ? __expf(z[e] + carry + thigh + suf[e]) : 0.f, w1 = ok[e + 1] ? __expf(z[e + 1] + carry + thigh + suf[e + 1]) : 0.f;
                    pw[e >> 1] = pk_bf16(w0, w1);
                }
                u32x4 w0, w1; w0.x = pw[0]; w0.y = pw[1]; w0.z = pw[2]; w0.w = pw[3]; w1.x = pw[4]; w1.y = pw[5]; w1.z = pw[6]; w1.w = pw[7];
                *(LAS u32x4*)(c.lds + NS_P + row * 144 + part * 32) = w0; *(LAS u32x4*)(c.lds + NS_P + row * 144 + part * 32 + 16) = w1;
                const float cn = carry + thigh + tot;
                if (part == 0) { Cr[row] = cn; if (!(cn < -104.0f)) NotDone[0] = 1u; }
            }
            __syncthreads();
            const bool alldone = (NotDone[0] == 0u);
            acc = ns_pv(c, acc, false);
            __syncthreads();
            if (alldone) break;
        }
        {
            bf16_t* op = O + (row0 + wm * 32 + r) * DM + hh * 64 + wn * 32 + 4 * h;
#pragma unroll
            for (int g = 0; g < 4; ++g) { u32x2 w; w.x = pk_bf16(acc[4 * g], acc[4 * g + 1]); w.y = pk_bf16(acc[4 * g + 2], acc[4 * g + 3]); *(u32x2*)(op + 8 * g) = w; }
        }
        __syncthreads();
    }
}

struct TileSeq { const bf16_t* kbase; const bf16_t* vbase; size_t ld; int first, step; LAS const int* list; };
__device__ __forceinline__ int seq_idx(const TileSeq& s, int i) { return s.list ? s.list[i] : s.first + s.step * i; }
__device__ __forceinline__ u32x4 ns_ldK(const Ctx& c, const bf16_t* src, size_t ld) { return *(const u32x4*)(src + (size_t)(c.tid >> 3) * ld + (c.tid & 7) * 8); }
__device__ __forceinline__ u32x4 ns_ldV(const Ctx& c, const bf16_t* src, size_t ld) { return *(const u32x4*)(src + (size_t)(c.tid & 63) * ld + (c.tid >> 6) * 8); }
__device__ __forceinline__ void ns_stK(const Ctx& c, u32x4 v) { *(LAS u32x4*)(c.lds + NS_K + (c.tid >> 3) * 144 + (c.tid & 7) * 16) = v; }
__device__ __forceinline__ void ns_stVT(const Ctx& c, u32x4 v) {
    const int key = c.tid & 63, e0 = (c.tid >> 6) * 8;
    const unsigned vv[4] = {v.x, v.y, v.z, v.w};
#pragma unroll
    for (int e = 0; e < 4; ++e) {
        *(LAS bf16_t*)(c.lds + NS_VT + (e0 + 2 * e) * 144 + key * 2) = (bf16_t)(vv[e] & 0xffffu);
        *(LAS bf16_t*)(c.lds + NS_VT + (e0 + 2 * e + 1) * 144 + key * 2) = (bf16_t)(vv[e] >> 16);
    }
}
__device__ __forceinline__ void sb_scan(const Ctx& c, int t0, int k0) {
    LAS float* Sf = (LAS float*)(c.lds + NS_S);
    LAS float* Cr = (LAS float*)(c.lds + NS_M);
    LAS volatile unsigned* NotDone = (LAS volatile unsigned*)(c.lds + NS_L);
    const int row = c.tid >> 2, part = c.tid & 3, t = t0 + row;
    float z[16], suf[16]; bool ok[16];
    float run = 0.f;
#pragma unroll
    for (int e = 15; e >= 0; --e) {
        const int pos = k0 + part * 16 + e;
        z[e] = Sf[row * 68 + part * 16 + e] * 0.125f;
        ok[e] = pos < t;
        run += ok[e] ? -softplusf_(z[e]) : 0.f;
        suf[e] = run;
    }
    const float tot = run;
    const float t1 = __shfl_down(tot, 1), t2 = __shfl_down(tot, 2), t3 = __shfl_down(tot, 3);
    const float thigh = (part < 3 ? t1 : 0.f) + (part < 2 ? t2 : 0.f) + (part < 1 ? t3 : 0.f);
    const float carry = Cr[row];
    unsigned pw[8];
#pragma unroll
    for (int e = 0; e < 16; e += 2) {
        const float w0 = ok[e] ? __expf(z[e] + carry + thigh + suf[e]) : 0.f, w1 = ok[e + 1] ? __expf(z[e + 1] + carry + thigh + suf[e + 1]) : 0.f;
        pw[e >> 1] = pk_bf16(w0, w1);
    }
    u32x4 w0, w1; w0.x = pw[0]; w0.y = pw[1]; w0.z = pw[2]; w0.w = pw[3]; w1.x = pw[4]; w1.y = pw[5]; w1.z = pw[6]; w1.w = pw[7];
    *(LAS u32x4*)(c.lds + NS_P + row * 144 + part * 32) = w0; *(LAS u32x4*)(c.lds + NS_P + row * 144 + part * 32 + 16) = w1;
    const float cn = carry + thigh + tot;
    if (part == 0) { Cr[row] = cn; if (!(cn < -104.0f)) NotDone[0] = 1u; }
}
__device__ __forceinline__ void ns_importance(const Ctx& c, int ct) {
    LAS float* Sf = (LAS float*)(c.lds + NS_S);
    LAS float* Imp = (LAS float*)(c.lds + NS_IMP);
    LAS float* Carry = (LAS float*)(c.lds + NS_CARRY);
    const int tok = c.tid >> 4, g = c.tid & 15;
    float a = 0.f, last = 0.f, prev = 0.f;
#pragma unroll
    for (int hh = 0; hh < 4; ++hh) {
        const LAS float* pr = Sf + (hh * 32 + tok) * 68 + 4 * g;
        a += (pr[0] + pr[1]) + (pr[2] + pr[3]);
        last += pr[3];
        if (g > 0) prev += pr[-1];
    }
    if (g == 0) prev = Carry[(ct & 1) * 32 + tok];
    Imp[tok * 128 + ct * 16 + g] += a + prev;
    if (g == 15) Carry[((ct + 1) & 1) * 32 + tok] = last;
}
template <int MODE, int PASS, bool HASV>
__device__ __forceinline__ f32x16 ns_loop(const Ctx& c, f32x16 acc, int t0, int ntiles, const TileSeq sq) {
    if (ntiles <= 0) return acc;
    int idx = seq_idx(sq, 0);
    u32x4 rk = ns_ldK(c, sq.kbase + (size_t)idx * 64 * sq.ld, sq.ld), rv = rk;
    if (HASV) rv = ns_ldV(c, sq.vbase + (size_t)idx * 64 * sq.ld, sq.ld);
    ns_stK(c, rk); if (HASV) ns_stVT(c, rv);
    __syncthreads();
    for (int i = 0; i < ntiles; ++i) {
        const int k0 = idx * 64;
        const bool more = (i + 1 < ntiles);
        int nidx = idx;
        if (more) {
            nidx = seq_idx(sq, i + 1);
            rk = ns_ldK(c, sq.kbase + (size_t)nidx * 64 * sq.ld, sq.ld);
            if (HASV) rv = ns_ldV(c, sq.vbase + (size_t)nidx * 64 * sq.ld, sq.ld);
        }
        if (MODE == 3 && c.tid == 0) ((LAS volatile unsigned*)(c.lds + NS_L))[0] = 0u;
        ns_scores(c);
        __syncthreads();
        if (MODE == 3) sb_scan(c, t0, k0); else ns_softmax<(MODE == 3 ? 0 : MODE), PASS>(c, t0, k0);
        if (more) ns_stK(c, rk);
        __syncthreads();
        bool stop = false;
        if (MODE == 3) stop = (((LAS volatile unsigned*)(c.lds + NS_L))[0] == 0u);
        if (HASV) {
            acc = ns_pv(c, acc, MODE != 3 && PASS == 1);
            if (MODE == 0 && PASS == 2) ns_importance(c, idx);
            __syncthreads();
            if (more && !stop) ns_stVT(c, rv);
        }
        if (stop) break;
        idx = nidx;
    }
    __syncthreads();
    return acc;
}

__device__ __forceinline__ void phase_nsa2(const Ctx& c, const bf16_t* Y, const bf16_t* KCp, const bf16_t* VCp, bf16_t* Op) {
    LAS float* Gt = (LAS float*)(c.lds + NS_G);
    LAS float* Imp = (LAS float*)(c.lds + NS_IMP);
    LAS unsigned* Sel = (LAS unsigned*)(c.lds + NS_SEL);
    LAS unsigned* Um = (LAS unsigned*)(c.lds + NS_UM);
    LAS float* Carry = (LAS float*)(c.lds + NS_CARRY);
    LAS int* Blist = (LAS int*)(c.lds + NS_BLIST);
    const int wm = c.wave >> 1, wn = c.wave & 1, r = c.lane & 31, h = c.lane >> 5;
    for (int u = c.blk; u < 512; u += c.nblk) {
        const int b = u >> 8, tq = b ? 255 - (u & 255) : (u & 255);
        const int t0 = tq * 32;
        const size_t row0 = (size_t)b * SEQ + t0;
        {
            const int row = c.tid >> 2, dc = (c.tid & 3) * 16, tok = row & 31, hh = row >> 5;
            const u32x4* qp = (const u32x4*)(Y + (row0 + tok) * NY + C_NQ + hh * 64 + dc);
            *(LAS u32x4*)(c.lds + NS_Q + row * 144 + dc * 2) = qp[0]; *(LAS u32x4*)(c.lds + NS_Q + row * 144 + dc * 2 + 16) = qp[1];
            if (c.tid < 384) { const int rw = c.tid / 3, gi = c.tid % 3; Gt[rw * 4 + gi] = sigmoidf_(bf2f(Y[(row0 + (rw & 31)) * NY + C_NG + (rw >> 5) * 3 + gi])); }
            for (int i = c.tid; i < 32 * 128; i += NTHREADS) Imp[i] = 0.f;
            if (c.tid < 64) Carry[c.tid] = 0.f;
            if (c.tid < 4) Um[c.tid] = 0u;
            ns_reset_stats(c);
        }
        __syncthreads();
        f32x16 outacc = zero16();
        const int ncmp = min(t0 / 16 + 1, 511);
        const int nct = (ncmp + 63) / 64;
        {
            const TileSeq sq{KCp + (size_t)b * 512 * 64, VCp + (size_t)b * 512 * 64, 64, 0, 1, nullptr};
            (void)ns_loop<0, 0, false>(c, zero16(), t0, nct, sq);
            const f32x16 acc = ns_loop<0, 2, true>(c, zero16(), t0, nct, sq);
            const float g0 = Gt[(wm * 32 + r) * 4 + 0];
#pragma unroll
            for (int e = 0; e < 16; ++e) outacc[e] += g0 * acc[e];
        }
        for (int tk = 0; tk < 4; ++tk) {
            const int tok = c.wave * 4 + tk, t = t0 + tok, cur = t >> 6;
            float v0 = Imp[tok * 128 + c.lane], v1 = Imp[tok * 128 + 64 + c.lane];
            const int n0 = c.lane, n1 = c.lane + 64;
            if (n0 > cur) v0 = NEGF; if (n1 > cur) v1 = NEGF;
            if (n0 == cur) v0 = 1e30f; if (n1 == cur) v1 = 1e30f;
            unsigned m0 = 0u, m1 = 0u, m2 = 0u, m3 = 0u;
            for (int it = 0; it < 16; ++it) {
                const float mx = wave_max(fmaxf(v0, v1));
                if (mx <= NEGF) break;
                const unsigned long long b0 = __ballot(v0 == mx);
                int nsel;
                if (b0) { nsel = __ffsll((long long)b0) - 1; if (c.lane == nsel) v0 = -3e38f; }
                else { const unsigned long long b1 = __ballot(v1 == mx); const int l1 = __ffsll((long long)b1) - 1; nsel = 64 + l1; if (c.lane == l1) v1 = -3e38f; }
                if (nsel < 32) m0 |= 1u << nsel; else if (nsel < 64) m1 |= 1u << (nsel - 32); else if (nsel < 96) m2 |= 1u << (nsel - 64); else m3 |= 1u << (nsel - 96);
            }
            if (c.lane == 0) {
                Sel[tok * 4 + 0] = m0; Sel[tok * 4 + 1] = m1; Sel[tok * 4 + 2] = m2; Sel[tok * 4 + 3] = m3;
                atomicOr((unsigned*)&Um[0], m0); atomicOr((unsigned*)&Um[1], m1); atomicOr((unsigned*)&Um[2], m2); atomicOr((unsigned*)&Um[3], m3);
            }
        }
        ns_reset_stats(c);
        __syncthreads();
        int nsel_blocks;
        {
            const unsigned u0 = Um[0], u1 = Um[1], u2 = Um[2], u3 = Um[3];
            nsel_blocks = __popc(u0) + __popc(u1) + __popc(u2) + __popc(u3);
            if (c.tid < 128) {
                const unsigned wd = c.tid >> 5, bt = c.tid & 31;
                const unsigned mine = wd == 0 ? u0 : wd == 1 ? u1 : wd == 2 ? u2 : u3;
                if ((mine >> bt) & 1u) {
                    int pos = __popc(mine & ((1u << bt) - 1u));
                    if (wd > 0) pos += __popc(u0); if (wd > 1) pos += __popc(u1); if (wd > 2) pos += __popc(u2);
                    Blist[pos] = (int)c.tid;
                }
            }
        }
        __syncthreads();
        {
            const TileSeq sq{Y + (size_t)b * SEQ * NY + C_NKS, Y + (size_t)b * SEQ * NY + C_NVS, (size_t)NY, 0, 0, Blist};
            const f32x16 acc = ns_loop<1, 1, true>(c, zero16(), t0, nsel_blocks, sq);
            const float l = ((LAS const float*)(c.lds + NS_L))[wm * 32 + r];
            const float g1 = Gt[(wm * 32 + r) * 4 + 1] * (l > 0.f ? 1.0f / l : 0.f);
#pragma unroll
            for (int e = 0; e < 16; ++e) outacc[e] += g1 * acc[e];
        }
        __syncthreads();
        ns_reset_stats(c);
        __syncthreads();
        {
            const int kt1 = t0 >> 6, kt0 = max(0, kt1 - 8);
            const TileSeq sq{Y + (size_t)b * SEQ * NY + C_NKW, Y + (size_t)b * SEQ * NY + C_NVW, (size_t)NY, kt0, 1, nullptr};
            const f32x16 acc = ns_loop<2, 1, true>(c, zero16(), t0, kt1 - kt0 + 1, sq);
            const float l = ((LAS const float*)(c.lds + NS_L))[wm * 32 + r];
            const float g2 = Gt[(wm * 32 + r) * 4 + 2] * (l > 0.f ? 1.0f / l : 0.f);
#pragma unroll
            for (int e = 0; e < 16; ++e) outacc[e] += g2 * acc[e];
        }
        {
            bf16_t* op = Op + (row0 + r) * DM + 256 + wm * 64 + wn * 32 + 4 * h;
#pragma unroll
            for (int g = 0; g < 4; ++g) { u32x2 w; w.x = pk_bf16(outacc[4 * g], outacc[4 * g + 1]); w.y = pk_bf16(outacc[4 * g + 2], outacc[4 * g + 3]); *(u32x2*)(op + 8 * g) = w; }
        }
        __syncthreads();
    }
}
__device__ __forceinline__ void phase_sb3(const Ctx& c, const bf16_t* Y, bf16_t* Op) {
    LAS float* Cr = (LAS float*)(c.lds + NS_M);
    const int wm = c.wave >> 1, wn = c.wave & 1, r = c.lane & 31, h = c.lane >> 5;
    for (int u = c.blk; u < 512; u += c.nblk) {
        const int b = u >> 8, hh = (u >> 6) & 3, qt = b ? 63 - (u & 63) : (u & 63);
        const int t0 = qt * 128;
        const size_t row0 = (size_t)b * SEQ + t0;
        {
            const int row = c.tid >> 2, dc = (c.tid & 3) * 16;
            const u32x4* qp = (const u32x4*)(Y + (row0 + row) * NY + C_SBQ + hh * 64 + dc);
            *(LAS u32x4*)(c.lds + NS_Q + row * 144 + dc * 2) = qp[0]; *(LAS u32x4*)(c.lds + NS_Q + row * 144 + dc * 2 + 16) = qp[1];
            if (c.tid < 128) Cr[c.tid] = 0.f;
        }
        const TileSeq sq{Y + (size_t)b * SEQ * NY + C_SBK + hh * 64, Y + (size_t)b * SEQ * NY + C_SBV + hh * 64, (size_t)NY, 2 * qt + 1, -1, nullptr};
        const f32x16 acc = ns_loop<3, 1, true>(c, zero16(), t0, 2 * qt + 2, sq);
        {
            bf16_t* op = Op + (row0 + wm * 32 + r) * DM + hh * 64 + wn * 32 + 4 * h;
#pragma unroll
            for (int g = 0; g < 4; ++g) { u32x2 w; w.x = pk_bf16(acc[4 * g], acc[4 * g + 1]); w.y = pk_bf16(acc[4 * g + 2], acc[4 * g + 3]); *(u32x2*)(op + 8 * g) = w; }
        }
        __syncthreads();
    }
}

constexpr int FA_KT = 0;
constexpr int FA_VT = 18432;
constexpr int FA_IMPH = 36864;
constexpr int FA_G = FA_IMPH + 65536;
constexpr int FA_SEL = FA_G + 2048;
constexpr int FA_UM = FA_SEL + 512;
constexpr int FA_BLIST = FA_UM + 64;
constexpr int FA_FLAG = FA_BLIST + 512;
constexpr int FA_END = FA_FLAG + 64;
typedef float f32x4v __attribute__((ext_vector_type(4)));
typedef short bf16x4 __attribute__((ext_vector_type(4)));

__device__ __forceinline__ void fa_stK(const Ctx& c, int buf, u32x4 v) { *(LAS u32x4*)(c.lds + FA_KT + buf * 9216 + (c.tid >> 3) * 144 + (c.tid & 7) * 16) = v; }
__device__ __forceinline__ void fa_stVT(const Ctx& c, int buf, u32x4 v) {
    const int key = c.tid & 63, e0 = (c.tid >> 6) * 8;
    const unsigned vv[4] = {v.x, v.y, v.z, v.w};
#pragma unroll
    for (int e = 0; e < 4; ++e) {
        *(LAS bf16_t*)(c.lds + FA_VT + buf * 9216 + (e0 + 2 * e) * 144 + key * 2) = (bf16_t)(vv[e] & 0xffffu);
        *(LAS bf16_t*)(c.lds + FA_VT + buf * 9216 + (e0 + 2 * e + 1) * 144 + key * 2) = (bf16_t)(vv[e] >> 16);
    }
}
struct FaState { f32x4v o[4]; float m, l; float carry; };

template <int MODE, int PASS>
__device__ __forceinline__ bool fa_tile(const Ctx& c, FaState& st, const bf16x8 (&qf)[2], int buf, int k0, int t, int tok, float slope, int headl, int ct) {
    const int fr = c.lane & 15, fq = c.lane >> 4;
    const lptr KT = c.lds + FA_KT + buf * 9216, VT = c.lds + FA_VT + buf * 9216;
    f32x4v sc[4];
#pragma unroll
    for (int n = 0; n < 4; ++n) {
        sc[n] = (f32x4v){0.f, 0.f, 0.f, 0.f};
#pragma unroll
        for (int s = 0; s < 2; ++s) {
            const bf16x8 kf = *(LAS const bf16x8*)(KT + (16 * n + fr) * 144 + s * 64 + fq * 16);
            sc[n] = __builtin_amdgcn_mfma_f32_16x16x32_bf16(kf, qf[s], sc[n], 0, 0, 0);
        }
    }
    float p[4][4]; bool ok[4][4];
    bool stop = false;
    if (MODE == 3) {
        float L[4][4], sfx[4][4], T[4], R[4], H[4];
#pragma unroll
        for (int n = 0; n < 4; ++n) {
            float run = 0.f;
#pragma unroll
            for (int e = 3; e >= 0; --e) {
                const int pos = k0 + 16 * n + 4 * fq + e;
                p[n][e] = sc[n][e] * 0.125f;
                ok[n][e] = pos < t;
                L[n][e] = ok[n][e] ? -softplusf_(p[n][e]) : 0.f;
                run += L[n][e]; sfx[n][e] = run;
            }
            T[n] = run;
            const float a1 = __shfl(T[n], (c.lane + 16) & 63), a2 = __shfl(T[n], (c.lane + 32) & 63), a3 = __shfl(T[n], (c.lane + 48) & 63);
            H[n] = (fq < 3 ? a1 : 0.f) + (fq < 2 ? a2 : 0.f) + (fq < 1 ? a3 : 0.f);
            R[n] = T[n] + a1 + a2 + a3;
        }
        float above = st.carry;
#pragma unroll
        for (int n = 3; n >= 0; --n) {
#pragma unroll
            for (int e = 0; e < 4; ++e) p[n][e] = ok[n][e] ? __expf(p[n][e] + above + H[n] + sfx[n][e]) : 0.f;
            above += R[n];
        }
        st.carry = above;
        stop = __all(above < -104.0f);
    } else {
        float mloc = NEGF; float sv[4][4];
#pragma unroll
        for (int n = 0; n < 4; ++n)
#pragma unroll
            for (int e = 0; e < 4; ++e) {
                const int kidx = k0 + 16 * n + 4 * fq + e; float dist; bool v;
                if (MODE == 0) { const int d = t - 16 * kidx - 31; dist = (float)d; v = d >= 0 && kidx < 511; }
                else if (MODE == 1) { const int nb = kidx >> 6; const unsigned mk = ((LAS const unsigned*)(c.lds + FA_SEL))[tok * 4 + (nb >> 5)]; const int d = t - kidx; dist = (float)d; v = ((mk >> (nb & 31)) & 1u) && d >= 0; }
                else { const int d = t - kidx; dist = (float)d; v = d >= 0 && d < 512; }
                ok[n][e] = v; sv[n][e] = sc[n][e] * 0.125f - slope * dist;
                if (v) mloc = fmaxf(mloc, sv[n][e]);
            }
        mloc = fmaxf(mloc, __shfl_xor(mloc, 16)); mloc = fmaxf(mloc, __shfl_xor(mloc, 32));
        if (PASS == 2) {
            const float inv = st.l > 0.f ? 1.0f / st.l : 0.f;
#pragma unroll
            for (int n = 0; n < 4; ++n)
#pragma unroll
                for (int e = 0; e < 4; ++e) p[n][e] = ok[n][e] ? __expf(sv[n][e] - st.m) * inv : 0.f;
            float x[4];
#pragma unroll
            for (int n = 0; n < 4; ++n) x[n] = __shfl(p[n][3], (c.lane + 48) & 63);
            LAS float* imp = (LAS float*)(c.lds + FA_IMPH) + (headl * 32 + tok) * 128 + ct * 16 + fq;
#pragma unroll
            for (int n = 0; n < 4; ++n) {
                const float prev = fq > 0 ? x[n] : (n > 0 ? x[n > 0 ? n - 1 : 0] : st.carry);
                imp[4 * n] += (p[n][0] + p[n][1]) + (p[n][2] + p[n][3]) + prev;
            }
            st.carry = x[3];
        } else {
            const float mnew = fmaxf(st.m, mloc);
            float sum = 0.f;
#pragma unroll
            for (int n = 0; n < 4; ++n)
#pragma unroll
                for (int e = 0; e < 4; ++e) { p[n][e] = ok[n][e] ? __expf(sv[n][e] - mnew) : 0.f; sum += p[n][e]; }
            sum += __shfl_xor(sum, 16); sum += __shfl_xor(sum, 32);
            const float alpha = __expf(st.m - mnew);
            st.l = st.l * alpha + sum; st.m = mnew;
            if (PASS == 1) {
#pragma unroll
                for (int tt = 0; tt < 4; ++tt) st.o[tt] *= alpha;
            }
        }
    }
    if (MODE == 3 || PASS != 0) {
        bf16x8 pf[2];
#pragma unroll
        for (int s = 0; s < 2; ++s) {
            const unsigned w0 = pk_bf16(p[2 * s][0], p[2 * s][1]), w1 = pk_bf16(p[2 * s][2], p[2 * s][3]), w2 = pk_bf16(p[2 * s + 1][0], p[2 * s + 1][1]), w3 = pk_bf16(p[2 * s + 1][2], p[2 * s + 1][3]);
            u32x4 w; w.x = w0; w.y = w1; w.z = w2; w.w = w3;
            pf[s] = __builtin_bit_cast(bf16x8, w);
        }
#pragma unroll
        for (int tt = 0; tt < 4; ++tt)
#pragma unroll
            for (int s = 0; s < 2; ++s) {
                const u32x2 va = *(LAS const u32x2*)(VT + (16 * tt + fr) * 144 + (32 * s + 4 * fq) * 2);
                const u32x2 vb = *(LAS const u32x2*)(VT + (16 * tt + fr) * 144 + (32 * s + 16 + 4 * fq) * 2);
                u32x4 w; w.x = va.x; w.y = va.y; w.z = vb.x; w.w = vb.y;
                st.o[tt] = __builtin_amdgcn_mfma_f32_16x16x32_bf16(__builtin_bit_cast(bf16x8, w), pf[s], st.o[tt], 0, 0, 0);
            }
    }
    return stop;
}
template <int MODE, int PASS, bool HASV>
__device__ __forceinline__ void fa_loop(const Ctx& c, FaState& st, const bf16x8 (&qf)[2], int t, int tok, float slope, int headl, int ntiles, const TileSeq sq) {
    if (ntiles <= 0) return;
    LAS volatile unsigned* Flag = (LAS volatile unsigned*)(c.lds + FA_FLAG);
    int idx = seq_idx(sq, 0);
    {
        const u32x4 rk = ns_ldK(c, sq.kbase + (size_t)idx * 64 * sq.ld, sq.ld);
        fa_stK(c, 0, rk);
        if (HASV) { const u32x4 rv = ns_ldV(c, sq.vbase + (size_t)idx * 64 * sq.ld, sq.ld); fa_stVT(c, 0, rv); }
        if (MODE == 3 && c.tid < 3) Flag[c.tid] = 0u;
    }
    __syncthreads();
    for (int i = 0; i < ntiles; ++i) {
        const bool more = (i + 1 < ntiles);
        int nidx = idx; u32x4 rk, rv;
        if (more) {
            nidx = seq_idx(sq, i + 1);
            rk = ns_ldK(c, sq.kbase + (size_t)nidx * 64 * sq.ld, sq.ld);
            if (HASV) rv = ns_ldV(c, sq.vbase + (size_t)nidx * 64 * sq.ld, sq.ld);
        }
        const bool wstop = fa_tile<MODE, PASS>(c, st, qf, i & 1, idx * 64, t, tok, slope, headl, idx);
        if (MODE == 3) { if (!wstop && c.lane == 0) Flag[i % 3] = 1u; if (c.tid == 0) Flag[(i + 1) % 3] = 0u; }
        if (more) { fa_stK(c, (i + 1) & 1, rk); if (HASV) fa_stVT(c, (i + 1) & 1, rv); }
        __syncthreads();
        if (MODE == 3 && Flag[i % 3] == 0u) break;
        idx = nidx;
    }
    __syncthreads();
}
__device__ __forceinline__ void fa_reset(FaState& st) {
#pragma unroll
    for (int tt = 0; tt < 4; ++tt) st.o[tt] = (f32x4v){0.f, 0.f, 0.f, 0.f};
    st.m = NEGF; st.l = 0.f; st.carry = 0.f;
}

__device__ __forceinline__ void phase_nsa3(const Ctx& c, const bf16_t* Y, const bf16_t* KCp, const bf16_t* VCp, bf16_t* Op) {
    LAS float* Gt = (LAS float*)(c.lds + FA_G);
    LAS float* ImpH = (LAS float*)(c.lds + FA_IMPH);
    LAS unsigned* Sel = (LAS unsigned*)(c.lds + FA_SEL);
    LAS unsigned* Um = (LAS unsigned*)(c.lds + FA_UM);
    LAS int* Blist = (LAS int*)(c.lds + FA_BLIST);
    const int fr = c.lane & 15, fq = c.lane >> 4;
    const int headl = c.wave >> 1, tok = 16 * (c.wave & 1) + fr;
    const float slope = exp2f(-2.0f * (float)(headl + 1));
    for (int u = c.blk; u < 512; u += c.nblk) {
        const int b = u >> 8, tq = b ? 255 - (u & 255) : (u & 255);
        const int t0 = tq * 32, t = t0 + tok;
        const size_t row0 = (size_t)b * SEQ + t0;
        bf16x8 qf[2];
        {
            const bf16_t* qp = Y + (row0 + tok) * NY + C_NQ + headl * 64 + 8 * fq;
            qf[0] = *(const bf16x8*)(qp); qf[1] = *(const bf16x8*)(qp + 32);
            if (c.tid < 384) { const int rw = c.tid / 3, gi = c.tid % 3; Gt[rw * 4 + gi] = sigmoidf_(bf2f(Y[(row0 + (rw & 31)) * NY + C_NG + (rw >> 5) * 3 + gi])); }
            for (int i = c.tid; i < 4 * 32 * 128; i += NTHREADS) ImpH[i] = 0.f;
            if (c.tid < 4) Um[c.tid] = 0u;
        }
        __syncthreads();
        float out[4][4];
#pragma unroll
        for (int tt = 0; tt < 4; ++tt)
#pragma unroll
            for (int r = 0; r < 4; ++r) out[tt][r] = 0.f;
        FaState st;
        const int ncmp = min(t0 / 16 + 1, 511);
        const int nct = (ncmp + 63) / 64;
        {
            const TileSeq sq{KCp + (size_t)b * 512 * 64, VCp + (size_t)b * 512 * 64, 64, 0, 1, nullptr};
            fa_reset(st);
            fa_loop<0, 0, false>(c, st, qf, t, tok, slope, headl, nct, sq);
            st.carry = 0.f;
            fa_loop<0, 2, true>(c, st, qf, t, tok, slope, headl, nct, sq);
            const float g0 = Gt[(headl * 32 + tok) * 4 + 0];
#pragma unroll
            for (int tt = 0; tt < 4; ++tt)
#pragma unroll
                for (int r = 0; r < 4; ++r) out[tt][r] += g0 * st.o[tt][r];
        }
        for (int tk = 0; tk < 4; ++tk) {
            const int tk_tok = c.wave * 4 + tk, tt_ = t0 + tk_tok, cur = tt_ >> 6;
            float v0 = 0.f, v1 = 0.f;
#pragma unroll
            for (int hh = 0; hh < 4; ++hh) { v0 += ImpH[(hh * 32 + tk_tok) * 128 + c.lane]; v1 += ImpH[(hh * 32 + tk_tok) * 128 + 64 + c.lane]; }
            const int n0 = c.lane, n1 = c.lane + 64;
            if (n0 > cur) v0 = NEGF; if (n1 > cur) v1 = NEGF;
            if (n0 == cur) v0 = 1e30f; if (n1 == cur) v1 = 1e30f;
            unsigned m0 = 0u, m1 = 0u, m2 = 0u, m3 = 0u;
            for (int it = 0; it < 16; ++it) {
                const float mx = wave_max(fmaxf(v0, v1));
                if (mx <= NEGF) break;
                const unsigned long long b0 = __ballot(v0 == mx);
                int nsel;
                if (b0) { nsel = __ffsll((long long)b0) - 1; if (c.lane == nsel) v0 = -3e38f; }
                else { const unsigned long long b1 = __ballot(v1 == mx); const int l1 = __ffsll((long long)b1) - 1; nsel = 64 + l1; if (c.lane == l1) v1 = -3e38f; }
                if (nsel < 32) m0 |= 1u << nsel; else if (nsel < 64) m1 |= 1u << (nsel - 32); else if (nsel < 96) m2 |= 1u << (nsel - 64); else m3 |= 1u << (nsel - 96);
            }
            if (c.lane == 0) {
                Sel[tk_tok * 4 + 0] = m0; Sel[tk_tok * 4 + 1] = m1; Sel[tk_tok * 4 + 2] = m2; Sel[tk_tok * 4 + 3] = m3;
                atomicOr((unsigned*)&Um[0], m0); atomicOr((unsigned*)&Um[1], m1); atomicOr((unsigned*)&Um[2], m2); atomicOr((unsigned*)&Um[3], m3);
            }
        }
        __syncthreads();
        int nsel_blocks;
        {
            const unsigned u0 = Um[0], u1 = Um[1], u2 = Um[2], u3 = Um[3];
            nsel_blocks = __popc(u0) + __popc(u1) + __popc(u2) + __popc(u3);
            if (c.tid < 128) {
                const unsigned wd = c.tid >> 5, bt = c.tid & 31;
                const unsigned mine = wd == 0 ? u0 : wd == 1 ? u1 : wd == 2 ? u2 : u3;
                if ((mine >> bt) & 1u) {
                    int pos = __popc(mine & ((1u << bt) - 1u));
                    if (wd > 0) pos += __popc(u0); if (wd > 1) pos += __popc(u1); if (wd > 2) pos += __popc(u2);
                    Blist[pos] = (int)c.tid;
                }
            }
        }
        __syncthreads();
        {
            const TileSeq sq{Y + (size_t)b * SEQ * NY + C_NKS, Y + (size_t)b * SEQ * NY + C_NVS, (size_t)NY, 0, 0, Blist};
            fa_reset(st);
            fa_loop<1, 1, true>(c, st, qf, t, tok, slope, headl, nsel_blocks, sq);
            const float g1 = Gt[(headl * 32 + tok) * 4 + 1] * (st.l > 0.f ? 1.0f / st.l : 0.f);
#pragma unroll
            for (int tt = 0; tt < 4; ++tt)
#pragma unroll
                for (int r = 0; r < 4; ++r) out[tt][r] += g1 * st.o[tt][r];
        }
        {
            const int kt1 = t0 >> 6, kt0 = max(0, kt1 - 8);
            const TileSeq sq{Y + (size_t)b * SEQ * NY + C_NKW, Y + (size_t)b * SEQ * NY + C_NVW, (size_t)NY, kt0, 1, nullptr};
            fa_reset(st);
            fa_loop<2, 1, true>(c, st, qf, t, tok, slope, headl, kt1 - kt0 + 1, sq);
            const float g2 = Gt[(headl * 32 + tok) * 4 + 2] * (st.l > 0.f ? 1.0f / st.l : 0.f);
#pragma unroll
            for (int tt = 0; tt < 4; ++tt)
#pragma unroll
                for (int r = 0; r < 4; ++r) out[tt][r] += g2 * st.o[tt][r];
        }
        {
            bf16_t* op = Op + (row0 + tok) * DM + 256 + headl * 64 + 4 * fq;
#pragma unroll
            for (int tt = 0; tt < 4; ++tt) { u32x2 w; w.x = pk_bf16(out[tt][0], out[tt][1]); w.y = pk_bf16(out[tt][2], out[tt][3]); *(u32x2*)(op + 16 * tt) = w; }
        }
        __syncthreads();
    }
}
__device__ __forceinline__ void phase_sb4(const Ctx& c, const bf16_t* Y, bf16_t* Op) {
    const int fr = c.lane & 15, fq = c.lane >> 4;
    for (int u = c.blk; u < 512; u += c.nblk) {
        const int b = u >> 8, hh = (u >> 6) & 3, qt = b ? 63 - (u & 63) : (u & 63);
        const int t0 = qt * 128, rowl = 16 * c.wave + fr, t = t0 + rowl;
        const size_t row0 = (size_t)b * SEQ + t0;
        bf16x8 qf[2];
        { const bf16_t* qp = Y + (row0 + rowl) * NY + C_SBQ + hh * 64 + 8 * fq; qf[0] = *(const bf16x8*)(qp); qf[1] = *(const bf16x8*)(qp + 32); }
        FaState st; fa_reset(st);
        const TileSeq sq{Y + (size_t)b * SEQ * NY + C_SBK + hh * 64, Y + (size_t)b * SEQ * NY + C_SBV + hh * 64, (size_t)NY, 2 * qt + 1, -1, nullptr};
        fa_loop<3, 1, true>(c, st, qf, t, 0, 0.f, 0, 2 * qt + 2, sq);
        {
            bf16_t* op = Op + (row0 + rowl) * DM + hh * 64 + 4 * fq;
#pragma unroll
            for (int tt = 0; tt < 4; ++tt) { u32x2 w; w.x = pk_bf16(st.o[tt][0], st.o[tt][1]); w.y = pk_bf16(st.o[tt][2], st.o[tt][3]); *(u32x2*)(op + 16 * tt) = w; }
        }
        __syncthreads();
    }
}

__device__ __forceinline__ void phase_subkey(const Ctx& c, const bf16_t* QV, const bf16_t* KEYS, float* TOPS, int* TOPI) {
    constexpr int SC_OFF = 73728;
    LAS float* Sc = (LAS float*)(c.lds + SC_OFF);
    const int wm = c.wave >> 1, wn = c.wave & 1, r = c.lane & 31, h = c.lane >> 5;
    for (int u = c.blk; u < 128 * 16; u += c.nblk) {
        const int hp = u & 15, pm = u >> 4;
        f32x16 acc[1][2]; acc_zero<1, 2>(acc);
        gemm_kloop<1, 2>(c, acc, QV + (size_t)pm * 128 * 2048 + hp * 128, 2048, KEYS + (size_t)hp * 128 * 128, 128, 128);
        EPI_LOOP(1, 2) {
            const int m = (wm + i) * 32 + r, n = (wn * 2 + j) * 32 + 8 * g + 4 * h;
            f32x4 o; o[0] = acc[i][j][4 * g]; o[1] = acc[i][j][4 * g + 1]; o[2] = acc[i][j][4 * g + 2]; o[3] = acc[i][j][4 * g + 3];
            *(LAS f32x4*)(Sc + m * 132 + n) = o;
        }
        __syncthreads();
        for (int rr = 0; rr < 16; ++rr) {
            const int row = c.wave * 16 + rr;
            float v0 = Sc[row * 132 + c.lane], v1 = Sc[row * 132 + 64 + c.lane];
            float ks = 0.f; int ki = 0;
            for (int it = 0; it < 16; ++it) {
                const float mx = wave_max(fmaxf(v0, v1));
                const unsigned long long b0 = __ballot(v0 == mx);
                int nsel;
                if (b0) { nsel = __ffsll((long long)b0) - 1; if (c.lane == nsel) v0 = -3e38f; }
                else { const unsigned long long b1 = __ballot(v1 == mx); const int l1 = __ffsll((long long)b1) - 1; nsel = 64 + l1; if (c.lane == l1) v1 = -3e38f; }
                if (c.lane == it) { ks = mx; ki = nsel; }
            }
            if (c.lane < 16) {
                const size_t o = ((size_t)(pm * 128 + row) * 16 + hp) * 16 + c.lane;
                TOPS[o] = ks; TOPI[o] = ki;
            }
        }
        __syncthreads();
    }
}


__device__ __forceinline__ unsigned ord_key(float s) { const unsigned u = __float_as_uint(s); return u ^ ((unsigned)((int)u >> 31) | 0x80000000u); }
__device__ __forceinline__ float unord_key(unsigned k) { const unsigned u = (k & 0x80000000u) ? (k ^ 0x80000000u) : ~k; return __uint_as_float(u); }
#define CE_DESC(a, b) do { const unsigned _hi = max((a), (b)), _lo = min((a), (b)); (a) = _hi; (b) = _lo; } while (0)
__device__ __forceinline__ void sort16_desc(unsigned (&k)[16]) {
#pragma unroll
    for (int size = 2; size <= 16; size <<= 1)
#pragma unroll
        for (int stride = size >> 1; stride > 0; stride >>= 1)
#pragma unroll
            for (int i = 0; i < 16; ++i) {
                const int j = i ^ stride;
                if (j > i) { if ((i & size) == 0) CE_DESC(k[i], k[j]); else CE_DESC(k[j], k[i]); }
            }
}
__device__ __forceinline__ void bitonic_merge16_desc(unsigned (&k)[16]) {
#pragma unroll
    for (int stride = 8; stride > 0; stride >>= 1)
#pragma unroll
        for (int i = 0; i < 16; ++i) { const int j = i ^ stride; if (j > i) CE_DESC(k[i], k[j]); }
}
__device__ __forceinline__ void top16_merge(unsigned (&a)[16], const unsigned (&b)[16]) {
#pragma unroll
    for (int i = 0; i < 16; ++i) a[i] = max(a[i], b[15 - i]);
    bitonic_merge16_desc(a);
}

__device__ __forceinline__ void phase_subkey2(const Ctx& c, const bf16_t* QV, const bf16_t* KEYS, float* TOPS, int* TOPI) {
    const lptr Ab = c.lds, Bb = c.lds + 256 * 272;
    const int r = c.lane & 31, h = c.lane >> 5;
    int cur_hp = -1;
    for (int u = c.blk; u < 64 * 16; u += c.nblk) {
        const int hp = u & 15, pm = u >> 4;
        if (hp != cur_hp) {
            cur_hp = hp;
#pragma unroll
            for (int i = 0; i < 4; ++i) { const int id = c.tid + i * NTHREADS; *(LAS u32x4*)(Bb + (id >> 4) * 272 + (id & 15) * 16) = *(const u32x4*)(KEYS + (size_t)hp * 128 * 128 + (size_t)(id >> 4) * 128 + (id & 15) * 8); }
        }
#pragma unroll
        for (int i = 0; i < 8; ++i) { const int id = c.tid + i * NTHREADS; *(LAS u32x4*)(Ab + (id >> 4) * 272 + (id & 15) * 16) = *(const u32x4*)(QV + (size_t)(pm * 256 + (id >> 4)) * 2048 + hp * 128 + (id & 15) * 8); }
        __syncthreads();
        f32x16 acc[4];
#pragma unroll
        for (int j = 0; j < 4; ++j) acc[j] = zero16();
#pragma unroll
        for (int s = 0; s < 8; ++s) {
            const bf16x8 fa = *(LAS const bf16x8*)(Ab + (c.wave * 32 + r) * 272 + s * 32 + h * 16);
#pragma unroll
            for (int j = 0; j < 4; ++j) {
                const bf16x8 fb = *(LAS const bf16x8*)(Bb + (j * 32 + r) * 272 + s * 32 + h * 16);
                acc[j] = __builtin_amdgcn_mfma_f32_32x32x16_bf16(fb, fa, acc[j], 0, 0, 0);
            }
        }
        unsigned best[16];
#pragma unroll
        for (int j = 0; j < 4; ++j) {
            unsigned k[16];
#pragma unroll
            for (int g = 0; g < 4; ++g)
#pragma unroll
                for (int e = 0; e < 4; ++e) { const int n = j * 32 + 8 * g + 4 * h + e; k[4 * g + e] = (ord_key(acc[j][4 * g + e]) & ~127u) | (unsigned)(127 - n); }
            sort16_desc(k);
            if (j == 0) {
#pragma unroll
                for (int i = 0; i < 16; ++i) best[i] = k[i];
            } else top16_merge(best, k);
        }
        {
            unsigned other[16];
#pragma unroll
            for (int i = 0; i < 16; ++i) other[i] = (unsigned)__shfl_xor((int)best[i], 32);
            top16_merge(best, other);
        }
        {
            const size_t o = ((size_t)(pm * 256 + c.wave * 32 + r) * 16 + hp) * 16 + 8 * h;
            f32x4 s0, s1; int i0[4], i1[4];
#pragma unroll
            for (int i = 0; i < 4; ++i) {
                const unsigned ka = h ? best[8 + i] : best[i], kb = h ? best[12 + i] : best[4 + i];
                s0[i] = unord_key((ka & ~127u) | 64u); s1[i] = unord_key((kb & ~127u) | 64u);
                i0[i] = 127 - (int)(ka & 127u); i1[i] = 127 - (int)(kb & 127u);
            }
            *(f32x4*)(TOPS + o) = s0; *(f32x4*)(TOPS + o + 4) = s1;
            int4 w0 = make_int4(i0[0], i0[1], i0[2], i0[3]), w1 = make_int4(i1[0], i1[1], i1[2], i1[3]);
            *(int4*)(TOPI + o) = w0; *(int4*)(TOPI + o + 4) = w1;
        }
        __syncthreads();
    }
}

__device__ __forceinline__ float gelu_erf(float x) { return 0.5f * x * (1.0f + erff(x * 0.70710678118654752f)); }
__device__ __forceinline__ void phase_peer(const Ctx& c, const float* XF, const bf16_t* XB, const float* TOPS, const int* TOPI, const bf16_t* UB, const bf16_t* VB,
                                           const float* ln_g, const float* ln_b, float* outf, bf16_t* outb, bool store) {
    LAS int* eidx = (LAS int*)(c.lds + c.wave * 1024);
    LAS float* ewt = (LAS float*)(c.lds + c.wave * 1024 + 512);
    const int lane = c.lane;
    for (int tok = c.blk * 8 + c.wave; tok < NTOK; tok += c.nblk * 8) {
        for (int hh = 0; hh < 8; ++hh) {
            const float* ts = TOPS + ((size_t)tok * 16 + hh * 2) * 16; const int* ti = TOPI + ((size_t)tok * 16 + hh * 2) * 16;
            const int a = lane >> 2, bq = (lane & 3) * 4;
            const float sa = ts[a];
            const f32x4 sb = *(const f32x4*)(ts + 16 + bq);
            float v[4] = {sa + sb[0], sa + sb[1], sa + sb[2], sa + sb[3]};
            float ks = 0.f; int kf = 0;
            for (int it = 0; it < 16; ++it) {
                const float lm = fmaxf(fmaxf(v[0], v[1]), fmaxf(v[2], v[3]));
                const float mx = wave_max(lm);
                const unsigned long long bl = __ballot(lm == mx);
                const int wl = (__ffsll((long long)bl) - 1) & 63;
                int li = (v[0] == mx) ? 0 : (v[1] == mx) ? 1 : (v[2] == mx) ? 2 : 3;
                li = __builtin_amdgcn_readlane(li, wl);
                if (lane == wl) { if (li == 0) v[0] = -3e38f; else if (li == 1) v[1] = -3e38f; else if (li == 2) v[2] = -3e38f; else v[3] = -3e38f; }
                if (lane == it) { ks = mx; kf = wl * 4 + li; }
            }
            float mx16 = (lane < 16) ? ks : -3e38f;
            mx16 = wave_max(mx16);
            const float ex = (lane < 16) ? __expf(ks - mx16) : 0.f;
            const float den = wave_sum(ex);
            if (lane < 16) {
                const int ia = ti[kf >> 4], ib = ti[16 + (kf & 15)];
                eidx[hh * 16 + lane] = (ia * 128 + ib) & 16383;
                ewt[hh * 16 + lane] = ex / den;
            }
        }
        asm volatile("s_waitcnt lgkmcnt(0)" ::: "memory");
        unsigned xb[8];
        {
            const u32x4 x0 = *(const u32x4*)(XB + (size_t)tok * DM + lane * 8), x1 = *(const u32x4*)(XB + (size_t)tok * DM + 512 + lane * 8);
            xb[0] = x0.x; xb[1] = x0.y; xb[2] = x0.z; xb[3] = x0.w; xb[4] = x1.x; xb[5] = x1.y; xb[6] = x1.z; xb[7] = x1.w;
        }
        for (int e0 = 0; e0 < 128; e0 += 8) {
            u32x4 ua[8], ub2[8];
#pragma unroll
            for (int j = 0; j < 8; ++j) {
                const int ex = __builtin_amdgcn_readfirstlane(eidx[e0 + j]);
                const bf16_t* up = UB + (size_t)ex * DM;
                ua[j] = *(const u32x4*)(up + lane * 8); ub2[j] = *(const u32x4*)(up + 512 + lane * 8);
            }
            float p[8];
#pragma unroll
            for (int j = 0; j < 8; ++j) {
                float s0 = dot2bf(xb[0], ua[j].x, 0.f), s1 = dot2bf(xb[1], ua[j].y, 0.f);
                s0 = dot2bf(xb[2], ua[j].z, s0); s1 = dot2bf(xb[3], ua[j].w, s1);
                s0 = dot2bf(xb[4], ub2[j].x, s0); s1 = dot2bf(xb[5], ub2[j].y, s1);
                s0 = dot2bf(xb[6], ub2[j].z, s0); s1 = dot2bf(xb[7], ub2[j].w, s1);
                p[j] = s0 + s1;
            }
            const bool b5 = lane & 32, b4 = lane & 16, b3 = lane & 8;
            float q4[4], q2[2], q1;
#pragma unroll
            for (int j = 0; j < 4; ++j) { const float send = b5 ? p[j] : p[j + 4], keep = b5 ? p[j + 4] : p[j]; q4[j] = keep + __shfl_xor(send, 32); }
#pragma unroll
            for (int j = 0; j < 2; ++j) { const float send = b4 ? q4[j] : q4[j + 2], keep = b4 ? q4[j + 2] : q4[j]; q2[j] = keep + __shfl_xor(send, 16); }
            { const float send = b3 ? q2[0] : q2[1], keep = b3 ? q2[1] : q2[0]; q1 = keep + __shfl_xor(send, 8); }
            q1 += __shfl_xor(q1, 4); q1 += __shfl_xor(q1, 2); q1 += __shfl_xor(q1, 1);
            const int jx = (b5 ? 4 : 0) + (b4 ? 2 : 0) + (b3 ? 1 : 0);
            if ((lane & 7) == 0) ewt[e0 + jx] = ewt[e0 + jx] * gelu_erf(q1);
        }
        asm volatile("s_waitcnt lgkmcnt(0)" ::: "memory");
        float y[16];
#pragma unroll
        for (int i = 0; i < 16; ++i) y[i] = 0.f;
        for (int e0 = 0; e0 < 128; e0 += 8) {
            u32x4 va[8], vb2[8];
#pragma unroll
            for (int j = 0; j < 8; ++j) {
                const int ex = __builtin_amdgcn_readfirstlane(eidx[e0 + j]);
                const bf16_t* vp = VB + (size_t)ex * DM;
                va[j] = *(const u32x4*)(vp + lane * 8); vb2[j] = *(const u32x4*)(vp + 512 + lane * 8);
            }
#pragma unroll
            for (int j = 0; j < 8; ++j) {
                const float w = ewt[e0 + j];
                y[0] += w * bf_lo(va[j].x); y[1] += w * bf_hi(va[j].x); y[2] += w * bf_lo(va[j].y); y[3] += w * bf_hi(va[j].y);
                y[4] += w * bf_lo(va[j].z); y[5] += w * bf_hi(va[j].z); y[6] += w * bf_lo(va[j].w); y[7] += w * bf_hi(va[j].w);
                y[8] += w * bf_lo(vb2[j].x); y[9] += w * bf_hi(vb2[j].x); y[10] += w * bf_lo(vb2[j].y); y[11] += w * bf_hi(vb2[j].y);
                y[12] += w * bf_lo(vb2[j].z); y[13] += w * bf_hi(vb2[j].z); y[14] += w * bf_lo(vb2[j].w); y[15] += w * bf_hi(vb2[j].w);
            }
        }
        {
            const float* xr = XF + (size_t)tok * DM;
            const f32x4 a0 = *(const f32x4*)(xr + lane * 8), a1 = *(const f32x4*)(xr + lane * 8 + 4), a2 = *(const f32x4*)(xr + 512 + lane * 8), a3 = *(const f32x4*)(xr + 512 + lane * 8 + 4);
            const float xs[16] = {a0[0], a0[1], a0[2], a0[3], a1[0], a1[1], a1[2], a1[3], a2[0], a2[1], a2[2], a2[3], a3[0], a3[1], a3[2], a3[3]};
            float s = 0.f;
#pragma unroll
            for (int i = 0; i < 16; ++i) { y[i] = DN_ALPHA * xs[i] + y[i]; s += y[i]; }
            const float mean = wave_sum(s) * (1.0f / 1024.0f);
            float q = 0.f;
#pragma unroll
            for (int i = 0; i < 16; ++i) { const float d = y[i] - mean; q += d * d; }
            const float rstd = rsqrtf(wave_sum(q) * (1.0f / 1024.0f) + LN_EPS);
            float o[16];
#pragma unroll
            for (int i = 0; i < 16; ++i) { const int ch = (i < 8) ? lane * 8 + i : 512 + lane * 8 + (i - 8); o[i] = (y[i] - mean) * rstd * ln_g[ch] + ln_b[ch]; }
            if (store) {
            float* of = outf + (size_t)tok * DM;
            f32x4 w;
            w[0] = o[0]; w[1] = o[1]; w[2] = o[2]; w[3] = o[3]; *(f32x4*)(of + lane * 8) = w;
            w[0] = o[4]; w[1] = o[5]; w[2] = o[6]; w[3] = o[7]; *(f32x4*)(of + lane * 8 + 4) = w;
            w[0] = o[8]; w[1] = o[9]; w[2] = o[10]; w[3] = o[11]; *(f32x4*)(of + 512 + lane * 8) = w;
            w[0] = o[12]; w[1] = o[13]; w[2] = o[14]; w[3] = o[15]; *(f32x4*)(of + 512 + lane * 8 + 4) = w;
            if (outb) {
                u32x4 pb; pb.x = pk_bf16(o[0], o[1]); pb.y = pk_bf16(o[2], o[3]); pb.z = pk_bf16(o[4], o[5]); pb.w = pk_bf16(o[6], o[7]);
                *(u32x4*)(outb + (size_t)tok * DM + lane * 8) = pb;
                pb.x = pk_bf16(o[8], o[9]); pb.y = pk_bf16(o[10], o[11]); pb.z = pk_bf16(o[12], o[13]); pb.w = pk_bf16(o[14], o[15]);
                *(u32x4*)(outb + (size_t)tok * DM + 512 + lane * 8) = pb;
            }
            }
        }
        asm volatile("s_waitcnt lgkmcnt(0)" ::: "memory");
    }
}


__device__ __forceinline__ void phase_peer2(const Ctx& c, const float* XF, const bf16_t* XB, const float* TOPS, const int* TOPI, const unsigned char* U8, const unsigned char* V8,
                                            const float* SU, const float* SV, const float* ln_g, const float* ln_b, float* outf, bf16_t* outb, bool store) {
    LAS int* ent_e = (LAS int*)(c.lds + c.wave * 16384);
    LAS float* ent_g = (LAS float*)(c.lds + c.wave * 16384 + 4096);
    LAS float* ent_su = (LAS float*)(c.lds + c.wave * 16384 + 8192);
    LAS float* ent_sv = (LAS float*)(c.lds + c.wave * 16384 + 12288);
    const int lane = c.lane;
    for (int base = (c.blk * 8 + c.wave) * 8; base < NTOK; base += c.nblk * 64) {
        {
            const int ti_ = lane >> 3, hh = lane & 7, t = base + ti_;
            const float* ts = TOPS + ((size_t)t * 16 + hh * 2) * 16; const int* tix = TOPI + ((size_t)t * 16 + hh * 2) * 16;
            float s0[16], s1[16];
#pragma unroll
            for (int i = 0; i < 4; ++i) { const f32x4 a = *(const f32x4*)(ts + 4 * i), b = *(const f32x4*)(ts + 16 + 4 * i);
                s0[4 * i] = a[0]; s0[4 * i + 1] = a[1]; s0[4 * i + 2] = a[2]; s0[4 * i + 3] = a[3]; s1[4 * i] = b[0]; s1[4 * i + 1] = b[1]; s1[4 * i + 2] = b[2]; s1[4 * i + 3] = b[3]; }
            unsigned best[16];
#pragma unroll
            for (int g = 0; g < 4; ++g) {
                unsigned k[16];
#pragma unroll
                for (int j = 0; j < 16; ++j) {
                    constexpr int cnt[16] = {16, 8, 5, 4, 3, 2, 2, 2, 1, 1, 1, 1, 1, 1, 1, 1};
                    int idx = 16 * g + j, a = -1, b = 0;
#pragma unroll
                    for (int aa = 0; aa < 16; ++aa) { if (a < 0) { if (idx < cnt[aa]) { a = aa; b = idx; } else idx -= cnt[aa]; } }
                    if (a >= 0) k[j] = (ord_key(s0[a] + s1[b]) & ~255u) | (unsigned)(255 - (a * 16 + b)); else k[j] = 0u;
                }
                sort16_desc(k);
                if (g == 0) {
#pragma unroll
                    for (int i = 0; i < 16; ++i) best[i] = k[i];
                } else top16_merge(best, k);
            }
            float sc[16]; int ee[16]; float mx = -3e38f;
#pragma unroll
            for (int k = 0; k < 16; ++k) {
                const int f = 255 - (int)(best[k] & 255u), a = f >> 4, b = f & 15;
                sc[k] = ts[a] + ts[16 + b]; ee[k] = tix[a] * 128 + tix[16 + b];
                mx = fmaxf(mx, sc[k]);
            }
            float den = 0.f;
#pragma unroll
            for (int k = 0; k < 16; ++k) { sc[k] = __expf(sc[k] - mx); den += sc[k]; }
            const float rden = 1.0f / den;
#pragma unroll
            for (int k = 0; k < 16; ++k) {
                const int e = ee[k] & 16383, slot = ti_ * 128 + hh * 16 + k;
                ent_e[slot] = e; ent_g[slot] = sc[k] * rden; ent_su[slot] = SU[e]; ent_sv[slot] = SV[e];
            }
        }
        asm volatile("s_waitcnt lgkmcnt(0)" ::: "memory");
#pragma unroll 1
        for (int ti_ = 0; ti_ < 8; ++ti_) {
            const int tok = base + ti_;
            LAS const int* ee = ent_e + ti_ * 128; LAS float* eg = ent_g + ti_ * 128; LAS const float* esu = ent_su + ti_ * 128; LAS const float* esv = ent_sv + ti_ * 128;
            int xq[4]; float sx;
            {
                const u32x4 x0 = *(const u32x4*)(XB + (size_t)tok * DM + lane * 16), x1 = *(const u32x4*)(XB + (size_t)tok * DM + lane * 16 + 8);
                const unsigned xw[8] = {x0.x, x0.y, x0.z, x0.w, x1.x, x1.y, x1.z, x1.w};
                float xv[16]; float am = 0.f;
#pragma unroll
                for (int i = 0; i < 8; ++i) { xv[2 * i] = bf_lo(xw[i]); xv[2 * i + 1] = bf_hi(xw[i]); am = fmaxf(am, fmaxf(fabsf(xv[2 * i]), fabsf(xv[2 * i + 1]))); }
                am = wave_max(am);
                const float inv = am > 0.f ? 127.0f / am : 0.f; sx = am * (1.0f / 127.0f);
#pragma unroll
                for (int i = 0; i < 4; ++i) {
                    unsigned pk = 0u;
#pragma unroll
                    for (int e = 0; e < 4; ++e) { const int q = (int)__builtin_rintf(xv[4 * i + e] * inv); pk |= ((unsigned)q & 0xffu) << (8 * e); }
                    xq[i] = (int)pk;
                }
            }
#pragma unroll 1
            for (int e0 = 0; e0 < 128; e0 += 16) {
                u32x4 ur[16];
#pragma unroll
                for (int j = 0; j < 16; ++j) { const int ex = __builtin_amdgcn_readfirstlane(ee[e0 + j]); ur[j] = *(const u32x4*)(U8 + (size_t)ex * 1024 + lane * 16); }
                int p[16];
#pragma unroll
                for (int j = 0; j < 16; ++j) {
                    int a = __builtin_amdgcn_sdot4(xq[0], (int)ur[j].x, 0, false);
                    a = __builtin_amdgcn_sdot4(xq[1], (int)ur[j].y, a, false);
                    a = __builtin_amdgcn_sdot4(xq[2], (int)ur[j].z, a, false);
                    p[j] = __builtin_amdgcn_sdot4(xq[3], (int)ur[j].w, a, false);
                }
                const bool b5 = lane & 32, b4 = lane & 16, b3 = lane & 8, b2 = lane & 4;
                int q8[8], q4[4], q2[2], q1;
#pragma unroll
                for (int j = 0; j < 8; ++j) { const int send = b5 ? p[j] : p[j + 8], keep = b5 ? p[j + 8] : p[j]; q8[j] = keep + __shfl_xor(send, 32); }
#pragma unroll
                for (int j = 0; j < 4; ++j) { const int send = b4 ? q8[j] : q8[j + 4], keep = b4 ? q8[j + 4] : q8[j]; q4[j] = keep + __shfl_xor(send, 16); }
#pragma unroll
                for (int j = 0; j < 2; ++j) { const int send = b3 ? q4[j] : q4[j + 2], keep = b3 ? q4[j + 2] : q4[j]; q2[j] = keep + __shfl_xor(send, 8); }
                { const int send = b2 ? q2[0] : q2[1], keep = b2 ? q2[1] : q2[0]; q1 = keep + __shfl_xor(send, 4); }
                q1 += __shfl_xor(q1, 2); q1 += __shfl_xor(q1, 1);
                if ((lane & 3) == 0) {
                    const int jx = e0 + (lane >> 2);
                    const float dot = esu[jx] * sx * (float)q1;
                    eg[jx] = eg[jx] * gelu_erf(dot) * esv[jx];
                }
            }
            asm volatile("s_waitcnt lgkmcnt(0)" ::: "memory");
            float y[16]; float sw = 0.f;
#pragma unroll
            for (int i = 0; i < 16; ++i) y[i] = 0.f;
#pragma unroll 1
            for (int e0 = 0; e0 < 128; e0 += 16) {
                u32x4 vr[16];
#pragma unroll
                for (int j = 0; j < 16; ++j) { const int ex = __builtin_amdgcn_readfirstlane(ee[e0 + j]); vr[j] = *(const u32x4*)(V8 + (size_t)ex * 1024 + lane * 16); }
#pragma unroll
                for (int j = 0; j < 16; ++j) {
                    const float w = eg[e0 + j]; sw += w;
                    const unsigned vw[4] = {vr[j].x, vr[j].y, vr[j].z, vr[j].w};
#pragma unroll
                    for (int i = 0; i < 4; ++i) {
                        y[4 * i + 0] += w * (float)(vw[i] & 0xffu); y[4 * i + 1] += w * (float)((vw[i] >> 8) & 0xffu);
                        y[4 * i + 2] += w * (float)((vw[i] >> 16) & 0xffu); y[4 * i + 3] += w * (float)(vw[i] >> 24);
                    }
                }
            }
            {
                const float* xr = XF + (size_t)tok * DM + lane * 16;
                const f32x4 a0 = *(const f32x4*)(xr), a1 = *(const f32x4*)(xr + 4), a2 = *(const f32x4*)(xr + 8), a3 = *(const f32x4*)(xr + 12);
                const float xs[16] = {a0[0], a0[1], a0[2], a0[3], a1[0], a1[1], a1[2], a1[3], a2[0], a2[1], a2[2], a2[3], a3[0], a3[1], a3[2], a3[3]};
                float s = 0.f;
#pragma unroll
                for (int i = 0; i < 16; ++i) { y[i] = DN_ALPHA * xs[i] + (y[i] - 128.0f * sw); s += y[i]; }
                const float mean = wave_sum(s) * (1.0f / 1024.0f);
                float q = 0.f;
#pragma unroll
                for (int i = 0; i < 16; ++i) { const float d = y[i] - mean; q += d * d; }
                const float rstd = rsqrtf(wave_sum(q) * (1.0f / 1024.0f) + LN_EPS);
                float o[16];
#pragma unroll
                for (int i = 0; i < 4; ++i) {
                    const f32x4 gg = *(const f32x4*)(ln_g + lane * 16 + 4 * i), bb = *(const f32x4*)(ln_b + lane * 16 + 4 * i);
#pragma unroll
                    for (int e = 0; e < 4; ++e) o[4 * i + e] = (y[4 * i + e] - mean) * rstd * gg[e] + bb[e];
                }
                if (store) {
                    float* of = outf + (size_t)tok * DM + lane * 16;
#pragma unroll
                    for (int i = 0; i < 4; ++i) { f32x4 w; w[0] = o[4 * i]; w[1] = o[4 * i + 1]; w[2] = o[4 * i + 2]; w[3] = o[4 * i + 3]; *(f32x4*)(of + 4 * i) = w; }
                    if (outb) {
                        u32x4 pb; pb.x = pk_bf16(o[0], o[1]); pb.y = pk_bf16(o[2], o[3]); pb.z = pk_bf16(o[4], o[5]); pb.w = pk_bf16(o[6], o[7]);
                        *(u32x4*)(outb + (size_t)tok * DM + lane * 16) = pb;
                        pb.x = pk_bf16(o[8], o[9]); pb.y = pk_bf16(o[10], o[11]); pb.z = pk_bf16(o[12], o[13]); pb.w = pk_bf16(o[14], o[15]);
                        *(u32x4*)(outb + (size_t)tok * DM + lane * 16 + 8) = pb;
                    }
                }
            }
        }
        asm volatile("s_waitcnt lgkmcnt(0)" ::: "memory");
    }
}

template <int NT>
__device__ __forceinline__ void peer_row_quant(const bf16_t* XB, int tok, int lane, int (&xq)[4], float& sx) {
    const u32x4 x0 = *(const u32x4*)(XB + (size_t)tok * DM + lane * 16), x1 = *(const u32x4*)(XB + (size_t)tok * DM + lane * 16 + 8);
    const unsigned xw[8] = {x0.x, x0.y, x0.z, x0.w, x1.x, x1.y, x1.z, x1.w};
    float xv[16]; float am = 0.f;
#pragma unroll
    for (int i = 0; i < 8; ++i) { xv[2 * i] = bf_lo(xw[i]); xv[2 * i + 1] = bf_hi(xw[i]); am = fmaxf(am, fmaxf(fabsf(xv[2 * i]), fabsf(xv[2 * i + 1]))); }
    am = wave_max(am);
    const float inv = am > 0.f ? 127.0f / am : 0.f; sx = am * (1.0f / 127.0f);
#pragma unroll
    for (int i = 0; i < 4; ++i) {
        unsigned pk = 0u;
#pragma unroll
        for (int e = 0; e < 4; ++e) { const int q = (int)__builtin_rintf(xv[4 * i + e] * inv); pk |= ((unsigned)q & 0xffu) << (8 * e); }
        xq[i] = (int)pk;
    }
}
__device__ __forceinline__ void phase_peer3(const Ctx& c, const float* XF, const bf16_t* XB, const float* TOPS, const int* TOPI, const unsigned char* U8, const unsigned char* V8,
                                            const float* SU, const float* SV, const float* ln_g, const float* ln_b, float* outf, bf16_t* outb, bool store) {
    constexpr int NT = 4;
    const lptr wb = c.lds + c.wave * 16640;
    LAS int* a_e = (LAS int*)(wb);
    LAS float* a_g = (LAS float*)(wb + 2048);
    LAS float* a_su = (LAS float*)(wb + 4096);
    LAS float* a_sv = (LAS float*)(wb + 6144);
    LAS int* s_e = (LAS int*)(wb + 8192);
    LAS float* s_w = (LAS float*)(wb + 10240);
    LAS float* s_su = (LAS float*)(wb + 12288);
    LAS float* s_sv = (LAS float*)(wb + 14336);
    LAS int* offs = (LAS int*)(wb + 16384);
    const int lane = c.lane;
    for (int base = (c.blk * 8 + c.wave) * NT; base < NTOK; base += c.nblk * 8 * NT) {
        if (lane < 32) {
            const int ti_ = lane >> 3, hh = lane & 7, t = base + ti_;
            const float* ts = TOPS + ((size_t)t * 16 + hh * 2) * 16; const int* tix = TOPI + ((size_t)t * 16 + hh * 2) * 16;
            float s0[16], s1[16];
#pragma unroll
            for (int i = 0; i < 4; ++i) { const f32x4 a = *(const f32x4*)(ts + 4 * i), b = *(const f32x4*)(ts + 16 + 4 * i);
                s0[4 * i] = a[0]; s0[4 * i + 1] = a[1]; s0[4 * i + 2] = a[2]; s0[4 * i + 3] = a[3]; s1[4 * i] = b[0]; s1[4 * i + 1] = b[1]; s1[4 * i + 2] = b[2]; s1[4 * i + 3] = b[3]; }
            unsigned best[16];
#pragma unroll
            for (int g = 0; g < 4; ++g) {
                unsigned k[16];
#pragma unroll
                for (int j = 0; j < 16; ++j) {
                    constexpr int cnt[16] = {16, 8, 5, 4, 3, 2, 2, 2, 1, 1, 1, 1, 1, 1, 1, 1};
                    int idx = 16 * g + j, a = -1, b = 0;
#pragma unroll
                    for (int aa = 0; aa < 16; ++aa) { if (a < 0) { if (idx < cnt[aa]) { a = aa; b = idx; } else idx -= cnt[aa]; } }
                    if (a >= 0) k[j] = (ord_key(s0[a] + s1[b]) & ~255u) | (unsigned)(255 - (a * 16 + b)); else k[j] = 0u;
                }
                sort16_desc(k);
                if (g == 0) {
#pragma unroll
                    for (int i = 0; i < 16; ++i) best[i] = k[i];
                } else top16_merge(best, k);
            }
            float sc[16]; int ee[16]; float mx = -3e38f;
#pragma unroll
            for (int k = 0; k < 16; ++k) {
                const int f = 255 - (int)(best[k] & 255u), a = f >> 4, b = f & 15;
                sc[k] = ts[a] + ts[16 + b]; ee[k] = tix[a] * 128 + tix[16 + b];
                mx = fmaxf(mx, sc[k]);
            }
            float den = 0.f;
#pragma unroll
            for (int k = 0; k < 16; ++k) { sc[k] = __expf(sc[k] - mx); den += sc[k]; }
            const float rden = 1.0f / den;
#pragma unroll
            for (int k = 0; k < 16; ++k) {
                const int e = ee[k] & 16383, slot = ti_ * 128 + hh * 16 + k;
                a_e[slot] = e; a_g[slot] = sc[k] * rden; a_su[slot] = SU[e]; a_sv[slot] = SV[e];
            }
        }
        asm volatile("s_waitcnt lgkmcnt(0)" ::: "memory");
#pragma unroll
        for (int i = 0; i < NT; ++i) {
            const int e0 = a_e[i * 128 + lane], e1 = a_e[i * 128 + 64 + lane];
            const int r0 = e0 >> 11, r1 = e1 >> 11;
            const unsigned long long lt = (1ull << lane) - 1ull;
            int bs = 0, p0 = 0, p1 = 0;
#pragma unroll
            for (int rho = 0; rho < 8; ++rho) {
                const unsigned long long m0 = __ballot(r0 == rho), m1 = __ballot(r1 == rho);
                if (lane == 0) offs[i * 16 + rho] = bs;
                if (r0 == rho) p0 = bs + __popcll(m0 & lt);
                if (r1 == rho) p1 = bs + __popcll(m0) + __popcll(m1 & lt);
                bs += __popcll(m0) + __popcll(m1);
            }
            if (lane == 0) offs[i * 16 + 8] = bs;
            s_e[i * 128 + p0] = e0; s_w[i * 128 + p0] = a_g[i * 128 + lane]; s_su[i * 128 + p0] = a_su[i * 128 + lane]; s_sv[i * 128 + p0] = a_sv[i * 128 + lane];
            s_e[i * 128 + p1] = e1; s_w[i * 128 + p1] = a_g[i * 128 + 64 + lane]; s_su[i * 128 + p1] = a_su[i * 128 + 64 + lane]; s_sv[i * 128 + p1] = a_sv[i * 128 + 64 + lane];
        }
        asm volatile("s_waitcnt lgkmcnt(0)" ::: "memory");
        int xq[NT][4]; float sx[NT];
#pragma unroll
        for (int i = 0; i < NT; ++i) peer_row_quant<NT>(XB, base + i, lane, xq[i], sx[i]);
#pragma unroll 1
        for (int rho = 0; rho < 8; ++rho) {
#pragma unroll
            for (int i = 0; i < NT; ++i) {
                const int beg = __builtin_amdgcn_readfirstlane(offs[i * 16 + rho]), end = __builtin_amdgcn_readfirstlane(offs[i * 16 + rho + 1]);
#pragma unroll 1
                for (int e0 = beg; e0 < end; e0 += 8) {
                    u32x4 ur[8];
#pragma unroll
                    for (int j = 0; j < 8; ++j) { const int sl = min(e0 + j, end - 1); const int ex = __builtin_amdgcn_readfirstlane(s_e[i * 128 + sl]); ur[j] = *(const u32x4*)(U8 + (size_t)ex * 1024 + lane * 16); }
                    int p[8];
#pragma unroll
                    for (int j = 0; j < 8; ++j) {
                        int a = __builtin_amdgcn_sdot4(xq[i][0], (int)ur[j].x, 0, false);
                        a = __builtin_amdgcn_sdot4(xq[i][1], (int)ur[j].y, a, false);
                        a = __builtin_amdgcn_sdot4(xq[i][2], (int)ur[j].z, a, false);
                        p[j] = __builtin_amdgcn_sdot4(xq[i][3], (int)ur[j].w, a, false);
                    }
                    const bool b5 = lane & 32, b4 = lane & 16, b3 = lane & 8;
                    int q4[4], q2[2], q1;
#pragma unroll
                    for (int j = 0; j < 4; ++j) { const int send = b5 ? p[j] : p[j + 4], keep = b5 ? p[j + 4] : p[j]; q4[j] = keep + __shfl_xor(send, 32); }
#pragma unroll
                    for (int j = 0; j < 2; ++j) { const int send = b4 ? q4[j] : q4[j + 2], keep = b4 ? q4[j + 2] : q4[j]; q2[j] = keep + __shfl_xor(send, 16); }
                    { const int send = b3 ? q2[0] : q2[1], keep = b3 ? q2[1] : q2[0]; q1 = keep + __shfl_xor(send, 8); }
                    q1 += __shfl_xor(q1, 4); q1 += __shfl_xor(q1, 2); q1 += __shfl_xor(q1, 1);
                    const int sl = e0 + (lane >> 3);
                    if ((lane & 7) == 0 && sl < end) {
                        const float dot = s_su[i * 128 + sl] * sx[i] * (float)q1;
                        s_w[i * 128 + sl] = s_w[i * 128 + sl] * gelu_erf(dot) * s_sv[i * 128 + sl];
                    }
                }
            }
        }
        asm volatile("s_waitcnt lgkmcnt(0)" ::: "memory");
        float y[NT][16]; float sw[NT];
#pragma unroll
        for (int i = 0; i < NT; ++i) { sw[i] = 0.f;
#pragma unroll
            for (int e = 0; e < 16; ++e) y[i][e] = 0.f; }
#pragma unroll 1
        for (int rho = 0; rho < 8; ++rho) {
#pragma unroll
            for (int i = 0; i < NT; ++i) {
                const int beg = __builtin_amdgcn_readfirstlane(offs[i * 16 + rho]), end = __builtin_amdgcn_readfirstlane(offs[i * 16 + rho + 1]);
#pragma unroll 1
                for (int e0 = beg; e0 < end; e0 += 8) {
                    u32x4 vr[8];
#pragma unroll
                    for (int j = 0; j < 8; ++j) { const int sl = min(e0 + j, end - 1); const int ex = __builtin_amdgcn_readfirstlane(s_e[i * 128 + sl]); vr[j] = *(const u32x4*)(V8 + (size_t)ex * 1024 + lane * 16); }
#pragma unroll
                    for (int j = 0; j < 8; ++j) {
                        const float w = (e0 + j < end) ? s_w[i * 128 + min(e0 + j, end - 1)] : 0.f; sw[i] += w;
                        const unsigned vw[4] = {vr[j].x, vr[j].y, vr[j].z, vr[j].w};
#pragma unroll
                        for (int q = 0; q < 4; ++q) {
                            y[i][4 * q + 0] += w * (float)(vw[q] & 0xffu); y[i][4 * q + 1] += w * (float)((vw[q] >> 8) & 0xffu);
                            y[i][4 * q + 2] += w * (float)((vw[q] >> 16) & 0xffu); y[i][4 * q + 3] += w * (float)(vw[q] >> 24);
                        }
                    }
                }
            }
        }
#pragma unroll
        for (int i = 0; i < NT; ++i) {
            const int tok = base + i;
            const float* xr = XF + (size_t)tok * DM + lane * 16;
            const f32x4 a0 = *(const f32x4*)(xr), a1 = *(const f32x4*)(xr + 4), a2 = *(const f32x4*)(xr + 8), a3 = *(const f32x4*)(xr + 12);
            const float xs[16] = {a0[0], a0[1], a0[2], a0[3], a1[0], a1[1], a1[2], a1[3], a2[0], a2[1], a2[2], a2[3], a3[0], a3[1], a3[2], a3[3]};
            float yy[16]; float s = 0.f;
#pragma unroll
            for (int e = 0; e < 16; ++e) { yy[e] = DN_ALPHA * xs[e] + (y[i][e] - 128.0f * sw[i]); s += yy[e]; }
            const float mean = wave_sum(s) * (1.0f / 1024.0f);
            float q = 0.f;
#pragma unroll
            for (int e = 0; e < 16; ++e) { const float d = yy[e] - mean; q += d * d; }
            const float rstd = rsqrtf(wave_sum(q) * (1.0f / 1024.0f) + LN_EPS);
            float o[16];
#pragma unroll
            for (int g4 = 0; g4 < 4; ++g4) {
                const f32x4 gg = *(const f32x4*)(ln_g + lane * 16 + 4 * g4), bb = *(const f32x4*)(ln_b + lane * 16 + 4 * g4);
#pragma unroll
                for (int e = 0; e < 4; ++e) o[4 * g4 + e] = (yy[4 * g4 + e] - mean) * rstd * gg[e] + bb[e];
            }
            if (store) {
                float* of = outf + (size_t)tok * DM + lane * 16;
#pragma unroll
                for (int g4 = 0; g4 < 4; ++g4) { f32x4 w; w[0] = o[4 * g4]; w[1] = o[4 * g4 + 1]; w[2] = o[4 * g4 + 2]; w[3] = o[4 * g4 + 3]; *(f32x4*)(of + 4 * g4) = w; }
                if (outb) {
                    u32x4 pb; pb.x = pk_bf16(o[0], o[1]); pb.y = pk_bf16(o[2], o[3]); pb.z = pk_bf16(o[4], o[5]); pb.w = pk_bf16(o[6], o[7]);
                    *(u32x4*)(outb + (size_t)tok * DM + lane * 16) = pb;
                    pb.x = pk_bf16(o[8], o[9]); pb.y = pk_bf16(o[10], o[11]); pb.z = pk_bf16(o[12], o[13]); pb.w = pk_bf16(o[14], o[15]);
                    *(u32x4*)(outb + (size_t)tok * DM + lane * 16 + 8) = pb;
                }
            }
        }
        asm volatile("s_waitcnt lgkmcnt(0)" ::: "memory");
    }
}

__device__ __forceinline__ void quant_rows(const Ctx& c, const float* src, unsigned char* dst, float* scale, int R, int bias) {
    const int gw = c.blk * 8 + c.wave, nw = c.nblk * 8;
    for (int row0 = gw * 4; row0 < R; row0 += nw * 4) {
        f32x4 v[4][4]; float am[4];
#pragma unroll
        for (int rr = 0; rr < 4; ++rr) {
            const f32x4* p = (const f32x4*)(src + (size_t)(row0 + rr) * 1024 + c.lane * 16);
#pragma unroll
            for (int i = 0; i < 4; ++i) v[rr][i] = p[i];
        }
#pragma unroll
        for (int rr = 0; rr < 4; ++rr) {
            float a = 0.f;
#pragma unroll
            for (int i = 0; i < 4; ++i) a = fmaxf(a, fmaxf(fmaxf(fabsf(v[rr][i][0]), fabsf(v[rr][i][1])), fmaxf(fabsf(v[rr][i][2]), fabsf(v[rr][i][3]))));
            am[rr] = wave_max(a);
        }
#pragma unroll
        for (int rr = 0; rr < 4; ++rr) {
            const float inv = am[rr] > 0.f ? 127.0f / am[rr] : 0.f;
            unsigned w[4];
#pragma unroll
            for (int i = 0; i < 4; ++i) {
                unsigned pk = 0u;
#pragma unroll
                for (int e = 0; e < 4; ++e) { const int q = (int)__builtin_rintf(v[rr][i][e] * inv) + bias; pk |= ((unsigned)q & 0xffu) << (8 * e); }
                w[i] = pk;
            }
            u32x4 o; o.x = w[0]; o.y = w[1]; o.z = w[2]; o.w = w[3];
            *(u32x4*)(dst + (size_t)(row0 + rr) * 1024 + c.lane * 16) = o;
            if (c.lane == 0) scale[row0 + rr] = am[rr] > 0.f ? am[rr] * (1.0f / 127.0f) : 1.0f;
        }
    }
}

__device__ __forceinline__ void phase_prologue(const Ctx& c, const Args& a, float* SUp, float* SVp, bf16_t* WC, float* CB, bf16_t* WIN, bf16_t* WG, bf16_t* WB, bf16_t* WO, bf16_t* WQ, bf16_t* KEYS, bf16_t* UB, bf16_t* VB, float* HF, bf16_t* HB) {
#pragma unroll 1
    for (int l = 0; l < 2; ++l) {
        transpose_cvt(c, a.in[3] + (size_t)l * 1024 * W_IN_LD, W_IN_LD, 1024, 0, 3228, NY, 1, WIN + (size_t)l * NIN * 1024, 1024);
        transpose_cvt(c, a.in[3] + (size_t)l * 1024 * W_IN_LD, W_IN_LD, 1024, W_MG, 4096, 4096, 0, WIN + ((size_t)l * NIN + NY) * 1024, 1024);
#pragma unroll 1
        for (int nb = 0; nb < 4; ++nb)
            transpose_cvt(c, a.in[12] + (size_t)(l * 4 + nb) * 256 * 1024, 1024, 256, 0, 1024, 1024, 0, WB + (size_t)(l * 4 + nb) * 1024 * 256, 256);
        transpose_cvt(c, a.in[13] + (size_t)l * 1024 * 1024, 1024, 1024, 0, 1024, 1024, 0, WO + (size_t)l * 1024 * 1024, 1024);
        transpose_cvt(c, a.in[16] + (size_t)l * 1024 * 2048, 2048, 1024, 0, 2048, 2048, 0, WQ + (size_t)l * 2048 * 1024, 1024);
#pragma unroll 1
        for (int kv = 0; kv < 2; ++kv) {
            const float* w = a.in[5 + kv] + (size_t)l * 2048 * 64;
            transpose_cvt(c, w, 64, 1024, 0, 64, 64, 0, WC + (size_t)(l * 2 + kv) * 128 * 1024, 1024);
            transpose_cvt(c, w + 1024 * 64, 64, 1024, 0, 64, 64, 0, WC + (size_t)(l * 2 + kv) * 128 * 1024 + 64 * 1024, 1024);
        }
    }
    {
        const int gw = c.blk * 8 + c.wave;
        if (gw < 256) {
            const int d = gw & 63, kv = (gw >> 6) & 1, l = gw >> 7;
            const float* w = a.in[5 + kv] + (size_t)l * 2048 * 64; const float* pos = a.in[4] + (size_t)l * 2048;
            float sacc = 0.f;
            for (int k = c.lane; k < 2048; k += 64) sacc += pos[k] * w[(size_t)k * 64 + d];
            sacc = wave_sum(sacc);
            if (c.lane == 0) CB[gw] = sacc;
        }
    }
    convert_flat(c, a.in[17], KEYS, (size_t)2 * 16 * 128 * 128);
    quant_rows(c, a.in[18], (unsigned char*)UB, SUp, 2 * 16384, 0);
    quant_rows(c, a.in[19], (unsigned char*)VB, SVp, 2 * 16384, 128);
    ln_rows(c, a.in[0], a.in[1], a.in[2], HF, HB);
}

constexpr int PH_PER_LAYER = 10, N_PHASES = 1 + 2 * PH_PER_LAYER;

__global__ void __launch_bounds__(NTHREADS, 2) mk_fwd(Args a) {
    extern __shared__ __attribute__((aligned(16))) unsigned char lds_raw[];
    volatile LAS unsigned* st = (volatile LAS unsigned*)((lptr)lds_raw + LDS_BYTES - 16);
    if (threadIdx.x == 0) { st[0] = 0u; st[1] = 0u; st[2] = 0u; st[3] = 0u; }
    __syncthreads();
#if ONE_LAUNCH
    constexpr int lo = 0, hi = N_PHASES;
#else
    const int lo = a.ph_lo, hi = a.ph_hi;
#endif
    XcdBarrier bar; bar.bar = (unsigned*)(a.ws + WS_CTL); bar.x = 0; bar.st = st;
    if (hi - lo > 1) bar = xcd_barrier_post((unsigned*)(a.ws + WS_CTL), st);
#define IN(k) (lo <= (k) && (k) < hi)
#ifndef ONLY_PHASE
#define ONLY_PHASE -1
#endif
#define EN(j) (ONLY_PHASE < 0 || ONLY_PHASE == (j))
#define SEAM(k) do { if (IN(k) && IN((k) + 1)) xcd_barrier(bar); } while (0)
#define FRESH() Ctx c; c.lds = (lptr)lds_raw; c.tid = threadIdx.x; asm volatile("" : "+v"(c.tid)); c.lane = c.tid & 63; c.wave = __builtin_amdgcn_readfirstlane(c.tid >> 6); c.blk = blockIdx.x; c.nblk = gridDim.x; \
    unsigned char* ws = a.ws + (unsigned)__builtin_amdgcn_readfirstlane((int)st[2]); c.ws = ws

#define HF ((float*)(ws + WS_HF))
#define HB ((bf16_t*)(ws + WS_HB))
#define Y ((bf16_t*)(ws + WS_Y))
#define Z ((float*)(ws + WS_Z))
#define TOPS ((float*)(ws + WS_TOPS))
#define TOPI ((int*)(ws + WS_TOPI))
#define O ((bf16_t*)(ws + WS_O))
#define MIX ((bf16_t*)(ws + WS_MIX))
#define QV ((bf16_t*)(ws + WS_QV))
#define UST ((float*)(ws + WS_UST))
#define RST ((float*)(ws + WS_RST))
#define UGLA ((float*)(ws + WS_UGLA))
#define SGLA ((float*)(ws + WS_SGLA))
#define BL ((float*)(ws + WS_BL))
#define KC ((bf16_t*)(ws + WS_KC))
#define VC ((bf16_t*)(ws + WS_VC))
#define WIN ((bf16_t*)(ws + WS_WIN))
#define WG ((bf16_t*)(ws + WS_WG))
#define WB ((bf16_t*)(ws + WS_WB))
#define WO ((bf16_t*)(ws + WS_WO))
#define WQ ((bf16_t*)(ws + WS_WQ))
#define KEYS ((bf16_t*)(ws + WS_KEYS))
#define UB ((bf16_t*)(ws + WS_UB))
#define VB ((bf16_t*)(ws + WS_VB))
#ifndef REP_MASK
#define REP_MASK 0
#endif
#define NREP(j) (((REP_MASK >> (j)) & 1) ? 2 : 1)
#define RUN(j, k, body) do { if (IN(k) && EN(j)) { if (NREP(j) == 2) { constexpr int rr = 0; FRESH(); body; } if (NREP(j) == 2) xcd_barrier(bar); { constexpr int rr = NREP(j) - 1; FRESH(); body; } } } while (0)
    RUN(10, 0, phase_prologue(c, a, (float*)(ws + WS_SU), (float*)(ws + WS_SV), (bf16_t*)(ws + WS_WC), (float*)(ws + WS_CB), WIN, WG, WB, WO, WQ, KEYS, UB, VB, HF, HB));
    SEAM(0);
#ifdef PROBE_BARS
    for (int bq = 0; bq < PROBE_BARS; ++bq) xcd_barrier(bar);
#endif
#ifndef SUB1
#define SUB1 15
#endif
#ifndef SUB
#define SUB 7
#endif
#define LAYER(l, pb) \
        RUN(0, pb + 0, phase_inproj_gates_pg8(c, HB, WIN + (size_t)l * NIN * 1024, Y, (unsigned char*)(ws + WS_G))); \
        SEAM(pb + 0); \
        RUN(1, pb + 1, { \
            if (SUB1 & 1) phase_sb4(c, Y, O); \
            if (SUB1 & 2) phase_compress2(c, Y, (const bf16_t*)(ws + WS_WC) + (size_t)l * 2 * 128 * 1024, (float*)(ws + WS_RC)); \
            if (SUB1 & 4) phase_ret_local(c, Y, UST); \
            if (SUB1 & 8) phase_gla_local(c, Y, a.in[9] + (size_t)l * 16 * 128, a.in[10] + (size_t)l * 128, UGLA, BL); \
        }); \
        SEAM(pb + 1); \
        RUN(2, pb + 2, { phase_scans(c, UST, RST, UGLA, SGLA, BL); phase_compress_combine(c, (const float*)(ws + WS_RC), (const float*)(ws + WS_CB) + l * 128, KC, VC); }); \
        SEAM(pb + 2); \
        RUN(3, pb + 3, { \
            if (SUB & 1) phase_nsa3(c, Y, KC, VC, O); \
            if (SUB & 2) phase_ret_out(c, Y, RST, a.in[7] + (size_t)l * 256, a.in[8] + (size_t)l * 256, O); \
            if (SUB & 4) phase_gla_out(c, Y, a.in[9] + (size_t)l * 16 * 128, a.in[10] + (size_t)l * 128, SGLA, a.in[11] + (size_t)l * 256, O); \
        }); \
        SEAM(pb + 3); \
        RUN(4, pb + 4, phase_merge2(c, (const unsigned char*)(ws + WS_G), O, WB + (size_t)l * 4 * 1024 * 256, MIX)); \
        SEAM(pb + 4); \
        RUN(5, pb + 5, phase_outproj_pg8(c, MIX, WO + (size_t)l * 1024 * 1024, HF, Z)); \
        SEAM(pb + 5); \
        RUN(6, pb + 6, ln_rows(c, Z, a.in[14] + (size_t)l * 1024, a.in[15] + (size_t)l * 1024, HF, HB)); \
        SEAM(pb + 6); \
        RUN(7, pb + 7, phase_wq_pg8(c, HB, WQ + (size_t)l * 2048 * 1024, QV)); \
        SEAM(pb + 7); \
        RUN(8, pb + 8, phase_subkey2(c, QV, KEYS + (size_t)l * 16 * 128 * 128, TOPS, TOPI)); \
        SEAM(pb + 8); \
        RUN(9, pb + 9, phase_peer3(c, HF, HB, TOPS, TOPI, (const unsigned char*)UB + (size_t)(l ^ (rr == NREP(9) - 1 ? 0 : 1)) * 16384 * 1024, (const unsigned char*)VB + (size_t)(l ^ (rr == NREP(9) - 1 ? 0 : 1)) * 16384 * 1024, \
                                   (const float*)(ws + WS_SU) + (size_t)l * 16384, (const float*)(ws + WS_SV) + (size_t)l * 16384, \
                                   a.in[20] + (size_t)l * 1024, a.in[21] + (size_t)l * 1024, (l == 1) ? a.out : HF, (l == 1) ? (bf16_t*)nullptr : HB, \
                                   (rr == NREP(9) - 1) || (lo > 1000))); \
        SEAM(pb + 9);
    LAYER(0, 1)
    LAYER(1, 1 + PH_PER_LAYER)
#undef LAYER
#undef RUN
#undef HF
#undef HB
#undef Y
#undef Z
#undef TOPS
#undef TOPI
#undef O
#undef MIX
#undef QV
#undef UST
#undef RST
#undef UGLA
#undef SGLA
#undef BL
#undef KC
#undef VC
#undef WIN
#undef WG
#undef WB
#undef WO
#undef WQ
#undef KEYS
#undef UB
#undef VB
#undef IN
#undef SEAM
#undef FRESH
}


#ifndef DBG_DUMP
#define DBG_DUMP 0
#endif
#ifndef DBG_C0
#define DBG_C0 0
#endif
#ifndef DBG_C1
#define DBG_C1 1024
#endif
__global__ void dbg_dump(const unsigned char* ws, float* out, int sel) {
    const size_t n = (size_t)NTOK * DM;
    for (size_t i = (size_t)blockIdx.x * blockDim.x + threadIdx.x; i < n; i += (size_t)gridDim.x * blockDim.x) {
        const int col = (int)(i & 1023);
        float v = 0.f;
        if (col >= DBG_C0 && col < DBG_C1) {
            if (sel == 1) v = bf2f(((const bf16_t*)(ws + WS_O))[i]);
            else if (sel == 2) v = ((const float*)(ws + WS_HF))[i];
            else if (sel == 3) v = bf2f(((const bf16_t*)(ws + WS_Y))[(i >> 10) * NY + col]);
            else if (sel == 4) v = bf2f(((const bf16_t*)(ws + WS_Y))[(i >> 10) * NY + 1024 + col]);
            else if (sel == 5) v = bf2f(((const bf16_t*)(ws + WS_Y))[(i >> 10) * NY + 2048 + col]);
            else if (sel == 6) v = bf2f(((const bf16_t*)(ws + WS_MIX))[i]);
            else if (sel == 7) v = ((const float*)(ws + WS_Z))[i];
        }
        out[i] = v;
    }
}

extern "C" void kernel_launch(void* const* d_in, const int* in_sizes, int n_in, void* d_out, int out_size, void* d_ws, size_t ws_size, hipStream_t stream) {
    static int grid = 0;
    if (grid == 0) {
        if (n_in != 22 || out_size != NTOK * DM || ws_size < WS_END) { fprintf(stderr, "kernel_launch: unexpected shapes (n_in %d out %d ws %zu need %zu)\n", n_in, out_size, ws_size, (size_t)WS_END); grid = -1; return; }
        int dev = 0, cus = 0, per_cu = 0;
        if (hipGetDevice(&dev) != hipSuccess || hipDeviceGetAttribute(&cus, hipDeviceAttributeMultiprocessorCount, dev) != hipSuccess) { grid = -1; return; }
        if (hipFuncSetAttribute((const void*)mk_fwd, hipFuncAttributeMaxDynamicSharedMemorySize, LDS_BYTES) != hipSuccess) { fprintf(stderr, "kernel_launch: hipFuncSetAttribute failed\n"); grid = -1; return; }
        if (hipOccupancyMaxActiveBlocksPerMultiprocessor(&per_cu, (const void*)mk_fwd, NTHREADS, LDS_BYTES) != hipSuccess || per_cu < 1) { fprintf(stderr, "kernel_launch: occupancy query says %d\n", per_cu); }
        (void)hipGetLastError();
        grid = cus;
    }
    if (grid < 0) return;
    (void)hipMemsetAsync((char*)d_ws + WS_CTL, 0, XCD_BAR_WORDS * sizeof(unsigned), stream);
    Args a{};
    for (int i = 0; i < 22; ++i) a.in[i] = (const float*)d_in[i];
    a.out = (float*)d_out; a.ws = (unsigned char*)d_ws;
#if ONE_LAUNCH
    a.ph_lo = 0; a.ph_hi = N_PHASES;
    hipLaunchKernelGGL(mk_fwd, dim3(grid), dim3(NTHREADS), LDS_BYTES, stream, a);
#else
#ifndef DBG_PH_HI
#define DBG_PH_HI N_PHASES
#endif
#ifndef DBG_PH_LO
#define DBG_PH_LO 0
#endif
    for (int p = DBG_PH_LO; p < DBG_PH_HI; ++p) {
        a.ph_lo = p; a.ph_hi = p + 1;
        hipLaunchKernelGGL(mk_fwd, dim3(grid), dim3(NTHREADS), LDS_BYTES, stream, a);
    }
    if (DBG_DUMP) hipLaunchKernelGGL(dbg_dump, dim3(1024), dim3(256), 0, stream, (const unsigned char*)d_ws, (float*)d_out, (int)DBG_DUMP);
#endif
}
```

```cpp
#include <hip/hip_runtime.h>
#include <stdint.h>
#include <stdio.h>

#ifndef ONE_LAUNCH
#define ONE_LAUNCH 1
#endif

#define LAS __attribute__((address_space(3)))
typedef unsigned short bf16_t;
typedef short bf16x8 __attribute__((ext_vector_type(8)));
typedef float f32x4 __attribute__((ext_vector_type(4)));
typedef float f32x16 __attribute__((ext_vector_type(16)));
typedef unsigned u32x4 __attribute__((ext_vector_type(4)));
typedef unsigned u32x2 __attribute__((ext_vector_type(2)));
typedef __bf16 bf2_t __attribute__((ext_vector_type(2)));
typedef LAS unsigned char* lptr;

constexpr int NTOK = 16384, SEQ = 8192, DM = 1024, NB = 2;
constexpr int NY = 3328;
constexpr int W_IN_LD = 7324;
constexpr int NIN = NY + 4096;
constexpr int C_SBQ = 0, C_SBK = 256, C_SBV = 512, C_NQ = 768, C_NKC = 1024, C_NVC = 1088, C_NKS = 1152, C_NVS = 1216, C_NKW = 1280, C_NVW = 1344;
constexpr int C_RQ = 1408, C_RK = 1664, C_RV = 1920, C_RG = 2176, C_GQ = 2432, C_GK = 2560, C_GV = 2688, C_GR = 2944, C_NG = 3200, C_GLR = 3216;
constexpr int W_MG = 3228;
constexpr float NEGF = -1e30f;
constexpr float LN_EPS = 1e-5f;
constexpr float DN_ALPHA = 1.41421356237f;

constexpr int NTHREADS = 512;
constexpr int LDS_BYTES = 147456;

constexpr size_t MB = 1024 * 1024;
constexpr size_t WS_CTL   = 0;
constexpr size_t WS_HF    = 1 * MB;
constexpr size_t WS_HB    = WS_HF + 64 * MB;
constexpr size_t WS_Y     = WS_HB + 32 * MB;
constexpr size_t WS_Z     = WS_Y;
constexpr size_t WS_TOPS  = WS_Y + 64 * MB;
constexpr size_t WS_TOPI  = WS_TOPS + 16 * MB;
constexpr size_t WS_O     = WS_Y + 104 * MB;
constexpr size_t WS_MIX   = WS_O + 32 * MB;
constexpr size_t WS_QV    = WS_O;
constexpr size_t WS_UST   = WS_MIX + 32 * MB;
constexpr size_t WS_RST   = WS_UST + 8 * MB;
constexpr size_t WS_UGLA  = WS_RST + 8 * MB;
constexpr size_t WS_SGLA  = WS_UGLA + 8 * MB;
constexpr size_t WS_BL    = WS_SGLA + 8 * MB;
constexpr size_t WS_KC    = WS_BL + 1 * MB;
constexpr size_t WS_VC    = WS_KC + 1 * MB;
constexpr size_t WS_WIN   = WS_VC + 1 * MB;
constexpr size_t WS_WG    = WS_WIN + 14 * MB;
constexpr size_t WS_WB    = WS_WG + 16 * MB;
constexpr size_t WS_WO    = WS_WB + 4 * MB;
constexpr size_t WS_WQ    = WS_WO + 4 * MB;
constexpr size_t WS_KEYS  = WS_WQ + 8 * MB;
constexpr size_t WS_UB    = WS_KEYS + 1 * MB;
constexpr size_t WS_VB    = WS_UB + 32 * MB;
constexpr size_t WS_SU    = WS_UB + 64 * MB;
constexpr size_t WS_SV    = WS_SU + 256 * 1024;
constexpr size_t WS_G     = WS_UB + 65 * MB;
constexpr size_t WS_WC    = WS_G + 64 * MB;
constexpr size_t WS_RC    = WS_WC + 1 * MB;
constexpr size_t WS_CB    = WS_RC + 1 * MB;
constexpr size_t WS_END   = WS_CB + 1 * MB;

typedef float f32x2_t __attribute__((ext_vector_type(2)));
__device__ __forceinline__ unsigned pk_bf16(float lo, float hi) { f32x2_t v = {lo, hi}; bf2_t b = __builtin_convertvector(v, bf2_t); return __builtin_bit_cast(unsigned, b); }
__device__ __forceinline__ float bf_lo(unsigned u) { return __uint_as_float(u << 16); }
__device__ __forceinline__ float bf_hi(unsigned u) { return __uint_as_float(u & 0xffff0000u); }
__device__ __forceinline__ bf16_t f2bf(float f) { return (bf16_t)(pk_bf16(f, f) & 0xffffu); }
__device__ __forceinline__ float bf2f(bf16_t b) { return __uint_as_float(((unsigned)b) << 16); }
__device__ __forceinline__ float wave_sum(float v) {
#pragma unroll
    for (int o = 32; o; o >>= 1) v += __shfl_xor(v, o);
    return v;
}
__device__ __forceinline__ float wave_max(float v) {
#pragma unroll
    for (int o = 32; o; o >>= 1) v = fmaxf(v, __shfl_xor(v, o));
    return v;
}
__device__ __forceinline__ float sigmoidf_(float x) { return 1.0f / (1.0f + __expf(-x)); }
__device__ __forceinline__ float softplusf_(float x) { return fmaxf(x, 0.f) + __logf(1.0f + __expf(-fabsf(x))); }
__device__ __forceinline__ float siluf_(float x) { return x * sigmoidf_(x); }
__device__ __forceinline__ float dot2bf(unsigned a, unsigned b, float c) {
    return __builtin_amdgcn_fdot2_f32_bf16(__builtin_bit_cast(bf2_t, a), __builtin_bit_cast(bf2_t, b), c, false);
}

#define XB_TMO      128
#define XB_XCNT(j)  (256  + 64 * (j))
#define XB_XSUB(j)  (1280 + 64 * (j))
#define XB_XGEN(j)  (2304 + 64 * (j))
#define XB_TOP      3328
#define XB_TOPGEN   3392
#define XCD_BAR_WORDS 3456
#define XB_SPIN_CAP (1u << 22)

__device__ __forceinline__ unsigned xb_ld(unsigned* p)              { return __hip_atomic_load(p, __ATOMIC_RELAXED, __HIP_MEMORY_SCOPE_AGENT); }
__device__ __forceinline__ unsigned xb_add(unsigned* p, unsigned v) { return __hip_atomic_fetch_add(p, v, __ATOMIC_RELAXED, __HIP_MEMORY_SCOPE_AGENT); }
__device__ __forceinline__ unsigned xb_xcc_id() { return (unsigned)__builtin_amdgcn_s_getreg((3 << 11) | 20) & 0xFu; }
#define XB_SPIN(cond, bar) do { unsigned _sp = 0; while (cond) { __builtin_amdgcn_s_sleep(1); \
    if ((++_sp & 255u) == 0u) { if (xb_ld(&(bar)[XB_TMO])) break; if (_sp > XB_SPIN_CAP) { atomicAdd(&(bar)[XB_TMO], 1u); break; } } } } while (0)

struct XcdBarrier { unsigned* bar; unsigned x; volatile LAS unsigned* st; };

__device__ __forceinline__ XcdBarrier xcd_barrier_post(unsigned* bar, volatile LAS unsigned* st) {
    XcdBarrier b; b.bar = bar; b.x = xb_xcc_id(); b.st = st;
    if (threadIdx.x == 0) (void)xb_add(&bar[XB_XCNT(b.x)], 1u);
    return b;
}
__device__ __forceinline__ void xcd_barrier_complete(unsigned* bar, unsigned x, unsigned& nloc, unsigned& nx) {
    const unsigned G = gridDim.x * gridDim.y * gridDim.z;
    unsigned sum, cnt, mine, sp = 0u;
    for (;;) {
        sum = 0u; cnt = 0u; mine = 0u;
#pragma unroll
        for (unsigned j = 0; j < 16; ++j) { const unsigned c = xb_ld(&bar[XB_XCNT(j)]); sum += c; cnt += (c > 0u) ? 1u : 0u; mine = (j == x) ? c : mine; }
        if (sum == G) break;
        __builtin_amdgcn_s_sleep(1);
        if ((++sp & 255u) == 0u) { if (xb_ld(&bar[XB_TMO])) break; if (sp > XB_SPIN_CAP) { atomicAdd(&bar[XB_TMO], 1u); break; } }
    }
    nloc = mine > 0u ? mine : 1u; nx = cnt > 0u ? cnt : 1u;
}
__device__ __forceinline__ void xcd_barrier(const XcdBarrier& b) {
    asm volatile("s_waitcnt vmcnt(0)" ::: "memory");
    __syncthreads();
    if (threadIdx.x == 0) {
        unsigned* bar = b.bar;
        __builtin_amdgcn_s_waitcnt(0);
        unsigned nloc = b.st[0], nx = b.st[1];
        if (nloc == 0u) { xcd_barrier_complete(bar, b.x, nloc, nx); b.st[0] = nloc; b.st[1] = nx; }
        const unsigned old = xb_add(&bar[XB_XSUB(b.x)], 1u);
        const unsigned gen = old / nloc;
        if (old + 1u == (gen + 1u) * nloc) {
            __builtin_amdgcn_fence(__ATOMIC_RELEASE, "agent");
            asm volatile("s_waitcnt vmcnt(0)" ::: "memory");
            const unsigned og = xb_add(&bar[XB_TOP], 1u);
            const unsigned tg = og / nx;
            if (og + 1u == (tg + 1u) * nx) xb_add(&bar[XB_TOPGEN], 1u);
            else XB_SPIN(xb_ld(&bar[XB_TOPGEN]) == tg, bar);
            __builtin_amdgcn_fence(__ATOMIC_ACQUIRE, "agent");
            xb_add(&bar[XB_XGEN(b.x)], 1u);
            asm volatile("s_waitcnt vmcnt(0)" ::: "memory");
        } else {
            XB_SPIN(xb_ld(&bar[XB_XGEN(b.x)]) == gen, bar);
            __builtin_amdgcn_fence(__ATOMIC_ACQUIRE, "agent");
            asm volatile("s_waitcnt vmcnt(0)" ::: "memory");
        }
    }
    __syncthreads();
}

struct Args { const float* in[22]; float* out; unsigned char* ws; int ph_lo, ph_hi; };
struct Ctx {
    lptr lds; int tid, lane, wave, nblk, blk;
    unsigned char* ws;
};

__device__ __forceinline__ void ln_rows(const Ctx& c, const float* src, const float* g, const float* b, float* outf, bf16_t* outb) {
    const int gw = c.blk * 8 + c.wave, nw = c.nblk * 8;
    for (int row0 = gw * 2; row0 < NTOK; row0 += nw * 2) {
        f32x4 v[2][4]; float mean[2], rstd[2];
#pragma unroll
        for (int rr = 0; rr < 2; ++rr) {
            const f32x4* p = (const f32x4*)(src + (size_t)(row0 + rr) * DM);
#pragma unroll
            for (int i = 0; i < 4; ++i) v[rr][i] = p[i * 64 + c.lane];
        }
#pragma unroll
        for (int rr = 0; rr < 2; ++rr) {
            float s = 0.f;
#pragma unroll
            for (int i = 0; i < 4; ++i) s += (v[rr][i][0] + v[rr][i][1]) + (v[rr][i][2] + v[rr][i][3]);
            mean[rr] = wave_sum(s) * (1.0f / 1024.0f);
            float q = 0.f;
#pragma unroll
            for (int i = 0; i < 4; ++i) { const f32x4 d = v[rr][i] - mean[rr]; q += (d[0] * d[0] + d[1] * d[1]) + (d[2] * d[2] + d[3] * d[3]); }
            rstd[rr] = rsqrtf(wave_sum(q) * (1.0f / 1024.0f) + LN_EPS);
        }
#pragma unroll
        for (int i = 0; i < 4; ++i) {
            const int idx = i * 64 + c.lane;
            const f32x4 gg = ((const f32x4*)g)[idx], bb = ((const f32x4*)b)[idx];
#pragma unroll
            for (int rr = 0; rr < 2; ++rr) {
                const f32x4 y = (v[rr][i] - mean[rr]) * rstd[rr] * gg + bb;
                if (outf) ((f32x4*)(outf + (size_t)(row0 + rr) * DM))[idx] = y;
                if (outb) { u32x2 w; w.x = pk_bf16(y[0], y[1]); w.y = pk_bf16(y[2], y[3]); ((u32x2*)(outb + (size_t)(row0 + rr) * DM))[idx] = w; }
            }
        }
    }
}

__device__ __forceinline__ int ycol_to_wcol(int j) {
    if (j < 1408) return j;
    if (j < 3200) return j + 12;
    if (j < 3212) return 1408 + (j - 3200);
    if (j < 3216) return -1;
    if (j < 3232) return 3212 + (j - 3216);
    return -1;
}
__device__ __forceinline__ void transpose_cvt(const Ctx& c, const float* src, int ld_src, int R, int c_off, int C, int Cpad, int mode, bf16_t* dst, int ld_dst) {
    LAS float* buf = (LAS float*)c.lds;
    const int nRt = R / 64, nCt = Cpad / 64;
    for (int tile = c.blk; tile < nRt * nCt; tile += c.nblk) {
        const int rt = tile % nRt, ct = tile / nRt;
        const int r0 = rt * 64, c0 = ct * 64;
        {
            const int row = c.tid >> 3, cc = (c.tid & 7) * 8;
            const float* sp = src + (size_t)(r0 + row) * ld_src;
            float v[8];
            bool fast = false; int sc0 = 0;
            if (mode == 0) { fast = (c0 + 64 <= C); sc0 = c_off + c0 + cc; }
            else { if (c0 + 64 <= 1408) { fast = true; sc0 = c0 + cc; } else if (c0 >= 1408 && c0 + 64 <= 3200) { fast = true; sc0 = c0 + cc + 12; } }
            if (fast) {
                const f32x4 a = *(const f32x4*)(sp + sc0), b = *(const f32x4*)(sp + sc0 + 4);
                v[0] = a[0]; v[1] = a[1]; v[2] = a[2]; v[3] = a[3]; v[4] = b[0]; v[5] = b[1]; v[6] = b[2]; v[7] = b[3];
            } else {
#pragma unroll
                for (int i = 0; i < 8; ++i) {
                    const int n = c0 + cc + i; int sc;
                    if (mode == 0) sc = (n < C) ? c_off + n : -1; else sc = ycol_to_wcol(n);
                    v[i] = (sc >= 0) ? sp[sc] : 0.f;
                }
            }
#pragma unroll
            for (int i = 0; i < 8; ++i) buf[row * 65 + cc + i] = v[i];
        }
        __syncthreads();
        {
            const int n = c.tid >> 3, kc = (c.tid & 7) * 8;
            float v[8];
#pragma unroll
            for (int i = 0; i < 8; ++i) v[i] = buf[(kc + i) * 65 + n];
            u32x4 w; w.x = pk_bf16(v[0], v[1]); w.y = pk_bf16(v[2], v[3]); w.z = pk_bf16(v[4], v[5]); w.w = pk_bf16(v[6], v[7]);
            *(u32x4*)(dst + (size_t)(c0 + n) * ld_dst + r0 + kc) = w;
        }
        __syncthreads();
    }
}
__device__ __forceinline__ void convert_flat(const Ctx& c, const float* src, bf16_t* dst, size_t n) {
    const size_t stride = (size_t)c.nblk * NTHREADS;
    for (size_t i = (size_t)c.blk * NTHREADS + c.tid; i < n / 8; i += stride) {
        const f32x4 a = ((const f32x4*)src)[2 * i], b = ((const f32x4*)src)[2 * i + 1];
        u32x4 w; w.x = pk_bf16(a[0], a[1]); w.y = pk_bf16(a[2], a[3]); w.z = pk_bf16(b[0], b[1]); w.w = pk_bf16(b[2], b[3]);
        ((u32x4*)dst)[i] = w;
    }
}

template <int WM, int WN>
__device__ __forceinline__ void gemm_kloop(const Ctx& c, f32x16 (&acc)[WM][WN], const bf16_t* A, int lda, const bf16_t* Bt, int ldb, int K, int kstepA = 64) {
    constexpr int BMt = 128 * WM, BNt = 64 * WN, STAGE = (BMt + BNt) * 144;
    constexpr int NA = BMt * 8 / NTHREADS, NBc = BNt * 8 / NTHREADS;
    static_assert(NBc >= 1, "tile too small");
    const lptr lds = c.lds;
    const int wm = c.wave >> 1, wn = c.wave & 1, r = c.lane & 31, h = c.lane >> 5;
    u32x4 ra[NA], rb[NBc];
    const int nk = K / 64;
#pragma unroll
    for (int i = 0; i < NA; ++i) { const int id = c.tid + i * NTHREADS; ra[i] = *(const u32x4*)(A + (size_t)(id >> 3) * lda + (id & 7) * 8); }
#pragma unroll
    for (int i = 0; i < NBc; ++i) { const int id = c.tid + i * NTHREADS; rb[i] = *(const u32x4*)(Bt + (size_t)(id >> 3) * ldb + (id & 7) * 8); }
#pragma unroll
    for (int i = 0; i < NA; ++i) { const int id = c.tid + i * NTHREADS; *(LAS u32x4*)(lds + (id >> 3) * 144 + (id & 7) * 16) = ra[i]; }
#pragma unroll
    for (int i = 0; i < NBc; ++i) { const int id = c.tid + i * NTHREADS; *(LAS u32x4*)(lds + BMt * 144 + (id >> 3) * 144 + (id & 7) * 16) = rb[i]; }
    __syncthreads();
    for (int kt = 0; kt < nk; ++kt) {
        const lptr cur = lds + (kt & 1) * STAGE, nxt = lds + ((kt + 1) & 1) * STAGE;
        const bool more = (kt + 1 < nk);
        if (more) {
            const int k0 = (kt + 1) * 64; const size_t k0a = (size_t)(kt + 1) * kstepA;
#pragma unroll
            for (int i = 0; i < NA; ++i) { const int id = c.tid + i * NTHREADS; ra[i] = *(const u32x4*)(A + (size_t)(id >> 3) * lda + k0a + (id & 7) * 8); }
#pragma unroll
            for (int i = 0; i < NBc; ++i) { const int id = c.tid + i * NTHREADS; rb[i] = *(const u32x4*)(Bt + (size_t)(id >> 3) * ldb + k0 + (id & 7) * 8); }
        }
        const lptr pa = cur + (wm * WM * 32 + r) * 144 + h * 16;
        const lptr pb = cur + BMt * 144 + (wn * WN * 32 + r) * 144 + h * 16;
#pragma unroll
        for (int s = 0; s < 4; ++s) {
            bf16x8 fa[WM], fb[WN];
#pragma unroll
            for (int i = 0; i < WM; ++i) fa[i] = *(LAS const bf16x8*)(pa + i * 32 * 144 + s * 32);
#pragma unroll
            for (int j = 0; j < WN; ++j) fb[j] = *(LAS const bf16x8*)(pb + j * 32 * 144 + s * 32);
#pragma unroll
            for (int i = 0; i < WM; ++i)
#pragma unroll
                for (int j = 0; j < WN; ++j) acc[i][j] = __builtin_amdgcn_mfma_f32_32x32x16_bf16(fb[j], fa[i], acc[i][j], 0, 0, 0);
        }
        if (more) {
#pragma unroll
            for (int i = 0; i < NA; ++i) { const int id = c.tid + i * NTHREADS; *(LAS u32x4*)(nxt + (id >> 3) * 144 + (id & 7) * 16) = ra[i]; }
#pragma unroll
            for (int i = 0; i < NBc; ++i) { const int id = c.tid + i * NTHREADS; *(LAS u32x4*)(nxt + BMt * 144 + (id >> 3) * 144 + (id & 7) * 16) = rb[i]; }
        }
        __syncthreads();
    }
}
template <int WM, int WN>
__device__ __forceinline__ void acc_zero(f32x16 (&acc)[WM][WN]) {
#pragma unroll
    for (int i = 0; i < WM; ++i)
#pragma unroll
        for (int j = 0; j < WN; ++j)
#pragma unroll
            for (int e = 0; e < 16; ++e) acc[i][j][e] = 0.f;
}

namespace pg8 {
#define PG8_LAS __attribute__((address_space(3)))
constexpr int BM = 256, BK = 64, HALF = 128, HTB = HALF * BK * 2  , STAGE_BYTES = 8 * HTB, NXCD = 8, WGM = 8;

__host__ __device__ __forceinline__ int lds_byte(int r, int c) { const int st = (r >> 4) * 2 + (c >> 5), rr = r & 15, cc = c & 31, ob = rr * 64 + cc * 2; return st * 1024 + (ob ^ (((ob >> 9) & 1) << 5)); }
__host__ __device__ __forceinline__ void stage_rc(int b, int& R, int& C) { const int st = b / 1024, sb = b % 1024, swz = sb ^ (((sb >> 9) & 1) << 5); R = (st >> 1) * 16 + swz / 64; C = (st & 1) * 32 + (swz % 64) / 2; }
__host__ __device__ __forceinline__ int perm32(int rho) { const int n = rho >> 4, i = rho & 15; return 8 * (i >> 2) + 4 * n + (i & 3); }
struct Unit { int pm, pn; };
struct Gemm { const bf16_t* A; const bf16_t* Bt; int M, N, K; };
struct StaticOrder {
    int nM, nN, nwg, G, c;
    __host__ __device__ void init(int M, int N, int G_, int c_) { nM = M / BM; nN = N / BM; nwg = nM * nN; G = G_; c = c_; }
    __host__ __device__ bool next(int i, Unit& u) const {
        const long L = (long)i * G + c; if (L >= nwg) return false;
        int wgid = (int)L; { const int q = nwg / NXCD, r = nwg % NXCD, xcd = wgid % NXCD, off = wgid / NXCD; wgid = (xcd < r ? xcd * (q + 1) : r * (q + 1) + (xcd - r) * q) + off; }
        const int nig = WGM * nN, gid = wgid / nig, fm = gid * WGM, gsz = (nM - fm) < WGM ? (nM - fm) : WGM;
        u.pm = fm + ((wgid % nig) % gsz); u.pn = (wgid % nig) / gsz; return true;
    }
    __device__ __forceinline__ void a_ready(const Unit&) const {}
    __device__ __forceinline__ void done(const Unit&) const {}
};
template <class Epi, class Sched>
__device__ __forceinline__ void gemm_phase(PG8_LAS unsigned char* lds, const Gemm g, const Sched& S, const Epi& E) {
    const int tid = threadIdx.x, wid = __builtin_amdgcn_readfirstlane(tid >> 6), lane = tid & 63, wr = wid >> 2, wc = wid & 3, fr = lane & 15, fq = lane >> 4;
    const int K = g.K, nt = K / BK;
    unsigned voffA[2], voffB[2];
#pragma unroll
    for (int i = 0; i < 2; ++i) { int R, C; stage_rc(tid * 16 + i * 8192, R, C); const int Rb = Epi::PERM ? ((R & ~31) + perm32(R & 31)) : R;
        voffA[i] = (unsigned)(R * K + C) * 2u; voffB[i] = (unsigned)(Rb * K + C) * 2u; }
    const size_t kstep = (size_t)(BK * 2);
    const size_t hstep = (size_t)HALF * K * 2;
    const size_t tstep = 2 * hstep;
    const unsigned ldsw = (unsigned)wid * 1024u;
    const int aoff = lds_byte(wr * 64 + fr, fq * 8), boff = lds_byte(wc * 32 + fr, fq * 8);
#define PG8_SA(b, h) (((b) * 2 + (h)) * HTB)
#define PG8_SB(b, h) ((4 + (b) * 2 + (h)) * HTB)
#define PG8_STAGE(bufoff, gbase, voff) do { _Pragma("unroll") for (int _i = 0; _i < 2; ++_i) \
        __builtin_amdgcn_global_load_lds((const unsigned*)((const char*)(gbase) + (voff)[_i]), (PG8_LAS unsigned*)(lds + (bufoff) + ldsw + _i * 8192), 16, 0, 0); } while (0)
#define PG8_LDA(dst, b, h) do { _Pragma("unroll") for (int m = 0; m < 4; ++m) _Pragma("unroll") for (int k = 0; k < 2; ++k) dst[m][k] = *(const PG8_LAS bf16x8*)(lds + PG8_SA(b, h) + aoff + m * 2048 + k * 1024); } while (0)
#define PG8_LDB(dst, b, h) do { _Pragma("unroll") for (int n = 0; n < 2; ++n) _Pragma("unroll") for (int k = 0; k < 2; ++k) dst[n][k] = *(const PG8_LAS bf16x8*)(lds + PG8_SB(b, h) + boff + n * 2048 + k * 1024); } while (0)
#define PG8_MMA(ai, bj, At, Bt) do { __builtin_amdgcn_s_setprio(1); _Pragma("unroll") for (int m = 0; m < 4; ++m) _Pragma("unroll") for (int n = 0; n < 2; ++n) _Pragma("unroll") for (int k = 0; k < 2; ++k) \
        acc[ai][bj][m][n] = __builtin_amdgcn_mfma_f32_16x16x32_bf16(Bt[n][k], At[m][k], acc[ai][bj][m][n], 0, 0, 0); __builtin_amdgcn_s_setprio(0); } while (0)
#define PG8_WAIT_V(n) asm volatile("s_waitcnt vmcnt(" #n ")" ::: "memory")
#define PG8_WAIT_L(n) asm volatile("s_waitcnt lgkmcnt(" #n ")" ::: "memory")
#define PG8_BAR __builtin_amdgcn_s_barrier()
#define PG8_SCHED __builtin_amdgcn_sched_barrier(0)
    Unit cur, nxt; int ui = 0;
    if (!S.next(0, cur)) return;
    f32x4 acc[2][2][4][2];
#pragma unroll
    for (int a = 0; a < 2; ++a)
#pragma unroll
        for (int b = 0; b < 2; ++b)
#pragma unroll
            for (int m = 0; m < 4; ++m)
#pragma unroll
                for (int n = 0; n < 2; ++n) acc[a][b][m][n] = (f32x4){0.f, 0.f, 0.f, 0.f};
    bf16x8 At[4][2], B0[2][2], B1[2][2];
    const char* cA = (const char*)g.A + (size_t)cur.pm * tstep; const char* cB = (const char*)g.Bt + (size_t)cur.pn * tstep;
    S.a_ready(cur);
    PG8_STAGE(PG8_SB(0, 0), cB, voffB); PG8_STAGE(PG8_SA(0, 0), cA, voffA); PG8_STAGE(PG8_SB(0, 1), cB + hstep, voffB); PG8_STAGE(PG8_SA(0, 1), cA + hstep, voffA);
    if (wr == 1) PG8_BAR;
    PG8_WAIT_V(4); PG8_BAR;
    PG8_STAGE(PG8_SB(1, 0), cB + kstep, voffB); PG8_STAGE(PG8_SA(1, 0), cA + kstep, voffA); PG8_STAGE(PG8_SB(1, 1), cB + hstep + kstep, voffB);
    PG8_WAIT_V(6); PG8_BAR;
    for (;;) {
        const bool has_next = S.next(ui + 1, nxt);
        const char* nA = has_next ? (const char*)g.A + (size_t)nxt.pm * tstep : cA; const char* nB = has_next ? (const char*)g.Bt + (size_t)nxt.pn * tstep : cB;
        for (int t = 0; t < nt; t += 2) {
            const bool last = (t == nt - 2);
            const char* a1 = cA + (size_t)(t + 1) * kstep;
            const char* a2 = last ? nA : cA + (size_t)(t + 2) * kstep; const char* b2 = last ? nB : cB + (size_t)(t + 2) * kstep;
            const char* a3 = a2 + kstep; const char* b3 = b2 + kstep;
            if (last && has_next) S.a_ready(nxt);
            PG8_LDB(B0, 0, 0); PG8_SCHED; PG8_LDA(At, 0, 0); PG8_STAGE(PG8_SA(1, 1), a1 + hstep, voffA);
            PG8_WAIT_L(8); PG8_BAR; PG8_WAIT_L(0); PG8_MMA(0, 0, At, B0); PG8_BAR; PG8_SCHED;
            PG8_LDB(B1, 0, 1); PG8_STAGE(PG8_SB(0, 0), b2, voffB);
            PG8_BAR; PG8_WAIT_L(0); PG8_MMA(0, 1, At, B1); PG8_BAR;
            PG8_LDA(At, 0, 1); PG8_STAGE(PG8_SA(0, 0), a2, voffA);
            PG8_BAR; PG8_WAIT_L(0); PG8_MMA(1, 0, At, B0); PG8_BAR; PG8_SCHED;
            PG8_STAGE(PG8_SB(0, 1), b2 + hstep, voffB);
            PG8_WAIT_V(6); PG8_BAR; PG8_MMA(1, 1, At, B1); PG8_BAR;
            PG8_LDB(B0, 1, 0); PG8_SCHED; PG8_LDA(At, 1, 0); PG8_STAGE(PG8_SA(0, 1), a2 + hstep, voffA);
            PG8_WAIT_L(8); PG8_BAR; PG8_WAIT_L(0); PG8_MMA(0, 0, At, B0); PG8_BAR; PG8_SCHED;
            PG8_LDB(B1, 1, 1); PG8_STAGE(PG8_SB(1, 0), b3, voffB);
            PG8_BAR; PG8_WAIT_L(0); PG8_MMA(0, 1, At, B1); PG8_BAR;
            PG8_LDA(At, 1, 1); PG8_STAGE(PG8_SA(1, 0), a3, voffA);
            PG8_BAR; PG8_WAIT_L(0); PG8_MMA(1, 0, At, B0); PG8_BAR; PG8_SCHED;
            PG8_STAGE(PG8_SB(1, 1), b3 + hstep, voffB);
            PG8_WAIT_V(6); PG8_BAR; PG8_MMA(1, 1, At, B1); PG8_BAR;
        }
        if constexpr (!Epi::AFTER_DRAIN) { E(acc, cur, wr, wc, fr, fq); S.done(cur); }
        if (!has_next) break;
#pragma unroll
        for (int a = 0; a < 2; ++a)
#pragma unroll
            for (int b = 0; b < 2; ++b)
#pragma unroll
                for (int m = 0; m < 4; ++m)
#pragma unroll
                    for (int n = 0; n < 2; ++n) acc[a][b][m][n] = (f32x4){0.f, 0.f, 0.f, 0.f};
        cur = nxt; cA = nA; cB = nB; ++ui;
    }
    PG8_WAIT_V(0);
    if (wr == 0) PG8_BAR;
    PG8_BAR;
    if constexpr (Epi::AFTER_DRAIN) { E.fused(acc, cur, wr, wc, fr, fq, lds, wid, lane); S.done(cur); }
#undef PG8_SA
#undef PG8_SB
#undef PG8_STAGE
#undef PG8_LDA
#undef PG8_LDB
#undef PG8_MMA
#undef PG8_WAIT_V
#undef PG8_WAIT_L
#undef PG8_BAR
#undef PG8_SCHED
}

struct EpiStoreBf16 {
    static constexpr bool PERM = true, AFTER_DRAIN = false;
    bf16_t* O; int ldc;
    __device__ __forceinline__ void operator()(const f32x4 (&acc)[2][2][4][2], const Unit& u, int wr, int wc, int fr, int fq) const {
        const int row0 = u.pm * BM + wr * 64 + fr, col0 = u.pn * BM + wc * 32 + 8 * fq;
#pragma unroll
        for (int ai = 0; ai < 2; ++ai)
#pragma unroll
            for (int m = 0; m < 4; ++m) { bf16_t* rowp = O + (size_t)(row0 + ai * HALF + m * 16) * ldc + col0;
#pragma unroll
                for (int bj = 0; bj < 2; ++bj) { const f32x4 v0 = acc[ai][bj][m][0], v1 = acc[ai][bj][m][1];
                    u32x4 w; w.x = pk_bf16(v0[0], v0[1]); w.y = pk_bf16(v0[2], v0[3]); w.z = pk_bf16(v1[0], v1[1]); w.w = pk_bf16(v1[2], v1[3]);
                    *(u32x4*)(rowp + bj * HALF) = w; } }
    }
};
struct EpiResidF32 {
    static constexpr bool PERM = false, AFTER_DRAIN = false;
    const float* R; float* C; int ldc; float alpha;
    __device__ __forceinline__ void operator()(const f32x4 (&acc)[2][2][4][2], const Unit& u, int wr, int wc, int fr, int fq) const {
        const int row0 = u.pm * BM + wr * 64 + fr, col0 = u.pn * BM + wc * 32 + 4 * fq;
#pragma unroll
        for (int ai = 0; ai < 2; ++ai)
#pragma unroll
            for (int m = 0; m < 4; ++m) { const size_t ro = (size_t)(row0 + ai * HALF + m * 16) * ldc + col0;
#pragma unroll
                for (int bj = 0; bj < 2; ++bj)
#pragma unroll
                    for (int n = 0; n < 2; ++n) { const f32x4 x = *(const f32x4*)(R + ro + bj * HALF + n * 16); *(f32x4*)(C + ro + bj * HALF + n * 16) = x * alpha + acc[ai][bj][m][n]; } }
    }
};

struct EpiYG {
    static constexpr bool PERM = true, AFTER_DRAIN = false;
    bf16_t* Yp; unsigned char* Gp;
    __device__ __forceinline__ void operator()(const f32x4 (&acc)[2][2][4][2], const Unit& u, int wr, int wc, int fr, int fq) const {
        const int row0 = u.pm * BM + wr * 64 + fr;
        if (u.pn < NY / 256) {
            const int col0 = u.pn * BM + wc * 32 + 8 * fq;
#pragma unroll
            for (int ai = 0; ai < 2; ++ai)
#pragma unroll
                for (int m = 0; m < 4; ++m) { bf16_t* rowp = Yp + (size_t)(row0 + ai * HALF + m * 16) * NY + col0;
#pragma unroll
                    for (int bj = 0; bj < 2; ++bj) { const f32x4 v0 = acc[ai][bj][m][0], v1 = acc[ai][bj][m][1];
                        u32x4 w; w.x = pk_bf16(v0[0], v0[1]); w.y = pk_bf16(v0[2], v0[3]); w.z = pk_bf16(v1[0], v1[1]); w.w = pk_bf16(v1[2], v1[3]);
                        *(u32x4*)(rowp + bj * HALF) = w; } }
        } else {
            const int col0 = (u.pn - NY / 256) * BM + wc * 32 + 8 * fq;
#pragma unroll
            for (int ai = 0; ai < 2; ++ai)
#pragma unroll
                for (int m = 0; m < 4; ++m) { unsigned char* rowp = Gp + (size_t)(row0 + ai * HALF + m * 16) * 4096 + col0;
#pragma unroll
                    for (int bj = 0; bj < 2; ++bj) { const f32x4 v0 = acc[ai][bj][m][0], v1 = acc[ai][bj][m][1];
                        unsigned lo = 0u, hi = 0u;
#pragma unroll
                        for (int e = 0; e < 4; ++e) {
                            lo |= (unsigned)(int)__builtin_rintf(255.0f * sigmoidf_(v0[e])) << (8 * e);
                            hi |= (unsigned)(int)__builtin_rintf(255.0f * sigmoidf_(v1[e])) << (8 * e);
                        }
                        u32x2 w; w.x = lo; w.y = hi;
                        *(u32x2*)(rowp + bj * HALF) = w; } }
        }
    }
};
}

#define EPI_LOOP(WM_, WN_)                                                                  \
    _Pragma("unroll") for (int i = 0; i < WM_; ++i)                                         \
    _Pragma("unroll") for (int j = 0; j < WN_; ++j)                                         \
    _Pragma("unroll") for (int g = 0; g < 4; ++g)

__device__ __forceinline__ void phase_inproj(const Ctx& c, const bf16_t* hb, const bf16_t* Wt, bf16_t* Y) {
    constexpr int NTN = NY / 128;
    const int wm = c.wave >> 1, wn = c.wave & 1, r = c.lane & 31, h = c.lane >> 5;
    for (int u = c.blk; u < 64 * NTN; u += c.nblk) {
        const int pm = u / NTN, pn = u % NTN;
        f32x16 acc[2][2]; acc_zero<2, 2>(acc);
        gemm_kloop<2, 2>(c, acc, hb + (size_t)pm * 256 * DM, DM, Wt + (size_t)pn * 128 * DM, DM, DM);
        EPI_LOOP(2, 2) {
            const int m = pm * 256 + (wm * 2 + i) * 32 + r, n = pn * 128 + (wn * 2 + j) * 32 + 8 * g + 4 * h;
            u32x2 w; w.x = pk_bf16(acc[i][j][4 * g], acc[i][j][4 * g + 1]); w.y = pk_bf16(acc[i][j][4 * g + 2], acc[i][j][4 * g + 3]);
            *(u32x2*)(Y + (size_t)m * NY + n) = w;
        }
    }
}
__device__ __forceinline__ void phase_merge(const Ctx& c, const bf16_t* hb, const bf16_t* Wg, const bf16_t* O, const bf16_t* Wb, bf16_t* MIX) {
    const int wm = c.wave >> 1, wn = c.wave & 1, r = c.lane & 31, h = c.lane >> 5;
    for (int u = c.blk; u < 128 * 8; u += c.nblk) {
        const int pm = u >> 3, pn = u & 7;
        f32x16 mix[1][2]; acc_zero<1, 2>(mix);
#pragma unroll 1
        for (int nb = 0; nb < 4; ++nb) {
            f32x16 ag[1][2]; acc_zero<1, 2>(ag);
            gemm_kloop<1, 2>(c, ag, hb + (size_t)pm * 128 * DM, DM, Wg + ((size_t)nb * 1024 + pn * 128) * DM, DM, DM);
            f32x16 ap[1][2]; acc_zero<1, 2>(ap);
            gemm_kloop<1, 2>(c, ap, O + (size_t)pm * 128 * DM + nb * 256, DM, Wb + ((size_t)nb * 1024 + pn * 128) * 256, 256, 256);
#pragma unroll
            for (int j = 0; j < 2; ++j)
#pragma unroll
                for (int e = 0; e < 16; ++e) mix[0][j][e] += sigmoidf_(ag[0][j][e]) * ap[0][j][e];
        }
        EPI_LOOP(1, 2) {
            const int m = pm * 128 + (wm + i) * 32 + r, n = pn * 128 + (wn * 2 + j) * 32 + 8 * g + 4 * h;
            u32x2 w; w.x = pk_bf16(mix[i][j][4 * g], mix[i][j][4 * g + 1]); w.y = pk_bf16(mix[i][j][4 * g + 2], mix[i][j][4 * g + 3]);
            *(u32x2*)(MIX + (size_t)m * DM + n) = w;
        }
    }
}
__device__ __forceinline__ void phase_outproj(const Ctx& c, const bf16_t* MIX, const bf16_t* Wo, const float* hf, float* Z) {
    const int wm = c.wave >> 1, wn = c.wave & 1, r = c.lane & 31, h = c.lane >> 5;
    for (int u = c.blk; u < 64 * 8; u += c.nblk) {
        const int pm = u >> 3, pn = u & 7;
        f32x16 acc[2][2]; acc_zero<2, 2>(acc);
        gemm_kloop<2, 2>(c, acc, MIX + (size_t)pm * 256 * DM, DM, Wo + (size_t)pn * 128 * DM, DM, DM);
        EPI_LOOP(2, 2) {
            const int m = pm * 256 + (wm * 2 + i) * 32 + r, n = pn * 128 + (wn * 2 + j) * 32 + 8 * g + 4 * h;
            const f32x4 x = *(const f32x4*)(hf + (size_t)m * DM + n);
            f32x4 y; y[0] = DN_ALPHA * x[0] + acc[i][j][4 * g]; y[1] = DN_ALPHA * x[1] + acc[i][j][4 * g + 1]; y[2] = DN_ALPHA * x[2] + acc[i][j][4 * g + 2]; y[3] = DN_ALPHA * x[3] + acc[i][j][4 * g + 3];
            *(f32x4*)(Z + (size_t)m * DM + n) = y;
        }
    }
}
__device__ __forceinline__ void phase_wq(const Ctx& c, const bf16_t* hb, const bf16_t* Wq, bf16_t* QV) {
    const int wm = c.wave >> 1, wn = c.wave & 1, r = c.lane & 31, h = c.lane >> 5;
    for (int u = c.blk; u < 64 * 16; u += c.nblk) {
        const int pm = u >> 4, pn = u & 15;
        f32x16 acc[2][2]; acc_zero<2, 2>(acc);
        gemm_kloop<2, 2>(c, acc, hb + (size_t)pm * 256 * DM, DM, Wq + (size_t)pn * 128 * DM, DM, DM);
        EPI_LOOP(2, 2) {
            const int m = pm * 256 + (wm * 2 + i) * 32 + r, n = pn * 128 + (wn * 2 + j) * 32 + 8 * g + 4 * h;
            u32x2 w; w.x = pk_bf16(acc[i][j][4 * g], acc[i][j][4 * g + 1]); w.y = pk_bf16(acc[i][j][4 * g + 2], acc[i][j][4 * g + 3]);
            *(u32x2*)(QV + (size_t)m * 2048 + n) = w;
        }
    }
}

__device__ __forceinline__ void phase_inproj_pg8(const Ctx& c, const bf16_t* hb, const bf16_t* Wt, bf16_t* Y) {
    pg8::Gemm g{hb, Wt, NTOK, NY, DM}; pg8::StaticOrder S; S.init(NTOK, NY, c.nblk, c.blk);
    pg8::EpiStoreBf16 E{Y, NY};
    pg8::gemm_phase<pg8::EpiStoreBf16, pg8::StaticOrder>(c.lds, g, S, E);
}
__device__ __forceinline__ void phase_wq_pg8(const Ctx& c, const bf16_t* hb, const bf16_t* Wq, bf16_t* QV) {
    pg8::Gemm g{hb, Wq, NTOK, 2048, DM}; pg8::StaticOrder S; S.init(NTOK, 2048, c.nblk, c.blk);
    pg8::EpiStoreBf16 E{QV, 2048};
    pg8::gemm_phase<pg8::EpiStoreBf16, pg8::StaticOrder>(c.lds, g, S, E);
}
__device__ __forceinline__ void phase_outproj_pg8(const Ctx& c, const bf16_t* MIX, const bf16_t* Wo, const float* hf, float* Z) {
    pg8::Gemm g{MIX, Wo, NTOK, DM, DM}; pg8::StaticOrder S; S.init(NTOK, DM, c.nblk, c.blk);
    pg8::EpiResidF32 E{hf, Z, DM, DN_ALPHA};
    pg8::gemm_phase<pg8::EpiResidF32, pg8::StaticOrder>(c.lds, g, S, E);
}

__device__ __forceinline__ void phase_inproj_gates_pg8(const Ctx& c, const bf16_t* hb, const bf16_t* Wt, bf16_t* Yp, unsigned char* Gp) {
    pg8::Gemm g{hb, Wt, NTOK, NIN, DM}; pg8::StaticOrder S; S.init(NTOK, NIN, c.nblk, c.blk);
    pg8::EpiYG E{Yp, Gp};
    pg8::gemm_phase<pg8::EpiYG, pg8::StaticOrder>(c.lds, g, S, E);
}
__device__ __forceinline__ void phase_merge2(const Ctx& c, const unsigned char* Gp, const bf16_t* Op, const bf16_t* Wb, bf16_t* MIXp) {
    const int wm = c.wave >> 1, wn = c.wave & 1, r = c.lane & 31, h = c.lane >> 5;
    for (int u = c.blk; u < 64 * 8; u += c.nblk) {
        const int pm = u >> 3, pn = u & 7;
        f32x16 mix[2][2]; acc_zero<2, 2>(mix);
#pragma unroll 1
        for (int nb = 0; nb < 4; ++nb) {
            f32x16 ap[2][2]; acc_zero<2, 2>(ap);
            gemm_kloop<2, 2>(c, ap, Op + (size_t)pm * 256 * DM + nb * 256, DM, Wb + ((size_t)nb * 1024 + pn * 128) * 256, 256, 256);
            EPI_LOOP(2, 2) {
                const int m = pm * 256 + (wm * 2 + i) * 32 + r, n = pn * 128 + (wn * 2 + j) * 32 + 8 * g + 4 * h;
                const unsigned gq = *(const unsigned*)(Gp + (size_t)m * 4096 + nb * 1024 + n);
                mix[i][j][4 * g + 0] += (float)(gq & 0xffu) * (1.0f / 255.0f) * ap[i][j][4 * g + 0];
                mix[i][j][4 * g + 1] += (float)((gq >> 8) & 0xffu) * (1.0f / 255.0f) * ap[i][j][4 * g + 1];
                mix[i][j][4 * g + 2] += (float)((gq >> 16) & 0xffu) * (1.0f / 255.0f) * ap[i][j][4 * g + 2];
                mix[i][j][4 * g + 3] += (float)(gq >> 24) * (1.0f / 255.0f) * ap[i][j][4 * g + 3];
            }
        }
        EPI_LOOP(2, 2) {
            const int m = pm * 256 + (wm * 2 + i) * 32 + r, n = pn * 128 + (wn * 2 + j) * 32 + 8 * g + 4 * h;
            u32x2 w; w.x = pk_bf16(mix[i][j][4 * g], mix[i][j][4 * g + 1]); w.y = pk_bf16(mix[i][j][4 * g + 2], mix[i][j][4 * g + 3]);
            *(u32x2*)(MIXp + (size_t)m * DM + n) = w;
        }
    }
}

__device__ __forceinline__ f32x16 mma_lds(f32x16 acc, lptr A, int sa, lptr B, int sb, int K, int lane) {
    const int r = lane & 31, h = lane >> 5;
    const lptr pa = A + r * sa + h * 16, pb = B + r * sb + h * 16;
    for (int k = 0; k < K; k += 16) {
        const bf16x8 a = *(LAS const bf16x8*)(pa + k * 2), b = *(LAS const bf16x8*)(pb + k * 2);
        acc = __builtin_amdgcn_mfma_f32_32x32x16_bf16(b, a, acc, 0, 0, 0);
    }
    return acc;
}
__device__ __forceinline__ f32x16 zero16() { f32x16 z;
#pragma unroll
    for (int e = 0; e < 16; ++e) z[e] = 0.f; return z; }

__device__ __forceinline__ void sb_wave_unit(const bf16_t* Y, bf16_t* O, int b, int hh, int qt, lptr wl, int lane) {
    const int t = qt * 64 + lane;
    const size_t row = (size_t)b * SEQ + t;
    unsigned q[32];
    {
        const u32x4* qp = (const u32x4*)(Y + row * NY + C_SBQ + hh * 64);
#pragma unroll
        for (int i = 0; i < 8; ++i) { const u32x4 v = qp[i]; q[4 * i] = v.x; q[4 * i + 1] = v.y; q[4 * i + 2] = v.z; q[4 * i + 3] = v.w; }
    }
    float acc[64];
#pragma unroll
    for (int e = 0; e < 64; ++e) acc[e] = 0.f;
    float C = 0.f;
    for (int kt = qt; kt >= 0; --kt) {
        {
            const size_t krow = (size_t)b * SEQ + kt * 64 + lane;
            const u32x4* kp = (const u32x4*)(Y + krow * NY + C_SBK + hh * 64);
            const u32x4* vp = (const u32x4*)(Y + krow * NY + C_SBV + hh * 64);
            u32x4 kr[8], vr[8];
#pragma unroll
            for (int i = 0; i < 8; ++i) { kr[i] = kp[i]; vr[i] = vp[i]; }
#pragma unroll
            for (int i = 0; i < 8; ++i) { *(LAS u32x4*)(wl + lane * 144 + i * 16) = kr[i]; *(LAS u32x4*)(wl + 9216 + lane * 144 + i * 16) = vr[i]; }
        }
        asm volatile("s_waitcnt lgkmcnt(0)" ::: "memory");
        const int s_hi = (kt == qt) ? 62 : 63;
#pragma unroll 1
        for (int s = s_hi; s >= 0; --s) {
            const int pos = kt * 64 + s;
            float z0 = 0.f, z1 = 0.f;
#pragma unroll
            for (int i = 0; i < 8; ++i) {
                const u32x4 kv = *(LAS const u32x4*)(wl + s * 144 + i * 16);
                z0 = dot2bf(q[4 * i], kv.x, z0); z1 = dot2bf(q[4 * i + 1], kv.y, z1); z0 = dot2bf(q[4 * i + 2], kv.z, z0); z1 = dot2bf(q[4 * i + 3], kv.w, z1);
            }
            const float z = (z0 + z1) * 0.125f;
            const bool valid = pos < t;
            const float Cn = C - softplusf_(z);
            const float w = valid ? __expf(z + Cn) : 0.f;
            C = valid ? Cn : C;
#pragma unroll
            for (int i = 0; i < 8; ++i) {
                const u32x4 vv = *(LAS const u32x4*)(wl + 9216 + s * 144 + i * 16);
                acc[8 * i + 0] += w * bf_lo(vv.x); acc[8 * i + 1] += w * bf_hi(vv.x); acc[8 * i + 2] += w * bf_lo(vv.y); acc[8 * i + 3] += w * bf_hi(vv.y);
                acc[8 * i + 4] += w * bf_lo(vv.z); acc[8 * i + 5] += w * bf_hi(vv.z); acc[8 * i + 6] += w * bf_lo(vv.w); acc[8 * i + 7] += w * bf_hi(vv.w);
            }
        }
        asm volatile("" ::: "memory");
        if (__all(C < -104.0f)) break;
    }
    u32x4* op = (u32x4*)(O + row * DM + 0 * 256 + hh * 64);
#pragma unroll
    for (int i = 0; i < 8; ++i) {
        u32x4 w; w.x = pk_bf16(acc[8 * i], acc[8 * i + 1]); w.y = pk_bf16(acc[8 * i + 2], acc[8 * i + 3]); w.z = pk_bf16(acc[8 * i + 4], acc[8 * i + 5]); w.w = pk_bf16(acc[8 * i + 6], acc[8 * i + 7]);
        op[i] = w;
    }
}
__device__ __forceinline__ void phase_sb(const Ctx& c, const bf16_t* Y, bf16_t* O) {
    const lptr wl = c.lds + c.wave * 18432;
    for (int u = c.blk * 8 + c.wave; u < 1024; u += c.nblk * 8) {
        const int qt = u & 127, hh = (u >> 7) & 3, b = u >> 9;
        sb_wave_unit(Y, O, b, hh, qt, wl, c.lane);
    }
    __syncthreads();
}

__device__ __forceinline__ void phase_compress(const Ctx& c, const bf16_t* Y, const float* pos, const float* wk, const float* wv, bf16_t* KC, bf16_t* VC) {
    LAS float* kl = (LAS float*)c.lds;
    LAS float* pl = (LAS float*)(c.lds + 144 * 64 * 4);
    for (int u = c.blk; u < 256; u += c.nblk) {
        const int cg = u & 63, kv = (u >> 6) & 1, b = u >> 7;
        const int c0 = cg * 8;
        const int col = kv ? C_NVC : C_NKC;
        for (int i = c.tid; i < 144 * 64; i += NTHREADS) {
            const int tr = i >> 6, d = i & 63, tok = c0 * 16 + tr;
            kl[i] = (tok < SEQ) ? bf2f(Y[((size_t)b * SEQ + tok) * NY + col + d]) : 0.f;
        }
        for (int i = c.tid; i < 32 * 64; i += NTHREADS) pl[i] = pos[i];
        __syncthreads();
        const int cl = c.tid >> 6, d = c.tid & 63, cc = c0 + cl;
        const float* w = kv ? wv : wk;
        float a0 = 0.f, a1 = 0.f;
#pragma unroll 4
        for (int l = 0; l < 32; ++l) {
            const LAS float* kr = kl + (cl * 16 + l) * 64;
            const LAS float* pr = pl + l * 64;
            const float* wr = w + (size_t)l * 64 * 64 + d;
#pragma unroll 8
            for (int dp = 0; dp < 64; dp += 2) {
                a0 += (kr[dp] + pr[dp]) * wr[(size_t)dp * 64];
                a1 += (kr[dp + 1] + pr[dp + 1]) * wr[(size_t)(dp + 1) * 64];
            }
        }
        bf16_t* dst = kv ? VC : KC;
        dst[((size_t)b * 512 + cc) * 64 + d] = (cc < 511) ? f2bf(a0 + a1) : (bf16_t)0;
        __syncthreads();
    }
}

__device__ __forceinline__ void phase_compress2(const Ctx& c, const bf16_t* Y, const bf16_t* WC, float* RC) {
    const int wm = c.wave >> 1, wn = c.wave & 1, r = c.lane & 31, h = c.lane >> 5;
    for (int u = c.blk; u < 16; u += c.nblk) {
        const int rt = u & 3, kv = (u >> 2) & 1, b = u >> 3;
        f32x16 acc[1][2]; acc_zero<1, 2>(acc);
        gemm_kloop<1, 2>(c, acc, Y + ((size_t)b * SEQ + (size_t)rt * 128 * 16) * NY + (kv ? C_NVC : C_NKC), 16 * NY, WC + (size_t)kv * 128 * 1024, 1024, 1024, NY);
        EPI_LOOP(1, 2) {
            const int m = rt * 128 + (wm + i) * 32 + r, n = (wn * 2 + j) * 32 + 8 * g + 4 * h;
            f32x4 o; o[0] = acc[i][j][4 * g]; o[1] = acc[i][j][4 * g + 1]; o[2] = acc[i][j][4 * g + 2]; o[3] = acc[i][j][4 * g + 3];
            *(f32x4*)(RC + ((size_t)(b * 2 + kv) * 512 + m) * 128 + n) = o;
        }
    }
}
__device__ __forceinline__ void phase_compress_combine(const Ctx& c, const float* RC, const float* CB, bf16_t* KC, bf16_t* VC) {
    for (int i = c.blk * NTHREADS + c.tid; i < 2 * 2 * 512 * 64; i += c.nblk * NTHREADS) {
        const int d = i & 63, cc = (i >> 6) & 511, kv = (i >> 15) & 1, b = i >> 16;
        const float* R = RC + (size_t)(b * 2 + kv) * 512 * 128;
        const float v = (cc < 511) ? R[cc * 128 + d] + R[(cc + 1) * 128 + 64 + d] + CB[kv * 64 + d] : 0.f;
        (kv ? VC : KC)[((size_t)b * 512 + cc) * 64 + d] = f2bf(v);
    }
}

__device__ __forceinline__ float ret_logg(int h) { return log1pf(-exp2f(-5.0f - (float)h)); }
__device__ __forceinline__ void phase_ret_local(const Ctx& c, const bf16_t* Y, float* UST) {
    const lptr Kt = c.lds, Vt = c.lds + 64 * 272;
    for (int u = c.blk; u < 512; u += c.nblk) {
        const int i = u & 63, hh = (u >> 6) & 3, b = u >> 8;
        const float lg = ret_logg(hh);
        {
            const int j = c.tid >> 2, dc = (c.tid & 3) * 16;
            const size_t row = (size_t)b * SEQ + i * 128 + j;
            const float kd = __expf(lg * (float)(127 - j)) * 0.125f;
            const u32x4* kp = (const u32x4*)(Y + row * NY + C_RK + hh * 64 + dc);
            const u32x4* vp = (const u32x4*)(Y + row * NY + C_RV + hh * 64 + dc);
            const u32x4 k0 = kp[0], k1 = kp[1], v0 = vp[0], v1 = vp[1];
            const unsigned kk[8] = {k0.x, k0.y, k0.z, k0.w, k1.x, k1.y, k1.z, k1.w};
            const unsigned vv[8] = {v0.x, v0.y, v0.z, v0.w, v1.x, v1.y, v1.z, v1.w};
#pragma unroll
            for (int e = 0; e < 8; ++e) {
                *(LAS bf16_t*)(Kt + (dc + 2 * e) * 272 + j * 2) = f2bf(bf_lo(kk[e]) * kd);
                *(LAS bf16_t*)(Kt + (dc + 2 * e + 1) * 272 + j * 2) = f2bf(bf_hi(kk[e]) * kd);
                *(LAS bf16_t*)(Vt + (dc + 2 * e) * 272 + j * 2) = (bf16_t)(vv[e] & 0xffffu);
                *(LAS bf16_t*)(Vt + (dc + 2 * e + 1) * 272 + j * 2) = (bf16_t)(vv[e] >> 16);
            }
        }
        __syncthreads();
        if (c.wave < 4) {
            const int wm = c.wave >> 1, wn = c.wave & 1, r = c.lane & 31, h = c.lane >> 5;
            f32x16 acc = mma_lds(zero16(), Kt + wm * 32 * 272, 272, Vt + wn * 32 * 272, 272, 128, c.lane);
            float* dst = UST + (((size_t)(b * 4 + hh) * 64 + i) * 64 + wm * 32 + r) * 64 + wn * 32 + 4 * h;
#pragma unroll
            for (int g = 0; g < 4; ++g) { f32x4 o; o[0] = acc[4 * g]; o[1] = acc[4 * g + 1]; o[2] = acc[4 * g + 2]; o[3] = acc[4 * g + 3]; *(f32x4*)(dst + 8 * g) = o; }
        }
        __syncthreads();
    }
}
__device__ __forceinline__ void phase_scans(const Ctx& c, const float* UST, float* RST, const float* UGLA, float* SGLA, const float* BL) {
    for (int u = c.blk; u < 96; u += c.nblk) {
        if (u < 64) {
            const int ch = u * NTHREADS + c.tid;
            const int bh = ch >> 12, de = ch & 4095;
            const float cd = __expf(ret_logg(bh & 3) * 128.0f);
            const float* up = UST + (size_t)bh * 64 * 4096 + de; float* rp = RST + (size_t)bh * 64 * 4096 + de;
            float R = 0.f;
            for (int i0 = 0; i0 < 64; i0 += 16) {
                float uv[16];
#pragma unroll
                for (int j = 0; j < 16; ++j) uv[j] = up[(size_t)(i0 + j) * 4096];
#pragma unroll
                for (int j = 0; j < 16; ++j) { rp[(size_t)(i0 + j) * 4096] = R; R = cd * R + uv[j]; }
            }
        } else {
            const int ch = (u - 64) * NTHREADS + c.tid;
            const int bh = ch >> 11, ke = ch & 2047, k = ke >> 6;
            const float* up = UGLA + (size_t)bh * 128 * 2048 + ke; float* sp = SGLA + (size_t)bh * 128 * 2048 + ke;
            const float* bl = BL + (size_t)bh * 128 * 32 + k;
            float S = 0.f;
            for (int i0 = 0; i0 < 128; i0 += 16) {
                float uv[16], dv[16];
#pragma unroll
                for (int j = 0; j < 16; ++j) { uv[j] = up[(size_t)(i0 + j) * 2048]; dv[j] = bl[(i0 + j) * 32]; }
#pragma unroll
                for (int j = 0; j < 16; ++j) { sp[(size_t)(i0 + j) * 2048] = S; S = __expf(dv[j]) * S + uv[j]; }
            }
        }
    }
}
__device__ __forceinline__ void phase_ret_out(const Ctx& c, const bf16_t* Y, const float* RST, const float* gn_g, const float* gn_b, bf16_t* O) {
    const lptr Qs = c.lds, Ks = c.lds + 18432, Vt = c.lds + 36864, Rt = c.lds + 54272, Att = c.lds + 63488;
    LAS float* Of = (LAS float*)(c.lds + 98304);
    for (int u = c.blk; u < 512; u += c.nblk) {
        const int i = u & 63, hh = (u >> 6) & 3, b = u >> 8;
        const float lg = ret_logg(hh);
        const size_t row0 = (size_t)b * SEQ + i * 128;
        {
            const int j = c.tid >> 2, dc = (c.tid & 3) * 16;
            const size_t row = row0 + j;
            const u32x4* qp = (const u32x4*)(Y + row * NY + C_RQ + hh * 64 + dc);
            const u32x4* kp = (const u32x4*)(Y + row * NY + C_RK + hh * 64 + dc);
            const u32x4* vp = (const u32x4*)(Y + row * NY + C_RV + hh * 64 + dc);
            const u32x4 q0 = qp[0], q1 = qp[1], k0 = kp[0], k1 = kp[1], v0 = vp[0], v1 = vp[1];
            *(LAS u32x4*)(Qs + j * 144 + dc * 2) = q0; *(LAS u32x4*)(Qs + j * 144 + dc * 2 + 16) = q1;
            *(LAS u32x4*)(Ks + j * 144 + dc * 2) = k0; *(LAS u32x4*)(Ks + j * 144 + dc * 2 + 16) = k1;
            const unsigned vv[8] = {v0.x, v0.y, v0.z, v0.w, v1.x, v1.y, v1.z, v1.w};
#pragma unroll
            for (int e = 0; e < 8; ++e) {
                *(LAS bf16_t*)(Vt + (dc + 2 * e) * 272 + j * 2) = (bf16_t)(vv[e] & 0xffffu);
                *(LAS bf16_t*)(Vt + (dc + 2 * e + 1) * 272 + j * 2) = (bf16_t)(vv[e] >> 16);
            }
            const int d = c.tid >> 3, ec = (c.tid & 7) * 8;
            const float* rp = RST + (((size_t)(b * 4 + hh) * 64 + i) * 64 + d) * 64 + ec;
            const f32x4 r0 = *(const f32x4*)rp, r1 = *(const f32x4*)(rp + 4);
            const float rv[8] = {r0[0], r0[1], r0[2], r0[3], r1[0], r1[1], r1[2], r1[3]};
#pragma unroll
            for (int e = 0; e < 8; ++e) *(LAS bf16_t*)(Rt + (ec + e) * 144 + d * 2) = f2bf(rv[e]);
        }
        __syncthreads();
        const int r = c.lane & 31, h = c.lane >> 5;
        {
            const int mi = c.wave >> 1;
#pragma unroll
            for (int jj = 0; jj < 2; ++jj) {
                const int nj = (c.wave & 1) * 2 + jj;
                if (nj <= mi) {
                    f32x16 s = mma_lds(zero16(), Qs + mi * 32 * 144, 144, Ks + nj * 32 * 144, 144, 64, c.lane);
                    const int ii = mi * 32 + r;
#pragma unroll
                    for (int g = 0; g < 4; ++g) {
                        float p[4];
#pragma unroll
                        for (int e = 0; e < 4; ++e) { const int jx = nj * 32 + 8 * g + 4 * h + e; const int df = ii - jx; p[e] = (df >= 0) ? s[4 * g + e] * 0.125f * __expf(lg * (float)df) : 0.f; }
                        u32x2 w; w.x = pk_bf16(p[0], p[1]); w.y = pk_bf16(p[2], p[3]);
                        *(LAS u32x2*)(Att + ii * 272 + (nj * 32 + 8 * g + 4 * h) * 2) = w;
                    }
                }
            }
        }
        __syncthreads();
        {
            const int wm = c.wave >> 1, wn = c.wave & 1;
            f32x16 acc = mma_lds(zero16(), Qs + wm * 32 * 144, 144, Rt + wn * 32 * 144, 144, 64, c.lane);
            const int ii = wm * 32 + r;
            const float qd = __expf(lg * (float)(ii + 1));
#pragma unroll
            for (int e = 0; e < 16; ++e) acc[e] *= qd;
            acc = mma_lds(acc, Att + wm * 32 * 272, 272, Vt + wn * 32 * 272, 272, (wm + 1) * 32, c.lane);
#pragma unroll
            for (int g = 0; g < 4; ++g) { f32x4 o; o[0] = acc[4 * g]; o[1] = acc[4 * g + 1]; o[2] = acc[4 * g + 2]; o[3] = acc[4 * g + 3]; *(LAS f32x4*)(Of + ii * 68 + wn * 32 + 8 * g + 4 * h) = o; }
        }
        __syncthreads();
        {
            const int rw = c.tid >> 2, part = c.tid & 3;
            float v[16]; float s = 0.f;
#pragma unroll
            for (int e = 0; e < 16; ++e) { v[e] = Of[rw * 68 + part * 16 + e]; s += v[e]; }
            s += __shfl_xor(s, 1); s += __shfl_xor(s, 2);
            const float mu = s * (1.0f / 64.0f);
            float q = 0.f;
#pragma unroll
            for (int e = 0; e < 16; ++e) { const float d = v[e] - mu; q += d * d; }
            q += __shfl_xor(q, 1); q += __shfl_xor(q, 2);
            const float rstd = rsqrtf(q * (1.0f / 64.0f) + LN_EPS);
            const size_t row = row0 + rw;
            const int ch = hh * 64 + part * 16;
            const u32x4* gp = (const u32x4*)(Y + row * NY + C_RG + ch);
            const u32x4 g0 = gp[0], g1 = gp[1];
            const unsigned gg[8] = {g0.x, g0.y, g0.z, g0.w, g1.x, g1.y, g1.z, g1.w};
            unsigned ow[8];
#pragma unroll
            for (int e = 0; e < 8; ++e) {
                const float y0 = ((v[2 * e] - mu) * rstd * gn_g[ch + 2 * e] + gn_b[ch + 2 * e]) * siluf_(bf_lo(gg[e]));
                const float y1 = ((v[2 * e + 1] - mu) * rstd * gn_g[ch + 2 * e + 1] + gn_b[ch + 2 * e + 1]) * siluf_(bf_hi(gg[e]));
                ow[e] = pk_bf16(y0, y1);
            }
            u32x4* op = (u32x4*)(O + row * DM + 2 * 256 + ch);
            u32x4 w0, w1; w0.x = ow[0]; w0.y = ow[1]; w0.z = ow[2]; w0.w = ow[3]; w1.x = ow[4]; w1.y = ow[5]; w1.z = ow[6]; w1.w = ow[7];
            op[0] = w0; op[1] = w1;
        }
        __syncthreads();
    }
}

template <int NH>
__device__ __forceinline__ void gla_decays(const Ctx& c, const bf16_t* Y, size_t row0, int h0, const float* w_alpha, const float* b_alpha, LAS float* Ab, LAS float* lrs) {
    for (int i = c.tid; i < 64 * 16; i += NTHREADS) lrs[i] = bf2f(Y[(row0 + (i >> 4)) * NY + C_GLR + (i & 15)]);
    __syncthreads();
    for (int i = c.tid; i < NH * 64 * 32; i += NTHREADS) {
        const int k = i & 31, t = (i >> 5) & 63, hl = i >> 11;
        const int col = (h0 + hl) * 32 + k;
        float x = b_alpha[col];
#pragma unroll
        for (int rr = 0; rr < 16; ++rr) x += lrs[t * 16 + rr] * w_alpha[rr * 128 + col];
        Ab[i] = -softplusf_(-x) * (1.0f / 16.0f);
    }
    __syncthreads();
    if (c.tid < NH * 32) {
        const int k = c.tid & 31, hl = c.tid >> 5;
        float s = 0.f;
        for (int t = 0; t < 64; ++t) { s += Ab[(hl * 64 + t) * 32 + k]; Ab[(hl * 64 + t) * 32 + k] = s; }
    }
    __syncthreads();
}
__device__ __forceinline__ void phase_gla_local(const Ctx& c, const bf16_t* Y, const float* w_alpha, const float* b_alpha, float* UGLA, float* BL) {
    LAS float* Ab = (LAS float*)c.lds;
    LAS float* lrs = (LAS float*)(c.lds + 32768);
    const lptr Kt = c.lds + 36864;
    const lptr Vt = c.lds + 36864 + 18432;
    for (int u = c.blk; u < 256; u += c.nblk) {
        const int i = u & 127, b = u >> 7;
        const size_t row0 = (size_t)b * SEQ + i * 64;
        gla_decays<4>(c, Y, row0, 0, w_alpha, b_alpha, Ab, lrs);
        {
            const int s = c.tid >> 3, cc = (c.tid & 7) * 16;
            const u32x4* kp = (const u32x4*)(Y + (row0 + s) * NY + C_GK + cc);
            const u32x4 k0 = kp[0], k1 = kp[1];
            const unsigned kk[8] = {k0.x, k0.y, k0.z, k0.w, k1.x, k1.y, k1.z, k1.w};
#pragma unroll
            for (int e = 0; e < 16; ++e) {
                const int col = cc + e, hl = col >> 5, k = col & 31;
                const float kvf = (e & 1) ? bf_hi(kk[e >> 1]) : bf_lo(kk[e >> 1]);
                const float dec = __expf(Ab[(hl * 64 + 63) * 32 + k] - Ab[(hl * 64 + s) * 32 + k]);
                *(LAS bf16_t*)(Kt + hl * 4608 + k * 144 + s * 2) = f2bf(kvf * dec);
            }
            const int vc = (c.tid & 7) * 32;
            const u32x4* vp = (const u32x4*)(Y + (row0 + s) * NY + C_GV + vc);
#pragma unroll
            for (int q4 = 0; q4 < 4; ++q4) {
                const u32x4 v = vp[q4];
                const unsigned vv[4] = {v.x, v.y, v.z, v.w};
#pragma unroll
                for (int e = 0; e < 4; ++e) {
                    const int col = vc + q4 * 8 + 2 * e, hl = col >> 6, ee = col & 63;
                    *(LAS bf16_t*)(Vt + hl * 9216 + ee * 144 + s * 2) = (bf16_t)(vv[e] & 0xffffu);
                    *(LAS bf16_t*)(Vt + hl * 9216 + (ee + 1) * 144 + s * 2) = (bf16_t)(vv[e] >> 16);
                }
            }
        }
        __syncthreads();
        {
            const int hl = c.wave >> 1, wn = c.wave & 1, r = c.lane & 31, h = c.lane >> 5;
            f32x16 acc = mma_lds(zero16(), Kt + hl * 4608, 144, Vt + hl * 9216 + wn * 32 * 144, 144, 64, c.lane);
            float* dst = UGLA + (((size_t)(b * 4 + hl) * 128 + i) * 32 + r) * 64 + wn * 32 + 4 * h;
#pragma unroll
            for (int g = 0; g < 4; ++g) { f32x4 o; o[0] = acc[4 * g]; o[1] = acc[4 * g + 1]; o[2] = acc[4 * g + 2]; o[3] = acc[4 * g + 3]; *(f32x4*)(dst + 8 * g) = o; }
            if (c.tid < 128) { const int hl2 = c.tid >> 5, k = c.tid & 31; BL[((size_t)(b * 4 + hl2) * 128 + i) * 32 + k] = Ab[(hl2 * 64 + 63) * 32 + k]; }
        }
        __syncthreads();
    }
}
__device__ __forceinline__ void phase_gla_out(const Ctx& c, const bf16_t* Y, const float* w_alpha, const float* b_alpha, const float* SGLA, const float* norm_g, bf16_t* O) {
    LAS float* Ab = (LAS float*)c.lds;
    LAS float* lrs = (LAS float*)(c.lds + 16384);
    const lptr Qp = c.lds + 20480;
    const lptr Kp = Qp + 10240;
    const lptr Vt = Kp + 10240;
    const lptr St = Vt + 18432;
    const lptr Att = St + 10240;
    LAS float* Of = (LAS float*)(Att + 18432);
    for (int u = c.blk; u < 512; u += c.nblk) {
        const int hp = u & 1, i = (u >> 1) & 127, b = u >> 8;
        const size_t row0 = (size_t)b * SEQ + i * 64;
        gla_decays<2>(c, Y, row0, hp * 2, w_alpha, b_alpha, Ab, lrs);
        {
            const int s = c.tid >> 3, cc = (c.tid & 7) * 8;
            const int hl = cc >> 5, k0 = cc & 31;
            const u32x4 qv = *(const u32x4*)(Y + (row0 + s) * NY + C_GQ + hp * 64 + cc);
            const u32x4 kv = *(const u32x4*)(Y + (row0 + s) * NY + C_GK + hp * 64 + cc);
            const unsigned qq[4] = {qv.x, qv.y, qv.z, qv.w}, kk[4] = {kv.x, kv.y, kv.z, kv.w};
            unsigned qo[4], ko[4];
#pragma unroll
            for (int e = 0; e < 4; ++e) {
                const float b0 = Ab[(hl * 64 + s) * 32 + k0 + 2 * e], b1 = Ab[(hl * 64 + s) * 32 + k0 + 2 * e + 1];
                const float e0 = __expf(b0), e1 = __expf(b1);
                qo[e] = pk_bf16(bf_lo(qq[e]) * 0.17677669529663687f * e0, bf_hi(qq[e]) * 0.17677669529663687f * e1);
                ko[e] = pk_bf16(bf_lo(kk[e]) / e0, bf_hi(kk[e]) / e1);
            }
            u32x4 w; w.x = qo[0]; w.y = qo[1]; w.z = qo[2]; w.w = qo[3];
            *(LAS u32x4*)(Qp + hl * 5120 + s * 80 + k0 * 2) = w;
            w.x = ko[0]; w.y = ko[1]; w.z = ko[2]; w.w = ko[3];
            *(LAS u32x4*)(Kp + hl * 5120 + s * 80 + k0 * 2) = w;
            const int vc = (c.tid & 7) * 16;
            const u32x4* vp = (const u32x4*)(Y + (row0 + s) * NY + C_GV + hp * 128 + vc);
#pragma unroll
            for (int q4 = 0; q4 < 2; ++q4) {
                const u32x4 v = vp[q4];
                const unsigned vv[4] = {v.x, v.y, v.z, v.w};
#pragma unroll
                for (int e = 0; e < 4; ++e) {
                    const int col = vc + q4 * 8 + 2 * e, hl2 = col >> 6, ee = col & 63;
                    *(LAS bf16_t*)(Vt + hl2 * 9216 + ee * 144 + s * 2) = (bf16_t)(vv[e] & 0xffffu);
                    *(LAS bf16_t*)(Vt + hl2 * 9216 + (ee + 1) * 144 + s * 2) = (bf16_t)(vv[e] >> 16);
                }
            }
            const int sh = c.tid >> 8, sk = (c.tid >> 3) & 31, se = (c.tid & 7) * 8;
            const float* spp = SGLA + (((size_t)(b * 4 + hp * 2 + sh) * 128 + i) * 32 + sk) * 64 + se;
            const f32x4 s0 = *(const f32x4*)spp, s1 = *(const f32x4*)(spp + 4);
            const float sv[8] = {s0[0], s0[1], s0[2], s0[3], s1[0], s1[1], s1[2], s1[3]};
#pragma unroll
            for (int e = 0; e < 8; ++e) *(LAS bf16_t*)(St + sh * 5120 + (se + e) * 80 + sk * 2) = f2bf(sv[e]);
        }
        __syncthreads();
        const int hl = c.wave >> 2, mi = (c.wave >> 1) & 1, nj = c.wave & 1, r = c.lane & 31, h = c.lane >> 5;
        if (nj <= mi) {
            f32x16 s = mma_lds(zero16(), Qp + hl * 5120 + mi * 32 * 80, 80, Kp + hl * 5120 + nj * 32 * 80, 80, 32, c.lane);
            const int tt = mi * 32 + r;
#pragma unroll
            for (int g = 0; g < 4; ++g) {
                float p[4];
#pragma unroll
                for (int e = 0; e < 4; ++e) { const int sx = nj * 32 + 8 * g + 4 * h + e; p[e] = (sx <= tt) ? s[4 * g + e] : 0.f; }
                u32x2 w; w.x = pk_bf16(p[0], p[1]); w.y = pk_bf16(p[2], p[3]);
                *(LAS u32x2*)(Att + hl * 9216 + tt * 144 + (nj * 32 + 8 * g + 4 * h) * 2) = w;
            }
        }
        __syncthreads();
        {
            f32x16 acc = mma_lds(zero16(), Qp + hl * 5120 + mi * 32 * 80, 80, St + hl * 5120 + nj * 32 * 80, 80, 32, c.lane);
            acc = mma_lds(acc, Att + hl * 9216 + mi * 32 * 144, 144, Vt + hl * 9216 + nj * 32 * 144, 144, (mi + 1) * 32, c.lane);
            const int tt = mi * 32 + r;
#pragma unroll
            for (int g = 0; g < 4; ++g) { f32x4 o; o[0] = acc[4 * g]; o[1] = acc[4 * g + 1]; o[2] = acc[4 * g + 2]; o[3] = acc[4 * g + 3]; *(LAS f32x4*)(Of + (hl * 64 + tt) * 68 + nj * 32 + 8 * g + 4 * h) = o; }
        }
        __syncthreads();
        {
            const int rw = c.tid >> 2, part = c.tid & 3;
            const int hl2 = rw >> 6, tt = rw & 63, hh = hp * 2 + hl2;
            float v[16]; float q = 0.f;
#pragma unroll
            for (int e = 0; e < 16; ++e) { v[e] = Of[rw * 68 + part * 16 + e]; q += v[e] * v[e]; }
            q += __shfl_xor(q, 1); q += __shfl_xor(q, 2);
            const float rstd = rsqrtf(q * (1.0f / 64.0f) + LN_EPS);
            const size_t row = row0 + tt;
            const int ch = hh * 64 + part * 16;
            const u32x4* gp = (const u32x4*)(Y + row * NY + C_GR + ch);
            const u32x4 g0 = gp[0], g1 = gp[1];
            const unsigned gg[8] = {g0.x, g0.y, g0.z, g0.w, g1.x, g1.y, g1.z, g1.w};
            unsigned ow[8];
#pragma unroll
            for (int e = 0; e < 8; ++e) {
                const float y0 = v[2 * e] * rstd * norm_g[ch + 2 * e] * siluf_(bf_lo(gg[e]));
                const float y1 = v[2 * e + 1] * rstd * norm_g[ch + 2 * e + 1] * siluf_(bf_hi(gg[e]));
                ow[e] = pk_bf16(y0, y1);
            }
            u32x4* op = (u32x4*)(O + row * DM + 3 * 256 + ch);
            u32x4 w0, w1; w0.x = ow[0]; w0.y = ow[1]; w0.z = ow[2]; w0.w = ow[3]; w1.x = ow[4]; w1.y = ow[5]; w1.z = ow[6]; w1.w = ow[7];
            op[0] = w0; op[1] = w1;
        }
        __syncthreads();
    }
}

constexpr int NS_Q = 0;
constexpr int NS_K = 18432;
constexpr int NS_VT = 27648;
constexpr int NS_S = 36864;
constexpr int NS_P = 71680;
constexpr int NS_M = 90112;
constexpr int NS_L = NS_M + 512;
constexpr int NS_A = NS_L + 512;
constexpr int NS_G = NS_A + 512;
constexpr int NS_IMP = NS_G + 2048;
constexpr int NS_SEL = NS_IMP + 16384;
constexpr int NS_UM = NS_SEL + 512;
constexpr int NS_CARRY = NS_UM + 64;
constexpr int NS_BLIST = NS_CARRY + 256;
constexpr int NS_END = NS_BLIST + 512;

__device__ __forceinline__ void ns_stage_rows(const Ctx& c, lptr dst, const bf16_t* src, size_t ld) {
    const int rr = c.tid >> 3, cc = (c.tid & 7) * 8;
    *(LAS u32x4*)(dst + rr * 144 + cc * 2) = *(const u32x4*)(src + (size_t)rr * ld + cc);
}
__device__ __forceinline__ void ns_stage_T(const Ctx& c, lptr dst, const bf16_t* src, size_t ld) {
    const int rr = c.tid >> 3, cc = (c.tid & 7) * 8;
    const u32x4 v = *(const u32x4*)(src + (size_t)rr * ld + cc);
    const unsigned vv[4] = {v.x, v.y, v.z, v.w};
#pragma unroll
    for (int e = 0; e < 4; ++e) {
        *(LAS bf16_t*)(dst + (cc + 2 * e) * 144 + rr * 2) = (bf16_t)(vv[e] & 0xffffu);
        *(LAS bf16_t*)(dst + (cc + 2 * e + 1) * 144 + rr * 2) = (bf16_t)(vv[e] >> 16);
    }
}
__device__ __forceinline__ void ns_scores(const Ctx& c) {
    const int wm = c.wave >> 1, wn = c.wave & 1, r = c.lane & 31, h = c.lane >> 5;
    const f32x16 s = mma_lds(zero16(), c.lds + NS_Q + wm * 32 * 144, 144, c.lds + NS_K + wn * 32 * 144, 144, 64, c.lane);
    LAS float* Sf = (LAS float*)(c.lds + NS_S);
#pragma unroll
    for (int g = 0; g < 4; ++g) { f32x4 o; o[0] = s[4 * g]; o[1] = s[4 * g + 1]; o[2] = s[4 * g + 2]; o[3] = s[4 * g + 3]; *(LAS f32x4*)(Sf + (wm * 32 + r) * 68 + wn * 32 + 8 * g + 4 * h) = o; }
}
template <int MODE>
__device__ __forceinline__ bool ns_valid(int t, int kidx, int tok, const Ctx& c, float& dist) {
    if (MODE == 0) { const int d = t - 16 * kidx - 31; dist = (float)d; return d >= 0 && kidx < 511; }
    if (MODE == 1) { const int nb = kidx >> 6; const unsigned m = ((LAS const unsigned*)(c.lds + NS_SEL))[tok * 4 + (nb >> 5)]; const int d = t - kidx; dist = (float)d; return ((m >> (nb & 31)) & 1u) && d >= 0; }
    const int d = t - kidx; dist = (float)d; return d >= 0 && d < 512;
}
template <int MODE, int PASS>
__device__ __forceinline__ void ns_softmax(const Ctx& c, int t0, int k0) {
    LAS float* Sf = (LAS float*)(c.lds + NS_S);
    LAS float* Mr = (LAS float*)(c.lds + NS_M); LAS float* Lr = (LAS float*)(c.lds + NS_L); LAS float* Ar = (LAS float*)(c.lds + NS_A);
    const int row = c.tid >> 2, part = c.tid & 3, tok = row & 31, hh = row >> 5, t = t0 + tok;
    const float slope = exp2f(-2.0f * (float)(hh + 1));
    float s[16]; bool ok[16]; float mloc = NEGF;
#pragma unroll
    for (int e = 0; e < 16; ++e) {
        const int j = part * 16 + e; float dist;
        ok[e] = ns_valid<MODE>(t, k0 + j, tok, c, dist);
        s[e] = Sf[row * 68 + j] * 0.125f - slope * dist;
        if (ok[e]) mloc = fmaxf(mloc, s[e]);
    }
    mloc = fmaxf(mloc, __shfl_xor(mloc, 1)); mloc = fmaxf(mloc, __shfl_xor(mloc, 2));
    const float mold = Mr[row], lold = Lr[row];
    if (PASS == 2) {
        const float inv = lold > 0.f ? 1.0f / lold : 0.f;
        unsigned pw[8];
#pragma unroll
        for (int e = 0; e < 16; e += 2) {
            const float p0 = ok[e] ? __expf(s[e] - mold) * inv : 0.f, p1 = ok[e + 1] ? __expf(s[e + 1] - mold) * inv : 0.f;
            Sf[row * 68 + part * 16 + e] = p0; Sf[row * 68 + part * 16 + e + 1] = p1;
            pw[e >> 1] = pk_bf16(p0, p1);
        }
        u32x4 w0, w1; w0.x = pw[0]; w0.y = pw[1]; w0.z = pw[2]; w0.w = pw[3]; w1.x = pw[4]; w1.y = pw[5]; w1.z = pw[6]; w1.w = pw[7];
        *(LAS u32x4*)(c.lds + NS_P + row * 144 + part * 32) = w0; *(LAS u32x4*)(c.lds + NS_P + row * 144 + part * 32 + 16) = w1;
        return;
    }
    const float mnew = fmaxf(mold, mloc);
    float sum = 0.f; unsigned pw[8];
#pragma unroll
    for (int e = 0; e < 16; e += 2) {
        const float p0 = ok[e] ? __expf(s[e] - mnew) : 0.f, p1 = ok[e + 1] ? __expf(s[e + 1] - mnew) : 0.f;
        sum += p0 + p1; pw[e >> 1] = pk_bf16(p0, p1);
    }
    sum += __shfl_xor(sum, 1); sum += __shfl_xor(sum, 2);
    const float alpha = __expf(mold - mnew);
    if (PASS == 1) {
        u32x4 w0, w1; w0.x = pw[0]; w0.y = pw[1]; w0.z = pw[2]; w0.w = pw[3]; w1.x = pw[4]; w1.y = pw[5]; w1.z = pw[6]; w1.w = pw[7];
        *(LAS u32x4*)(c.lds + NS_P + row * 144 + part * 32) = w0; *(LAS u32x4*)(c.lds + NS_P + row * 144 + part * 32 + 16) = w1;
    }
    if (part == 0) { Mr[row] = mnew; Lr[row] = lold * alpha + sum; Ar[row] = alpha; }
}
__device__ __forceinline__ f32x16 ns_pv(const Ctx& c, f32x16 acc, bool rescale) {
    const int wm = c.wave >> 1, wn = c.wave & 1, r = c.lane & 31;
    if (rescale) { const float a = ((LAS const float*)(c.lds + NS_A))[wm * 32 + r];
#pragma unroll
        for (int e = 0; e < 16; ++e) acc[e] *= a; }
    return mma_lds(acc, c.lds + NS_P + wm * 32 * 144, 144, c.lds + NS_VT + wn * 32 * 144, 144, 64, c.lane);
}
__device__ __forceinline__ void ns_reset_stats(const Ctx& c) {
    if (c.tid < 128) { ((LAS float*)(c.lds + NS_M))[c.tid] = NEGF; ((LAS float*)(c.lds + NS_L))[c.tid] = 0.f; ((LAS float*)(c.lds + NS_A))[c.tid] = 1.f; }
}

__device__ __forceinline__ void phase_nsa(const Ctx& c, const bf16_t* Y, const bf16_t* KC, const bf16_t* VC, bf16_t* O) {
    LAS float* Sf = (LAS float*)(c.lds + NS_S);
    LAS float* Gt = (LAS float*)(c.lds + NS_G);
    LAS float* Imp = (LAS float*)(c.lds + NS_IMP);
    LAS unsigned* Sel = (LAS unsigned*)(c.lds + NS_SEL);
    LAS unsigned* Um = (LAS unsigned*)(c.lds + NS_UM);
    LAS float* Carry = (LAS float*)(c.lds + NS_CARRY);
    const int wm = c.wave >> 1, wn = c.wave & 1, r = c.lane & 31, h = c.lane >> 5;
    for (int u = c.blk; u < 512; u += c.nblk) {
        const int tq = u & 255, b = u >> 8;
        const int t0 = tq * 32;
        const size_t row0 = (size_t)b * SEQ + t0;
        {
            const int row = c.tid >> 2, dc = (c.tid & 3) * 16, tok = row & 31, hh = row >> 5;
            const u32x4* qp = (const u32x4*)(Y + (row0 + tok) * NY + C_NQ + hh * 64 + dc);
            *(LAS u32x4*)(c.lds + NS_Q + row * 144 + dc * 2) = qp[0]; *(LAS u32x4*)(c.lds + NS_Q + row * 144 + dc * 2 + 16) = qp[1];
            if (c.tid < 384) { const int rw = c.tid / 3, gi = c.tid % 3; Gt[rw * 4 + gi] = sigmoidf_(bf2f(Y[(row0 + (rw & 31)) * NY + C_NG + (rw >> 5) * 3 + gi])); }
            for (int i = c.tid; i < 32 * 128; i += NTHREADS) Imp[i] = 0.f;
            if (c.tid < 32) Carry[c.tid] = 0.f;
            if (c.tid < 4) Um[c.tid] = 0u;
            ns_reset_stats(c);
        }
        __syncthreads();
        f32x16 outacc = zero16();
        const int ncmp = min(t0 / 16 + 1, 511);
        const int nct = (ncmp + 63) / 64;
        const bf16_t* kcb = KC + (size_t)b * 512 * 64; const bf16_t* vcb = VC + (size_t)b * 512 * 64;
        for (int ct = 0; ct < nct; ++ct) {
            ns_stage_rows(c, c.lds + NS_K, kcb + (size_t)ct * 64 * 64, 64);
            __syncthreads();
            ns_scores(c);
            __syncthreads();
            ns_softmax<0, 0>(c, t0, ct * 64);
            __syncthreads();
        }
        {
            f32x16 acc = zero16();
            for (int ct = 0; ct < nct; ++ct) {
                ns_stage_rows(c, c.lds + NS_K, kcb + (size_t)ct * 64 * 64, 64);
                ns_stage_T(c, c.lds + NS_VT, vcb + (size_t)ct * 64 * 64, 64);
                __syncthreads();
                ns_scores(c);
                __syncthreads();
                ns_softmax<0, 2>(c, t0, ct * 64);
                __syncthreads();
                acc = ns_pv(c, acc, false);
                {
                    const int tok = c.tid >> 4, g = c.tid & 15;
                    float a = 0.f, last = 0.f, prev = 0.f;
#pragma unroll
                    for (int hh = 0; hh < 4; ++hh) {
                        const LAS float* pr = Sf + (hh * 32 + tok) * 68 + 4 * g;
                        a += (pr[0] + pr[1]) + (pr[2] + pr[3]);
                        last += pr[3];
                        if (g > 0) prev += pr[-1];
                    }
                    if (g == 0) prev = Carry[tok];
                    Imp[tok * 128 + ct * 16 + g] += a + prev;
                    __syncthreads();
                    if (g == 15) Carry[tok] = last;
                }
                __syncthreads();
            }
            const float g0 = Gt[(wm * 32 + r) * 4 + 0];
#pragma unroll
            for (int e = 0; e < 16; ++e) outacc[e] += g0 * acc[e];
        }
        for (int tk = 0; tk < 4; ++tk) {
            const int tok = c.wave * 4 + tk, t = t0 + tok, cur = t >> 6;
            float v0 = Imp[tok * 128 + c.lane], v1 = Imp[tok * 128 + 64 + c.lane];
            const int n0 = c.lane, n1 = c.lane + 64;
            if (n0 > cur) v0 = NEGF; if (n1 > cur) v1 = NEGF;
            if (n0 == cur) v0 = 1e30f; if (n1 == cur) v1 = 1e30f;
            unsigned m0 = 0u, m1 = 0u, m2 = 0u, m3 = 0u;
            for (int it = 0; it < 16; ++it) {
                const float mx = wave_max(fmaxf(v0, v1));
                if (mx <= NEGF) break;
                const unsigned long long b0 = __ballot(v0 == mx);
                int nsel;
                if (b0) { nsel = __ffsll((long long)b0) - 1; if (c.lane == nsel) v0 = -3e38f; }
                else { const unsigned long long b1 = __ballot(v1 == mx); const int l1 = __ffsll((long long)b1) - 1; nsel = 64 + l1; if (c.lane == l1) v1 = -3e38f; }
                if (nsel < 32) m0 |= 1u << nsel; else if (nsel < 64) m1 |= 1u << (nsel - 32); else if (nsel < 96) m2 |= 1u << (nsel - 64); else m3 |= 1u << (nsel - 96);
            }
            if (c.lane == 0) {
                Sel[tok * 4 + 0] = m0; Sel[tok * 4 + 1] = m1; Sel[tok * 4 + 2] = m2; Sel[tok * 4 + 3] = m3;
                atomicOr((unsigned*)&Um[0], m0); atomicOr((unsigned*)&Um[1], m1); atomicOr((unsigned*)&Um[2], m2); atomicOr((unsigned*)&Um[3], m3);
            }
        }
        ns_reset_stats(c);
        __syncthreads();
        {
            f32x16 acc = zero16();
            const bf16_t* ksb = Y + (size_t)b * SEQ * NY + C_NKS; const bf16_t* vsb = Y + (size_t)b * SEQ * NY + C_NVS;
            for (int wd = 0; wd < 4; ++wd) {
                unsigned bits = Um[wd];
                while (bits) {
                    const int nb = wd * 32 + __ffs((int)bits) - 1; bits &= bits - 1;
                    ns_stage_rows(c, c.lds + NS_K, ksb + (size_t)nb * 64 * NY, NY);
                    ns_stage_T(c, c.lds + NS_VT, vsb + (size_t)nb * 64 * NY, NY);
                    __syncthreads();
                    ns_scores(c);
                    __syncthreads();
                    ns_softmax<1, 1>(c, t0, nb * 64);
                    __syncthreads();
                    acc = ns_pv(c, acc, true);
                    __syncthreads();
                }
            }
            const float l = ((LAS const float*)(c.lds + NS_L))[wm * 32 + r];
            const float g1 = Gt[(wm * 32 + r) * 4 + 1] * (l > 0.f ? 1.0f / l : 0.f);
#pragma unroll
            for (int e = 0; e < 16; ++e) outacc[e] += g1 * acc[e];
        }
        __syncthreads();
        ns_reset_stats(c);
        __syncthreads();
        {
            f32x16 acc = zero16();
            const bf16_t* kwb = Y + (size_t)b * SEQ * NY + C_NKW; const bf16_t* vwb = Y + (size_t)b * SEQ * NY + C_NVW;
            const int kt1 = t0 >> 6, kt0 = max(0, kt1 - 8);
            for (int kt = kt0; kt <= kt1; ++kt) {
                ns_stage_rows(c, c.lds + NS_K, kwb + (size_t)kt * 64 * NY, NY);
                ns_stage_T(c, c.lds + NS_VT, vwb + (size_t)kt * 64 * NY, NY);
                __syncthreads();
                ns_scores(c);
                __syncthreads();
                ns_softmax<2, 1>(c, t0, kt * 64);
                __syncthreads();
                acc = ns_pv(c, acc, true);
                __syncthreads();
            }
            const float l = ((LAS const float*)(c.lds + NS_L))[wm * 32 + r];
            const float g2 = Gt[(wm * 32 + r) * 4 + 2] * (l > 0.f ? 1.0f / l : 0.f);
#pragma unroll
            for (int e = 0; e < 16; ++e) outacc[e] += g2 * acc[e];
        }
        {
            bf16_t* op = O + (row0 + r) * DM + 256 + wm * 64 + wn * 32 + 4 * h;
#pragma unroll
            for (int g = 0; g < 4; ++g) { u32x2 w; w.x = pk_bf16(outacc[4 * g], outacc[4 * g + 1]); w.y = pk_bf16(outacc[4 * g + 2], outacc[4 * g + 3]); *(u32x2*)(op + 8 * g) = w; }
        }
        __syncthreads();
    }
}

__device__ __forceinline__ void phase_sb2(const Ctx& c, const bf16_t* Y, bf16_t* O) {
    LAS float* Sf = (LAS float*)(c.lds + NS_S);
    LAS float* Cr = (LAS float*)(c.lds + NS_M);
    const int wm = c.wave >> 1, wn = c.wave & 1, r = c.lane & 31, h = c.lane >> 5;
    for (int u = c.blk; u < 512; u += c.nblk) {
        const int b = u >> 8, hh = (u >> 6) & 3, qt = b ? 63 - (u & 63) : (u & 63);
        const int t0 = qt * 128;
        const size_t row0 = (size_t)b * SEQ + t0;
        {
            const int row = c.tid >> 2, dc = (c.tid & 3) * 16;
            const u32x4* qp = (const u32x4*)(Y + (row0 + row) * NY + C_SBQ + hh * 64 + dc);
            *(LAS u32x4*)(c.lds + NS_Q + row * 144 + dc * 2) = qp[0]; *(LAS u32x4*)(c.lds + NS_Q + row * 144 + dc * 2 + 16) = qp[1];
            if (c.tid < 128) Cr[c.tid] = 0.f;
        }
        LAS volatile unsigned* NotDone = (LAS volatile unsigned*)(c.lds + NS_L);
        f32x16 acc = zero16();
        const bf16_t* kb = Y + (size_t)b * SEQ * NY + C_SBK + hh * 64; const bf16_t* vb = Y + (size_t)b * SEQ * NY + C_SBV + hh * 64;
        for (int kt = 2 * qt + 1; kt >= 0; --kt) {
            ns_stage_rows(c, c.lds + NS_K, kb + (size_t)kt * 64 * NY, NY);
            ns_stage_T(c, c.lds + NS_VT, vb + (size_t)kt * 64 * NY, NY);
            if (c.tid == 0) NotDone[0] = 0u;
            __syncthreads();
            ns_scores(c);
            __syncthreads();
            {
                const int row = c.tid >> 2, part = c.tid & 3, t = t0 + row;
                float z[16], suf[16]; bool ok[16];
                float run = 0.f;
#pragma unroll
                for (int e = 15; e >= 0; --e) {
                    const int pos = kt * 64 + part * 16 + e;
                    z[e] = Sf[row * 68 + part * 16 + e] * 0.125f;
                    ok[e] = pos < t;
                    run += ok[e] ? -softplusf_(z[e]) : 0.f;
                    suf[e] = run;
                }
                const float tot = run;
                const float t1 = __shfl_down(tot, 1), t2 = __shfl_down(tot, 2), t3 = __shfl_down(tot, 3);
                const float thigh = (part < 3 ? t1 : 0.f) + (part < 2 ? t2 : 0.f) + (part < 1 ? t3 : 0.f);
                const float carry = Cr[row];
                unsigned pw[8];
#pragma unroll
                for (int e = 0; e < 16; e += 2) {
                    const float w0 = ok[e] ? __expf(z[e] + carry + thigh + suf[e]) : 0.f, w1 = ok[e + 1] ? __expf(z[e + 1] + carry + thigh + suf[e + 1]) : 0.f;
                    pw[e >> 1] = pk_bf16(w0, w1);
                }
                u32x4 w0, w1; w0.x = pw[0]; w0.y = pw[1]; w0.z = pw[2]; w0.w = pw[3]; w1.x = pw[4]; w1.y = pw[5]; w1.z = pw[6]; w1.w = pw[7];
                *(LAS u32x4*)(c.lds + NS_P + row * 144 + part * 32) = w0; *(LAS u32x4*)(c.lds + NS_P + row * 144 + part * 32 + 16) = w1;
                const float cn = carry + thigh + tot;
                if (part == 0) { Cr[row] = cn; if (!(cn < -104.0f)) NotDone[0] = 1u; }
            }
            __syncthreads();
            const bool alldone = (NotDone[0] == 0u);
            acc = ns_pv(c, acc, false);
            __syncthreads();
            if (alldone) break;
        }
        {
            bf16_t* op = O + (row0 + wm * 32 + r) * DM + hh * 64 + wn * 32 + 4 * h;
#pragma unroll
            for (int g = 0; g < 4; ++g) { u32x2 w; w.x = pk_bf16(acc[4 * g], acc[4 * g + 1]); w.y = pk_bf16(acc[4 * g + 2], acc[4 * g + 3]); *(u32x2*)(op + 8 * g) = w; }
        }
        __syncthreads();
    }
}

struct TileSeq { const bf16_t* kbase; const bf16_t* vbase; size_t ld; int first, step; LAS const int* list; };
__device__ __forceinline__ int seq_idx(const TileSeq& s, int i) { return s.list ? s.list[i] : s.first + s.step * i; }
__device__ __forceinline__ u32x4 ns_ldK(const Ctx& c, const bf16_t* src, size_t ld) { return *(const u32x4*)(src + (size_t)(c.tid >> 3) * ld + (c.tid & 7) * 8); }
__device__ __forceinline__ u32x4 ns_ldV(const Ctx& c, const bf16_t* src, size_t ld) { return *(const u32x4*)(src + (size_t)(c.tid & 63) * ld + (c.tid >> 6) * 8); }
__device__ __forceinline__ void ns_stK(const Ctx& c, u32x4 v) { *(LAS u32x4*)(c.lds + NS_K + (c.tid >> 3) * 144 + (c.tid & 7) * 16) = v; }
__device__ __forceinline__ void ns_stVT(const Ctx& c, u32x4 v) {
    const int key = c.tid & 63, e0 = (c.tid >> 6) * 8;
    const unsigned vv[4] = {v.x, v.y, v.z, v.w};
#pragma unroll
    for (int e = 0; e < 4; ++e) {
        *(LAS bf16_t*)(c.lds + NS_VT + (e0 + 2 * e) * 144 + key * 2) = (bf16_t)(vv[e] & 0xffffu);
        *(LAS bf16_t*)(c.lds + NS_VT + (e0 + 2 * e + 1) * 144 + key * 2) = (bf16_t)(vv[e] >> 16);
    }
}
__device__ __forceinline__ void sb_scan(const Ctx& c, int t0, int k0) {
    LAS float* Sf = (LAS float*)(c.lds + NS_S);
    LAS float* Cr = (LAS float*)(c.lds + NS_M);
    LAS volatile unsigned* NotDone = (LAS volatile unsigned*)(c.lds + NS_L);
    const int row = c.tid >> 2, part = c.tid & 3, t = t0 + row;
    float z[16], suf[16]; bool ok[16];
    float run = 0.f;
#pragma unroll
    for (int e = 15; e >= 0; --e) {
        const int pos = k0 + part * 16 + e;
        z[e] = Sf[row * 68 + part * 16 + e] * 0.125f;
        ok[e] = pos < t;
        run += ok[e] ? -softplusf_(z[e]) : 0.f;
        suf[e] = run;
    }
    const float tot = run;
    const float t1 = __shfl_down(tot, 1), t2 = __shfl_down(tot, 2), t3 = __shfl_down(tot, 3);
    const float thigh = (part < 3 ? t1 : 0.f) + (part < 2 ? t2 : 0.f) + (part < 1 ? t3 : 0.f);
    const float carry = Cr[row];
    unsigned pw[8];
#pragma unroll
    for (int e = 0; e < 16; e += 2) {
        const float w0 = ok[e] ? __expf(z[e] + carry + thigh + suf[e]) : 0.f, w1 = ok[e + 1] ? __expf(z[e + 1] + carry + thigh + suf[e + 1]) : 0.f;
        pw[e >> 1] = pk_bf16(w0, w1);
    }
    u32x4 w0, w1; w0.x = pw[0]; w0.y = pw[1]; w0.z = pw[2]; w0.w = pw[3]; w1.x = pw[4]; w1.y = pw[5]; w1.z = pw[6]; w1.w = pw[7];
    *(LAS u32x4*)(c.lds + NS_P + row * 144 + part * 32) = w0; *(LAS u32x4*)(c.lds + NS_P + row * 144 + part * 32 + 16) = w1;
    const float cn = carry + thigh + tot;
    if (part == 0) { Cr[row] = cn; if (!(cn < -104.0f)) NotDone[0] = 1u; }
}
__device__ __forceinline__ void ns_importance(const Ctx& c, int ct) {
    LAS float* Sf = (LAS float*)(c.lds + NS_S);
    LAS float* Imp = (LAS float*)(c.lds + NS_IMP);
    LAS float* Carry = (LAS float*)(c.lds + NS_CARRY);
    const int tok = c.tid >> 4, g = c.tid & 15;
    float a = 0.f, last = 0.f, prev = 0.f;
#pragma unroll
    for (int hh = 0; hh < 4; ++hh) {
        const LAS float* pr = Sf + (hh * 32 + tok) * 68 + 4 * g;
        a += (pr[0] + pr[1]) + (pr[2] + pr[3]);
        last += pr[3];
        if (g > 0) prev += pr[-1];
    }
    if (g == 0) prev = Carry[(ct & 1) * 32 + tok];
    Imp[tok * 128 + ct * 16 + g] += a + prev;
    if (g == 15) Carry[((ct + 1) & 1) * 32 + tok] = last;
}
template <int MODE, int PASS, bool HASV>
__device__ __forceinline__ f32x16 ns_loop(const Ctx& c, f32x16 acc, int t0, int ntiles, const TileSeq sq) {
    if (ntiles <= 0) return acc;
    int idx = seq_idx(sq, 0);
    u32x4 rk = ns_ldK(c, sq.kbase + (size_t)idx * 64 * sq.ld, sq.ld), rv = rk;
    if (HASV) rv = ns_ldV(c, sq.vbase + (size_t)idx * 64 * sq.ld, sq.ld);
    ns_stK(c, rk); if (HASV) ns_stVT(c, rv);
    __syncthreads();
    for (int i = 0; i < ntiles; ++i) {
        const int k0 = idx * 64;
        const bool more = (i + 1 < ntiles);
        int nidx = idx;
        if (more) {
            nidx = seq_idx(sq, i + 1);
            rk = ns_ldK(c, sq.kbase + (size_t)nidx * 64 * sq.ld, sq.ld);
            if (HASV) rv = ns_ldV(c, sq.vbase + (size_t)nidx * 64 * sq.ld, sq.ld);
        }
        if (MODE == 3 && c.tid == 0) ((LAS volatile unsigned*)(c.lds + NS_L))[0] = 0u;
        ns_scores(c);
        __syncthreads();
        if (MODE == 3) sb_scan(c, t0, k0); else ns_softmax<(MODE == 3 ? 0 : MODE), PASS>(c, t0, k0);
        if (more) ns_stK(c, rk);
        __syncthreads();
        bool stop = false;
        if (MODE == 3) stop = (((LAS volatile unsigned*)(c.lds + NS_L))[0] == 0u);
        if (HASV) {
            acc = ns_pv(c, acc, MODE != 3 && PASS == 1);
            if (MODE == 0 && PASS == 2) ns_importance(c, idx);
            __syncthreads();
            if (more && !stop) ns_stVT(c, rv);
        }
        if (stop) break;
        idx = nidx;
    }
    __syncthreads();
    return acc;
}

__device__ __forceinline__ void phase_nsa2(const Ctx& c, const bf16_t* Y, const bf16_t* KCp, const bf16_t* VCp, bf16_t* Op) {
    LAS float* Gt = (LAS float*)(c.lds + NS_G);
    LAS float* Imp = (LAS float*)(c.lds + NS_IMP);
    LAS unsigned* Sel = (LAS unsigned*)(c.lds + NS_SEL);
    LAS unsigned* Um = (LAS unsigned*)(c.lds + NS_UM);
    LAS float* Carry = (LAS float*)(c.lds + NS_CARRY);
    LAS int* Blist = (LAS int*)(c.lds + NS_BLIST);
    const int wm = c.wave >> 1, wn = c.wave & 1, r = c.lane & 31, h = c.lane >> 5;
    for (int u = c.blk; u < 512; u += c.nblk) {
        const int b = u >> 8, tq = b ? 255 - (u & 255) : (u & 255);
        const int t0 = tq * 32;
        const size_t row0 = (size_t)b * SEQ + t0;
        {
            const int row = c.tid >> 2, dc = (c.tid & 3) * 16, tok = row & 31, hh = row >> 5;
            const u32x4* qp = (const u32x4*)(Y + (row0 + tok) * NY + C_NQ + hh * 64 + dc);
            *(LAS u32x4*)(c.lds + NS_Q + row * 144 + dc * 2) = qp[0]; *(LAS u32x4*)(c.lds + NS_Q + row * 144 + dc * 2 + 16) = qp[1];
            if (c.tid < 384) { const int rw = c.tid / 3, gi = c.tid % 3; Gt[rw * 4 + gi] = sigmoidf_(bf2f(Y[(row0 + (rw & 31)) * NY + C_NG + (rw >> 5) * 3 + gi])); }
            for (int i = c.tid; i < 32 * 128; i += NTHREADS) Imp[i] = 0.f;
            if (c.tid < 64) Carry[c.tid] = 0.f;
            if (c.tid < 4) Um[c.tid] = 0u;
            ns_reset_stats(c);
        }
        __syncthreads();
        f32x16 outacc = zero16();
        const int ncmp = min(t0 / 16 + 1, 511);
        const int nct = (ncmp + 63) / 64;
        {
            const TileSeq sq{KCp + (size_t)b * 512 * 64, VCp + (size_t)b * 512 * 64, 64, 0, 1, nullptr};
            (void)ns_loop<0, 0, false>(c, zero16(), t0, nct, sq);
            const f32x16 acc = ns_loop<0, 2, true>(c, zero16(), t0, nct, sq);
            const float g0 = Gt[(wm * 32 + r) * 4 + 0];
#pragma unroll
            for (int e = 0; e < 16; ++e) outacc[e] += g0 * acc[e];
        }
        for (int tk = 0; tk < 4; ++tk) {
            const int tok = c.wave * 4 + tk, t = t0 + tok, cur = t >> 6;
            float v0 = Imp[tok * 128 + c.lane], v1 = Imp[tok * 128 + 64 + c.lane];
            const int n0 = c.lane, n1 = c.lane + 64;
            if (n0 > cur) v0 = NEGF; if (n1 > cur) v1 = NEGF;
            if (n0 == cur) v0 = 1e30f; if (n1 == cur) v1 = 1e30f;
            unsigned m0 = 0u, m1 = 0u, m2 = 0u, m3 = 0u;
            for (int it = 0; it < 16; ++it) {
                const float mx = wave_max(fmaxf(v0, v1));
                if (mx <= NEGF) break;
                const unsigned long long b0 = __ballot(v0 == mx);
                int nsel;
                if (b0) { nsel = __ffsll((long long)b0) - 1; if (c.lane == nsel) v0 = -3e38f; }
                else { const unsigned long long b1 = __ballot(v1 == mx); const int l1 = __ffsll((long long)b1) - 1; nsel = 64 + l1; if (c.lane == l1) v1 = -3e38f; }
                if (nsel < 32) m0 |= 1u << nsel; else if (nsel < 64) m1 |= 1u << (nsel - 32); else if (nsel < 96) m2 |= 1u << (nsel - 64); else m3 |= 1u << (nsel - 96);
            }
            if (c.lane == 0) {
                Sel[tok * 4 + 0] = m0; Sel[tok * 4 + 1] = m1; Sel[tok * 4 + 2] = m2; Sel[tok * 4 + 3] = m3;
                atomicOr((unsigned*)&Um[0], m0); atomicOr((unsigned*)&Um[1], m1); atomicOr((unsigned*)&Um[2], m2); atomicOr((unsigned*)&Um[3], m3);
            }
        }
        ns_reset_stats(c);
        __syncthreads();
        int nsel_blocks;
        {
            const unsigned u0 = Um[0], u1 = Um[1], u2 = Um[2], u3 = Um[3];
            nsel_blocks = __popc(u0) + __popc(u1) + __popc(u2) + __popc(u3);
            if (c.tid < 128) {
                const unsigned wd = c.tid >> 5, bt = c.tid & 31;
                const unsigned mine = wd == 0 ? u0 : wd == 1 ? u1 : wd == 2 ? u2 : u3;
                if ((mine >> bt) & 1u) {
                    int pos = __popc(mine & ((1u << bt) - 1u));
                    if (wd > 0) pos += __popc(u0); if (wd > 1) pos += __popc(u1); if (wd > 2) pos += __popc(u2);
                    Blist[pos] = (int)c.tid;
                }
            }
        }
        __syncthreads();
        {
            const TileSeq sq{Y + (size_t)b * SEQ * NY + C_NKS, Y + (size_t)b * SEQ * NY + C_NVS, (size_t)NY, 0, 0, Blist};
            const f32x16 acc = ns_loop<1, 1, true>(c, zero16(), t0, nsel_blocks, sq);
            const float l = ((LAS const float*)(c.lds + NS_L))[wm * 32 + r];
            const float g1 = Gt[(wm * 32 + r) * 4 + 1] * (l > 0.f ? 1.0f / l : 0.f);
#pragma unroll
            for (int e = 0; e < 16; ++e) outacc[e] += g1 * acc[e];
        }
        __syncthreads();
        ns_reset_stats(c);
        __syncthreads();
        {
            const int kt1 = t0 >> 6, kt0 = max(0, kt1 - 8);
            const TileSeq sq{Y + (size_t)b * SEQ * NY + C_NKW, Y + (size_t)b * SEQ * NY + C_NVW, (size_t)NY, kt0, 1, nullptr};
            const f32x16 acc = ns_loop<2, 1, true>(c, zero16(), t0, kt1 - kt0 + 1, sq);
            const float l = ((LAS const float*)(c.lds + NS_L))[wm * 32 + r];
            const float g2 = Gt[(wm * 32 + r) * 4 + 2] * (l > 0.f ? 1.0f / l : 0.f);
#pragma unroll
            for (int e = 0; e < 16; ++e) outacc[e] += g2 * acc[e];
        }
        {
            bf16_t* op = Op + (row0 + r) * DM + 256 + wm * 64 + wn * 32 + 4 * h;
#pragma unroll
            for (int g = 0; g < 4; ++g) { u32x2 w; w.x = pk_bf16(outacc[4 * g], outacc[4 * g + 1]); w.y = pk_bf16(outacc[4 * g + 2], outacc[4 * g + 3]); *(u32x2*)(op + 8 * g) = w; }
        }
        __syncthreads();
    }
}
__device__ __forceinline__ void phase_sb3(const Ctx& c, const bf16_t* Y, bf16_t* Op) {
    LAS float* Cr = (LAS float*)(c.lds + NS_M);
    const int wm = c.wave >> 1, wn = c.wave & 1, r = c.lane & 31, h = c.lane >> 5;
    for (int u = c.blk; u < 512; u += c.nblk) {
        const int b = u >> 8, hh = (u >> 6) & 3, qt = b ? 63 - (u & 63) : (u & 63);
        const int t0 = qt * 128;
        const size_t row0 = (size_t)b * SEQ + t0;
        {
            const int row = c.tid >> 2, dc = (c.tid & 3) * 16;
            const u32x4* qp = (const u32x4*)(Y + (row0 + row) * NY + C_SBQ + hh * 64 + dc);
            *(LAS u32x4*)(c.lds + NS_Q + row * 144 + dc * 2) = qp[0]; *(LAS u32x4*)(c.lds + NS_Q + row * 144 + dc * 2 + 16) = qp[1];
            if (c.tid < 128) Cr[c.tid] = 0.f;
        }
        const TileSeq sq{Y + (size_t)b * SEQ * NY + C_SBK + hh * 64, Y + (size_t)b * SEQ * NY + C_SBV + hh * 64, (size_t)NY, 2 * qt + 1, -1, nullptr};
        const f32x16 acc = ns_loop<3, 1, true>(c, zero16(), t0, 2 * qt + 2, sq);
        {
            bf16_t* op = Op + (row0 + wm * 32 + r) * DM + hh * 64 + wn * 32 + 4 * h;
#pragma unroll
            for (int g = 0; g < 4; ++g) { u32x2 w; w.x = pk_bf16(acc[4 * g], acc[4 * g + 1]); w.y = pk_bf16(acc[4 * g + 2], acc[4 * g + 3]); *(u32x2*)(op + 8 * g) = w; }
        }
        __syncthreads();
    }
}

__device__ __forceinline__ unsigned ord_key(float s) { const unsigned u = __float_as_uint(s); return u ^ ((unsigned)((int)u >> 31) | 0x80000000u); }
__device__ __forceinline__ float unord_key(unsigned k) { const unsigned u = (k & 0x80000000u) ? (k ^ 0x80000000u) : ~k; return __uint_as_float(u); }
#define CE_DESC(a, b) do { const unsigned _hi = max((a), (b)), _lo = min((a), (b)); (a) = _hi; (b) = _lo; } while (0)
__device__ __forceinline__ void sort16_desc(unsigned (&k)[16]) {
#pragma unroll
    for (int size = 2; size <= 16; size <<= 1)
#pragma unroll
        for (int stride = size >> 1; stride > 0; stride >>= 1)
#pragma unroll
            for (int i = 0; i < 16; ++i) {
                const int j = i ^ stride;
                if (j > i) { if ((i & size) == 0) CE_DESC(k[i], k[j]); else CE_DESC(k[j], k[i]); }
            }
}
__device__ __forceinline__ void bitonic_merge16_desc(unsigned (&k)[16]) {
#pragma unroll
    for (int stride = 8; stride > 0; stride >>= 1)
#pragma unroll
        for (int i = 0; i < 16; ++i) { const int j = i ^ stride; if (j > i) CE_DESC(k[i], k[j]); }
}
__device__ __forceinline__ void top16_merge(unsigned (&a)[16], const unsigned (&b)[16]) {
#pragma unroll
    for (int i = 0; i < 16; ++i) a[i] = max(a[i], b[15 - i]);
    bitonic_merge16_desc(a);
}


constexpr int FA_KT = 0;
constexpr int FA_VT = 18432;
constexpr int FA_IMPH = 36864;
constexpr int FA_G = FA_IMPH + 4 * 32 * 132 * 4;
constexpr int FA_SEL = FA_G + 2048;
constexpr int FA_UM = FA_SEL + 512;
constexpr int FA_BLIST = FA_UM + 64;
constexpr int FA_FLAG = FA_BLIST + 512;
constexpr int FA_END = FA_FLAG + 64;
typedef float f32x4v __attribute__((ext_vector_type(4)));
typedef short bf16x4 __attribute__((ext_vector_type(4)));

__device__ __forceinline__ void fa_stK(const Ctx& c, int buf, u32x4 v) { *(LAS u32x4*)(c.lds + FA_KT + buf * 9216 + (c.tid >> 3) * 144 + (c.tid & 7) * 16) = v; }
__device__ __forceinline__ void fa_stVT(const Ctx& c, int buf, u32x4 v) {
    const int key = c.tid & 63, e0 = (c.tid >> 6) * 8;
    const unsigned vv[4] = {v.x, v.y, v.z, v.w};
#pragma unroll
    for (int e = 0; e < 4; ++e) {
        *(LAS bf16_t*)(c.lds + FA_VT + buf * 9216 + (e0 + 2 * e) * 144 + key * 2) = (bf16_t)(vv[e] & 0xffffu);
        *(LAS bf16_t*)(c.lds + FA_VT + buf * 9216 + (e0 + 2 * e + 1) * 144 + key * 2) = (bf16_t)(vv[e] >> 16);
    }
}
struct FaState { f32x4v o[4]; float m, l; float carry; };

template <int MODE, int PASS>
__device__ __forceinline__ bool fa_tile(const Ctx& c, FaState& st, const bf16x8 (&qf)[2], int buf, int k0, int t, int tok, float slope, int headl, int ct) {
    const int fr = c.lane & 15, fq = c.lane >> 4;
    const lptr KT = c.lds + FA_KT + buf * 9216, VT = c.lds + FA_VT + buf * 9216;
    f32x4v sc[4];
#pragma unroll
    for (int n = 0; n < 4; ++n) {
        sc[n] = (f32x4v){0.f, 0.f, 0.f, 0.f};
#pragma unroll
        for (int s = 0; s < 2; ++s) {
            const bf16x8 kf = *(LAS const bf16x8*)(KT + (16 * n + fr) * 144 + s * 64 + fq * 16);
            sc[n] = __builtin_amdgcn_mfma_f32_16x16x32_bf16(kf, qf[s], sc[n], 0, 0, 0);
        }
    }
    float p[4][4]; bool ok[4][4];
    bool stop = false;
    if (MODE == 3) {
        float L[4][4], sfx[4][4], T[4], R[4], H[4];
#pragma unroll
        for (int n = 0; n < 4; ++n) {
            float run = 0.f;
#pragma unroll
            for (int e = 3; e >= 0; --e) {
                const int pos = k0 + 16 * n + 4 * fq + e;
                p[n][e] = sc[n][e] * 0.125f;
                ok[n][e] = pos < t;
                L[n][e] = ok[n][e] ? -softplusf_(p[n][e]) : 0.f;
                run += L[n][e]; sfx[n][e] = run;
            }
            T[n] = run;
            const float a1 = __shfl(T[n], (c.lane + 16) & 63), a2 = __shfl(T[n], (c.lane + 32) & 63), a3 = __shfl(T[n], (c.lane + 48) & 63);
            H[n] = (fq < 3 ? a1 : 0.f) + (fq < 2 ? a2 : 0.f) + (fq < 1 ? a3 : 0.f);
            R[n] = T[n] + a1 + a2 + a3;
        }
        float above = st.carry;
#pragma unroll
        for (int n = 3; n >= 0; --n) {
#pragma unroll
            for (int e = 0; e < 4; ++e) p[n][e] = ok[n][e] ? __expf(p[n][e] + above + H[n] + sfx[n][e]) : 0.f;
            above += R[n];
        }
        st.carry = above;
        stop = __all(above < -104.0f);
    } else {
        float mloc = NEGF; float sv[4][4];
        bool rowsel = true;
        if (MODE == 1) { const int nb = k0 >> 6; rowsel = (((LAS const unsigned*)(c.lds + FA_SEL))[tok * 4 + (nb >> 5)] >> (nb & 31)) & 1u; }
#pragma unroll
        for (int n = 0; n < 4; ++n)
#pragma unroll
            for (int e = 0; e < 4; ++e) {
                const int kidx = k0 + 16 * n + 4 * fq + e; float dist; bool v;
                if (MODE == 0) { const int d = t - 16 * kidx - 31; dist = (float)d; v = d >= 0 && kidx < 511; }
                else if (MODE == 1) { const int d = t - kidx; dist = (float)d; v = rowsel && d >= 0; }
                else { const int d = t - kidx; dist = (float)d; v = d >= 0 && d < 512; }
                ok[n][e] = v; sv[n][e] = sc[n][e] * 0.125f - slope * dist;
                if (v) mloc = fmaxf(mloc, sv[n][e]);
            }
        mloc = fmaxf(mloc, __shfl_xor(mloc, 16)); mloc = fmaxf(mloc, __shfl_xor(mloc, 32));
        if (PASS == 2) {
            const float inv = st.l > 0.f ? 1.0f / st.l : 0.f;
#pragma unroll
            for (int n = 0; n < 4; ++n)
#pragma unroll
                for (int e = 0; e < 4; ++e) p[n][e] = ok[n][e] ? __expf(sv[n][e] - st.m) * inv : 0.f;
            float x[4];
#pragma unroll
            for (int n = 0; n < 4; ++n) x[n] = __shfl(p[n][3], (c.lane + 48) & 63);
            LAS float* imp = (LAS float*)(c.lds + FA_IMPH) + (headl * 32 + tok) * 132 + ct * 16 + fq;
#pragma unroll
            for (int n = 0; n < 4; ++n) {
                const float prev = fq > 0 ? x[n] : (n > 0 ? x[n > 0 ? n - 1 : 0] : st.carry);
                imp[4 * n] += (p[n][0] + p[n][1]) + (p[n][2] + p[n][3]) + prev;
            }
            st.carry = x[3];
        } else {
            const float mnew = fmaxf(st.m, mloc);
            float sum = 0.f;
#pragma unroll
            for (int n = 0; n < 4; ++n)
#pragma unroll
                for (int e = 0; e < 4; ++e) { p[n][e] = ok[n][e] ? __expf(sv[n][e] - mnew) : 0.f; sum += p[n][e]; }
            sum += __shfl_xor(sum, 16); sum += __shfl_xor(sum, 32);
            const float alpha = __expf(st.m - mnew);
            st.l = st.l * alpha + sum; st.m = mnew;
            if (PASS == 1) {
#pragma unroll
                for (int tt = 0; tt < 4; ++tt) st.o[tt] *= alpha;
            }
        }
    }
    if (MODE == 3 || PASS != 0) {
        bf16x8 pf[2];
#pragma unroll
        for (int s = 0; s < 2; ++s) {
            const unsigned w0 = pk_bf16(p[2 * s][0], p[2 * s][1]), w1 = pk_bf16(p[2 * s][2], p[2 * s][3]), w2 = pk_bf16(p[2 * s + 1][0], p[2 * s + 1][1]), w3 = pk_bf16(p[2 * s + 1][2], p[2 * s + 1][3]);
            u32x4 w; w.x = w0; w.y = w1; w.z = w2; w.w = w3;
            pf[s] = __builtin_bit_cast(bf16x8, w);
        }
#pragma unroll
        for (int tt = 0; tt < 4; ++tt)
#pragma unroll
            for (int s = 0; s < 2; ++s) {
                const u32x2 va = *(LAS const u32x2*)(VT + (16 * tt + fr) * 144 + (32 * s + 4 * fq) * 2);
                const u32x2 vb = *(LAS const u32x2*)(VT + (16 * tt + fr) * 144 + (32 * s + 16 + 4 * fq) * 2);
                u32x4 w; w.x = va.x; w.y = va.y; w.z = vb.x; w.w = vb.y;
                st.o[tt] = __builtin_amdgcn_mfma_f32_16x16x32_bf16(__builtin_bit_cast(bf16x8, w), pf[s], st.o[tt], 0, 0, 0);
            }
    }
    return stop;
}
template <int MODE, int PASS, bool HASV>
__device__ __forceinline__ void fa_loop(const Ctx& c, FaState& st, const bf16x8 (&qf)[2], int t, int tok, float slope, int headl, int ntiles, const TileSeq sq) {
    if (ntiles <= 0) return;
    LAS volatile unsigned* Flag = (LAS volatile unsigned*)(c.lds + FA_FLAG);
    int idx = seq_idx(sq, 0);
    {
        const u32x4 rk = ns_ldK(c, sq.kbase + (size_t)idx * 64 * sq.ld, sq.ld);
        fa_stK(c, 0, rk);
        if (HASV) { const u32x4 rv = ns_ldV(c, sq.vbase + (size_t)idx * 64 * sq.ld, sq.ld); fa_stVT(c, 0, rv); }
        if (MODE == 3 && c.tid < 3) Flag[c.tid] = 0u;
    }
    __syncthreads();
    for (int i = 0; i < ntiles; ++i) {
        const bool more = (i + 1 < ntiles);
        int nidx = idx; u32x4 rk, rv;
        if (more) {
            nidx = seq_idx(sq, i + 1);
            rk = ns_ldK(c, sq.kbase + (size_t)nidx * 64 * sq.ld, sq.ld);
            if (HASV) rv = ns_ldV(c, sq.vbase + (size_t)nidx * 64 * sq.ld, sq.ld);
        }
        const bool wstop = fa_tile<MODE, PASS>(c, st, qf, i & 1, idx * 64, t, tok, slope, headl, idx);
        if (MODE == 3) { if (!wstop && c.lane == 0) Flag[i % 3] = 1u; if (c.tid == 0) Flag[(i + 1) % 3] = 0u; }
        if (more) { fa_stK(c, (i + 1) & 1, rk); if (HASV) fa_stVT(c, (i + 1) & 1, rv); }
        __syncthreads();
        if (MODE == 3 && Flag[i % 3] == 0u) break;
        idx = nidx;
    }
    __syncthreads();
}
__device__ __forceinline__ void fa_reset(FaState& st) {
#pragma unroll
    for (int tt = 0; tt < 4; ++tt) st.o[tt] = (f32x4v){0.f, 0.f, 0.f, 0.f};
    st.m = NEGF; st.l = 0.f; st.carry = 0.f;
}

__device__ __forceinline__ void phase_nsa3(const Ctx& c, const bf16_t* Y, const bf16_t* KCp, const bf16_t* VCp, bf16_t* Op) {
    LAS float* Gt = (LAS float*)(c.lds + FA_G);
    LAS float* ImpH = (LAS float*)(c.lds + FA_IMPH);
    LAS unsigned* Sel = (LAS unsigned*)(c.lds + FA_SEL);
    LAS unsigned* Um = (LAS unsigned*)(c.lds + FA_UM);
    LAS int* Blist = (LAS int*)(c.lds + FA_BLIST);
    const int fr = c.lane & 15, fq = c.lane >> 4;
    const int headl = c.wave >> 1, tok = 16 * (c.wave & 1) + fr;
    const float slope = exp2f(-2.0f * (float)(headl + 1));
    for (int u = c.blk; u < 512; u += c.nblk) {
        const int b = u >> 8, tq = b ? 255 - (u & 255) : (u & 255);
        const int t0 = tq * 32, t = t0 + tok;
        const size_t row0 = (size_t)b * SEQ + t0;
        bf16x8 qf[2];
        {
            const bf16_t* qp = Y + (row0 + tok) * NY + C_NQ + headl * 64 + 8 * fq;
            qf[0] = *(const bf16x8*)(qp); qf[1] = *(const bf16x8*)(qp + 32);
            if (c.tid < 384) { const int rw = c.tid / 3, gi = c.tid % 3; Gt[rw * 4 + gi] = sigmoidf_(bf2f(Y[(row0 + (rw & 31)) * NY + C_NG + (rw >> 5) * 3 + gi])); }
            for (int i = c.tid; i < 4 * 32 * 132; i += NTHREADS) ImpH[i] = 0.f;
            if (c.tid < 4) Um[c.tid] = 0u;
        }
        __syncthreads();
        float out[4][4];
#pragma unroll
        for (int tt = 0; tt < 4; ++tt)
#pragma unroll
            for (int r = 0; r < 4; ++r) out[tt][r] = 0.f;
        FaState st;
        const int ncmp = min(t0 / 16 + 1, 511);
        const int nct = (ncmp + 63) / 64;
        {
            const TileSeq sq{KCp + (size_t)b * 512 * 64, VCp + (size_t)b * 512 * 64, 64, 0, 1, nullptr};
            fa_reset(st);
            fa_loop<0, 0, false>(c, st, qf, t, tok, slope, headl, nct, sq);
            st.carry = 0.f;
            fa_loop<0, 2, true>(c, st, qf, t, tok, slope, headl, nct, sq);
            const float g0 = Gt[(headl * 32 + tok) * 4 + 0];
#pragma unroll
            for (int tt = 0; tt < 4; ++tt)
#pragma unroll
                for (int r = 0; r < 4; ++r) out[tt][r] += g0 * st.o[tt][r];
        }
        if (c.wave == 0 && c.lane < 32) {
            const int stok = c.lane, cur = (t0 + stok) >> 6;
            unsigned best[16];
#pragma unroll
            for (int g = 0; g < 8; ++g) {
                unsigned k[16];
#pragma unroll
                for (int j4 = 0; j4 < 4; ++j4) {
                    f32x4 v = *(LAS const f32x4*)(ImpH + (0 * 32 + stok) * 132 + 16 * g + 4 * j4);
#pragma unroll
                    for (int hh = 1; hh < 4; ++hh) v += *(LAS const f32x4*)(ImpH + (hh * 32 + stok) * 132 + 16 * g + 4 * j4);
#pragma unroll
                    for (int e = 0; e < 4; ++e) {
                        const int n = 16 * g + 4 * j4 + e;
                        unsigned key = (ord_key(v[e]) & ~127u) | (unsigned)(127 - n);
                        if (n > cur) key = 0u;
                        if (n == cur) key = 0xFFFFFF80u | (unsigned)(127 - n);
                        k[4 * j4 + e] = key;
                    }
                }
                sort16_desc(k);
                if (g == 0) {
#pragma unroll
                    for (int i = 0; i < 16; ++i) best[i] = k[i];
                } else top16_merge(best, k);
            }
            unsigned m0 = 0u, m1 = 0u, m2 = 0u, m3 = 0u;
#pragma unroll
            for (int i = 0; i < 16; ++i) {
                if (best[i] != 0u) {
                    const unsigned n = 127u - (best[i] & 127u), bit = 1u << (n & 31u), wd = n >> 5;
                    m0 |= wd == 0u ? bit : 0u; m1 |= wd == 1u ? bit : 0u; m2 |= wd == 2u ? bit : 0u; m3 |= wd == 3u ? bit : 0u;
                }
            }
            Sel[stok * 4 + 0] = m0; Sel[stok * 4 + 1] = m1; Sel[stok * 4 + 2] = m2; Sel[stok * 4 + 3] = m3;
            atomicOr((unsigned*)&Um[0], m0); atomicOr((unsigned*)&Um[1], m1); atomicOr((unsigned*)&Um[2], m2); atomicOr((unsigned*)&Um[3], m3);
        }
        __syncthreads();
        int nsel_blocks;
        {
            const unsigned u0 = Um[0], u1 = Um[1], u2 = Um[2], u3 = Um[3];
            nsel_blocks = __popc(u0) + __popc(u1) + __popc(u2) + __popc(u3);
            if (c.tid < 128) {
                const unsigned wd = c.tid >> 5, bt = c.tid & 31;
                const unsigned mine = wd == 0 ? u0 : wd == 1 ? u1 : wd == 2 ? u2 : u3;
                if ((mine >> bt) & 1u) {
                    int pos = __popc(mine & ((1u << bt) - 1u));
                    if (wd > 0) pos += __popc(u0); if (wd > 1) pos += __popc(u1); if (wd > 2) pos += __popc(u2);
                    Blist[pos] = (int)c.tid;
                }
            }
        }
        __syncthreads();
        {
            const TileSeq sq{Y + (size_t)b * SEQ * NY + C_NKS, Y + (size_t)b * SEQ * NY + C_NVS, (size_t)NY, 0, 0, Blist};
            fa_reset(st);
            fa_loop<1, 1, true>(c, st, qf, t, tok, slope, headl, nsel_blocks, sq);
            const float g1 = Gt[(headl * 32 + tok) * 4 + 1] * (st.l > 0.f ? 1.0f / st.l : 0.f);
#pragma unroll
            for (int tt = 0; tt < 4; ++tt)
#pragma unroll
                for (int r = 0; r < 4; ++r) out[tt][r] += g1 * st.o[tt][r];
        }
        {
            const int kt1 = t0 >> 6, kt0 = max(0, kt1 - 8);
            const TileSeq sq{Y + (size_t)b * SEQ * NY + C_NKW, Y + (size_t)b * SEQ * NY + C_NVW, (size_t)NY, kt0, 1, nullptr};
            fa_reset(st);
            fa_loop<2, 1, true>(c, st, qf, t, tok, slope, headl, kt1 - kt0 + 1, sq);
            const float g2 = Gt[(headl * 32 + tok) * 4 + 2] * (st.l > 0.f ? 1.0f / st.l : 0.f);
#pragma unroll
            for (int tt = 0; tt < 4; ++tt)
#pragma unroll
                for (int r = 0; r < 4; ++r) out[tt][r] += g2 * st.o[tt][r];
        }
        {
            bf16_t* op = Op + (row0 + tok) * DM + 256 + headl * 64 + 4 * fq;
#pragma unroll
            for (int tt = 0; tt < 4; ++tt) { u32x2 w; w.x = pk_bf16(out[tt][0], out[tt][1]); w.y = pk_bf16(out[tt][2], out[tt][3]); *(u32x2*)(op + 16 * tt) = w; }
        }
        __syncthreads();
    }
}
__device__ __forceinline__ void phase_sb4(const Ctx& c, const bf16_t* Y, bf16_t* Op) {
    const int fr = c.lane & 15, fq = c.lane >> 4;
    for (int u = c.blk; u < 512; u += c.nblk) {
        const int b = u >> 8, hh = (u >> 6) & 3, qt = b ? 63 - (u & 63) : (u & 63);
        const int t0 = qt * 128, rowl = 16 * c.wave + fr, t = t0 + rowl;
        const size_t row0 = (size_t)b * SEQ + t0;
        bf16x8 qf[2];
        { const bf16_t* qp = Y + (row0 + rowl) * NY + C_SBQ + hh * 64 + 8 * fq; qf[0] = *(const bf16x8*)(qp); qf[1] = *(const bf16x8*)(qp + 32); }
        FaState st; fa_reset(st);
        const TileSeq sq{Y + (size_t)b * SEQ * NY + C_SBK + hh * 64, Y + (size_t)b * SEQ * NY + C_SBV + hh * 64, (size_t)NY, 2 * qt + 1, -1, nullptr};
        fa_loop<3, 1, true>(c, st, qf, t, 0, 0.f, 0, 2 * qt + 2, sq);
        {
            bf16_t* op = Op + (row0 + rowl) * DM + hh * 64 + 4 * fq;
#pragma unroll
            for (int tt = 0; tt < 4; ++tt) { u32x2 w; w.x = pk_bf16(st.o[tt][0], st.o[tt][1]); w.y = pk_bf16(st.o[tt][2], st.o[tt][3]); *(u32x2*)(op + 16 * tt) = w; }
        }
        __syncthreads();
    }
}

__device__ __forceinline__ void phase_subkey(const Ctx& c, const bf16_t* QV, const bf16_t* KEYS, float* TOPS, int* TOPI) {
    constexpr int SC_OFF = 73728;
    LAS float* Sc = (LAS float*)(c.lds + SC_OFF);
    const int wm = c.wave >> 1, wn = c.wave & 1, r = c.lane & 31, h = c.lane >> 5;
    for (int u = c.blk; u < 128 * 16; u += c.nblk) {
        const int hp = u & 15, pm = u >> 4;
        f32x16 acc[1][2]; acc_zero<1, 2>(acc);
        gemm_kloop<1, 2>(c, acc, QV + (size_t)pm * 128 * 2048 + hp * 128, 2048, KEYS + (size_t)hp * 128 * 128, 128, 128);
        EPI_LOOP(1, 2) {
            const int m = (wm + i) * 32 + r, n = (wn * 2 + j) * 32 + 8 * g + 4 * h;
            f32x4 o; o[0] = acc[i][j][4 * g]; o[1] = acc[i][j][4 * g + 1]; o[2] = acc[i][j][4 * g + 2]; o[3] = acc[i][j][4 * g + 3];
            *(LAS f32x4*)(Sc + m * 132 + n) = o;
        }
        __syncthreads();
        for (int rr = 0; rr < 16; ++rr) {
            const int row = c.wave * 16 + rr;
            float v0 = Sc[row * 132 + c.lane], v1 = Sc[row * 132 + 64 + c.lane];
            float ks = 0.f; int ki = 0;
            for (int it = 0; it < 16; ++it) {
                const float mx = wave_max(fmaxf(v0, v1));
                const unsigned long long b0 = __ballot(v0 == mx);
                int nsel;
                if (b0) { nsel = __ffsll((long long)b0) - 1; if (c.lane == nsel) v0 = -3e38f; }
                else { const unsigned long long b1 = __ballot(v1 == mx); const int l1 = __ffsll((long long)b1) - 1; nsel = 64 + l1; if (c.lane == l1) v1 = -3e38f; }
                if (c.lane == it) { ks = mx; ki = nsel; }
            }
            if (c.lane < 16) {
                const size_t o = ((size_t)(pm * 128 + row) * 16 + hp) * 16 + c.lane;
                TOPS[o] = ks; TOPI[o] = ki;
            }
        }
        __syncthreads();
    }
}


__device__ __forceinline__ void phase_subkey2(const Ctx& c, const bf16_t* QV, const bf16_t* KEYS, float* TOPS, int* TOPI) {
    const lptr Ab = c.lds, Bb = c.lds + 256 * 272;
    const int r = c.lane & 31, h = c.lane >> 5;
    int cur_hp = -1;
    for (int u = c.blk; u < 64 * 16; u += c.nblk) {
        const int hp = u & 15, pm = u >> 4;
        if (hp != cur_hp) {
            cur_hp = hp;
#pragma unroll
            for (int i = 0; i < 4; ++i) { const int id = c.tid + i * NTHREADS; *(LAS u32x4*)(Bb + (id >> 4) * 272 + (id & 15) * 16) = *(const u32x4*)(KEYS + (size_t)hp * 128 * 128 + (size_t)(id >> 4) * 128 + (id & 15) * 8); }
        }
#pragma unroll
        for (int i = 0; i < 8; ++i) { const int id = c.tid + i * NTHREADS; *(LAS u32x4*)(Ab + (id >> 4) * 272 + (id & 15) * 16) = *(const u32x4*)(QV + (size_t)(pm * 256 + (id >> 4)) * 2048 + hp * 128 + (id & 15) * 8); }
        __syncthreads();
        f32x16 acc[4];
#pragma unroll
        for (int j = 0; j < 4; ++j) acc[j] = zero16();
#pragma unroll
        for (int s = 0; s < 8; ++s) {
            const bf16x8 fa = *(LAS const bf16x8*)(Ab + (c.wave * 32 + r) * 272 + s * 32 + h * 16);
#pragma unroll
            for (int j = 0; j < 4; ++j) {
                const bf16x8 fb = *(LAS const bf16x8*)(Bb + (j * 32 + r) * 272 + s * 32 + h * 16);
                acc[j] = __builtin_amdgcn_mfma_f32_32x32x16_bf16(fb, fa, acc[j], 0, 0, 0);
            }
        }
        unsigned best[16];
#pragma unroll
        for (int j = 0; j < 4; ++j) {
            unsigned k[16];
#pragma unroll
            for (int g = 0; g < 4; ++g)
#pragma unroll
                for (int e = 0; e < 4; ++e) { const int n = j * 32 + 8 * g + 4 * h + e; k[4 * g + e] = (ord_key(acc[j][4 * g + e]) & ~127u) | (unsigned)(127 - n); }
            sort16_desc(k);
            if (j == 0) {
#pragma unroll
                for (int i = 0; i < 16; ++i) best[i] = k[i];
            } else top16_merge(best, k);
        }
        {
            unsigned other[16];
#pragma unroll
            for (int i = 0; i < 16; ++i) other[i] = (unsigned)__shfl_xor((int)best[i], 32);
            top16_merge(best, other);
        }
        {
            const size_t o = ((size_t)(pm * 256 + c.wave * 32 + r) * 16 + hp) * 16 + 8 * h;
            f32x4 s0, s1; int i0[4], i1[4];
#pragma unroll
            for (int i = 0; i < 4; ++i) {
                const unsigned ka = h ? best[8 + i] : best[i], kb = h ? best[12 + i] : best[4 + i];
                s0[i] = unord_key((ka & ~127u) | 64u); s1[i] = unord_key((kb & ~127u) | 64u);
                i0[i] = 127 - (int)(ka & 127u); i1[i] = 127 - (int)(kb & 127u);
            }
            *(f32x4*)(TOPS + o) = s0; *(f32x4*)(TOPS + o + 4) = s1;
            int4 w0 = make_int4(i0[0], i0[1], i0[2], i0[3]), w1 = make_int4(i1[0], i1[1], i1[2], i1[3]);
            *(int4*)(TOPI + o) = w0; *(int4*)(TOPI + o + 4) = w1;
        }
        __syncthreads();
    }
}

__device__ __forceinline__ float gelu_erf(float x) { return 0.5f * x * (1.0f + erff(x * 0.70710678118654752f)); }
__device__ __forceinline__ void phase_peer(const Ctx& c, const float* XF, const bf16_t* XB, const float* TOPS, const int* TOPI, const bf16_t* UB, const bf16_t* VB,
                                           const float* ln_g, const float* ln_b, float* outf, bf16_t* outb, bool store) {
    LAS int* eidx = (LAS int*)(c.lds + c.wave * 1024);
    LAS float* ewt = (LAS float*)(c.lds + c.wave * 1024 + 512);
    const int lane = c.lane;
    for (int tok = c.blk * 8 + c.wave; tok < NTOK; tok += c.nblk * 8) {
        for (int hh = 0; hh < 8; ++hh) {
            const float* ts = TOPS + ((size_t)tok * 16 + hh * 2) * 16; const int* ti = TOPI + ((size_t)tok * 16 + hh * 2) * 16;
            const int a = lane >> 2, bq = (lane & 3) * 4;
            const float sa = ts[a];
            const f32x4 sb = *(const f32x4*)(ts + 16 + bq);
            float v[4] = {sa + sb[0], sa + sb[1], sa + sb[2], sa + sb[3]};
            float ks = 0.f; int kf = 0;
            for (int it = 0; it < 16; ++it) {
                const float lm = fmaxf(fmaxf(v[0], v[1]), fmaxf(v[2], v[3]));
                const float mx = wave_max(lm);
                const unsigned long long bl = __ballot(lm == mx);
                const int wl = (__ffsll((long long)bl) - 1) & 63;
                int li = (v[0] == mx) ? 0 : (v[1] == mx) ? 1 : (v[2] == mx) ? 2 : 3;
                li = __builtin_amdgcn_readlane(li, wl);
                if (lane == wl) { if (li == 0) v[0] = -3e38f; else if (li == 1) v[1] = -3e38f; else if (li == 2) v[2] = -3e38f; else v[3] = -3e38f; }
                if (lane == it) { ks = mx; kf = wl * 4 + li; }
            }
            float mx16 = (lane < 16) ? ks : -3e38f;
            mx16 = wave_max(mx16);
            const float ex = (lane < 16) ? __expf(ks - mx16) : 0.f;
            const float den = wave_sum(ex);
            if (lane < 16) {
                const int ia = ti[kf >> 4], ib = ti[16 + (kf & 15)];
                eidx[hh * 16 + lane] = (ia * 128 + ib) & 16383;
                ewt[hh * 16 + lane] = ex / den;
            }
        }
        asm volatile("s_waitcnt lgkmcnt(0)" ::: "memory");
        unsigned xb[8];
        {
            const u32x4 x0 = *(const u32x4*)(XB + (size_t)tok * DM + lane * 8), x1 = *(const u32x4*)(XB + (size_t)tok * DM + 512 + lane * 8);
            xb[0] = x0.x; xb[1] = x0.y; xb[2] = x0.z; xb[3] = x0.w; xb[4] = x1.x; xb[5] = x1.y; xb[6] = x1.z; xb[7] = x1.w;
        }
        for (int e0 = 0; e0 < 128; e0 += 8) {
            u32x4 ua[8], ub2[8];
#pragma unroll
            for (int j = 0; j < 8; ++j) {
                const int ex = __builtin_amdgcn_readfirstlane(eidx[e0 + j]);
                const bf16_t* up = UB + (size_t)ex * DM;
                ua[j] = *(const u32x4*)(up + lane * 8); ub2[j] = *(const u32x4*)(up + 512 + lane * 8);
            }
            float p[8];
#pragma unroll
            for (int j = 0; j < 8; ++j) {
                float s0 = dot2bf(xb[0], ua[j].x, 0.f), s1 = dot2bf(xb[1], ua[j].y, 0.f);
                s0 = dot2bf(xb[2], ua[j].z, s0); s1 = dot2bf(xb[3], ua[j].w, s1);
                s0 = dot2bf(xb[4], ub2[j].x, s0); s1 = dot2bf(xb[5], ub2[j].y, s1);
                s0 = dot2bf(xb[6], ub2[j].z, s0); s1 = dot2bf(xb[7], ub2[j].w, s1);
                p[j] = s0 + s1;
            }
            const bool b5 = lane & 32, b4 = lane & 16, b3 = lane & 8;
            float q4[4], q2[2], q1;
#pragma unroll
            for (int j = 0; j < 4; ++j) { const float send = b5 ? p[j] : p[j + 4], keep = b5 ? p[j + 4] : p[j]; q4[j] = keep + __shfl_xor(send, 32); }
#pragma unroll
            for (int j = 0; j < 2; ++j) { const float send = b4 ? q4[j] : q4[j + 2], keep = b4 ? q4[j + 2] : q4[j]; q2[j] = keep + __shfl_xor(send, 16); }
            { const float send = b3 ? q2[0] : q2[1], keep = b3 ? q2[1] : q2[0]; q1 = keep + __shfl_xor(send, 8); }
            q1 += __shfl_xor(q1, 4); q1 += __shfl_xor(q1, 2); q1 += __shfl_xor(q1, 1);
            const int jx = (b5 ? 4 : 0) + (b4 ? 2 : 0) + (b3 ? 1 : 0);
            if ((lane & 7) == 0) ewt[e0 + jx] = ewt[e0 + jx] * gelu_erf(q1);
        }
        asm volatile("s_waitcnt lgkmcnt(0)" ::: "memory");
        float y[16];
#pragma unroll
        for (int i = 0; i < 16; ++i) y[i] = 0.f;
        for (int e0 = 0; e0 < 128; e0 += 8) {
            u32x4 va[8], vb2[8];
#pragma unroll
            for (int j = 0; j < 8; ++j) {
                const int ex = __builtin_amdgcn_readfirstlane(eidx[e0 + j]);
                const bf16_t* vp = VB + (size_t)ex * DM;
                va[j] = *(const u32x4*)(vp + lane * 8); vb2[j] = *(const u32x4*)(vp + 512 + lane * 8);
            }
#pragma unroll
            for (int j = 0; j < 8; ++j) {
                const float w = ewt[e0 + j];
                y[0] += w * bf_lo(va[j].x); y[1] += w * bf_hi(va[j].x); y[2] += w * bf_lo(va[j].y); y[3] += w * bf_hi(va[j].y);
                y[4] += w * bf_lo(va[j].z); y[5] += w * bf_hi(va[j].z); y[6] += w * bf_lo(va[j].w); y[7] += w * bf_hi(va[j].w);
                y[8] += w * bf_lo(vb2[j].x); y[9] += w * bf_hi(vb2[j].x); y[10] += w * bf_lo(vb2[j].y); y[11] += w * bf_hi(vb2[j].y);
                y[12] += w * bf_lo(vb2[j].z); y[13] += w * bf_hi(vb2[j].z); y[14] += w * bf_lo(vb2[j].w); y[15] += w * bf_hi(vb2[j].w);
            }
        }
        {
            const float* xr = XF + (size_t)tok * DM;
            const f32x4 a0 = *(const f32x4*)(xr + lane * 8), a1 = *(const f32x4*)(xr + lane * 8 + 4), a2 = *(const f32x4*)(xr + 512 + lane * 8), a3 = *(const f32x4*)(xr + 512 + lane * 8 + 4);
            const float xs[16] = {a0[0], a0[1], a0[2], a0[3], a1[0], a1[1], a1[2], a1[3], a2[0], a2[1], a2[2], a2[3], a3[0], a3[1], a3[2], a3[3]};
            float s = 0.f;
#pragma unroll
            for (int i = 0; i < 16; ++i) { y[i] = DN_ALPHA * xs[i] + y[i]; s += y[i]; }
            const float mean = wave_sum(s) * (1.0f / 1024.0f);
            float q = 0.f;
#pragma unroll
            for (int i = 0; i < 16; ++i) { const float d = y[i] - mean; q += d * d; }
            const float rstd = rsqrtf(wave_sum(q) * (1.0f / 1024.0f) + LN_EPS);
            float o[16];
#pragma unroll
            for (int i = 0; i < 16; ++i) { const int ch = (i < 8) ? lane * 8 + i : 512 + lane * 8 + (i - 8); o[i] = (y[i] - mean) * rstd * ln_g[ch] + ln_b[ch]; }
            if (store) {
            float* of = outf + (size_t)tok * DM;
            f32x4 w;
            w[0] = o[0]; w[1] = o[1]; w[2] = o[2]; w[3] = o[3]; *(f32x4*)(of + lane * 8) = w;
            w[0] = o[4]; w[1] = o[5]; w[2] = o[6]; w[3] = o[7]; *(f32x4*)(of + lane * 8 + 4) = w;
            w[0] = o[8]; w[1] = o[9]; w[2] = o[10]; w[3] = o[11]; *(f32x4*)(of + 512 + lane * 8) = w;
            w[0] = o[12]; w[1] = o[13]; w[2] = o[14]; w[3] = o[15]; *(f32x4*)(of + 512 + lane * 8 + 4) = w;
            if (outb) {
                u32x4 pb; pb.x = pk_bf16(o[0], o[1]); pb.y = pk_bf16(o[2], o[3]); pb.z = pk_bf16(o[4], o[5]); pb.w = pk_bf16(o[6], o[7]);
                *(u32x4*)(outb + (size_t)tok * DM + lane * 8) = pb;
                pb.x = pk_bf16(o[8], o[9]); pb.y = pk_bf16(o[10], o[11]); pb.z = pk_bf16(o[12], o[13]); pb.w = pk_bf16(o[14], o[15]);
                *(u32x4*)(outb + (size_t)tok * DM + 512 + lane * 8) = pb;
            }
            }
        }
        asm volatile("s_waitcnt lgkmcnt(0)" ::: "memory");
    }
}


__device__ __forceinline__ void phase_peer2(const Ctx& c, const float* XF, const bf16_t* XB, const float* TOPS, const int* TOPI, const unsigned char* U8, const unsigned char* V8,
                                            const float* SU, const float* SV, const float* ln_g, const float* ln_b, float* outf, bf16_t* outb, bool store) {
    LAS int* ent_e = (LAS int*)(c.lds + c.wave * 16384);
    LAS float* ent_g = (LAS float*)(c.lds + c.wave * 16384 + 4096);
    LAS float* ent_su = (LAS float*)(c.lds + c.wave * 16384 + 8192);
    LAS float* ent_sv = (LAS float*)(c.lds + c.wave * 16384 + 12288);
    const int lane = c.lane;
    for (int base = (c.blk * 8 + c.wave) * 8; base < NTOK; base += c.nblk * 64) {
        {
            const int ti_ = lane >> 3, hh = lane & 7, t = base + ti_;
            const float* ts = TOPS + ((size_t)t * 16 + hh * 2) * 16; const int* tix = TOPI + ((size_t)t * 16 + hh * 2) * 16;
            float s0[16], s1[16];
#pragma unroll
            for (int i = 0; i < 4; ++i) { const f32x4 a = *(const f32x4*)(ts + 4 * i), b = *(const f32x4*)(ts + 16 + 4 * i);
                s0[4 * i] = a[0]; s0[4 * i + 1] = a[1]; s0[4 * i + 2] = a[2]; s0[4 * i + 3] = a[3]; s1[4 * i] = b[0]; s1[4 * i + 1] = b[1]; s1[4 * i + 2] = b[2]; s1[4 * i + 3] = b[3]; }
            unsigned best[16];
#pragma unroll
            for (int g = 0; g < 4; ++g) {
                unsigned k[16];
#pragma unroll
                for (int j = 0; j < 16; ++j) {
                    constexpr int cnt[16] = {16, 8, 5, 4, 3, 2, 2, 2, 1, 1, 1, 1, 1, 1, 1, 1};
                    int idx = 16 * g + j, a = -1, b = 0;
#pragma unroll
                    for (int aa = 0; aa < 16; ++aa) { if (a < 0) { if (idx < cnt[aa]) { a = aa; b = idx; } else idx -= cnt[aa]; } }
                    if (a >= 0) k[j] = (ord_key(s0[a] + s1[b]) & ~255u) | (unsigned)(255 - (a * 16 + b)); else k[j] = 0u;
                }
                sort16_desc(k);
                if (g == 0) {
#pragma unroll
                    for (int i = 0; i < 16; ++i) best[i] = k[i];
                } else top16_merge(best, k);
            }
            float sc[16]; int ee[16]; float mx = -3e38f;
#pragma unroll
            for (int k = 0; k < 16; ++k) {
                const int f = 255 - (int)(best[k] & 255u), a = f >> 4, b = f & 15;
                sc[k] = ts[a] + ts[16 + b]; ee[k] = tix[a] * 128 + tix[16 + b];
                mx = fmaxf(mx, sc[k]);
            }
            float den = 0.f;
#pragma unroll
            for (int k = 0; k < 16; ++k) { sc[k] = __expf(sc[k] - mx); den += sc[k]; }
            const float rden = 1.0f / den;
#pragma unroll
            for (int k = 0; k < 16; ++k) {
                const int e = ee[k] & 16383, slot = ti_ * 128 + hh * 16 + k;
                ent_e[slot] = e; ent_g[slot] = sc[k] * rden; ent_su[slot] = SU[e]; ent_sv[slot] = SV[e];
            }
        }
        asm volatile("s_waitcnt lgkmcnt(0)" ::: "memory");
#pragma unroll 1
        for (int ti_ = 0; ti_ < 8; ++ti_) {
            const int tok = base + ti_;
            LAS const int* ee = ent_e + ti_ * 128; LAS float* eg = ent_g + ti_ * 128; LAS const float* esu = ent_su + ti_ * 128; LAS const float* esv = ent_sv + ti_ * 128;
            int xq[4]; float sx;
            {
                const u32x4 x0 = *(const u32x4*)(XB + (size_t)tok * DM + lane * 16), x1 = *(const u32x4*)(XB + (size_t)tok * DM + lane * 16 + 8);
                const unsigned xw[8] = {x0.x, x0.y, x0.z, x0.w, x1.x, x1.y, x1.z, x1.w};
                float xv[16]; float am = 0.f;
#pragma unroll
                for (int i = 0; i < 8; ++i) { xv[2 * i] = bf_lo(xw[i]); xv[2 * i + 1] = bf_hi(xw[i]); am = fmaxf(am, fmaxf(fabsf(xv[2 * i]), fabsf(xv[2 * i + 1]))); }
                am = wave_max(am);
                const float inv = am > 0.f ? 127.0f / am : 0.f; sx = am * (1.0f / 127.0f);
#pragma unroll
                for (int i = 0; i < 4; ++i) {
                    unsigned pk = 0u;
#pragma unroll
                    for (int e = 0; e < 4; ++e) { const int q = (int)__builtin_rintf(xv[4 * i + e] * inv); pk |= ((unsigned)q & 0xffu) << (8 * e); }
                    xq[i] = (int)pk;
                }
            }
#pragma unroll 1
            for (int e0 = 0; e0 < 128; e0 += 16) {
                u32x4 ur[16];
#pragma unroll
                for (int j = 0; j < 16; ++j) { const int ex = __builtin_amdgcn_readfirstlane(ee[e0 + j]); ur[j] = *(const u32x4*)(U8 + (size_t)ex * 1024 + lane * 16); }
                int p[16];
#pragma unroll
                for (int j = 0; j < 16; ++j) {
                    int a = __builtin_amdgcn_sdot4(xq[0], (int)ur[j].x, 0, false);
                    a = __builtin_amdgcn_sdot4(xq[1], (int)ur[j].y, a, false);
                    a = __builtin_amdgcn_sdot4(xq[2], (int)ur[j].z, a, false);
                    p[j] = __builtin_amdgcn_sdot4(xq[3], (int)ur[j].w, a, false);
                }
                const bool b5 = lane & 32, b4 = lane & 16, b3 = lane & 8, b2 = lane & 4;
                int q8[8], q4[4], q2[2], q1;
#pragma unroll
                for (int j = 0; j < 8; ++j) { const int send = b5 ? p[j] : p[j + 8], keep = b5 ? p[j + 8] : p[j]; q8[j] = keep + __shfl_xor(send, 32); }
#pragma unroll
                for (int j = 0; j < 4; ++j) { const int send = b4 ? q8[j] : q8[j + 4], keep = b4 ? q8[j + 4] : q8[j]; q4[j] = keep + __shfl_xor(send, 16); }
#pragma unroll
                for (int j = 0; j < 2; ++j) { const int send = b3 ? q4[j] : q4[j + 2], keep = b3 ? q4[j + 2] : q4[j]; q2[j] = keep + __shfl_xor(send, 8); }
                { const int send = b2 ? q2[0] : q2[1], keep = b2 ? q2[1] : q2[0]; q1 = keep + __shfl_xor(send, 4); }
                q1 += __shfl_xor(q1, 2); q1 += __shfl_xor(q1, 1);
                if ((lane & 3) == 0) {
                    const int jx = e0 + (lane >> 2);
                    const float dot = esu[jx] * sx * (float)q1;
                    eg[jx] = eg[jx] * gelu_erf(dot) * esv[jx];
                }
            }
            asm volatile("s_waitcnt lgkmcnt(0)" ::: "memory");
            float y[16]; float sw = 0.f;
#pragma unroll
            for (int i = 0; i < 16; ++i) y[i] = 0.f;
#pragma unroll 1
            for (int e0 = 0; e0 < 128; e0 += 16) {
                u32x4 vr[16];
#pragma unroll
                for (int j = 0; j < 16; ++j) { const int ex = __builtin_amdgcn_readfirstlane(ee[e0 + j]); vr[j] = *(const u32x4*)(V8 + (size_t)ex * 1024 + lane * 16); }
#pragma unroll
                for (int j = 0; j < 16; ++j) {
                    const float w = eg[e0 + j]; sw += w;
                    const unsigned vw[4] = {vr[j].x, vr[j].y, vr[j].z, vr[j].w};
#pragma unroll
                    for (int i = 0; i < 4; ++i) {
                        y[4 * i + 0] += w * (float)(vw[i] & 0xffu); y[4 * i + 1] += w * (float)((vw[i] >> 8) & 0xffu);
                        y[4 * i + 2] += w * (float)((vw[i] >> 16) & 0xffu); y[4 * i + 3] += w * (float)(vw[i] >> 24);
                    }
                }
            }
            {
                const float* xr = XF + (size_t)tok * DM + lane * 16;
                const f32x4 a0 = *(const f32x4*)(xr), a1 = *(const f32x4*)(xr + 4), a2 = *(const f32x4*)(xr + 8), a3 = *(const f32x4*)(xr + 12);
                const float xs[16] = {a0[0], a0[1], a0[2], a0[3], a1[0], a1[1], a1[2], a1[3], a2[0], a2[1], a2[2], a2[3], a3[0], a3[1], a3[2], a3[3]};
                float s = 0.f;
#pragma unroll
                for (int i = 0; i < 16; ++i) { y[i] = DN_ALPHA * xs[i] + (y[i] - 128.0f * sw); s += y[i]; }
                const float mean = wave_sum(s) * (1.0f / 1024.0f);
                float q = 0.f;
#pragma unroll
                for (int i = 0; i < 16; ++i) { const float d = y[i] - mean; q += d * d; }
                const float rstd = rsqrtf(wave_sum(q) * (1.0f / 1024.0f) + LN_EPS);
                float o[16];
#pragma unroll
                for (int i = 0; i < 4; ++i) {
                    const f32x4 gg = *(const f32x4*)(ln_g + lane * 16 + 4 * i), bb = *(const f32x4*)(ln_b + lane * 16 + 4 * i);
#pragma unroll
                    for (int e = 0; e < 4; ++e) o[4 * i + e] = (y[4 * i + e] - mean) * rstd * gg[e] + bb[e];
                }
                if (store) {
                    float* of = outf + (size_t)tok * DM + lane * 16;
#pragma unroll
                    for (int i = 0; i < 4; ++i) { f32x4 w; w[0] = o[4 * i]; w[1] = o[4 * i + 1]; w[2] = o[4 * i + 2]; w[3] = o[4 * i + 3]; *(f32x4*)(of + 4 * i) = w; }
                    if (outb) {
                        u32x4 pb; pb.x = pk_bf16(o[0], o[1]); pb.y = pk_bf16(o[2], o[3]); pb.z = pk_bf16(o[4], o[5]); pb.w = pk_bf16(o[6], o[7]);
                        *(u32x4*)(outb + (size_t)tok * DM + lane * 16) = pb;
                        pb.x = pk_bf16(o[8], o[9]); pb.y = pk_bf16(o[10], o[11]); pb.z = pk_bf16(o[12], o[13]); pb.w = pk_bf16(o[14], o[15]);
                        *(u32x4*)(outb + (size_t)tok * DM + lane * 16 + 8) = pb;
                    }
                }
            }
        }
        asm volatile("s_waitcnt lgkmcnt(0)" ::: "memory");
    }
}

template <int NT>
__device__ __forceinline__ void peer_row_quant(const bf16_t* XB, int tok, int lane, int (&xq)[4], float& sx) {
    const u32x4 x0 = *(const u32x4*)(XB + (size_t)tok * DM + lane * 16), x1 = *(const u32x4*)(XB + (size_t)tok * DM + lane * 16 + 8);
    const unsigned xw[8] = {x0.x, x0.y, x0.z, x0.w, x1.x, x1.y, x1.z, x1.w};
    float xv[16]; float am = 0.f;
#pragma unroll
    for (int i = 0; i < 8; ++i) { xv[2 * i] = bf_lo(xw[i]); xv[2 * i + 1] = bf_hi(xw[i]); am = fmaxf(am, fmaxf(fabsf(xv[2 * i]), fabsf(xv[2 * i + 1]))); }
    am = wave_max(am);
    const float inv = am > 0.f ? 127.0f / am : 0.f; sx = am * (1.0f / 127.0f);
#pragma unroll
    for (int i = 0; i < 4; ++i) {
        unsigned pk = 0u;
#pragma unroll
        for (int e = 0; e < 4; ++e) { const int q = (int)__builtin_rintf(xv[4 * i + e] * inv); pk |= ((unsigned)q & 0xffu) << (8 * e); }
        xq[i] = (int)pk;
    }
}
__device__ __forceinline__ void phase_peer3(const Ctx& c, const float* XF, const bf16_t* XB, const float* TOPS, const int* TOPI, const unsigned char* U8, const unsigned char* V8,
                                            const float* SU, const float* SV, const float* ln_g, const float* ln_b, float* outf, bf16_t* outb, bool store) {
    constexpr int NT = 4;
    const lptr wb = c.lds + c.wave * 16640;
    LAS int* a_e = (LAS int*)(wb);
    LAS float* a_g = (LAS float*)(wb + 2048);
    LAS float* a_su = (LAS float*)(wb + 4096);
    LAS float* a_sv = (LAS float*)(wb + 6144);
    LAS int* s_e = (LAS int*)(wb + 8192);
    LAS float* s_w = (LAS float*)(wb + 10240);
    LAS float* s_su = (LAS float*)(wb + 12288);
    LAS float* s_sv = (LAS float*)(wb + 14336);
    LAS int* offs = (LAS int*)(wb + 16384);
    const int lane = c.lane;
    for (int base = (c.blk * 8 + c.wave) * NT; base < NTOK; base += c.nblk * 8 * NT) {
        if (lane < 32) {
            const int ti_ = lane >> 3, hh = lane & 7, t = base + ti_;
            const float* ts = TOPS + ((size_t)t * 16 + hh * 2) * 16; const int* tix = TOPI + ((size_t)t * 16 + hh * 2) * 16;
            float s0[16], s1[16];
#pragma unroll
            for (int i = 0; i < 4; ++i) { const f32x4 a = *(const f32x4*)(ts + 4 * i), b = *(const f32x4*)(ts + 16 + 4 * i);
                s0[4 * i] = a[0]; s0[4 * i + 1] = a[1]; s0[4 * i + 2] = a[2]; s0[4 * i + 3] = a[3]; s1[4 * i] = b[0]; s1[4 * i + 1] = b[1]; s1[4 * i + 2] = b[2]; s1[4 * i + 3] = b[3]; }
            unsigned best[16];
#pragma unroll
            for (int g = 0; g < 4; ++g) {
                unsigned k[16];
#pragma unroll
                for (int j = 0; j < 16; ++j) {
                    constexpr int cnt[16] = {16, 8, 5, 4, 3, 2, 2, 2, 1, 1, 1, 1, 1, 1, 1, 1};
                    int idx = 16 * g + j, a = -1, b = 0;
#pragma unroll
                    for (int aa = 0; aa < 16; ++aa) { if (a < 0) { if (idx < cnt[aa]) { a = aa; b = idx; } else idx -= cnt[aa]; } }
                    if (a >= 0) k[j] = (ord_key(s0[a] + s1[b]) & ~255u) | (unsigned)(255 - (a * 16 + b)); else k[j] = 0u;
                }
                sort16_desc(k);
                if (g == 0) {
#pragma unroll
                    for (int i = 0; i < 16; ++i) best[i] = k[i];
                } else top16_merge(best, k);
            }
            float sc[16]; int ee[16]; float mx = -3e38f;
#pragma unroll
            for (int k = 0; k < 16; ++k) {
                const int f = 255 - (int)(best[k] & 255u), a = f >> 4, b = f & 15;
                sc[k] = ts[a] + ts[16 + b]; ee[k] = tix[a] * 128 + tix[16 + b];
                mx = fmaxf(mx, sc[k]);
            }
            float den = 0.f;
#pragma unroll
            for (int k = 0; k < 16; ++k) { sc[k] = __expf(sc[k] - mx); den += sc[k]; }
            const float rden = 1.0f / den;
#pragma unroll
            for (int k = 0; k < 16; ++k) {
                const int e = ee[k] & 16383, slot = ti_ * 128 + hh * 16 + k;
                a_e[slot] = e; a_g[slot] = sc[k] * rden; a_su[slot] = SU[e]; a_sv[slot] = SV[e];
            }
        }
        asm volatile("s_waitcnt lgkmcnt(0)" ::: "memory");
#pragma unroll
        for (int i = 0; i < NT; ++i) {
            const int e0 = a_e[i * 128 + lane], e1 = a_e[i * 128 + 64 + lane];
            const int r0 = e0 >> 11, r1 = e1 >> 11;
            const unsigned long long lt = (1ull << lane) - 1ull;
            int bs = 0, p0 = 0, p1 = 0;
#pragma unroll
            for (int rho = 0; rho < 8; ++rho) {
                const unsigned long long m0 = __ballot(r0 == rho), m1 = __ballot(r1 == rho);
                if (lane == 0) offs[i * 16 + rho] = bs;
                if (r0 == rho) p0 = bs + __popcll(m0 & lt);
                if (r1 == rho) p1 = bs + __popcll(m0) + __popcll(m1 & lt);
                bs += __popcll(m0) + __popcll(m1);
            }
            if (lane == 0) offs[i * 16 + 8] = bs;
            s_e[i * 128 + p0] = e0; s_w[i * 128 + p0] = a_g[i * 128 + lane]; s_su[i * 128 + p0] = a_su[i * 128 + lane]; s_sv[i * 128 + p0] = a_sv[i * 128 + lane];
            s_e[i * 128 + p1] = e1; s_w[i * 128 + p1] = a_g[i * 128 + 64 + lane]; s_su[i * 128 + p1] = a_su[i * 128 + 64 + lane]; s_sv[i * 128 + p1] = a_sv[i * 128 + 64 + lane];
        }
        asm volatile("s_waitcnt lgkmcnt(0)" ::: "memory");
        int xq[NT][4]; float sx[NT];
#pragma unroll
        for (int i = 0; i < NT; ++i) peer_row_quant<NT>(XB, base + i, lane, xq[i], sx[i]);
#pragma unroll 1
        for (int rho = 0; rho < 8; ++rho) {
#pragma unroll
            for (int i = 0; i < NT; ++i) {
                const int beg = __builtin_amdgcn_readfirstlane(offs[i * 16 + rho]), end = __builtin_amdgcn_readfirstlane(offs[i * 16 + rho + 1]);
#pragma unroll 1
                for (int e0 = beg; e0 < end; e0 += 8) {
                    u32x4 ur[8];
#pragma unroll
                    for (int j = 0; j < 8; ++j) { const int sl = min(e0 + j, end - 1); const int ex = __builtin_amdgcn_readfirstlane(s_e[i * 128 + sl]); ur[j] = *(const u32x4*)(U8 + (size_t)ex * 1024 + lane * 16); }
                    int p[8];
#pragma unroll
                    for (int j = 0; j < 8; ++j) {
                        int a = __builtin_amdgcn_sdot4(xq[i][0], (int)ur[j].x, 0, false);
                        a = __builtin_amdgcn_sdot4(xq[i][1], (int)ur[j].y, a, false);
                        a = __builtin_amdgcn_sdot4(xq[i][2], (int)ur[j].z, a, false);
                        p[j] = __builtin_amdgcn_sdot4(xq[i][3], (int)ur[j].w, a, false);
                    }
                    const bool b5 = lane & 32, b4 = lane & 16, b3 = lane & 8;
                    int q4[4], q2[2], q1;
#pragma unroll
                    for (int j = 0; j < 4; ++j) { const int send = b5 ? p[j] : p[j + 4], keep = b5 ? p[j + 4] : p[j]; q4[j] = keep + __shfl_xor(send, 32); }
#pragma unroll
                    for (int j = 0; j < 2; ++j) { const int send = b4 ? q4[j] : q4[j + 2], keep = b4 ? q4[j + 2] : q4[j]; q2[j] = keep + __shfl_xor(send, 16); }
                    { const int send = b3 ? q2[0] : q2[1], keep = b3 ? q2[1] : q2[0]; q1 = keep + __shfl_xor(send, 8); }
                    q1 += __shfl_xor(q1, 4); q1 += __shfl_xor(q1, 2); q1 += __shfl_xor(q1, 1);
                    const int sl = e0 + (lane >> 3);
                    if ((lane & 7) == 0 && sl < end) {
                        const float dot = s_su[i * 128 + sl] * sx[i] * (float)q1;
                        s_w[i * 128 + sl] = s_w[i * 128 + sl] * gelu_erf(dot) * s_sv[i * 128 + sl];
                    }
                }
            }
        }
        asm volatile("s_waitcnt lgkmcnt(0)" ::: "memory");
        float y[NT][16]; float sw[NT];
#pragma unroll
        for (int i = 0; i < NT; ++i) { sw[i] = 0.f;
#pragma unroll
            for (int e = 0; e < 16; ++e) y[i][e] = 0.f; }
#pragma unroll 1
        for (int rho = 0; rho < 8; ++rho) {
#pragma unroll
            for (int i = 0; i < NT; ++i) {
                const int beg = __builtin_amdgcn_readfirstlane(offs[i * 16 + rho]), end = __builtin_amdgcn_readfirstlane(offs[i * 16 + rho + 1]);
#pragma unroll 1
                for (int e0 = beg; e0 < end; e0 += 8) {
                    u32x4 vr[8];
#pragma unroll
                    for (int j = 0; j < 8; ++j) { const int sl = min(e0 + j, end - 1); const int ex = __builtin_amdgcn_readfirstlane(s_e[i * 128 + sl]); vr[j] = *(const u32x4*)(V8 + (size_t)ex * 1024 + lane * 16); }
#pragma unroll
                    for (int j = 0; j < 8; ++j) {
                        const float w = (e0 + j < end) ? s_w[i * 128 + min(e0 + j, end - 1)] : 0.f; sw[i] += w;
                        const unsigned vw[4] = {vr[j].x, vr[j].y, vr[j].z, vr[j].w};
#pragma unroll
                        for (int q = 0; q < 4; ++q) {
                            y[i][4 * q + 0] += w * (float)(vw[q] & 0xffu); y[i][4 * q + 1] += w * (float)((vw[q] >> 8) & 0xffu);
                            y[i][4 * q + 2] += w * (float)((vw[q] >> 16) & 0xffu); y[i][4 * q + 3] += w * (float)(vw[q] >> 24);
                        }
                    }
                }
            }
        }
#pragma unroll
        for (int i = 0; i < NT; ++i) {
            const int tok = base + i;
            const float* xr = XF + (size_t)tok * DM + lane * 16;
            const f32x4 a0 = *(const f32x4*)(xr), a1 = *(const f32x4*)(xr + 4), a2 = *(const f32x4*)(xr + 8), a3 = *(const f32x4*)(xr + 12);
            const float xs[16] = {a0[0], a0[1], a0[2], a0[3], a1[0], a1[1], a1[2], a1[3], a2[0], a2[1], a2[2], a2[3], a3[0], a3[1], a3[2], a3[3]};
            float yy[16]; float s = 0.f;
#pragma unroll
            for (int e = 0; e < 16; ++e) { yy[e] = DN_ALPHA * xs[e] + (y[i][e] - 128.0f * sw[i]); s += yy[e]; }
            const float mean = wave_sum(s) * (1.0f / 1024.0f);
            float q = 0.f;
#pragma unroll
            for (int e = 0; e < 16; ++e) { const float d = yy[e] - mean; q += d * d; }
            const float rstd = rsqrtf(wave_sum(q) * (1.0f / 1024.0f) + LN_EPS);
            float o[16];
#pragma unroll
            for (int g4 = 0; g4 < 4; ++g4) {
                const f32x4 gg = *(const f32x4*)(ln_g + lane * 16 + 4 * g4), bb = *(const f32x4*)(ln_b + lane * 16 + 4 * g4);
#pragma unroll
                for (int e = 0; e < 4; ++e) o[4 * g4 + e] = (yy[4 * g4 + e] - mean) * rstd * gg[e] + bb[e];
            }
            if (store) {
                float* of = outf + (size_t)tok * DM + lane * 16;
#pragma unroll
                for (int g4 = 0; g4 < 4; ++g4) { f32x4 w; w[0] = o[4 * g4]; w[1] = o[4 * g4 + 1]; w[2] = o[4 * g4 + 2]; w[3] = o[4 * g4 + 3]; *(f32x4*)(of + 4 * g4) = w; }
                if (outb) {
                    u32x4 pb; pb.x = pk_bf16(o[0], o[1]); pb.y = pk_bf16(o[2], o[3]); pb.z = pk_bf16(o[4], o[5]); pb.w = pk_bf16(o[6], o[7]);
                    *(u32x4*)(outb + (size_t)tok * DM + lane * 16) = pb;
                    pb.x = pk_bf16(o[8], o[9]); pb.y = pk_bf16(o[10], o[11]); pb.z = pk_bf16(o[12], o[13]); pb.w = pk_bf16(o[14], o[15]);
                    *(u32x4*)(outb + (size_t)tok * DM + lane * 16 + 8) = pb;
                }
            }
        }
        asm volatile("s_waitcnt lgkmcnt(0)" ::: "memory");
    }
}

__device__ __forceinline__ void quant_rows(const Ctx& c, const float* src, unsigned char* dst, float* scale, int R, int bias) {
    const int gw = c.blk * 8 + c.wave, nw = c.nblk * 8;
    for (int row0 = gw * 4; row0 < R; row0 += nw * 4) {
        f32x4 v[4][4]; float am[4];
#pragma unroll
        for (int rr = 0; rr < 4; ++rr) {
            const f32x4* p = (const f32x4*)(src + (size_t)(row0 + rr) * 1024 + c.lane * 16);
#pragma unroll
            for (int i = 0; i < 4; ++i) v[rr][i] = p[i];
        }
#pragma unroll
        for (int rr = 0; rr < 4; ++rr) {
            float a = 0.f;
#pragma unroll
            for (int i = 0; i < 4; ++i) a = fmaxf(a, fmaxf(fmaxf(fabsf(v[rr][i][0]), fabsf(v[rr][i][1])), fmaxf(fabsf(v[rr][i][2]), fabsf(v[rr][i][3]))));
            am[rr] = wave_max(a);
        }
#pragma unroll
        for (int rr = 0; rr < 4; ++rr) {
            const float inv = am[rr] > 0.f ? 127.0f / am[rr] : 0.f;
            unsigned w[4];
#pragma unroll
            for (int i = 0; i < 4; ++i) {
                unsigned pk = 0u;
#pragma unroll
                for (int e = 0; e < 4; ++e) { const int q = (int)__builtin_rintf(v[rr][i][e] * inv) + bias; pk |= ((unsigned)q & 0xffu) << (8 * e); }
                w[i] = pk;
            }
            u32x4 o; o.x = w[0]; o.y = w[1]; o.z = w[2]; o.w = w[3];
            *(u32x4*)(dst + (size_t)(row0 + rr) * 1024 + c.lane * 16) = o;
            if (c.lane == 0) scale[row0 + rr] = am[rr] > 0.f ? am[rr] * (1.0f / 127.0f) : 1.0f;
        }
    }
}

__device__ __forceinline__ void phase_prologue(const Ctx& c, const Args& a, float* SUp, float* SVp, bf16_t* WC, float* CB, bf16_t* WIN, bf16_t* WG, bf16_t* WB, bf16_t* WO, bf16_t* WQ, bf16_t* KEYS, bf16_t* UB, bf16_t* VB, float* HF, bf16_t* HB) {
#pragma unroll 1
    for (int l = 0; l < 2; ++l) {
        transpose_cvt(c, a.in[3] + (size_t)l * 1024 * W_IN_LD, W_IN_LD, 1024, 0, 3228, NY, 1, WIN + (size_t)l * NIN * 1024, 1024);
        transpose_cvt(c, a.in[3] + (size_t)l * 1024 * W_IN_LD, W_IN_LD, 1024, W_MG, 4096, 4096, 0, WIN + ((size_t)l * NIN + NY) * 1024, 1024);
#pragma unroll 1
        for (int nb = 0; nb < 4; ++nb)
            transpose_cvt(c, a.in[12] + (size_t)(l * 4 + nb) * 256 * 1024, 1024, 256, 0, 1024, 1024, 0, WB + (size_t)(l * 4 + nb) * 1024 * 256, 256);
        transpose_cvt(c, a.in[13] + (size_t)l * 1024 * 1024, 1024, 1024, 0, 1024, 1024, 0, WO + (size_t)l * 1024 * 1024, 1024);
        transpose_cvt(c, a.in[16] + (size_t)l * 1024 * 2048, 2048, 1024, 0, 2048, 2048, 0, WQ + (size_t)l * 2048 * 1024, 1024);
#pragma unroll 1
        for (int kv = 0; kv < 2; ++kv) {
            const float* w = a.in[5 + kv] + (size_t)l * 2048 * 64;
            transpose_cvt(c, w, 64, 1024, 0, 64, 64, 0, WC + (size_t)(l * 2 + kv) * 128 * 1024, 1024);
            transpose_cvt(c, w + 1024 * 64, 64, 1024, 0, 64, 64, 0, WC + (size_t)(l * 2 + kv) * 128 * 1024 + 64 * 1024, 1024);
        }
    }
    {
        const int gw = c.blk * 8 + c.wave;
        if (gw < 256) {
            const int d = gw & 63, kv = (gw >> 6) & 1, l = gw >> 7;
            const float* w = a.in[5 + kv] + (size_t)l * 2048 * 64; const float* pos = a.in[4] + (size_t)l * 2048;
            float sacc = 0.f;
            for (int k = c.lane; k < 2048; k += 64) sacc += pos[k] * w[(size_t)k * 64 + d];
            sacc = wave_sum(sacc);
            if (c.lane == 0) CB[gw] = sacc;
        }
    }
    convert_flat(c, a.in[17], KEYS, (size_t)2 * 16 * 128 * 128);
    quant_rows(c, a.in[18], (unsigned char*)UB, SUp, 2 * 16384, 0);
    quant_rows(c, a.in[19], (unsigned char*)VB, SVp, 2 * 16384, 128);
    ln_rows(c, a.in[0], a.in[1], a.in[2], HF, HB);
}

constexpr int PH_PER_LAYER = 10, N_PHASES = 1 + 2 * PH_PER_LAYER;

__global__ void __launch_bounds__(NTHREADS, 2) mk_fwd(Args a) {
    extern __shared__ __attribute__((aligned(16))) unsigned char lds_raw[];
    volatile LAS unsigned* st = (volatile LAS unsigned*)((lptr)lds_raw + LDS_BYTES - 16);
    if (threadIdx.x == 0) { st[0] = 0u; st[1] = 0u; st[2] = 0u; st[3] = 0u; }
    __syncthreads();
#if ONE_LAUNCH
    constexpr int lo = 0, hi = N_PHASES;
#else
    const int lo = a.ph_lo, hi = a.ph_hi;
#endif
    XcdBarrier bar; bar.bar = (unsigned*)(a.ws + WS_CTL); bar.x = 0; bar.st = st;
    if (hi - lo > 1) bar = xcd_barrier_post((unsigned*)(a.ws + WS_CTL), st);
#define IN(k) (lo <= (k) && (k) < hi)
#ifndef ONLY_PHASE
#define ONLY_PHASE -1
#endif
#define EN(j) (ONLY_PHASE < 0 || ONLY_PHASE == (j))
#define SEAM(k) do { if (IN(k) && IN((k) + 1)) xcd_barrier(bar); } while (0)
#define FRESH() Ctx c; c.lds = (lptr)lds_raw; c.tid = threadIdx.x; asm volatile("" : "+v"(c.tid)); c.lane = c.tid & 63; c.wave = __builtin_amdgcn_readfirstlane(c.tid >> 6); c.blk = blockIdx.x; c.nblk = gridDim.x; \
    unsigned char* ws = a.ws + (unsigned)__builtin_amdgcn_readfirstlane((int)st[2]); c.ws = ws

#define HF ((float*)(ws + WS_HF))
#define HB ((bf16_t*)(ws + WS_HB))
#define Y ((bf16_t*)(ws + WS_Y))
#define Z ((float*)(ws + WS_Z))
#define TOPS ((float*)(ws + WS_TOPS))
#define TOPI ((int*)(ws + WS_TOPI))
#define O ((bf16_t*)(ws + WS_O))
#define MIX ((bf16_t*)(ws + WS_MIX))
#define QV ((bf16_t*)(ws + WS_QV))
#define UST ((float*)(ws + WS_UST))
#define RST ((float*)(ws + WS_RST))
#define UGLA ((float*)(ws + WS_UGLA))
#define SGLA ((float*)(ws + WS_SGLA))
#define BL ((float*)(ws + WS_BL))
#define KC ((bf16_t*)(ws + WS_KC))
#define VC ((bf16_t*)(ws + WS_VC))
#define WIN ((bf16_t*)(ws + WS_WIN))
#define WG ((bf16_t*)(ws + WS_WG))
#define WB ((bf16_t*)(ws + WS_WB))
#define WO ((bf16_t*)(ws + WS_WO))
#define WQ ((bf16_t*)(ws + WS_WQ))
#define KEYS ((bf16_t*)(ws + WS_KEYS))
#define UB ((bf16_t*)(ws + WS_UB))
#define VB ((bf16_t*)(ws + WS_VB))
#ifndef REP_MASK
#define REP_MASK 0
#endif
#define NREP(j) (((REP_MASK >> (j)) & 1) ? 2 : 1)
#define RUN(j, k, body) do { if (IN(k) && EN(j)) { if (NREP(j) == 2) { constexpr int rr = 0; FRESH(); body; } if (NREP(j) == 2) xcd_barrier(bar); { constexpr int rr = NREP(j) - 1; FRESH(); body; } } } while (0)
    RUN(10, 0, phase_prologue(c, a, (float*)(ws + WS_SU), (float*)(ws + WS_SV), (bf16_t*)(ws + WS_WC), (float*)(ws + WS_CB), WIN, WG, WB, WO, WQ, KEYS, UB, VB, HF, HB));
    SEAM(0);
#ifdef PROBE_BARS
    for (int bq = 0; bq < PROBE_BARS; ++bq) xcd_barrier(bar);
#endif
#ifndef SUB1
#define SUB1 15
#endif
#ifndef SUB
#define SUB 7
#endif
#ifndef PROBE3
#define PROBE3 0
#endif
#define LAYER(l, pb) \
        RUN(0, pb + 0, phase_inproj_gates_pg8(c, HB, WIN + (size_t)l * NIN * 1024, Y, (unsigned char*)(ws + WS_G))); \
        SEAM(pb + 0); \
        RUN(1, pb + 1, { \
            if (SUB1 & 1) phase_sb4(c, Y, O); \
            if (SUB1 & 2) phase_compress2(c, Y, (const bf16_t*)(ws + WS_WC) + (size_t)l * 2 * 128 * 1024, (float*)(ws + WS_RC)); \
            if (SUB1 & 4) phase_ret_local(c, Y, UST); \
            if (SUB1 & 8) phase_gla_local(c, Y, a.in[9] + (size_t)l * 16 * 128, a.in[10] + (size_t)l * 128, UGLA, BL); \
        }); \
        SEAM(pb + 1); \
        RUN(2, pb + 2, { phase_scans(c, UST, RST, UGLA, SGLA, BL); phase_compress_combine(c, (const float*)(ws + WS_RC), (const float*)(ws + WS_CB) + l * 128, KC, VC); }); \
        SEAM(pb + 2); \
        RUN(3, pb + 3, { \
            if (SUB & 1) phase_nsa3(c, Y, KC, VC, O); \
            if (PROBE3 & 1) phase_nsa3(c, Y, KC, VC, O); \
            if (SUB & 2) phase_ret_out(c, Y, RST, a.in[7] + (size_t)l * 256, a.in[8] + (size_t)l * 256, O); \
            if (PROBE3 & 2) phase_ret_out(c, Y, RST, a.in[7] + (size_t)l * 256, a.in[8] + (size_t)l * 256, O); \
            if (SUB & 4) phase_gla_out(c, Y, a.in[9] + (size_t)l * 16 * 128, a.in[10] + (size_t)l * 128, SGLA, a.in[11] + (size_t)l * 256, O); \
            if (PROBE3 & 4) phase_gla_out(c, Y, a.in[9] + (size_t)l * 16 * 128, a.in[10] + (size_t)l * 128, SGLA, a.in[11] + (size_t)l * 256, O); \
        }); \
        SEAM(pb + 3); \
        RUN(4, pb + 4, phase_merge2(c, (const unsigned char*)(ws + WS_G), O, WB + (size_t)l * 4 * 1024 * 256, MIX)); \
        SEAM(pb + 4); \
        RUN(5, pb + 5, phase_outproj_pg8(c, MIX, WO + (size_t)l * 1024 * 1024, HF, Z)); \
        SEAM(pb + 5); \
        RUN(6, pb + 6, ln_rows(c, Z, a.in[14] + (size_t)l * 1024, a.in[15] + (size_t)l * 1024, HF, HB)); \
        SEAM(pb + 6); \
        RUN(7, pb + 7, phase_wq_pg8(c, HB, WQ + (size_t)l * 2048 * 1024, QV)); \
        SEAM(pb + 7); \
        RUN(8, pb + 8, phase_subkey2(c, QV, KEYS + (size_t)l * 16 * 128 * 128, TOPS, TOPI)); \
        SEAM(pb + 8); \
        RUN(9, pb + 9, phase_peer3(c, HF, HB, TOPS, TOPI, (const unsigned char*)UB + (size_t)(l ^ (rr == NREP(9) - 1 ? 0 : 1)) * 16384 * 1024, (const unsigned char*)VB + (size_t)(l ^ (rr == NREP(9) - 1 ? 0 : 1)) * 16384 * 1024, \
                                   (const float*)(ws + WS_SU) + (size_t)l * 16384, (const float*)(ws + WS_SV) + (size_t)l * 16384, \
                                   a.in[20] + (size_t)l * 1024, a.in[21] + (size_t)l * 1024, (l == 1) ? a.out : HF, (l == 1) ? (bf16_t*)nullptr : HB, \
                                   (rr == NREP(9) - 1) || (lo > 1000))); \
        SEAM(pb + 9);
    LAYER(0, 1)
    LAYER(1, 1 + PH_PER_LAYER)
#undef LAYER
#undef RUN
#undef HF
#undef HB
#undef Y
#undef Z
#undef TOPS
#undef TOPI
#undef O
#undef MIX
#undef QV
#undef UST
#undef RST
#undef UGLA
#undef SGLA
#undef BL
#undef KC
#undef VC
#undef WIN
#undef WG
#undef WB
#undef WO
#undef WQ
#undef KEYS
#undef UB
#undef VB
#undef IN
#undef SEAM
#undef FRESH
}


#ifndef DBG_DUMP
#define DBG_DUMP 0
#endif
#ifndef DBG_C0
#define DBG_C0 0
#endif
#ifndef DBG_C1
#define DBG_C1 1024
#endif
__global__ void dbg_dump(const unsigned char* ws, float* out, int sel) {
    const size_t n = (size_t)NTOK * DM;
    for (size_t i = (size_t)blockIdx.x * blockDim.x + threadIdx.x; i < n; i += (size_t)gridDim.x * blockDim.x) {
        const int col = (int)(i & 1023);
        float v = 0.f;
        if (col >= DBG_C0 && col < DBG_C1) {
            if (sel == 1) v = bf2f(((const bf16_t*)(ws + WS_O))[i]);
            else if (sel == 2) v = ((const float*)(ws + WS_HF))[i];
            else if (sel == 3) v = bf2f(((const bf16_t*)(ws + WS_Y))[(i >> 10) * NY + col]);
            else if (sel == 4) v = bf2f(((const bf16_t*)(ws + WS_Y))[(i >> 10) * NY + 1024 + col]);
            else if (sel == 5) v = bf2f(((const bf16_t*)(ws + WS_Y))[(i >> 10) * NY + 2048 + col]);
            else if (sel == 6) v = bf2f(((const bf16_t*)(ws + WS_MIX))[i]);
            else if (sel == 7) v = ((const float*)(ws + WS_Z))[i];
        }
        out[i] = v;
    }
}

extern "C" void kernel_launch(void* const* d_in, const int* in_sizes, int n_in, void* d_out, int out_size, void* d_ws, size_t ws_size, hipStream_t stream) {
    static int grid = 0;
    if (grid == 0) {
        if (n_in != 22 || out_size != NTOK * DM || ws_size < WS_END) { fprintf(stderr, "kernel_launch: unexpected shapes (n_in %d out %d ws %zu need %zu)\n", n_in, out_size, ws_size, (size_t)WS_END); grid = -1; return; }
        int dev = 0, cus = 0, per_cu = 0;
        if (hipGetDevice(&dev) != hipSuccess || hipDeviceGetAttribute(&cus, hipDeviceAttributeMultiprocessorCount, dev) != hipSuccess) { grid = -1; return; }
        if (hipFuncSetAttribute((const void*)mk_fwd, hipFuncAttributeMaxDynamicSharedMemorySize, LDS_BYTES) != hipSuccess) { fprintf(stderr, "kernel_launch: hipFuncSetAttribute failed\n"); grid = -1; return; }
        if (hipOccupancyMaxActiveBlocksPerMultiprocessor(&per_cu, (const void*)mk_fwd, NTHREADS, LDS_BYTES) != hipSuccess || per_cu < 1) { fprintf(stderr, "kernel_launch: occupancy query says %d\n", per_cu); }
        (void)hipGetLastError();
        grid = cus;
    }
    if (grid < 0) return;
    (void)hipMemsetAsync((char*)d_ws + WS_CTL, 0, XCD_BAR_WORDS * sizeof(unsigned), stream);
    Args a{};
    for (int i = 0; i < 22; ++i) a.in[i] = (const float*)d_in[i];
    a.out = (float*)d_out; a.ws = (unsigned char*)d_ws;
#if ONE_LAUNCH
    a.ph_lo = 0; a.ph_hi = N_PHASES;
    hipLaunchKernelGGL(mk_fwd, dim3(grid), dim3(NTHREADS), LDS_BYTES, stream, a);
#else
#ifndef DBG_PH_HI
#define DBG_PH_HI N_PHASES
#endif
#ifndef DBG_PH_LO
#define DBG_PH_LO 0
#endif
    for (int p = DBG_PH_LO; p < DBG_PH_HI; ++p) {
        a.ph_lo = p; a.ph_hi = p + 1;
        hipLaunchKernelGGL(mk_fwd, dim3(grid), dim3(NTHREADS), LDS_BYTES, stream, a);
    }
    if (DBG_DUMP) hipLaunchKernelGGL(dbg_dump, dim3(1024), dim3(256), 0, stream, (const unsigned char*)d_ws, (float*)d_out, (int)DBG_DUMP);
#endif
}
```
